# Optimizing an MI355X kernel written in HIP

```python
import jax
import jax.numpy as jnp
from jax import lax
import numpy as np

D_MODEL = 1024
BATCH = 4
SEQ = 8192
DEPTH = 1
DEC_BATCH = 32
DEC_SEQ = 8
PAST_LEN = 16384
PAGE_SIZE = 128

D_CONV = D_MODEL // 2
CONV_K = 31
N_HEADS = 8
N_KV_HEADS = 2
HEAD_DIM = 64
GROUP = N_HEADS // N_KV_HEADS
Q_W = N_HEADS * HEAD_DIM
KV_W = N_KV_HEADS * HEAD_DIM
BLOCK = 64
N_SEL = 16
WINDOW = 512
ROPE_THETA = 10000.0
D_FF = ((8 * D_MODEL + 3 * 256 - 1) // (3 * 256)) * 256
Q_BLOCK = 128
EPS = 1e-6
FORCED_BONUS = 2.0 * GROUP
OFF_Q = 2 * D_CONV
OFF_KV = OFF_Q + Q_W
OFF_NG = OFF_KV + 6 * KV_W
OFF_MG = OFF_NG + 3 * N_HEADS
D_IN = OFF_MG + 2 * D_MODEL

kernel_name = 'hybrid_conformer_nsa_adaln_decoder_step'


def rms_norm(x, g):
    xf = x.astype(jnp.float32)
    y = xf * lax.rsqrt(jnp.mean(xf * xf, axis=-1, keepdims=True) + EPS)
    return (y * g.astype(jnp.float32)).astype(x.dtype)


def layer_norm(x, g, b):
    xf = x.astype(jnp.float32)
    mu = jnp.mean(xf, axis=-1, keepdims=True)
    var = jnp.mean(jnp.square(xf - mu), axis=-1, keepdims=True)
    y = (xf - mu) * lax.rsqrt(var + EPS)
    return (y * g.astype(jnp.float32) + b.astype(jnp.float32)).astype(x.dtype)


def rope(x, pos):
    half = HEAD_DIM // 2
    inv = jnp.power(ROPE_THETA, -jnp.arange(half, dtype=jnp.float32) / half)
    ang = pos.astype(jnp.float32)[:, None] * inv[None, :]
    cos = jnp.cos(ang)[None, :, None, :]
    sin = jnp.sin(ang)[None, :, None, :]
    xf = x.astype(jnp.float32)
    x1, x2 = xf[..., :half], xf[..., half:]
    return jnp.concatenate([x1 * cos - x2 * sin, x2 * cos + x1 * sin], axis=-1).astype(x.dtype)


def masked_softmax(s, mask):
    s = jnp.where(mask, s, -jnp.inf)
    m = jnp.max(s, axis=-1, keepdims=True)
    m = jnp.where(jnp.isfinite(m), m, 0.0)
    e = jnp.where(mask, jnp.exp(s - m), 0.0)
    return e / jnp.maximum(jnp.sum(e, axis=-1, keepdims=True), 1e-30)


def compress(rows, pos_mod, w):
    B, L, H, D = rows.shape
    blocks = rows.reshape(B, L // BLOCK, BLOCK, H, D)
    summ = jnp.mean((blocks * (1.0 + pos_mod)[None, None, :, None, :]).astype(jnp.float32), axis=2)
    return jnp.einsum('bnhd,de->bnhe', summ.astype(rows.dtype), w)


def front(x, c, pos, p):
    B, T, _ = x.shape
    mod = jax.nn.silu(c) @ p['w_ada'] + p['b_ada']
    sh1, sc1, g1, sh2, sc2, g2 = jnp.split(mod[:, None, :], 6, axis=-1)
    h = rms_norm(x, p['mix_norm_g']) * (1.0 + sc1) + sh1
    z = h @ p['w_in']
    glu, q, kv, ng, mg = jnp.split(z, [OFF_Q, OFF_KV, OFF_NG, OFF_MG], axis=-1)
    glu_a, glu_b = jnp.split(glu, 2, axis=-1)
    u = glu_a * jax.nn.sigmoid(glu_b)
    q = rms_norm(q.reshape(B, T, N_HEADS, HEAD_DIM), p['q_norm_g'])
    q_plain = q.reshape(B, T, N_KV_HEADS, GROUP, HEAD_DIM)
    q_rope = rope(q, pos).reshape(B, T, N_KV_HEADS, GROUP, HEAD_DIM)
    kv = kv.reshape(B, T, 6, N_KV_HEADS, HEAD_DIM)
    kng = p['k_norm_g']
    g_conv, g_nsa = jnp.split(jax.nn.sigmoid(mg), 2, axis=-1)
    return dict(
        g1=g1, sh2=sh2, sc2=sc2, g2=g2, u=u, q_plain=q_plain, q_rope=q_rope,
        k_cmp=rms_norm(kv[:, :, 0], kng[0]), v_cmp=kv[:, :, 1],
        k_sel=rope(rms_norm(kv[:, :, 2], kng[1]), pos), v_sel=kv[:, :, 3],
        k_win=rope(rms_norm(kv[:, :, 4], kng[2]), pos), v_win=kv[:, :, 5],
        branch_g=jax.nn.sigmoid(ng).reshape(B, T, N_KV_HEADS, GROUP, 3),
        g_conv=g_conv, g_nsa=g_nsa)


def conv_branch(u, u_prev, p):
    ext = jnp.concatenate([u_prev.astype(u.dtype), u], axis=1)
    y = lax.conv_general_dilated(ext, p['w_dw'][:, None, :].astype(u.dtype), window_strides=(1,),
                                 padding='VALID', dimension_numbers=('NWC', 'WIO', 'NWC'),
                                 feature_group_count=D_CONV) + p['b_dw']
    y = jax.nn.silu(layer_norm(y, p['conv_ln_g'], p['conv_ln_b']))
    return y @ p['w_pw2'], ext[:, -(CONV_K - 1):]


def nsa_attend(q_plain, q_rope, qpos, kc, vc, k_pool, v_pool, block_table, kw, vw, kwpos, branch_g):
    B, Q = q_plain.shape[:2]
    NB = kc.shape[1]
    scale = HEAD_DIM ** -0.5
    blk = jnp.arange(NB, dtype=jnp.int32)
    cur = qpos // BLOCK
    s_cmp = jnp.einsum('bqhgd,bnhd->bqhgn', q_plain, kc).astype(jnp.float32) * scale
    cmp_ok = (blk[None, :] + 1) * BLOCK <= qpos[:, None] + 1
    p_cmp = masked_softmax(s_cmp, cmp_ok[None, :, None, None, :])
    o_cmp = jnp.einsum('bqhgn,bnhd->bqhgd', p_cmp.astype(vc.dtype), vc)
    imp = jnp.sum(p_cmp, axis=3)
    visible = blk[None, :] <= cur[:, None]
    forced = (blk[None, :] == 0) | (blk[None, :] == cur[:, None]) | (blk[None, :] == cur[:, None] - 1)
    bonus = jnp.where(forced, FORCED_BONUS, 0.0)
    score = jnp.where(visible[None, :, None, :], imp + bonus[None, :, None, :], -1.0)
    _, idx = lax.top_k(score, min(N_SEL, NB))
    n_top = idx.shape[-1]
    phys = jax.vmap(lambda bt, i: bt[i])(block_table, idx)
    hidx = jnp.arange(N_KV_HEADS)[None, None, :, None]
    kg = k_pool[phys, :, hidx]
    vg = v_pool[phys, :, hidx]
    kpos = idx[..., None] * BLOCK + jnp.arange(BLOCK, dtype=jnp.int32)
    sel_ok = (kpos <= qpos[None, :, None, None, None]).reshape(B, Q, N_KV_HEADS, 1, n_top * BLOCK)
    s_sel = jnp.einsum('bqhgd,bqhnkd->bqhgnk', q_rope, kg).astype(jnp.float32)
    s_sel = s_sel.reshape(B, Q, N_KV_HEADS, GROUP, n_top * BLOCK) * scale
    p_sel = masked_softmax(s_sel, sel_ok)
    o_sel = jnp.einsum('bqhgm,bqhmd->bqhgd', p_sel.astype(vg.dtype),
                       vg.reshape(B, Q, N_KV_HEADS, n_top * BLOCK, HEAD_DIM))
    s_win = jnp.einsum('bqhgd,blhd->bqhgl', q_rope, kw).astype(jnp.float32) * scale
    win_ok = ((kwpos[None, :] <= qpos[:, None]) & (kwpos[None, :] > qpos[:, None] - WINDOW)
              & (kwpos[None, :] >= 0))
    p_win = masked_softmax(s_win, win_ok[None, :, None, None, :])
    o_win = jnp.einsum('bqhgl,blhd->bqhgd', p_win.astype(vw.dtype), vw)
    g = branch_g
    return g[..., 0:1] * o_cmp + g[..., 1:2] * o_sel + g[..., 2:3] * o_win


def back(x, f, u_out, o, p):
    B, T = x.shape[:2]
    nsa = o.reshape(B, T, Q_W) @ p['w_nsa_o']
    mix = (f['g_conv'] * u_out + f['g_nsa'] * nsa) @ p['w_out']
    x = x + f['g1'] * mix
    h = rms_norm(x, p['ffn_norm_g']) * (1.0 + f['sc2']) + f['sh2']
    ffn = (jax.nn.silu(h @ p['w_gate']) * (h @ p['w_up'])) @ p['w_down']
    return x + f['g2'] * ffn


def prompt_layer(x, c, p):
    B, T, _ = x.shape
    pos = jnp.arange(T, dtype=jnp.int32)
    f = front(x, c, pos, p)
    u_out, conv_state = conv_branch(f['u'], jnp.zeros((B, CONV_K - 1, D_CONV), x.dtype), p)
    kc = compress(f['k_cmp'], p['cmp_mod_k'], p['cmp_w_k'])
    vc = compress(f['v_cmp'], p['cmp_mod_v'], p['cmp_w_v'])
    nb = T // BLOCK
    k_pool = f['k_sel'].reshape(B * nb, BLOCK, N_KV_HEADS, HEAD_DIM)
    v_pool = f['v_sel'].reshape(B * nb, BLOCK, N_KV_HEADS, HEAD_DIM)
    block_table = jnp.arange(B * nb, dtype=jnp.int32).reshape(B, nb)
    pad = ((0, 0), (WINDOW, 0), (0, 0), (0, 0))
    kw_pad = jnp.pad(f['k_win'], pad)
    vw_pad = jnp.pad(f['v_win'], pad)

    def one_block(i):
        s0 = i * Q_BLOCK
        qpos = s0 + jnp.arange(Q_BLOCK, dtype=jnp.int32)
        sl = lambda a: lax.dynamic_slice_in_dim(a, s0, Q_BLOCK, axis=1)
        kw = lax.dynamic_slice_in_dim(kw_pad, s0, WINDOW + Q_BLOCK, axis=1)
        vw = lax.dynamic_slice_in_dim(vw_pad, s0, WINDOW + Q_BLOCK, axis=1)
        kwpos = s0 - WINDOW + jnp.arange(WINDOW + Q_BLOCK, dtype=jnp.int32)
        return nsa_attend(sl(f['q_plain']), sl(f['q_rope']), qpos, kc, vc, k_pool, v_pool,
                          block_table, kw, vw, kwpos, sl(f['branch_g']))

    o = lax.map(one_block, jnp.arange(T // Q_BLOCK, dtype=jnp.int32))
    o = jnp.moveaxis(o, 0, 1).reshape(B, T, N_KV_HEADS, GROUP, HEAD_DIM)
    y = back(x, f, u_out, o, p)
    keep = min(WINDOW, T)
    return y, (f['k_cmp'], f['v_cmp'], f['k_sel'], f['v_sel'],
               f['k_win'][:, -keep:], f['v_win'][:, -keep:], conv_state)


def sample_layer(x, c, cache_cmp_k, cache_cmp_v, cache_sel_k, cache_sel_v,
                 cache_win_k, cache_win_v, state_conv, page_table, p):
    B, T, _ = x.shape
    n_pages = page_table.shape[1]
    past_len = n_pages * PAGE_SIZE
    pos = past_len + jnp.arange(T, dtype=jnp.int32)
    f = front(x, c, pos, p)
    u_out, conv_state = conv_branch(f['u'], state_conv, p)
    n_new = -(-T // BLOCK)
    new_pad = ((0, 0), (0, n_new * BLOCK - T), (0, 0), (0, 0))
    past_k = cache_cmp_k[page_table].reshape(B, past_len, N_KV_HEADS, HEAD_DIM)
    past_v = cache_cmp_v[page_table].reshape(B, past_len, N_KV_HEADS, HEAD_DIM)
    kc = jnp.concatenate([compress(past_k, p['cmp_mod_k'], p['cmp_w_k']),
                          compress(jnp.pad(f['k_cmp'], new_pad), p['cmp_mod_k'], p['cmp_w_k'])], axis=1)
    vc = jnp.concatenate([compress(past_v, p['cmp_mod_v'], p['cmp_w_v']),
                          compress(jnp.pad(f['v_cmp'], new_pad), p['cmp_mod_v'], p['cmp_w_v'])], axis=1)
    bpp = PAGE_SIZE // BLOCK
    n_pool_blocks = cache_sel_k.shape[0] * bpp
    k_pool = jnp.concatenate([cache_sel_k.reshape(n_pool_blocks, BLOCK, N_KV_HEADS, HEAD_DIM),
                              jnp.pad(f['k_sel'], new_pad).reshape(B * n_new, BLOCK, N_KV_HEADS, HEAD_DIM)], axis=0)
    v_pool = jnp.concatenate([cache_sel_v.reshape(n_pool_blocks, BLOCK, N_KV_HEADS, HEAD_DIM),
                              jnp.pad(f['v_sel'], new_pad).reshape(B * n_new, BLOCK, N_KV_HEADS, HEAD_DIM)], axis=0)
    past_tbl = (page_table[:, :, None] * bpp + jnp.arange(bpp, dtype=jnp.int32)).reshape(B, n_pages * bpp)
    new_tbl = n_pool_blocks + jnp.arange(B * n_new, dtype=jnp.int32).reshape(B, n_new)
    block_table = jnp.concatenate([past_tbl, new_tbl], axis=1)
    buf = cache_win_k.shape[1]
    kw = jnp.concatenate([cache_win_k.astype(x.dtype), f['k_win']], axis=1)
    vw = jnp.concatenate([cache_win_v.astype(x.dtype), f['v_win']], axis=1)
    kwpos = past_len - buf + jnp.arange(buf + T, dtype=jnp.int32)
    o = nsa_attend(f['q_plain'], f['q_rope'], pos, kc, vc, k_pool, v_pool, block_table,
                   kw, vw, kwpos, f['branch_g'])
    y = back(x, f, u_out, o, p)
    keep = min(WINDOW, buf + T)
    return y, (f['k_cmp'], f['v_cmp'], f['k_sel'], f['v_sel'], kw[:, -keep:], vw[:, -keep:], conv_state)


def setup_inputs(seed: int = 0) -> dict:
    key = jax.random.key(seed)
    ks = iter(jax.random.split(key, 48))
    nrm = lambda shape, s: s * jax.random.normal(next(ks), shape, jnp.float32)
    n_pages = PAST_LEN // PAGE_SIZE
    used = DEC_BATCH * n_pages
    n_pool = used + max(1, used // 4)
    win_buf = min(WINDOW, PAST_LEN)
    L = DEPTH
    kv_pool = (L, n_pool, PAGE_SIZE, N_KV_HEADS, HEAD_DIM)
    kv_win = (L, DEC_BATCH, win_buf, N_KV_HEADS, HEAD_DIM)
    inputs = {}
    inputs['x_prompt'] = nrm((BATCH, SEQ, D_MODEL), 1.0)
    inputs['x_sample'] = nrm((DEC_BATCH, DEC_SEQ, D_MODEL), 1.0)
    inputs['cache_cmp_k'] = nrm(kv_pool, 1.0)
    inputs['cache_cmp_v'] = nrm(kv_pool, 1.0)
    inputs['cache_sel_k'] = nrm(kv_pool, 1.0)
    inputs['cache_sel_v'] = nrm(kv_pool, 1.0)
    inputs['cache_win_k'] = nrm(kv_win, 1.0)
    inputs['cache_win_v'] = nrm(kv_win, 1.0)
    inputs['state_conv'] = nrm((L, DEC_BATCH, CONV_K - 1, D_CONV), 0.5)
    inputs['page_table'] = jax.random.permutation(next(ks), n_pool)[:used].reshape(DEC_BATCH, n_pages).astype(jnp.int32)
    inputs['c_prompt'] = nrm((BATCH, D_MODEL), 1.0)
    inputs['c_sample'] = nrm((DEC_BATCH, D_MODEL), 1.0)
    inputs['w_ada'] = nrm((L, D_MODEL, 6 * D_MODEL), 0.5 * D_MODEL ** -0.5)
    inputs['b_ada'] = nrm((L, 6 * D_MODEL), 0.01)
    inputs['mix_norm_g'] = 1.0 + nrm((L, D_MODEL), 0.01)
    inputs['w_in'] = nrm((L, D_MODEL, D_IN), D_MODEL ** -0.5)
    inputs['q_norm_g'] = 1.0 + nrm((L, HEAD_DIM), 0.01)
    inputs['k_norm_g'] = 1.0 + nrm((L, 3, HEAD_DIM), 0.01)
    inputs['w_dw'] = nrm((L, CONV_K, D_CONV), CONV_K ** -0.5)
    inputs['b_dw'] = nrm((L, D_CONV), 0.01)
    inputs['conv_ln_g'] = 1.0 + nrm((L, D_CONV), 0.01)
    inputs['conv_ln_b'] = nrm((L, D_CONV), 0.01)
    inputs['w_pw2'] = nrm((L, D_CONV, D_MODEL), D_CONV ** -0.5)
    inputs['cmp_mod_k'] = nrm((L, BLOCK, HEAD_DIM), 0.1)
    inputs['cmp_w_k'] = nrm((L, HEAD_DIM, HEAD_DIM), HEAD_DIM ** -0.5)
    inputs['cmp_mod_v'] = nrm((L, BLOCK, HEAD_DIM), 0.1)
    inputs['cmp_w_v'] = nrm((L, HEAD_DIM, HEAD_DIM), HEAD_DIM ** -0.5)
    inputs['w_nsa_o'] = nrm((L, Q_W, D_MODEL), Q_W ** -0.5)
    inputs['w_out'] = nrm((L, D_MODEL, D_MODEL), D_MODEL ** -0.5)
    inputs['ffn_norm_g'] = 1.0 + nrm((L, D_MODEL), 0.01)
    inputs['w_gate'] = nrm((L, D_MODEL, D_FF), D_MODEL ** -0.5)
    inputs['w_up'] = nrm((L, D_MODEL, D_FF), D_MODEL ** -0.5)
    inputs['w_down'] = nrm((L, D_FF, D_MODEL), D_FF ** -0.5)
    return inputs


def reference(x_prompt, x_sample, cache_cmp_k, cache_cmp_v, cache_sel_k, cache_sel_v,
              cache_win_k, cache_win_v, state_conv, page_table, c_prompt, c_sample,
              w_ada, b_ada, mix_norm_g, w_in, q_norm_g, k_norm_g, w_dw, b_dw, conv_ln_g,
              conv_ln_b, w_pw2, cmp_mod_k, cmp_w_k, cmp_mod_v, cmp_w_v, w_nsa_o, w_out,
              ffn_norm_g, w_gate, w_up, w_down):
    yp, ys = x_prompt, x_sample
    st_p, st_s = [], []
    for l in range(DEPTH):
        p = dict(w_ada=w_ada[l], b_ada=b_ada[l], mix_norm_g=mix_norm_g[l], w_in=w_in[l],
                 q_norm_g=q_norm_g[l], k_norm_g=k_norm_g[l], w_dw=w_dw[l], b_dw=b_dw[l],
                 conv_ln_g=conv_ln_g[l], conv_ln_b=conv_ln_b[l], w_pw2=w_pw2[l],
                 cmp_mod_k=cmp_mod_k[l], cmp_w_k=cmp_w_k[l], cmp_mod_v=cmp_mod_v[l],
                 cmp_w_v=cmp_w_v[l], w_nsa_o=w_nsa_o[l], w_out=w_out[l],
                 ffn_norm_g=ffn_norm_g[l], w_gate=w_gate[l], w_up=w_up[l], w_down=w_down[l])
        yp, sp = prompt_layer(yp, c_prompt, p)
        ys, ss = sample_layer(ys, c_sample, cache_cmp_k[l], cache_cmp_v[l], cache_sel_k[l],
                              cache_sel_v[l], cache_win_k[l], cache_win_v[l], state_conv[l],
                              page_table, p)
        st_p.append(sp)
        st_s.append(ss)
    stk = lambda lst, j: jnp.stack([s[j] for s in lst])
    return (yp, ys,
            stk(st_p, 0), stk(st_p, 1), stk(st_p, 2), stk(st_p, 3), stk(st_p, 4), stk(st_p, 5), stk(st_p, 6),
            stk(st_s, 0), stk(st_s, 1), stk(st_s, 2), stk(st_s, 3), stk(st_s, 4), stk(st_s, 5), stk(st_s, 6))
```

```cpp
#include <hip/hip_runtime.h>
#include <cstdio>
#include <cstdint>
#include <cmath>
namespace pg8 {
#define PG8_LAS __attribute__((address_space(3)))
typedef unsigned short bf16_t;
typedef short bf16x8 __attribute__((ext_vector_type(8)));
typedef float f32x4 __attribute__((ext_vector_type(4)));
typedef unsigned u32x4 __attribute__((ext_vector_type(4)));
constexpr int BM = 256, BK = 64, HALF = 128, HTB = HALF * BK * 2  , STAGE_BYTES = 8 * HTB, NXCD = 8, WGM = 8;

__host__ __device__ __forceinline__ int lds_byte(int r, int c) { const int st = (r >> 4) * 2 + (c >> 5), rr = r & 15, cc = c & 31, ob = rr * 64 + cc * 2; return st * 1024 + (ob ^ (((ob >> 9) & 1) << 5)); }
__host__ __device__ __forceinline__ void stage_rc(int b, int& R, int& C) { const int st = b / 1024, sb = b % 1024, swz = sb ^ (((sb >> 9) & 1) << 5); R = (st >> 1) * 16 + swz / 64; C = (st & 1) * 32 + (swz % 64) / 2; }
__host__ __device__ __forceinline__ int perm32(int rho) { const int n = rho >> 4, i = rho & 15; return 8 * (i >> 2) + 4 * n + (i & 3); }

struct Unit { int pm, pn; };
struct Gemm { const bf16_t* A; const bf16_t* Bt; int M, N, K; };

struct StaticOrder {
    int nM, nN, nwg, G, c;
    __host__ __device__ void init(int M, int N, int G_, int c_) { nM = M / BM; nN = N / BM; nwg = nM * nN; G = G_; c = c_; }
    __host__ __device__ bool next(int i, Unit& u) const {
        const long L = (long)i * G + c; if (L >= nwg) return false;
        int wgid = (int)L; { const int q = nwg / NXCD, r = nwg % NXCD, xcd = wgid % NXCD, off = wgid / NXCD; wgid = (xcd < r ? xcd * (q + 1) : r * (q + 1) + (xcd - r) * q) + off; }
        const int nig = WGM * nN, gid = wgid / nig, fm = gid * WGM, gsz = (nM - fm) < WGM ? (nM - fm) : WGM;
        u.pm = fm + ((wgid % nig) % gsz); u.pn = (wgid % nig) / gsz; return true;
    }
    __device__ __forceinline__ void a_ready(const Unit&) const {}
    __device__ __forceinline__ void done(const Unit&) const {}
};

__device__ __forceinline__ unsigned cvt_pk_bf16(float lo, float hi) { unsigned r; asm volatile("v_cvt_pk_bf16_f32 %0, %1, %2" : "=v"(r) : "v"(lo), "v"(hi)); return r; }
typedef float f32x2 __attribute__((ext_vector_type(2)));

constexpr int ROWS_P = 32768;
__device__ __forceinline__ int mod_row(int r) { return r < ROWS_P ? (r >> 13) : 4 + ((r - ROWS_P) >> 3); }
__device__ __forceinline__ float bf_lo(unsigned w) { return __uint_as_float(w << 16); }
__device__ __forceinline__ float bf_hi(unsigned w) { return __uint_as_float(w & 0xffff0000u); }
__device__ __forceinline__ float sigmoid_f(float x) { return __builtin_amdgcn_rcpf(1.0f + __builtin_amdgcn_exp2f(-1.4426950408889634f * x)); }

struct EpiF32 {
    static constexpr bool PERM = false, AFTER_DRAIN = false;
    float* C; int ldc;
    __device__ __forceinline__ void operator()(const f32x4 (&acc)[2][2][4][2], const Unit& u, int wr, int wc, int fr, int fq) const {
        const int row0 = u.pm * BM + wr * 64 + fr, col0 = u.pn * BM + wc * 32 + 4 * fq;
#pragma unroll
        for (int ai = 0; ai < 2; ++ai)
#pragma unroll
            for (int m = 0; m < 4; ++m) { float* rowp = C + (size_t)(row0 + ai * HALF + m * 16) * ldc + col0;
#pragma unroll
                for (int bj = 0; bj < 2; ++bj)
#pragma unroll
                    for (int n = 0; n < 2; ++n) *(f32x4*)(rowp + bj * HALF + n * 16) = acc[ai][bj][m][n]; }
    }
};
template <bool ADD> struct EpiGate {
    static constexpr bool PERM = true, AFTER_DRAIN = false;
    bf16_t* O; const bf16_t* G; int ldc;
    __device__ __forceinline__ void operator()(const f32x4 (&acc)[2][2][4][2], const Unit& u, int wr, int wc, int fr, int fq) const {
        const int row0 = u.pm * BM + wr * 64 + fr, col0 = u.pn * BM + wc * 32 + 8 * fq;
#pragma unroll
        for (int ai = 0; ai < 2; ++ai)
#pragma unroll
            for (int m = 0; m < 4; ++m) { const size_t ro = (size_t)(row0 + ai * HALF + m * 16) * ldc + col0;
#pragma unroll
                for (int bj = 0; bj < 2; ++bj) {
                    const u32x4 g = *(const u32x4*)(G + ro + bj * HALF);
                    f32x4 v0 = acc[ai][bj][m][0], v1 = acc[ai][bj][m][1];
                    v0[0] *= bf_lo(g.x); v0[1] *= bf_hi(g.x); v0[2] *= bf_lo(g.y); v0[3] *= bf_hi(g.y);
                    v1[0] *= bf_lo(g.z); v1[1] *= bf_hi(g.z); v1[2] *= bf_lo(g.w); v1[3] *= bf_hi(g.w);
                    if (ADD) { const u32x4 t = *(const u32x4*)(O + ro + bj * HALF);
                        v0[0] += bf_lo(t.x); v0[1] += bf_hi(t.x); v0[2] += bf_lo(t.y); v0[3] += bf_hi(t.y);
                        v1[0] += bf_lo(t.z); v1[1] += bf_hi(t.z); v1[2] += bf_lo(t.w); v1[3] += bf_hi(t.w); }
                    u32x4 w; w.x = cvt_pk_bf16(v0[0], v0[1]); w.y = cvt_pk_bf16(v0[2], v0[3]); w.z = cvt_pk_bf16(v1[0], v1[1]); w.w = cvt_pk_bf16(v1[2], v1[3]);
                    *(u32x4*)(O + ro + bj * HALF) = w; } }
    }
};
struct EpiResGate {
    static constexpr bool PERM = false, AFTER_DRAIN = false;
    const float* bp; const float* bs; float* out; const float* modg;
    __device__ __forceinline__ void operator()(const f32x4 (&acc)[2][2][4][2], const Unit& u, int wr, int wc, int fr, int fq) const {
        const int row0 = u.pm * BM + wr * 64 + fr, col0 = u.pn * BM + wc * 32 + 4 * fq;
#pragma unroll
        for (int ai = 0; ai < 2; ++ai)
#pragma unroll
            for (int m = 0; m < 4; ++m) { const int r = row0 + ai * HALF + m * 16;
                const float* b = (r < ROWS_P ? bp + (size_t)r * 1024 : bs + (size_t)(r - ROWS_P) * 1024) + col0;
                const float* g = modg + (size_t)mod_row(r) * 6144 + col0; float* o = out + (size_t)r * 1024 + col0;
#pragma unroll
                for (int bj = 0; bj < 2; ++bj)
#pragma unroll
                    for (int n = 0; n < 2; ++n) { const f32x4 bv = *(const f32x4*)(b + bj * HALF + n * 16), gv = *(const f32x4*)(g + bj * HALF + n * 16);
                        *(f32x4*)(o + bj * HALF + n * 16) = bv + gv * acc[ai][bj][m][n]; } }
    }
};
struct EpiSwiGlu {
    static constexpr bool PERM = true, AFTER_DRAIN = false;
    bf16_t* O; int ldo;
    __device__ __forceinline__ void operator()(const f32x4 (&acc)[2][2][4][2], const Unit& u, int wr, int wc, int fr, int fq) const {
        const int row0 = u.pm * BM + wr * 64 + fr, oc0 = u.pn * 128 + wc * 16 + 4 * fq;
        typedef unsigned u32x2 __attribute__((ext_vector_type(2)));
#pragma unroll
        for (int ai = 0; ai < 2; ++ai)
#pragma unroll
            for (int m = 0; m < 4; ++m) { bf16_t* rowp = O + (size_t)(row0 + ai * HALF + m * 16) * ldo + oc0;
#pragma unroll
                for (int bj = 0; bj < 2; ++bj) { const f32x4 gt = acc[ai][bj][m][0], up = acc[ai][bj][m][1]; f32x4 a;
#pragma unroll
                    for (int i = 0; i < 4; ++i) a[i] = gt[i] * sigmoid_f(gt[i]) * up[i];
                    u32x2 w; w.x = cvt_pk_bf16(a[0], a[1]); w.y = cvt_pk_bf16(a[2], a[3]);
                    *(u32x2*)(rowp + bj * 64) = w; } }
    }
};
template <class Epi, class Sched, bool ALIGN_EPI = false, bool SP2 = false>
__device__ __forceinline__ void gemm_phase(PG8_LAS unsigned char* lds, const Gemm g, const Sched& S, const Epi& E) {
    const int tid = threadIdx.x, wid = __builtin_amdgcn_readfirstlane(tid >> 6), lane = tid & 63, wr = wid >> 2, wc = wid & 3, fr = lane & 15, fq = lane >> 4;
    const int K = g.K, nt = K / BK;
    unsigned voffA[2], voffB[2];
#pragma unroll
    for (int i = 0; i < 2; ++i) { int R, C; stage_rc(tid * 16 + i * 8192, R, C); const int Rb = Epi::PERM ? ((R & ~31) + perm32(R & 31)) : R;
        voffA[i] = (unsigned)(R * K + C) * 2u; voffB[i] = (unsigned)(Rb * K + C) * 2u; }
    const size_t kstep = (size_t)(BK * 2);
    const size_t hstep = (size_t)HALF * K * 2;
    const size_t tstep = 2 * hstep;
    const unsigned ldsw = (unsigned)wid * 1024u;
    const int aoff = lds_byte(wr * 64 + fr, fq * 8), boff = lds_byte(wc * 32 + fr, fq * 8);
#define PG8_SA(b, h) (((b) * 2 + (h)) * HTB)
#define PG8_SB(b, h) ((4 + (b) * 2 + (h)) * HTB)
#define PG8_STAGE(bufoff, gbase, voff) do { _Pragma("unroll") for (int _i = 0; _i < 2; ++_i) \
        __builtin_amdgcn_global_load_lds((const unsigned*)((const char*)(gbase) + (voff)[_i]), (PG8_LAS unsigned*)(lds + (bufoff) + ldsw + _i * 8192), 16, 0, 0); } while (0)
#define PG8_LDA(dst, b, h) do { _Pragma("unroll") for (int m = 0; m < 4; ++m) _Pragma("unroll") for (int k = 0; k < 2; ++k) dst[m][k] = *(const PG8_LAS bf16x8*)(lds + PG8_SA(b, h) + aoff + m * 2048 + k * 1024); } while (0)
#define PG8_LDB(dst, b, h) do { _Pragma("unroll") for (int n = 0; n < 2; ++n) _Pragma("unroll") for (int k = 0; k < 2; ++k) dst[n][k] = *(const PG8_LAS bf16x8*)(lds + PG8_SB(b, h) + boff + n * 2048 + k * 1024); } while (0)
#define PG8_MMA(ai, bj, At, Bt) do { __builtin_amdgcn_s_setprio(1); _Pragma("unroll") for (int m = 0; m < 4; ++m) _Pragma("unroll") for (int n = 0; n < 2; ++n) _Pragma("unroll") for (int k = 0; k < 2; ++k) \
        acc[ai][bj][m][n] = __builtin_amdgcn_mfma_f32_16x16x32_bf16(Bt[n][k], At[m][k], acc[ai][bj][m][n], 0, 0, 0); __builtin_amdgcn_s_setprio(0); } while (0)
#define PG8_WAIT_V(n) asm volatile("s_waitcnt vmcnt(" #n ")" ::: "memory")
#define PG8_WAIT_L(n) asm volatile("s_waitcnt lgkmcnt(" #n ")" ::: "memory")
#define PG8_BAR __builtin_amdgcn_s_barrier()
#define PG8_SCHED __builtin_amdgcn_sched_barrier(0)
    Unit cur, nxt; int ui = 0;
    if (!S.next(0, cur)) return;
    f32x4 acc[2][2][4][2];
#pragma unroll
    for (int a = 0; a < 2; ++a)
#pragma unroll
        for (int b = 0; b < 2; ++b)
#pragma unroll
            for (int m = 0; m < 4; ++m)
#pragma unroll
                for (int n = 0; n < 2; ++n) acc[a][b][m][n] = (f32x4){0.f, 0.f, 0.f, 0.f};
    bf16x8 At[4][2], B0[2][2], B1[2][2];
    const char* cA = (const char*)g.A + (size_t)cur.pm * tstep; const char* cB = (const char*)g.Bt + (size_t)cur.pn * tstep;
    S.a_ready(cur);
    if constexpr (SP2) {
        PG8_STAGE(PG8_SB(0, 0), cB, voffB); PG8_STAGE(PG8_SB(0, 1), cB + hstep, voffB); PG8_STAGE(PG8_SA(0, 0), cA, voffA); PG8_STAGE(PG8_SA(0, 1), cA + hstep, voffA);
        if (wr == 1) PG8_BAR;
        PG8_WAIT_V(2); PG8_BAR;
        PG8_STAGE(PG8_SB(1, 0), cB + kstep, voffB); PG8_STAGE(PG8_SA(1, 0), cA + kstep, voffA); PG8_STAGE(PG8_SB(1, 1), cB + hstep + kstep, voffB);
        PG8_WAIT_V(6); PG8_BAR;
    } else {
        PG8_STAGE(PG8_SB(0, 0), cB, voffB); PG8_STAGE(PG8_SA(0, 0), cA, voffA); PG8_STAGE(PG8_SB(0, 1), cB + hstep, voffB); PG8_STAGE(PG8_SA(0, 1), cA + hstep, voffA);
        if (wr == 1) PG8_BAR;
        PG8_WAIT_V(4); PG8_BAR;
        PG8_STAGE(PG8_SB(1, 0), cB + kstep, voffB); PG8_STAGE(PG8_SA(1, 0), cA + kstep, voffA); PG8_STAGE(PG8_SB(1, 1), cB + hstep + kstep, voffB);
        PG8_WAIT_V(6); PG8_BAR;
    }
    for (;;) {
        const bool has_next = S.next(ui + 1, nxt);
        const char* nA = has_next ? (const char*)g.A + (size_t)nxt.pm * tstep : cA; const char* nB = has_next ? (const char*)g.Bt + (size_t)nxt.pn * tstep : cB;
        for (int t = 0; t < nt; t += 2) {
            const bool last = (t == nt - 2);
            const char* a1 = cA + (size_t)(t + 1) * kstep;
            const char* a2 = last ? nA : cA + (size_t)(t + 2) * kstep; const char* b2 = last ? nB : cB + (size_t)(t + 2) * kstep;
            const char* a3 = a2 + kstep; const char* b3 = b2 + kstep;
            if (last && has_next) S.a_ready(nxt);
            if constexpr (SP2) {
            PG8_LDB(B0, 0, 0); PG8_LDB(B1, 0, 1); PG8_SCHED; PG8_LDA(At, 0, 0); PG8_STAGE(PG8_SA(1, 1), a1 + hstep, voffA);
            PG8_WAIT_V(8); PG8_WAIT_L(0); PG8_BAR; PG8_MMA(0, 0, At, B0); PG8_MMA(0, 1, At, B1); PG8_BAR; PG8_SCHED;
            PG8_LDA(At, 0, 1); PG8_STAGE(PG8_SB(0, 0), b2, voffB); PG8_STAGE(PG8_SB(0, 1), b2 + hstep, voffB); PG8_STAGE(PG8_SA(0, 0), a2, voffA);
            PG8_WAIT_V(8); PG8_WAIT_L(0); PG8_BAR; PG8_MMA(1, 0, At, B0); PG8_MMA(1, 1, At, B1); PG8_BAR; PG8_SCHED;
            PG8_LDB(B0, 1, 0); PG8_LDB(B1, 1, 1); PG8_SCHED; PG8_LDA(At, 1, 0); PG8_STAGE(PG8_SA(0, 1), a2 + hstep, voffA);
            PG8_WAIT_V(8); PG8_WAIT_L(0); PG8_BAR; PG8_MMA(0, 0, At, B0); PG8_MMA(0, 1, At, B1); PG8_BAR; PG8_SCHED;
            PG8_LDA(At, 1, 1); PG8_STAGE(PG8_SB(1, 0), b3, voffB); PG8_STAGE(PG8_SB(1, 1), b3 + hstep, voffB); PG8_STAGE(PG8_SA(1, 0), a3, voffA);
            PG8_WAIT_V(8); PG8_WAIT_L(0); PG8_BAR; PG8_MMA(1, 0, At, B0); PG8_MMA(1, 1, At, B1); PG8_BAR; PG8_SCHED;
            } else {
            PG8_LDB(B0, 0, 0); PG8_SCHED; PG8_LDA(At, 0, 0); PG8_STAGE(PG8_SA(1, 1), a1 + hstep, voffA);
            PG8_WAIT_L(8); PG8_BAR; PG8_WAIT_L(0); PG8_MMA(0, 0, At, B0); PG8_BAR; PG8_SCHED;
            PG8_LDB(B1, 0, 1); PG8_STAGE(PG8_SB(0, 0), b2, voffB);
            PG8_BAR; PG8_WAIT_L(0); PG8_MMA(0, 1, At, B1); PG8_BAR;
            PG8_LDA(At, 0, 1); PG8_STAGE(PG8_SA(0, 0), a2, voffA);
            PG8_BAR; PG8_WAIT_L(0); PG8_MMA(1, 0, At, B0); PG8_BAR; PG8_SCHED;
            PG8_STAGE(PG8_SB(0, 1), b2 + hstep, voffB);
            PG8_WAIT_V(6); PG8_BAR; PG8_MMA(1, 1, At, B1); PG8_BAR;
            PG8_LDB(B0, 1, 0); PG8_SCHED; PG8_LDA(At, 1, 0); PG8_STAGE(PG8_SA(0, 1), a2 + hstep, voffA);
            PG8_WAIT_L(8); PG8_BAR; PG8_WAIT_L(0); PG8_MMA(0, 0, At, B0); PG8_BAR; PG8_SCHED;
            PG8_LDB(B1, 1, 1); PG8_STAGE(PG8_SB(1, 0), b3, voffB);
            PG8_BAR; PG8_WAIT_L(0); PG8_MMA(0, 1, At, B1); PG8_BAR;
            PG8_LDA(At, 1, 1); PG8_STAGE(PG8_SA(1, 0), a3, voffA);
            PG8_BAR; PG8_WAIT_L(0); PG8_MMA(1, 0, At, B0); PG8_BAR; PG8_SCHED;
            PG8_STAGE(PG8_SB(1, 1), b3 + hstep, voffB);
            PG8_WAIT_V(6); PG8_BAR; PG8_MMA(1, 1, At, B1); PG8_BAR;
            }
        }
        if constexpr (ALIGN_EPI) { if (wr == 0) PG8_BAR; }
        if constexpr (!Epi::AFTER_DRAIN) { E(acc, cur, wr, wc, fr, fq); S.done(cur); }
        if (!has_next) break;
#pragma unroll
        for (int a = 0; a < 2; ++a)
#pragma unroll
            for (int b = 0; b < 2; ++b)
#pragma unroll
                for (int m = 0; m < 4; ++m)
#pragma unroll
                    for (int n = 0; n < 2; ++n) acc[a][b][m][n] = (f32x4){0.f, 0.f, 0.f, 0.f};
        cur = nxt; cA = nA; cB = nB; ++ui;
        if constexpr (ALIGN_EPI) { if (wr == 1) PG8_BAR; }
    }
    PG8_WAIT_V(0);
    if constexpr (!ALIGN_EPI) { if (wr == 0) PG8_BAR; }
    PG8_BAR;
    if constexpr (Epi::AFTER_DRAIN) { E.fused(acc, cur, wr, wc, fr, fq, lds, wid, lane); S.done(cur); }
#undef PG8_SA
#undef PG8_SB
#undef PG8_STAGE
#undef PG8_LDA
#undef PG8_LDB
#undef PG8_MMA
#undef PG8_WAIT_V
#undef PG8_WAIT_L
#undef PG8_BAR
#undef PG8_SCHED
}
}
#define GAS __attribute__((address_space(1)))
#define LAS __attribute__((address_space(3)))
typedef unsigned short bf16;
typedef unsigned v4u __attribute__((ext_vector_type(4)));
typedef float f32x4 __attribute__((ext_vector_type(4)));
typedef short bf16x8 __attribute__((ext_vector_type(8)));
typedef GAS unsigned gu32;
typedef GAS unsigned long long gu64;
#define RLX_AGENT __ATOMIC_RELAXED, __HIP_MEMORY_SCOPE_AGENT
#define LDS_WAIT() asm volatile("s_waitcnt lgkmcnt(0)" ::: "memory")
#define VM_WAIT() asm volatile("s_waitcnt vmcnt(0)" ::: "memory")
__device__ __forceinline__ unsigned long long rt() { return __builtin_amdgcn_s_memrealtime(); }
__device__ __forceinline__ unsigned f2bf(float f) { unsigned u = __builtin_bit_cast(unsigned, f); return (u + 0x7fffu + ((u >> 16) & 1u)) >> 16; }
__device__ __forceinline__ unsigned pk2(float lo, float hi) { return f2bf(lo) | (f2bf(hi) << 16); }

#define XB_TMO      128
#define XB_XCNT(j)  (256  + 64 * (j))
#define XB_XSUB(j)  (1280 + 64 * (j))
#define XB_XGEN(j)  (2304 + 64 * (j))
#define XB_TOP      3328
#define XB_TOPGEN   3392
#define XCD_BAR_WORDS 3456
#define XB_SPIN_CAP (1u << 18)

__device__ __forceinline__ unsigned xb_ld(unsigned* p)              { return __hip_atomic_load(p, __ATOMIC_RELAXED, __HIP_MEMORY_SCOPE_AGENT); }
__device__ __forceinline__ unsigned xb_add(unsigned* p, unsigned v) { return __hip_atomic_fetch_add(p, v, __ATOMIC_RELAXED, __HIP_MEMORY_SCOPE_AGENT); }
__device__ __forceinline__ unsigned xb_xcc_id() { return (unsigned)__builtin_amdgcn_s_getreg((3 << 11) | 20) & 0xFu; }
#define XB_SPIN(cond, bar) do { unsigned _sp = 0; while (cond) { __builtin_amdgcn_s_sleep(1); \
    if ((++_sp & 255u) == 0u) { if (xb_ld(&(bar)[XB_TMO])) break; if (_sp > XB_SPIN_CAP) { atomicAdd(&(bar)[XB_TMO], 1u); break; } } } } while (0)

struct XcdBarrier {
    unsigned* bar; unsigned x;
    volatile LAS unsigned* st;
};

__device__ __forceinline__ XcdBarrier xcd_barrier_post(unsigned* bar, volatile LAS unsigned* st) {
    XcdBarrier b; b.bar = bar; b.x = xb_xcc_id(); b.st = st;
    if (threadIdx.x == 0) (void)xb_add(&bar[XB_XCNT(b.x)], 1u);
    return b;
}
__device__ __forceinline__ void xcd_barrier_complete(unsigned* bar, unsigned x, unsigned& nloc, unsigned& nx) {
    const unsigned G = gridDim.x * gridDim.y * gridDim.z;
    unsigned sum, cnt, mine, sp = 0u;
    for (;;) {
        sum = 0u; cnt = 0u; mine = 0u;
#pragma unroll
        for (unsigned j = 0; j < 16; ++j) { const unsigned c = xb_ld(&bar[XB_XCNT(j)]); sum += c; cnt += (c > 0u) ? 1u : 0u; mine = (j == x) ? c : mine; }
        if (sum == G) break;
        __builtin_amdgcn_s_sleep(1);
        if ((++sp & 255u) == 0u) { if (xb_ld(&bar[XB_TMO])) break; if (sp > XB_SPIN_CAP) { atomicAdd(&bar[XB_TMO], 1u); break; } }
    }
    nloc = mine > 0u ? mine : 1u; nx = cnt > 0u ? cnt : 1u;
}

__device__ __forceinline__ void xcd_barrier(const XcdBarrier& b) {
    asm volatile("s_waitcnt vmcnt(0)" ::: "memory");
    __syncthreads();
    if (threadIdx.x == 0) {
        unsigned* bar = b.bar;
        __builtin_amdgcn_s_waitcnt(0);
        unsigned nloc = b.st[0], nx = b.st[1];
        if (nloc == 0u) { xcd_barrier_complete(bar, b.x, nloc, nx); b.st[0] = nloc; b.st[1] = nx; }
        const unsigned old = xb_add(&bar[XB_XSUB(b.x)], 1u);
        const unsigned gen = old / nloc;
        if (old + 1u == (gen + 1u) * nloc) {
            __builtin_amdgcn_fence(__ATOMIC_RELEASE, "agent");
            asm volatile("s_waitcnt vmcnt(0)" ::: "memory");
            const unsigned og = xb_add(&bar[XB_TOP], 1u);
            const unsigned tg = og / nx;
            if (og + 1u == (tg + 1u) * nx) xb_add(&bar[XB_TOPGEN], 1u);
            else XB_SPIN(xb_ld(&bar[XB_TOPGEN]) == tg, bar);
            __builtin_amdgcn_fence(__ATOMIC_ACQUIRE, "agent");
            xb_add(&bar[XB_XGEN(b.x)], 1u);
            asm volatile("s_waitcnt vmcnt(0)" ::: "memory");
        } else {
            XB_SPIN(xb_ld(&bar[XB_XGEN(b.x)]) == gen, bar);
            __builtin_amdgcn_fence(__ATOMIC_ACQUIRE, "agent");
            asm volatile("s_waitcnt vmcnt(0)" ::: "memory");
        }
    }
    __syncthreads();
}

constexpr int NWAVES = 8;
constexpr int MP = 32768, MS = 256, MT = MP + MS;
constexpr int DM = 1024, DIN = 4376, DINP = 4608, DFF = 2816, DCONV = 512, QW = 512;
constexpr int OFF_Q = 1024, OFF_KV = 1536, OFF_NG = 2304, OFF_MG = 2328;
constexpr int NSEQ = 36;
constexpr float EPS = 1e-6f;
constexpr size_t O_YP = 0, O_YS = 33554432, O_PCK = 33816576, O_PCV = O_PCK + 4194304, O_PSK = O_PCV + 4194304, O_PSV = O_PSK + 4194304,
                 O_PWK = O_PSV + 4194304, O_PWV = O_PWK + 262144, O_PCONV = O_PWV + 262144, O_SCK = O_PCONV + 61440, O_SCV = O_SCK + 32768,
                 O_SSK = O_SCV + 32768, O_SSV = O_SSK + 32768, O_SWK = O_SSV + 32768, O_SWV = O_SWK + 2097152, O_SCONV = O_SWV + 2097152, O_END = O_SCONV + 491520;
constexpr size_t MiB = 1u << 20;
constexpr size_t WS_CTL = 0, WS_MOD = 1 * MiB, ZERO_BYTES = 2 * MiB;
constexpr size_t WS_ROPE = 2 * MiB;
constexpr size_t WS_WIN = 5 * MiB, WS_WPW2 = 14 * MiB, WS_WNSA = 15 * MiB, WS_WOUT = 16 * MiB, WS_WGU = 18 * MiB, WS_WDOWN = 29 * MiB;
constexpr size_t WS_KC = 36 * MiB, WS_VC = 41 * MiB, WS_BG = 46 * MiB, WS_H = 50 * MiB, WS_U = 115 * MiB, WS_QP = 148 * MiB, WS_QR = 181 * MiB,
                 WS_CACT = 214 * MiB, WS_O = 247 * MiB, WS_GC = 280 * MiB, WS_GN = 345 * MiB, WS_T1 = 410 * MiB, WS_KWIN = 475 * MiB, WS_VWIN = 491 * MiB,
                 WS_ACT = 507 * MiB, WS_Z = 685 * MiB, WS_END = 1267 * MiB;
constexpr int ROPE_N = 8200;
constexpr int CW_BAR = 4096;
constexpr int RING_BYTES = 131072, MISC_OFF = RING_BYTES + 320, LDS_BYTES = 147456;

typedef unsigned v2u __attribute__((ext_vector_type(2)));
typedef float f32x2 __attribute__((ext_vector_type(2)));
__device__ __forceinline__ float bf2f(unsigned short b) { return __uint_as_float(((unsigned)b) << 16); }
__device__ __forceinline__ float wave_sum(float v) {
#pragma unroll
    for (int o = 1; o < 64; o <<= 1) v += __shfl_xor(v, o);
    return v;
}
__device__ __forceinline__ float wave_max(float v) {
#pragma unroll
    for (int o = 1; o < 64; o <<= 1) v = fmaxf(v, __shfl_xor(v, o));
    return v;
}
__device__ __forceinline__ float sigm(float x) { return 1.0f / (1.0f + __expf(-x)); }
__device__ __forceinline__ int mrow(int r) { return r < MP ? (r >> 13) : 4 + ((r - MP) >> 3); }
__device__ __forceinline__ int rope_idx(int r) { return r < MP ? (r & 8191) : 8192 + ((r - MP) & 7); }
__device__ __forceinline__ size_t kc_off(int s) { return s < 4 ? (size_t)s * 128 * 128 : (size_t)4 * 128 * 128 + (size_t)(s - 4) * 257 * 128; }

struct Args { const float* in[33]; float* out; unsigned char* ws; int ph_lo, ph_hi; };

template <int MODE> __device__ __forceinline__ int rowmap(int n) { return MODE == 0 ? n : (MODE == 1 ? 8 * (n >> 2) + (n & 3) : 8 * (n >> 2) + 4 + (n & 3)); }
template <int MODE> __device__ __forceinline__ void transpose_item(const float* W, int K, int N, bf16* WT, LAS float* scr, int item, int lane) {
    const int nblk = (N + 31) / 32, kb = item / nblk, nb = item % nblk, k0 = 64 * kb, n0 = 32 * nb;
    const int nn = n0 + (lane & 31);
#pragma unroll 8
    for (int i = 0; i < 32; ++i) { const int kk = 2 * i + (lane >> 5); scr[kk * 33 + (lane & 31)] = (nn < N) ? W[(size_t)(k0 + kk) * N + nn] : 0.f; }
    LDS_WAIT(); asm volatile("" ::: "memory");
    const int c = lane & 7;
#pragma unroll
    for (int j = 0; j < 4; ++j) { const int nl = (lane >> 3) + 8 * j, n = n0 + nl; const LAS float* s = scr + (8 * c) * 33 + nl;
        v4u o; o.x = pk2(s[0 * 33], s[1 * 33]); o.y = pk2(s[2 * 33], s[3 * 33]); o.z = pk2(s[4 * 33], s[5 * 33]); o.w = pk2(s[6 * 33], s[7 * 33]);
        if (n < N) *(v4u*)(WT + (size_t)rowmap<MODE>(n) * K + k0 + 8 * c) = o; }
    LDS_WAIT(); asm volatile("" ::: "memory");
}
__device__ __forceinline__ void compress_block(const float* rows, int nvalid, const float* pm, const float* w, float* outp, LAS float* scr, int lane) {
    const int col = 2 * lane, d = col & 63;
    f32x2 acc = {0.f, 0.f};
    for (int j = 0; j < nvalid; ++j) {
        const f32x2 x = *(const f32x2*)(rows + (size_t)j * 128 + col); const f32x2 m = *(const f32x2*)(pm + j * 64 + d);
        acc.x += x.x * (1.0f + m.x); acc.y += x.y * (1.0f + m.y);
    }
    scr[col] = acc.x * (1.0f / 64.0f); scr[col + 1] = acc.y * (1.0f / 64.0f);
    LDS_WAIT(); asm volatile("" ::: "memory");
    const int kvh = lane >> 5, e = 2 * (lane & 31);
    f32x2 o = {0.f, 0.f};
#pragma unroll 8
    for (int dd = 0; dd < 64; ++dd) { const float s = scr[kvh * 64 + dd]; const f32x2 ww = *(const f32x2*)(w + dd * 64 + e); o.x += s * ww.x; o.y += s * ww.y; }
    *(f32x2*)(outp + kvh * 64 + e) = o;
    LDS_WAIT(); asm volatile("" ::: "memory");
}
__device__ __forceinline__ void phase0(const Args& a, LAS unsigned char* lds, int gw, int NGW, int wave, int lane) {
    unsigned char* ws = a.ws;
    LAS float* scr = (LAS float*)(lds + wave * 16384);
    constexpr int I_IN = 16 * 137, I_PW2 = 8 * 32, I_NSA = 8 * 32, I_OUT = 16 * 32, I_G = 16 * 88, I_U = 16 * 88, I_D = 44 * 32;
    constexpr int N_TR = I_IN + I_PW2 + I_NSA + I_OUT + I_G + I_U + I_D;
    constexpr int N_MOD = 96 * 16;
    constexpr int N_CMP = 32 * 128 * 2;
    constexpr int N_ALL = N_TR + N_MOD + N_CMP;
    for (int it = gw; it < N_ALL; it += NGW) {
        int r = it;
        if (r < N_TR) {
            if (r < I_IN) { transpose_item<0>(a.in[15], 1024, DIN, (bf16*)(ws + WS_WIN), scr, r, lane); continue; } r -= I_IN;
            if (r < I_PW2) { transpose_item<0>(a.in[22], 512, 1024, (bf16*)(ws + WS_WPW2), scr, r, lane); continue; } r -= I_PW2;
            if (r < I_NSA) { transpose_item<0>(a.in[27], 512, 1024, (bf16*)(ws + WS_WNSA), scr, r, lane); continue; } r -= I_NSA;
            if (r < I_OUT) { transpose_item<0>(a.in[28], 1024, 1024, (bf16*)(ws + WS_WOUT), scr, r, lane); continue; } r -= I_OUT;
            if (r < I_G) { transpose_item<1>(a.in[30], 1024, DFF, (bf16*)(ws + WS_WGU), scr, r, lane); continue; } r -= I_G;
            if (r < I_U) { transpose_item<2>(a.in[31], 1024, DFF, (bf16*)(ws + WS_WGU), scr, r, lane); continue; } r -= I_U;
            transpose_item<0>(a.in[32], DFF, 1024, (bf16*)(ws + WS_WDOWN), scr, r, lane); continue;
        }
        r -= N_TR;
        if (r < N_MOD) {
            const int cb = r % 96, kb = r / 96, j = cb * 64 + lane, k0 = kb * 64;
            for (int mb = 0; mb < NSEQ; ++mb) { const float* cp = mb < 4 ? a.in[10] + mb * 1024 : a.in[11] + (mb - 4) * 1024; const float cv = cp[k0 + lane]; scr[mb * 64 + lane] = cv * sigm(cv); }
            LDS_WAIT(); asm volatile("" ::: "memory");
            float acc[NSEQ];
#pragma unroll
            for (int mb = 0; mb < NSEQ; ++mb) acc[mb] = 0.f;
            const float* wp = a.in[12] + (size_t)k0 * 6144 + j;
            for (int k4 = 0; k4 < 16; ++k4) {
                const float w0 = wp[(size_t)(4 * k4 + 0) * 6144], w1 = wp[(size_t)(4 * k4 + 1) * 6144], w2 = wp[(size_t)(4 * k4 + 2) * 6144], w3 = wp[(size_t)(4 * k4 + 3) * 6144];
#pragma unroll
                for (int mb = 0; mb < NSEQ; ++mb) { const f32x4 q = *(const LAS f32x4*)(scr + mb * 64 + 4 * k4); acc[mb] += q.x * w0 + q.y * w1 + q.z * w2 + q.w * w3; }
            }
            float* modp = (float*)(ws + WS_MOD);
            const float bias = (kb == 0) ? a.in[13][j] : 0.f;
#pragma unroll
            for (int mb = 0; mb < NSEQ; ++mb) atomicAdd(modp + mb * 6144 + j, acc[mb] + bias);
            LDS_WAIT(); asm volatile("" ::: "memory");
            continue;
        }
        r -= N_MOD;
        {
            const int kv = r & 1, pg = (r >> 1) & 127, sb = r >> 8;
            const int page = ((const int*)a.in[9])[sb * 128 + pg];
            const float* src = (kv ? a.in[3] : a.in[2]) + (size_t)page * (128 * 128);
            const float* pm = kv ? a.in[25] : a.in[23]; const float* w = kv ? a.in[26] : a.in[24];
            float* dst = (float*)(ws + (kv ? WS_VC : WS_KC)) + kc_off(4 + sb) + (size_t)(2 * pg) * 128;
            compress_block(src, 64, pm, w, dst, scr, lane);
            compress_block(src + 64 * 128, 64, pm, w, dst + 128, scr, lane);
        }
    }
    const int gt = gw * 64 + lane, NT = NGW * 64;
    { v4u* p = (v4u*)((bf16*)(ws + WS_WIN) + (size_t)DIN * 1024); const int n16 = (DINP - DIN) * 1024 * 2 / 16; const v4u z = {0u, 0u, 0u, 0u}; for (int i = gt; i < n16; i += NT) p[i] = z; }
    { float* rc = (float*)(ws + WS_ROPE); float* rs = rc + ROPE_N * 32;
      for (int i = gt; i < ROPE_N * 32; i += NT) {
          const int j = i & 31, p = i >> 5; const int pos = p < 8192 ? p : 16384 + (p - 8192);
          double inv = 1.0; for (int q = 0; q < j; ++q) inv *= 0.7498942093324558;
          const double ang = (double)pos * inv;
          const double kq = __builtin_rint(ang * 0.6366197723675814);
          double rr = __builtin_fma(-kq, 1.5707963267948966, ang); rr = __builtin_fma(-kq, 6.123233995736766e-17, rr);
          const double r2 = rr * rr;
          const double sn = rr * (1.0 + r2 * (-1.0 / 6 + r2 * (1.0 / 120 + r2 * (-1.0 / 5040 + r2 * (1.0 / 362880 + r2 * (-1.0 / 39916800 + r2 * (1.0 / 6227020800.0)))))));
          const double cs = 1.0 + r2 * (-0.5 + r2 * (1.0 / 24 + r2 * (-1.0 / 720 + r2 * (1.0 / 40320 + r2 * (-1.0 / 3628800 + r2 * (1.0 / 479001600.0))))));
          const int qd = ((int)(long long)kq) & 3;
          const double c = (qd == 0) ? cs : (qd == 1) ? -sn : (qd == 2) ? -cs : sn;
          const double s = (qd == 0) ? sn : (qd == 1) ? cs : (qd == 2) ? -sn : -cs;
          rc[i] = (float)c; rs[i] = (float)s; } }
    { const int per = 504 * 128 / 4, n4 = 32 * per;
      for (int i = gt; i < 2 * n4; i += NT) { const int kv = i >= n4, ii = kv ? i - n4 : i, sb = ii / per, o = ii % per;
          const f32x4 v = ((const f32x4*)((kv ? a.in[7] : a.in[6]) + (size_t)sb * 512 * 128 + 8 * 128))[o];
          ((f32x4*)(a.out + (kv ? O_SWV : O_SWK) + (size_t)sb * 512 * 128))[o] = v; } }
    { const int per = 22 * 512 / 4, n4 = 32 * per;
      for (int i = gt; i < n4; i += NT) { const int sb = i / per, o = i % per;
          ((f32x4*)(a.out + O_SCONV + (size_t)sb * 30 * 512))[o] = ((const f32x4*)(a.in[8] + (size_t)sb * 30 * 512 + 8 * 512))[o]; } }
}

__device__ __forceinline__ void norm_rows(const float* xp, const float* xs, const float* g, const float* modp, int sh_off, int sc_off, bf16* H, int gw, int NGW, int lane) {
    for (int r = gw; r < MT; r += NGW) {
        const f32x4* xr = (const f32x4*)(r < MP ? xp + (size_t)r * 1024 : xs + (size_t)(r - MP) * 1024) + lane;
        const float* mp = modp + (size_t)mrow(r) * 6144;
        f32x4 v[4]; float ss = 0.f;
#pragma unroll
        for (int j = 0; j < 4; ++j) { v[j] = xr[64 * j]; ss += (v[j].x * v[j].x + v[j].y * v[j].y) + (v[j].z * v[j].z + v[j].w * v[j].w); }
        const float rstd = 1.0f / sqrtf(wave_sum(ss) * (1.0f / 1024.0f) + EPS);
        v2u* o8 = (v2u*)(H + (size_t)r * 1024) + lane;
#pragma unroll
        for (int j = 0; j < 4; ++j) { const int c = 4 * (lane + 64 * j);
            const f32x4 gg = *(const f32x4*)(g + c), sc = *(const f32x4*)(mp + sc_off + c), sh = *(const f32x4*)(mp + sh_off + c);
            const f32x4 h = (v[j] * rstd * gg) * (1.0f + sc) + sh;
            v2u w; w.x = pk2(h.x, h.y); w.y = pk2(h.z, h.w); o8[64 * j] = w; }
    }
}

__device__ __forceinline__ void phase_post(const Args& a, int gw, int NGW, int lane) {
    unsigned char* ws = a.ws; float* out = a.out;
    const float* Z = (const float*)(ws + WS_Z);
    const float* rc = (const float*)(ws + WS_ROPE); const float* rs = rc + ROPE_N * 32;
    bf16* U = (bf16*)(ws + WS_U); bf16* QP = (bf16*)(ws + WS_QP); bf16* QR = (bf16*)(ws + WS_QR); bf16* GC = (bf16*)(ws + WS_GC); bf16* GN = (bf16*)(ws + WS_GN);
    float* BG = (float*)(ws + WS_BG); float* KWIN = (float*)(ws + WS_KWIN); float* VWIN = (float*)(ws + WS_VWIN);
    const float qg = a.in[16][lane]; const float kg0 = a.in[17][lane], kg1 = a.in[17][64 + lane], kg2 = a.in[17][128 + lane];
    for (int r = gw; r < MT; r += NGW) {
        const float* z = Z + (size_t)r * DINP;
        const bool smp = r >= MP; const int rs_ = r - MP, sb = rs_ >> 3, si = rs_ & 7, b = r >> 13, t = r & 8191;
        const int ri = rope_idx(r); const float cv = rc[ri * 32 + (lane & 31)], sv = rs[ri * 32 + (lane & 31)];
#pragma unroll
        for (int i = 0; i < 8; ++i) { const int c = lane + 64 * i; const float u = z[c] * sigm(z[512 + c]);
            U[(size_t)r * 512 + c] = (bf16)f2bf(u);
            if (smp) out[O_SCONV + (size_t)(sb * 30 + 22 + si) * 512 + c] = u;
            else if (t >= 8162) out[O_PCONV + (size_t)(b * 30 + t - 8162) * 512 + c] = u; }
#pragma unroll
        for (int h = 0; h < 8; ++h) { const float x = z[OFF_Q + 64 * h + lane]; const float ms = wave_sum(x * x) * (1.0f / 64.0f);
            const float y = x * (1.0f / sqrtf(ms + EPS)) * qg; const float oth = __shfl_xor(y, 32);
            const float yr = lane < 32 ? y * cv - oth * sv : y * cv + oth * sv;
            QP[(size_t)r * 512 + 64 * h + lane] = (bf16)f2bf(y); QR[(size_t)r * 512 + 64 * h + lane] = (bf16)f2bf(yr); }
#pragma unroll
        for (int j = 0; j < 6; ++j)
#pragma unroll
            for (int kvh = 0; kvh < 2; ++kvh) {
                float x = z[OFF_KV + 128 * j + 64 * kvh + lane];
                if ((j & 1) == 0) { const float ms = wave_sum(x * x) * (1.0f / 64.0f); x = x * (1.0f / sqrtf(ms + EPS)) * (j == 0 ? kg0 : (j == 2 ? kg1 : kg2));
                    if (j >= 2) { const float oth = __shfl_xor(x, 32); x = lane < 32 ? x * cv - oth * sv : x * cv + oth * sv; } }
                const int cc = kvh * 64 + lane;
                if (j < 4) { const size_t po = (j == 0 ? O_PCK : j == 1 ? O_PCV : j == 2 ? O_PSK : O_PSV), so = (j == 0 ? O_SCK : j == 1 ? O_SCV : j == 2 ? O_SSK : O_SSV);
                    if (smp) out[so + (size_t)rs_ * 128 + cc] = x; else out[po + (size_t)r * 128 + cc] = x; }
                else { if (smp) out[(j == 4 ? O_SWK : O_SWV) + (size_t)(sb * 512 + 504 + si) * 128 + cc] = x;
                       else { (j == 4 ? KWIN : VWIN)[(size_t)r * 128 + cc] = x; if (t >= 7680) out[(j == 4 ? O_PWK : O_PWV) + (size_t)(b * 512 + t - 7680) * 128 + cc] = x; } }
            }
        if (lane < 24) BG[(size_t)r * 24 + lane] = sigm(z[OFF_NG + lane]);
#pragma unroll 8
        for (int i = 0; i < 32; ++i) { const int c = lane + 64 * i; const float v = sigm(z[OFF_MG + c]);
            if (i < 16) GC[(size_t)r * 1024 + c] = (bf16)f2bf(v); else GN[(size_t)r * 1024 + c - 1024] = (bf16)f2bf(v); }
    }
}

__device__ __forceinline__ void phase_conv(const Args& a, LAS unsigned char* lds, int gw, int NGW, int wave, int lane) {
    unsigned char* ws = a.ws;
    const bf16* U = (const bf16*)(ws + WS_U); bf16* CACT = (bf16*)(ws + WS_CACT);
    const float* wdw = a.in[18]; const int c0 = lane * 8;
    float bdw[8], lg[8], lb[8];
#pragma unroll
    for (int i = 0; i < 8; ++i) { bdw[i] = a.in[19][c0 + i]; lg[i] = a.in[20][c0 + i]; lb[i] = a.in[21][c0 + i]; }
    for (int r = gw; r < MT; r += NGW) {
        const bool smp = r >= MP; const int rs_ = r - MP, sb = rs_ >> 3, si = rs_ & 7, t = r & 8191;
        float acc[8];
#pragma unroll
        for (int i = 0; i < 8; ++i) acc[i] = bdw[i];
        for (int j = 0; j < 31; ++j) {
            float x[8]; bool have = true;
            if (smp) { const int e = si + j;
                if (e < 30) { const f32x4 p0 = *(const f32x4*)(a.in[8] + (size_t)(sb * 30 + e) * 512 + c0), p1 = *(const f32x4*)(a.in[8] + (size_t)(sb * 30 + e) * 512 + c0 + 4);
                    x[0] = p0.x; x[1] = p0.y; x[2] = p0.z; x[3] = p0.w; x[4] = p1.x; x[5] = p1.y; x[6] = p1.z; x[7] = p1.w; }
                else { const v4u p = *(const v4u*)(U + (size_t)(MP + sb * 8 + e - 30) * 512 + c0);
                    x[0] = pg8::bf_lo(p.x); x[1] = pg8::bf_hi(p.x); x[2] = pg8::bf_lo(p.y); x[3] = pg8::bf_hi(p.y); x[4] = pg8::bf_lo(p.z); x[5] = pg8::bf_hi(p.z); x[6] = pg8::bf_lo(p.w); x[7] = pg8::bf_hi(p.w); } }
            else { const int tt = t - 30 + j;
                if (tt >= 0) { const v4u p = *(const v4u*)(U + (size_t)(r - 30 + j) * 512 + c0);
                    x[0] = pg8::bf_lo(p.x); x[1] = pg8::bf_hi(p.x); x[2] = pg8::bf_lo(p.y); x[3] = pg8::bf_hi(p.y); x[4] = pg8::bf_lo(p.z); x[5] = pg8::bf_hi(p.z); x[6] = pg8::bf_lo(p.w); x[7] = pg8::bf_hi(p.w); }
                else have = false; }
            if (have) { const f32x4 w0 = *(const f32x4*)(wdw + j * 512 + c0), w1 = *(const f32x4*)(wdw + j * 512 + c0 + 4);
                acc[0] += x[0] * w0.x; acc[1] += x[1] * w0.y; acc[2] += x[2] * w0.z; acc[3] += x[3] * w0.w; acc[4] += x[4] * w1.x; acc[5] += x[5] * w1.y; acc[6] += x[6] * w1.z; acc[7] += x[7] * w1.w; }
        }
        float s = 0.f;
#pragma unroll
        for (int i = 0; i < 8; ++i) s += acc[i];
        const float mean = wave_sum(s) * (1.0f / 512.0f); float q = 0.f;
#pragma unroll
        for (int i = 0; i < 8; ++i) { acc[i] -= mean; q += acc[i] * acc[i]; }
        const float rstd = 1.0f / sqrtf(wave_sum(q) * (1.0f / 512.0f) + EPS);
        float y[8];
#pragma unroll
        for (int i = 0; i < 8; ++i) { const float v = acc[i] * rstd * lg[i] + lb[i]; y[i] = v * sigm(v); }
        v4u o; o.x = pk2(y[0], y[1]); o.y = pk2(y[2], y[3]); o.z = pk2(y[4], y[5]); o.w = pk2(y[6], y[7]);
        *(v4u*)(CACT + (size_t)r * 512 + c0) = o;
    }
    LAS float* scr = (LAS float*)(lds + wave * 16384);
    for (int it = gw; it < 1024 + 64; it += NGW) {
        if (it < 1024) { const int kv = it & 1, n = (it >> 1) & 127, b = it >> 8;
            const float* rows = a.out + (kv ? O_PCV : O_PCK) + (size_t)(b * 8192 + 64 * n) * 128;
            float* dst = (float*)(ws + (kv ? WS_VC : WS_KC)) + kc_off(b) + (size_t)n * 128;
            compress_block(rows, 64, kv ? a.in[25] : a.in[23], kv ? a.in[26] : a.in[24], dst, scr, lane); }
        else { const int i2 = it - 1024, kv = i2 & 1, sb = i2 >> 1;
            const float* rows = a.out + (kv ? O_SCV : O_SCK) + (size_t)(sb * 8) * 128;
            float* dst = (float*)(ws + (kv ? WS_VC : WS_KC)) + kc_off(4 + sb) + (size_t)256 * 128;
            compress_block(rows, 8, kv ? a.in[25] : a.in[23], kv ? a.in[26] : a.in[24], dst, scr, lane); }
    }
}

struct KeySrc {
    bool smp; int b, sb, kvh; const int* ptab;
    const float *pselk, *pselv, *cselk, *cselv, *sselk, *sselv;
    const float *pwink, *pwinv, *cwink, *cwinv, *swink, *swinv;
};
__device__ __forceinline__ void attn_item(const Args& a, int r, int kvh, LAS float* scr, int lane) {
    unsigned char* ws = a.ws; float* out = a.out;
    const bool smp = r >= MP; const int rs_ = r - MP, sb = rs_ >> 3, si = rs_ & 7, b = r >> 13;
    const int seq = smp ? 4 + sb : b, qpos = smp ? 16384 + si : (r & 8191), cur = qpos >> 6, NB = smp ? 257 : 128;
    LAS float* s_qp = scr;
    LAS float* s_qr = scr + 256;
    LAS float* s_p = scr + 512;
    const bf16* QP = (const bf16*)(ws + WS_QP) + (size_t)r * 512 + kvh * 256; const bf16* QR = (const bf16*)(ws + WS_QR) + (size_t)r * 512 + kvh * 256;
    float qn2[4];
#pragma unroll
    for (int g = 0; g < 4; ++g) { const float x = bf2f(QP[g * 64 + lane]), y = bf2f(QR[g * 64 + lane]); s_qp[lane * 4 + g] = x; s_qr[lane * 4 + g] = y; qn2[g] = wave_sum(y * y); }
    const float gks = wave_max(fabsf(a.in[17][64 + lane])), gkw = wave_max(fabsf(a.in[17][128 + lane]));
    float mref_s[4], mref_w[4];
#pragma unroll
    for (int g = 0; g < 4; ++g) { const float qn = sqrtf(qn2[g]); mref_s[g] = qn * gks; mref_w[g] = qn * gkw; }
    LDS_WAIT(); asm volatile("" ::: "memory");
    const float* KC = (const float*)(ws + WS_KC) + kc_off(seq) + kvh * 64; const float* VC = (const float*)(ws + WS_VC) + kc_off(seq) + kvh * 64;
    const int n_ok = (qpos + 1) >> 6;
    float sc[5][4];
#pragma unroll
    for (int c = 0; c < 5; ++c) { const int n = lane + 64 * c;
#pragma unroll
        for (int g = 0; g < 4; ++g) sc[c][g] = 0.f;
        if (n < n_ok && n < NB) { const f32x4* kr = (const f32x4*)(KC + (size_t)n * 128);
#pragma unroll 4
            for (int d4 = 0; d4 < 16; ++d4) { const f32x4 k = kr[d4];
                const f32x4 q0 = *(const LAS f32x4*)(s_qp + (4 * d4 + 0) * 4), q1 = *(const LAS f32x4*)(s_qp + (4 * d4 + 1) * 4), q2 = *(const LAS f32x4*)(s_qp + (4 * d4 + 2) * 4), q3 = *(const LAS f32x4*)(s_qp + (4 * d4 + 3) * 4);
#pragma unroll
                for (int g = 0; g < 4; ++g) sc[c][g] += k.x * q0[g] + k.y * q1[g] + k.z * q2[g] + k.w * q3[g]; } } }
    float imp[5];
#pragma unroll
    for (int c = 0; c < 5; ++c) imp[c] = 0.f;
#pragma unroll
    for (int g = 0; g < 4; ++g) {
        float m = -INFINITY;
#pragma unroll
        for (int c = 0; c < 5; ++c) { const int n = lane + 64 * c; if (n < n_ok && n < NB) m = fmaxf(m, sc[c][g] * 0.125f); }
        m = wave_max(m); if (!(m > -INFINITY)) m = 0.f;
        float e[5], zs = 0.f;
#pragma unroll
        for (int c = 0; c < 5; ++c) { const int n = lane + 64 * c; e[c] = (n < n_ok && n < NB) ? __expf(sc[c][g] * 0.125f - m) : 0.f; zs += e[c]; }
        zs = wave_sum(zs); const float iz = 1.0f / fmaxf(zs, 1e-30f);
#pragma unroll
        for (int c = 0; c < 5; ++c) { const int n = lane + 64 * c; const float p = e[c] * iz; imp[c] += p; if (n < NB) s_p[n * 4 + g] = p; }
    }
    LDS_WAIT(); asm volatile("" ::: "memory");
    float o_cmp[4] = {0.f, 0.f, 0.f, 0.f};
    { const int nn = n_ok < NB ? n_ok : NB;
      for (int n = 0; n < nn; ++n) { const float v = VC[(size_t)n * 128 + lane]; const f32x4 p = *(const LAS f32x4*)(s_p + n * 4);
#pragma unroll
          for (int g = 0; g < 4; ++g) o_cmp[g] += p[g] * v; } }
    LDS_WAIT(); asm volatile("" ::: "memory");
    float score[5];
#pragma unroll
    for (int c = 0; c < 5; ++c) { const int n = lane + 64 * c;
        const bool forced = (n == 0) || (n == cur) || (n == cur - 1);
        score[c] = (n >= NB) ? -4.0f : (n <= cur ? imp[c] + (forced ? 8.0f : 0.f) : -1.0f); }
    const int* ptab = (const int*)a.in[9] + sb * 128;
    float l_sel[4] = {0.f, 0.f, 0.f, 0.f}, o_sel[4] = {0.f, 0.f, 0.f, 0.f};
    for (int round = 0; round < 16; ++round) {
        float bv = score[0]; int bi = lane;
#pragma unroll
        for (int c = 1; c < 5; ++c) if (score[c] > bv) { bv = score[c]; bi = lane + 64 * c; }
#pragma unroll
        for (int o = 1; o < 64; o <<= 1) { const float ov = __shfl_xor(bv, o); const int oi = __shfl_xor(bi, o); if (ov > bv || (ov == bv && oi < bi)) { bv = ov; bi = oi; } }
        const int n = __builtin_amdgcn_readfirstlane(bi);
#pragma unroll
        for (int c = 0; c < 5; ++c) if (n == lane + 64 * c) score[c] = -3.0f;
        if (n > cur) continue;
        const float* kb; const float* vb; int nvalid;
        if (!smp) { kb = out + O_PSK + (size_t)(b * 8192 + 64 * n) * 128; vb = out + O_PSV + (size_t)(b * 8192 + 64 * n) * 128; }
        else if (n < 256) { const int page = ptab[n >> 1]; const size_t ro = ((size_t)page * 128 + (n & 1) * 64) * 128; kb = a.in[4] + ro; vb = a.in[5] + ro; }
        else { kb = out + O_SSK + (size_t)(sb * 8) * 128; vb = out + O_SSV + (size_t)(sb * 8) * 128; }
        nvalid = qpos - 64 * n + 1; if (nvalid > 64) nvalid = 64;
        const bool valid = lane < nvalid;
        float s4[4] = {0.f, 0.f, 0.f, 0.f};
        { const f32x4* kr = (const f32x4*)(kb + (size_t)(valid ? lane : 0) * 128 + kvh * 64);
#pragma unroll 4
          for (int d4 = 0; d4 < 16; ++d4) { const f32x4 k = kr[d4];
              const f32x4 q0 = *(const LAS f32x4*)(s_qr + (4 * d4 + 0) * 4), q1 = *(const LAS f32x4*)(s_qr + (4 * d4 + 1) * 4), q2 = *(const LAS f32x4*)(s_qr + (4 * d4 + 2) * 4), q3 = *(const LAS f32x4*)(s_qr + (4 * d4 + 3) * 4);
#pragma unroll
              for (int g = 0; g < 4; ++g) s4[g] += k.x * q0[g] + k.y * q1[g] + k.z * q2[g] + k.w * q3[g]; } }
        f32x4 pv4;
#pragma unroll
        for (int g = 0; g < 4; ++g) { const float p = valid ? __expf(s4[g] * 0.125f - mref_s[g]) : 0.f; l_sel[g] += p; pv4[g] = p; }
        *(LAS f32x4*)(s_p + lane * 4) = pv4;
        LDS_WAIT(); asm volatile("" ::: "memory");
        for (int j = 0; j < nvalid; ++j) { const float v = vb[(size_t)j * 128 + kvh * 64 + lane]; const f32x4 p = *(const LAS f32x4*)(s_p + j * 4);
#pragma unroll
            for (int g = 0; g < 4; ++g) o_sel[g] += p[g] * v; }
        LDS_WAIT(); asm volatile("" ::: "memory");
    }
    float l_win[4] = {0.f, 0.f, 0.f, 0.f}, o_win[4] = {0.f, 0.f, 0.f, 0.f};
    { const int lo = qpos - 511 > 0 ? qpos - 511 : 0; const int cnt = qpos - lo + 1;
      for (int c0 = 0; c0 < cnt; c0 += 64) {
          const int nvalid = cnt - c0 < 64 ? cnt - c0 : 64; const bool valid = lane < nvalid; const int kpos = lo + c0 + (valid ? lane : 0);
          const float* kr_;
          if (!smp) kr_ = (const float*)(ws + WS_KWIN) + (size_t)(b * 8192 + kpos) * 128;
          else if (kpos >= 16384) kr_ = out + O_SWK + (size_t)(sb * 512 + 504 + kpos - 16384) * 128;
          else kr_ = a.in[6] + (size_t)(sb * 512 + kpos - 15872) * 128;
          float s4[4] = {0.f, 0.f, 0.f, 0.f};
          { const f32x4* kr = (const f32x4*)(kr_ + kvh * 64);
#pragma unroll 4
            for (int d4 = 0; d4 < 16; ++d4) { const f32x4 k = kr[d4];
                const f32x4 q0 = *(const LAS f32x4*)(s_qr + (4 * d4 + 0) * 4), q1 = *(const LAS f32x4*)(s_qr + (4 * d4 + 1) * 4), q2 = *(const LAS f32x4*)(s_qr + (4 * d4 + 2) * 4), q3 = *(const LAS f32x4*)(s_qr + (4 * d4 + 3) * 4);
#pragma unroll
                for (int g = 0; g < 4; ++g) s4[g] += k.x * q0[g] + k.y * q1[g] + k.z * q2[g] + k.w * q3[g]; } }
          f32x4 pv4;
#pragma unroll
          for (int g = 0; g < 4; ++g) { const float p = valid ? __expf(s4[g] * 0.125f - mref_w[g]) : 0.f; l_win[g] += p; pv4[g] = p; }
          *(LAS f32x4*)(s_p + lane * 4) = pv4;
          LDS_WAIT(); asm volatile("" ::: "memory");
          for (int j = 0; j < nvalid; ++j) { const int kp = lo + c0 + j; const float* vr;
              if (!smp) vr = (const float*)(ws + WS_VWIN) + (size_t)(b * 8192 + kp) * 128;
              else if (kp >= 16384) vr = out + O_SWV + (size_t)(sb * 512 + 504 + kp - 16384) * 128;
              else vr = a.in[7] + (size_t)(sb * 512 + kp - 15872) * 128;
              const float v = vr[kvh * 64 + lane]; const f32x4 p = *(const LAS f32x4*)(s_p + j * 4);
#pragma unroll
              for (int g = 0; g < 4; ++g) o_win[g] += p[g] * v; }
          LDS_WAIT(); asm volatile("" ::: "memory");
      } }
    const float* BG = (const float*)(ws + WS_BG) + (size_t)r * 24 + kvh * 12;
    bf16* O = (bf16*)(ws + WS_O) + (size_t)r * 512 + kvh * 256;
#pragma unroll
    for (int g = 0; g < 4; ++g) { const float ls = fmaxf(wave_sum(l_sel[g]), 1e-30f), lw = fmaxf(wave_sum(l_win[g]), 1e-30f);
        const float o = BG[g * 3 + 0] * o_cmp[g] + BG[g * 3 + 1] * (o_sel[g] / ls) + BG[g * 3 + 2] * (o_win[g] / lw);
        O[g * 64 + lane] = (bf16)f2bf(o); }
    LDS_WAIT(); asm volatile("" ::: "memory");
}
__device__ __forceinline__ void phase_attn(const Args& a, LAS unsigned char* lds, int gw, int NGW, int wave, int lane) {
    LAS float* scr = (LAS float*)(lds + wave * 16384);
    for (int it = gw; it < 2 * MT; it += NGW) { const int idx = it < 2 * MS ? 2 * MP + it : it - 2 * MS; attn_item(a, idx >> 1, idx & 1, scr, lane); }
}

constexpr int N_PHASES = 12;
#ifndef ONE_LAUNCH
#define ONE_LAUNCH 0
#endif
__global__ void __launch_bounds__(NWAVES * 64, 2) fwd(Args args) {
    extern __shared__ __attribute__((aligned(16))) unsigned char lds_raw[];
    LAS unsigned char* lds = (LAS unsigned char*)lds_raw;
    const int tid = threadIdx.x, lane = tid & 63, wave = __builtin_amdgcn_readfirstlane(tid >> 6);
    const int G = gridDim.x, bx = blockIdx.x;
    const int vcu = (G % 8 == 0) ? (bx % 8) * (G / 8) + bx / 8 : bx;
    const int gw = vcu * NWAVES + wave, NGW = G * NWAVES;
    unsigned char* ws = args.ws;
    for (int u = tid; u < (LDS_BYTES - RING_BYTES) / 4; u += NWAVES * 64) ((LAS unsigned*)(lds + RING_BYTES))[u] = 0u;
    __syncthreads();
    XcdBarrier bar; bar.bar = (unsigned*)(ws + WS_CTL) + CW_BAR; bar.x = 0; bar.st = nullptr;
    if (ONE_LAUNCH) bar = xcd_barrier_post((unsigned*)(ws + WS_CTL) + CW_BAR, (volatile LAS unsigned*)(lds + MISC_OFF) + 8);
    const int lo = args.ph_lo, hi = args.ph_hi;
#define IN(k) (lo <= (k) && (k) < hi)
#define SEAM(k) do { if (ONE_LAUNCH && IN(k) && IN((k) + 1)) xcd_barrier(bar); } while (0)
    const float* modp = (const float*)(ws + WS_MOD);
    if (IN(0)) { phase0(args, lds, gw, NGW, wave, lane); } SEAM(0);
    if (IN(1)) { norm_rows(args.in[0], args.in[1], args.in[14], modp, 0, 1024, (bf16*)(ws + WS_H), gw, NGW, lane); } SEAM(1);
    if (IN(2)) { pg8::Gemm g{(const bf16*)(ws + WS_H), (const bf16*)(ws + WS_WIN), MT, DINP, 1024}; pg8::StaticOrder S; S.init(MT, DINP, G, bx);
        pg8::EpiF32 E{(float*)(ws + WS_Z), DINP};
        pg8::gemm_phase<pg8::EpiF32, pg8::StaticOrder, true, true>(lds, g, S, E); } SEAM(2);
    if (IN(3)) { phase_post(args, gw, NGW, lane); } SEAM(3);
    if (IN(4)) { phase_conv(args, lds, gw, NGW, wave, lane); } SEAM(4);
    if (IN(5)) { pg8::Gemm g{(const bf16*)(ws + WS_CACT), (const bf16*)(ws + WS_WPW2), MT, 1024, 512}; pg8::StaticOrder S; S.init(MT, 1024, G, bx);
        pg8::EpiGate<false> E{(bf16*)(ws + WS_T1), (const bf16*)(ws + WS_GC), 1024};
        pg8::gemm_phase<pg8::EpiGate<false>, pg8::StaticOrder, true, true>(lds, g, S, E); } SEAM(5);
    if (IN(6)) { phase_attn(args, lds, gw, NGW, wave, lane); } SEAM(6);
    if (IN(7)) { pg8::Gemm g{(const bf16*)(ws + WS_O), (const bf16*)(ws + WS_WNSA), MT, 1024, 512}; pg8::StaticOrder S; S.init(MT, 1024, G, bx);
        pg8::EpiGate<true> E{(bf16*)(ws + WS_T1), (const bf16*)(ws + WS_GN), 1024};
        pg8::gemm_phase<pg8::EpiGate<true>, pg8::StaticOrder, true, true>(lds, g, S, E); } SEAM(7);
    if (IN(8)) { pg8::Gemm g{(const bf16*)(ws + WS_T1), (const bf16*)(ws + WS_WOUT), MT, 1024, 1024}; pg8::StaticOrder S; S.init(MT, 1024, G, bx);
        pg8::EpiResGate E{args.in[0], args.in[1], args.out, modp + 2048};
        pg8::gemm_phase<pg8::EpiResGate, pg8::StaticOrder, true, true>(lds, g, S, E); } SEAM(8);
    if (IN(9)) { norm_rows(args.out, args.out + (size_t)MP * 1024, args.in[29], modp, 3072, 4096, (bf16*)(ws + WS_H), gw, NGW, lane); } SEAM(9);
    if (IN(10)) { pg8::Gemm g{(const bf16*)(ws + WS_H), (const bf16*)(ws + WS_WGU), MT, 2 * DFF, 1024}; pg8::StaticOrder S; S.init(MT, 2 * DFF, G, bx);
        pg8::EpiSwiGlu E{(bf16*)(ws + WS_ACT), DFF};
        pg8::gemm_phase<pg8::EpiSwiGlu, pg8::StaticOrder, true, true>(lds, g, S, E); } SEAM(10);
    if (IN(11)) { pg8::Gemm g{(const bf16*)(ws + WS_ACT), (const bf16*)(ws + WS_WDOWN), MT, 1024, DFF}; pg8::StaticOrder S; S.init(MT, 1024, G, bx);
        pg8::EpiResGate E{args.out, args.out + (size_t)MP * 1024, args.out, modp + 5120};
        pg8::gemm_phase<pg8::EpiResGate, pg8::StaticOrder, true, true>(lds, g, S, E); }
#undef IN
#undef SEAM
}

extern "C" void kernel_launch(void* const* d_in, const int* in_sizes, int n_in, void* d_out, int out_size, void* d_ws, size_t ws_size, hipStream_t stream) {
    static int grid = 0;
    if (grid == 0) {
        if (n_in != 33 || (size_t)out_size != O_END || ws_size < WS_END) { fprintf(stderr, "kernel_launch: unexpected shapes (n_in %d out %d ws %zu)\n", n_in, out_size, ws_size); grid = -1; return; }
        int dev = 0, cus = 0, per_cu = 0;
        if (hipGetDevice(&dev) != hipSuccess || hipDeviceGetAttribute(&cus, hipDeviceAttributeMultiprocessorCount, dev) != hipSuccess) { grid = -1; return; }
        if (hipFuncSetAttribute((const void*)fwd, hipFuncAttributeMaxDynamicSharedMemorySize, LDS_BYTES) != hipSuccess) { fprintf(stderr, "kernel_launch: hipFuncSetAttribute failed\n"); grid = -1; return; }
        if (hipOccupancyMaxActiveBlocksPerMultiprocessor(&per_cu, (const void*)fwd, NWAVES * 64, LDS_BYTES) != hipSuccess || per_cu < 1) fprintf(stderr, "kernel_launch: occupancy query says %d\n", per_cu);
        (void)hipGetLastError();
        grid = cus;
    }
    if (grid < 0) return;
    (void)hipMemsetAsync((char*)d_ws, 0, ZERO_BYTES, stream);
    Args a{};
    for (int i = 0; i < 33; ++i) a.in[i] = (const float*)d_in[i];
    a.out = (float*)d_out; a.ws = (unsigned char*)d_ws;
#if ONE_LAUNCH
    a.ph_lo = 0; a.ph_hi = N_PHASES;
    hipLaunchKernelGGL(fwd, dim3(grid), dim3(NWAVES * 64), LDS_BYTES, stream, a);
#else
    for (int p = 0; p < N_PHASES; ++p) { a.ph_lo = p; a.ph_hi = p + 1; hipLaunchKernelGGL(fwd, dim3(grid), dim3(NWAVES * 64), LDS_BYTES, stream, a); }
#endif
}
```

```cpp
#include <hip/hip_runtime.h>
#include <cstdio>
#include <cstdint>
#include <cmath>
#ifndef PROBE_ATTN
#define PROBE_ATTN 0
#endif
namespace pg8 {
#define PG8_LAS __attribute__((address_space(3)))
typedef unsigned short bf16_t;
typedef short bf16x8 __attribute__((ext_vector_type(8)));
typedef float f32x4 __attribute__((ext_vector_type(4)));
typedef unsigned u32x4 __attribute__((ext_vector_type(4)));
constexpr int BM = 256, BK = 64, HALF = 128, HTB = HALF * BK * 2  , STAGE_BYTES = 8 * HTB, NXCD = 8, WGM = 8;

__host__ __device__ __forceinline__ int lds_byte(int r, int c) { const int st = (r >> 4) * 2 + (c >> 5), rr = r & 15, cc = c & 31, ob = rr * 64 + cc * 2; return st * 1024 + (ob ^ (((ob >> 9) & 1) << 5)); }
__host__ __device__ __forceinline__ void stage_rc(int b, int& R, int& C) { const int st = b / 1024, sb = b % 1024, swz = sb ^ (((sb >> 9) & 1) << 5); R = (st >> 1) * 16 + swz / 64; C = (st & 1) * 32 + (swz % 64) / 2; }
__host__ __device__ __forceinline__ int perm32(int rho) { const int n = rho >> 4, i = rho & 15; return 8 * (i >> 2) + 4 * n + (i & 3); }

struct Unit { int pm, pn; };
struct Gemm { const bf16_t* A; const bf16_t* Bt; int M, N, K; };

struct StaticOrder {
    int nM, nN, nwg, G, c;
    __host__ __device__ void init(int M, int N, int G_, int c_) { nM = M / BM; nN = N / BM; nwg = nM * nN; G = G_; c = c_; }
    __host__ __device__ bool next(int i, Unit& u) const {
        const long L = (long)i * G + c; if (L >= nwg) return false;
        int wgid = (int)L; { const int q = nwg / NXCD, r = nwg % NXCD, xcd = wgid % NXCD, off = wgid / NXCD; wgid = (xcd < r ? xcd * (q + 1) : r * (q + 1) + (xcd - r) * q) + off; }
        const int nig = WGM * nN, gid = wgid / nig, fm = gid * WGM, gsz = (nM - fm) < WGM ? (nM - fm) : WGM;
        u.pm = fm + ((wgid % nig) % gsz); u.pn = (wgid % nig) / gsz; return true;
    }
    __device__ __forceinline__ void a_ready(const Unit&) const {}
    __device__ __forceinline__ void done(const Unit&) const {}
};

typedef float f32x2_cv __attribute__((ext_vector_type(2))); typedef __bf16 bf16x2_cv __attribute__((ext_vector_type(2)));
__device__ __forceinline__ unsigned cvt_pk_bf16(float lo, float hi) { f32x2_cv v = {lo, hi}; bf16x2_cv b = __builtin_convertvector(v, bf16x2_cv); return __builtin_bit_cast(unsigned, b); }
typedef float f32x2 __attribute__((ext_vector_type(2)));

constexpr int ROWS_P = 32768;
__device__ __forceinline__ int mod_row(int r) { return r < ROWS_P ? (r >> 13) : 4 + ((r - ROWS_P) >> 3); }
__device__ __forceinline__ float bf_lo(unsigned w) { return __uint_as_float(w << 16); }
__device__ __forceinline__ float bf_hi(unsigned w) { return __uint_as_float(w & 0xffff0000u); }
__device__ __forceinline__ float sigmoid_f(float x) { return __builtin_amdgcn_rcpf(1.0f + __builtin_amdgcn_exp2f(-1.4426950408889634f * x)); }

struct EpiF32 {
    static constexpr bool PERM = false, AFTER_DRAIN = false;
    float* C; int ldc;
    __device__ __forceinline__ void operator()(const f32x4 (&acc)[2][2][4][2], const Unit& u, int wr, int wc, int fr, int fq) const {
        const int row0 = u.pm * BM + wr * 64 + fr, col0 = u.pn * BM + wc * 32 + 4 * fq;
#pragma unroll
        for (int ai = 0; ai < 2; ++ai)
#pragma unroll
            for (int m = 0; m < 4; ++m) { float* rowp = C + (size_t)(row0 + ai * HALF + m * 16) * ldc + col0;
#pragma unroll
                for (int bj = 0; bj < 2; ++bj)
#pragma unroll
                    for (int n = 0; n < 2; ++n) *(f32x4*)(rowp + bj * HALF + n * 16) = acc[ai][bj][m][n]; }
    }
};
template <bool ADD> struct EpiGate {
    static constexpr bool PERM = true, AFTER_DRAIN = false;
    bf16_t* O; const bf16_t* G; int ldc;
    __device__ __forceinline__ void operator()(const f32x4 (&acc)[2][2][4][2], const Unit& u, int wr, int wc, int fr, int fq) const {
        const int row0 = u.pm * BM + wr * 64 + fr, col0 = u.pn * BM + wc * 32 + 8 * fq;
#pragma unroll
        for (int ai = 0; ai < 2; ++ai)
#pragma unroll
            for (int m = 0; m < 4; ++m) { const size_t ro = (size_t)(row0 + ai * HALF + m * 16) * ldc + col0;
#pragma unroll
                for (int bj = 0; bj < 2; ++bj) {
                    const u32x4 g = *(const u32x4*)(G + ro + bj * HALF);
                    f32x4 v0 = acc[ai][bj][m][0], v1 = acc[ai][bj][m][1];
                    v0[0] *= bf_lo(g.x); v0[1] *= bf_hi(g.x); v0[2] *= bf_lo(g.y); v0[3] *= bf_hi(g.y);
                    v1[0] *= bf_lo(g.z); v1[1] *= bf_hi(g.z); v1[2] *= bf_lo(g.w); v1[3] *= bf_hi(g.w);
                    if (ADD) { const u32x4 t = *(const u32x4*)(O + ro + bj * HALF);
                        v0[0] += bf_lo(t.x); v0[1] += bf_hi(t.x); v0[2] += bf_lo(t.y); v0[3] += bf_hi(t.y);
                        v1[0] += bf_lo(t.z); v1[1] += bf_hi(t.z); v1[2] += bf_lo(t.w); v1[3] += bf_hi(t.w); }
                    u32x4 w; w.x = cvt_pk_bf16(v0[0], v0[1]); w.y = cvt_pk_bf16(v0[2], v0[3]); w.z = cvt_pk_bf16(v1[0], v1[1]); w.w = cvt_pk_bf16(v1[2], v1[3]);
                    *(u32x4*)(O + ro + bj * HALF) = w; } }
    }
};
struct EpiResGate {
    static constexpr bool PERM = false, AFTER_DRAIN = false;
    const float* bp; const float* bs; float* out; const float* modg;
    __device__ __forceinline__ void operator()(const f32x4 (&acc)[2][2][4][2], const Unit& u, int wr, int wc, int fr, int fq) const {
        const int row0 = u.pm * BM + wr * 64 + fr, col0 = u.pn * BM + wc * 32 + 4 * fq;
        const float* g = modg + (size_t)mod_row(u.pm * BM) * 6144 + col0;
        f32x4 gv[2][2];
#pragma unroll
        for (int bj = 0; bj < 2; ++bj)
#pragma unroll
            for (int n = 0; n < 2; ++n) gv[bj][n] = *(const f32x4*)(g + bj * HALF + n * 16);
#pragma unroll
        for (int ai = 0; ai < 2; ++ai)
#pragma unroll
            for (int m = 0; m < 4; ++m) { const int r = row0 + ai * HALF + m * 16;
                const float* b = (r < ROWS_P ? bp + (size_t)r * 1024 : bs + (size_t)(r - ROWS_P) * 1024) + col0; float* o = out + (size_t)r * 1024 + col0;
#pragma unroll
                for (int bj = 0; bj < 2; ++bj)
#pragma unroll
                    for (int n = 0; n < 2; ++n) { const f32x4 bv = *(const f32x4*)(b + bj * HALF + n * 16);
                        *(f32x4*)(o + bj * HALF + n * 16) = bv + gv[bj][n] * acc[ai][bj][m][n]; } }
    }
};
struct EpiSwiGlu {
    static constexpr bool PERM = true, AFTER_DRAIN = false;
    bf16_t* O; int ldo;
    __device__ __forceinline__ void operator()(const f32x4 (&acc)[2][2][4][2], const Unit& u, int wr, int wc, int fr, int fq) const {
        const int row0 = u.pm * BM + wr * 64 + fr, oc0 = u.pn * 128 + wc * 16 + 4 * fq;
        typedef unsigned u32x2 __attribute__((ext_vector_type(2)));
#pragma unroll
        for (int ai = 0; ai < 2; ++ai)
#pragma unroll
            for (int m = 0; m < 4; ++m) { bf16_t* rowp = O + (size_t)(row0 + ai * HALF + m * 16) * ldo + oc0;
#pragma unroll
                for (int bj = 0; bj < 2; ++bj) { const f32x4 gt = acc[ai][bj][m][0], up = acc[ai][bj][m][1]; f32x4 a;
#pragma unroll
                    for (int i = 0; i < 4; ++i) a[i] = gt[i] * sigmoid_f(gt[i]) * up[i];
                    u32x2 w; w.x = cvt_pk_bf16(a[0], a[1]); w.y = cvt_pk_bf16(a[2], a[3]);
                    *(u32x2*)(rowp + bj * 64) = w; } }
    }
};

struct EpiFront {
    static constexpr bool PERM = false, AFTER_DRAIN = false;
    float* out; unsigned char* ws; const float* qg; const float* kng; const float* rc; const float* rsn;
    size_t o_pck, o_sck, o_pwk, o_swk, o_pconv, o_sconv;
    size_t w_u, w_qp, w_qr, w_gc, w_gn, w_bg, w_ksb, w_vst, w_kwb, w_vwt, w_kwin, w_vwin;
    float c2;
    __device__ __forceinline__ void operator()(const f32x4 (&acc)[2][2][4][2], const Unit& u, int wr, int wc, int fr, int fq) const {
        typedef unsigned u32x2 __attribute__((ext_vector_type(2)));
        const int pn = u.pn; const bool smp = u.pm >= 128;
        const int row0 = u.pm * BM + wr * 64 + fr;
        if (pn < 4) {
            bf16_t* U = (bf16_t*)(ws + w_u);
#pragma unroll
            for (int ai = 0; ai < 2; ++ai)
#pragma unroll
                for (int m = 0; m < 4; ++m) { const int r = row0 + ai * HALF + m * 16;
#pragma unroll
                    for (int bj = 0; bj < 2; ++bj) { const int ch = 128 * pn + 64 * bj + 16 * wc + 4 * fq; const f32x4 a4 = acc[ai][bj][m][0], b4 = acc[ai][bj][m][1]; f32x4 u4;
#pragma unroll
                        for (int i = 0; i < 4; ++i) u4[i] = a4[i] * sigmoid_f(b4[i]);
                        u32x2 w; w.x = cvt_pk_bf16(u4[0], u4[1]); w.y = cvt_pk_bf16(u4[2], u4[3]); *(u32x2*)(U + (size_t)r * 512 + ch) = w;
                        if (smp) { const int rs_ = r - ROWS_P; *(f32x4*)(out + o_sconv + (size_t)((rs_ >> 3) * 30 + 22 + (rs_ & 7)) * 512 + ch) = u4; }
                        else { const int t = r & 8191; if (t >= 8162) *(f32x4*)(out + o_pconv + (size_t)((r >> 13) * 30 + t - 8162) * 512 + ch) = u4; } } }
        } else if (pn < 9) {
            const bool isq = pn < 6; const int kvt = pn - 6;
            const bool isv = !isq && (wc >= 2); const bool dorope = isq || (!isv && kvt >= 1);
            const float* gp = isq ? qg : kng + kvt * 64;
            f32x4 gn[2][2];
#pragma unroll
            for (int bj = 0; bj < 2; ++bj)
#pragma unroll
                for (int n = 0; n < 2; ++n) gn[bj][n] = isv ? (f32x4){1.f, 1.f, 1.f, 1.f} : *(const f32x4*)(gp + 32 * bj + 16 * n + 4 * fq);
#pragma unroll
            for (int ai = 0; ai < 2; ++ai)
#pragma unroll
                for (int m = 0; m < 4; ++m) { const int r = row0 + ai * HALF + m * 16;
                    f32x4 y[2][2];
#pragma unroll
                    for (int bj = 0; bj < 2; ++bj)
#pragma unroll
                        for (int n = 0; n < 2; ++n) y[bj][n] = acc[ai][bj][m][n];
                    if (!isv) { float ss = 0.f;
#pragma unroll
                        for (int bj = 0; bj < 2; ++bj)
#pragma unroll
                            for (int n = 0; n < 2; ++n) ss += (y[bj][n][0] * y[bj][n][0] + y[bj][n][1] * y[bj][n][1]) + (y[bj][n][2] * y[bj][n][2] + y[bj][n][3] * y[bj][n][3]);
                        ss += __shfl_xor(ss, 16); ss += __shfl_xor(ss, 32);
                        const float rstd = 1.0f / sqrtf(ss * (1.0f / 64.0f) + 1e-6f);
#pragma unroll
                        for (int bj = 0; bj < 2; ++bj)
#pragma unroll
                            for (int n = 0; n < 2; ++n) y[bj][n] = y[bj][n] * rstd * gn[bj][n]; }
                    const int ri = smp ? 8192 + ((r - ROWS_P) & 7) : (r & 8191);
                    f32x4 yr[2][2];
                    if (dorope) {
#pragma unroll
                        for (int n = 0; n < 2; ++n) { const f32x4 c4 = *(const f32x4*)(rc + (size_t)ri * 32 + 16 * n + 4 * fq), s4 = *(const f32x4*)(rsn + (size_t)ri * 32 + 16 * n + 4 * fq);
                            yr[0][n] = y[0][n] * c4 - y[1][n] * s4; yr[1][n] = y[1][n] * c4 + y[0][n] * s4; } }
                    if (isq) { const int h = 4 * (pn - 4) + wc; bf16_t* qp = (bf16_t*)(ws + w_qp) + (size_t)r * 512 + h * 64 + 4 * fq; bf16_t* qr = (bf16_t*)(ws + w_qr) + (size_t)r * 512 + h * 64 + 4 * fq;
#pragma unroll
                        for (int bj = 0; bj < 2; ++bj)
#pragma unroll
                            for (int n = 0; n < 2; ++n) { const f32x4 a4 = y[bj][n] * c2, b4 = yr[bj][n] * c2; u32x2 w;
                                w.x = cvt_pk_bf16(a4[0], a4[1]); w.y = cvt_pk_bf16(a4[2], a4[3]); *(u32x2*)(qp + 32 * bj + 16 * n) = w;
                                w.x = cvt_pk_bf16(b4[0], b4[1]); w.y = cvt_pk_bf16(b4[2], b4[3]); *(u32x2*)(qr + 32 * bj + 16 * n) = w; } }
                    else { const int kvh = wc & 1; const int j = 2 * kvt + (isv ? 1 : 0);
                        float* fo = nullptr;
                        if (smp) { const int rs_ = r - ROWS_P; fo = (j < 4) ? out + o_sck + (size_t)j * 32768 + (size_t)rs_ * 128 : out + o_swk + (size_t)(j - 4) * 2097152 + (size_t)((rs_ >> 3) * 512 + 504 + (rs_ & 7)) * 128; }
                        else { const int t = r & 8191; if (j < 4) fo = out + o_pck + (size_t)j * 4194304 + (size_t)r * 128; else if (t >= 7680) fo = out + o_pwk + (size_t)(j - 4) * 262144 + (size_t)((r >> 13) * 512 + t - 7680) * 128; }
                        if (fo) {
#pragma unroll
                            for (int bj = 0; bj < 2; ++bj)
#pragma unroll
                                for (int n = 0; n < 2; ++n) *(f32x4*)(fo + kvh * 64 + 32 * bj + 16 * n + 4 * fq) = dorope ? yr[bj][n] : y[bj][n]; }
#if defined(PROBE_ATTN) && PROBE_ATTN
                        if (!smp && kvt == 2) { float* kw = (float*)(ws + (isv ? w_vwin : w_kwin)) + (size_t)r * 128 + kvh * 64;
#pragma unroll
                            for (int bj = 0; bj < 2; ++bj)
#pragma unroll
                                for (int n = 0; n < 2; ++n) *(f32x4*)(kw + 32 * bj + 16 * n + 4 * fq) = dorope ? yr[bj][n] : y[bj][n]; }
#endif
                        if (!smp && kvt >= 1) { const int t = r & 8191, key = t & 63; const size_t blk = ((size_t)((r >> 13) * 128 + (t >> 6)) * 2 + kvh) * 4096;
                            if (!isv) { bf16_t* kd = (bf16_t*)(ws + (kvt == 1 ? w_ksb : w_kwb)) + blk + key * 64 + 4 * fq;
#pragma unroll
                                for (int bj = 0; bj < 2; ++bj)
#pragma unroll
                                    for (int n = 0; n < 2; ++n) { u32x2 w; w.x = cvt_pk_bf16(yr[bj][n][0], yr[bj][n][1]); w.y = cvt_pk_bf16(yr[bj][n][2], yr[bj][n][3]); *(u32x2*)(kd + 32 * bj + 16 * n) = w; } }
                            else { const int kp = (key & 32) | (((key >> 2) & 3) << 3) | (((key >> 4) & 1) << 2) | (key & 3);
                                bf16_t* vd = (bf16_t*)(ws + (kvt == 1 ? w_vst : w_vwt)) + blk + kp;
#pragma unroll
                                for (int bj = 0; bj < 2; ++bj)
#pragma unroll
                                    for (int n = 0; n < 2; ++n)
#pragma unroll
                                        for (int i = 0; i < 4; ++i) { const unsigned b2 = cvt_pk_bf16(y[bj][n][i], 0.f); vd[(size_t)(32 * bj + 16 * n + 4 * fq + i) * 64] = (bf16_t)(b2 & 0xffffu); } } }
                    } }
        } else if (pn < 17) {
            bf16_t* G = (bf16_t*)(ws + (pn < 13 ? w_gc : w_gn)); const int cb = 256 * ((pn - 9) & 3) + 32 * wc + 4 * fq;
#pragma unroll
            for (int ai = 0; ai < 2; ++ai)
#pragma unroll
                for (int m = 0; m < 4; ++m) { const int r = row0 + ai * HALF + m * 16;
#pragma unroll
                    for (int bj = 0; bj < 2; ++bj)
#pragma unroll
                        for (int n = 0; n < 2; ++n) { const f32x4 v = acc[ai][bj][m][n]; u32x2 w; w.x = cvt_pk_bf16(sigmoid_f(v[0]), sigmoid_f(v[1])); w.y = cvt_pk_bf16(sigmoid_f(v[2]), sigmoid_f(v[3]));
                            *(u32x2*)(G + (size_t)r * 1024 + cb + 128 * bj + 16 * n) = w; } }
        } else {
            if (wc == 0) { float* BG = (float*)(ws + w_bg);
#pragma unroll
                for (int ai = 0; ai < 2; ++ai)
#pragma unroll
                    for (int m = 0; m < 4; ++m) { const int r = row0 + ai * HALF + m * 16;
#pragma unroll
                        for (int n = 0; n < 2; ++n) { const int c = 16 * n + 4 * fq; if (c < 24) { const f32x4 v = acc[ai][0][m][n]; f32x4 o;
#pragma unroll
                                for (int i = 0; i < 4; ++i) o[i] = sigmoid_f(v[i]);
                                *(f32x4*)(BG + (size_t)r * 24 + c) = o; } } } }
        }
    }
};
template <class Epi, class Sched, bool ALIGN_EPI = false, bool SP2 = false>
__device__ __forceinline__ void gemm_phase(PG8_LAS unsigned char* lds, const Gemm g, const Sched& S, const Epi& E) {
    const int tid = threadIdx.x, wid = __builtin_amdgcn_readfirstlane(tid >> 6), lane = tid & 63, wr = wid >> 2, wc = wid & 3, fr = lane & 15, fq = lane >> 4;
    const int K = g.K, nt = K / BK;
    unsigned voffA[2], voffB[2];
#pragma unroll
    for (int i = 0; i < 2; ++i) { int R, C; stage_rc(tid * 16 + i * 8192, R, C); const int Rb = Epi::PERM ? ((R & ~31) + perm32(R & 31)) : R;
        voffA[i] = (unsigned)(R * K + C) * 2u; voffB[i] = (unsigned)(Rb * K + C) * 2u; }
    const size_t kstep = (size_t)(BK * 2);
    const size_t hstep = (size_t)HALF * K * 2;
    const size_t tstep = 2 * hstep;
    const unsigned ldsw = (unsigned)wid * 1024u;
    const int aoff = lds_byte(wr * 64 + fr, fq * 8), boff = lds_byte(wc * 32 + fr, fq * 8);
#define PG8_SA(b, h) (((b) * 2 + (h)) * HTB)
#define PG8_SB(b, h) ((4 + (b) * 2 + (h)) * HTB)
#define PG8_STAGE(bufoff, gbase, voff) do { _Pragma("unroll") for (int _i = 0; _i < 2; ++_i) \
        __builtin_amdgcn_global_load_lds((const unsigned*)((const char*)(gbase) + (voff)[_i]), (PG8_LAS unsigned*)(lds + (bufoff) + ldsw + _i * 8192), 16, 0, 0); } while (0)
#define PG8_LDA(dst, b, h) do { _Pragma("unroll") for (int m = 0; m < 4; ++m) _Pragma("unroll") for (int k = 0; k < 2; ++k) dst[m][k] = *(const PG8_LAS bf16x8*)(lds + PG8_SA(b, h) + aoff + m * 2048 + k * 1024); } while (0)
#define PG8_LDB(dst, b, h) do { _Pragma("unroll") for (int n = 0; n < 2; ++n) _Pragma("unroll") for (int k = 0; k < 2; ++k) dst[n][k] = *(const PG8_LAS bf16x8*)(lds + PG8_SB(b, h) + boff + n * 2048 + k * 1024); } while (0)
#define PG8_MMA(ai, bj, At, Bt) do { __builtin_amdgcn_s_setprio(1); _Pragma("unroll") for (int m = 0; m < 4; ++m) _Pragma("unroll") for (int n = 0; n < 2; ++n) _Pragma("unroll") for (int k = 0; k < 2; ++k) \
        acc[ai][bj][m][n] = __builtin_amdgcn_mfma_f32_16x16x32_bf16(Bt[n][k], At[m][k], acc[ai][bj][m][n], 0, 0, 0); __builtin_amdgcn_s_setprio(0); } while (0)
#define PG8_WAIT_V(n) asm volatile("s_waitcnt vmcnt(" #n ")" ::: "memory")
#define PG8_WAIT_L(n) asm volatile("s_waitcnt lgkmcnt(" #n ")" ::: "memory")
#define PG8_BAR __builtin_amdgcn_s_barrier()
#define PG8_SCHED __builtin_amdgcn_sched_barrier(0)
    Unit cur, nxt; int ui = 0;
    if (!S.next(0, cur)) return;
    f32x4 acc[2][2][4][2];
#pragma unroll
    for (int a = 0; a < 2; ++a)
#pragma unroll
        for (int b = 0; b < 2; ++b)
#pragma unroll
            for (int m = 0; m < 4; ++m)
#pragma unroll
                for (int n = 0; n < 2; ++n) acc[a][b][m][n] = (f32x4){0.f, 0.f, 0.f, 0.f};
    bf16x8 At[4][2], B0[2][2], B1[2][2];
    const char* cA = (const char*)g.A + (size_t)cur.pm * tstep; const char* cB = (const char*)g.Bt + (size_t)cur.pn * tstep;
    S.a_ready(cur);
    if constexpr (SP2) {
        PG8_STAGE(PG8_SB(0, 0), cB, voffB); PG8_STAGE(PG8_SB(0, 1), cB + hstep, voffB); PG8_STAGE(PG8_SA(0, 0), cA, voffA); PG8_STAGE(PG8_SA(0, 1), cA + hstep, voffA);
        if (wr == 1) PG8_BAR;
        PG8_WAIT_V(2); PG8_BAR;
        PG8_STAGE(PG8_SB(1, 0), cB + kstep, voffB); PG8_STAGE(PG8_SA(1, 0), cA + kstep, voffA); PG8_STAGE(PG8_SB(1, 1), cB + hstep + kstep, voffB);
        PG8_WAIT_V(6); PG8_BAR;
    } else {
        PG8_STAGE(PG8_SB(0, 0), cB, voffB); PG8_STAGE(PG8_SA(0, 0), cA, voffA); PG8_STAGE(PG8_SB(0, 1), cB + hstep, voffB); PG8_STAGE(PG8_SA(0, 1), cA + hstep, voffA);
        if (wr == 1) PG8_BAR;
        PG8_WAIT_V(4); PG8_BAR;
        PG8_STAGE(PG8_SB(1, 0), cB + kstep, voffB); PG8_STAGE(PG8_SA(1, 0), cA + kstep, voffA); PG8_STAGE(PG8_SB(1, 1), cB + hstep + kstep, voffB);
        PG8_WAIT_V(6); PG8_BAR;
    }
    for (;;) {
        const bool has_next = S.next(ui + 1, nxt);
        const char* nA = has_next ? (const char*)g.A + (size_t)nxt.pm * tstep : cA; const char* nB = has_next ? (const char*)g.Bt + (size_t)nxt.pn * tstep : cB;
        for (int t = 0; t < nt; t += 2) {
            const bool last = (t == nt - 2);
            const char* a1 = cA + (size_t)(t + 1) * kstep;
            const char* a2 = last ? nA : cA + (size_t)(t + 2) * kstep; const char* b2 = last ? nB : cB + (size_t)(t + 2) * kstep;
            const char* a3 = a2 + kstep; const char* b3 = b2 + kstep;
            if (last && has_next) S.a_ready(nxt);
            if constexpr (SP2) {
            PG8_LDB(B0, 0, 0); PG8_LDB(B1, 0, 1); PG8_SCHED; PG8_LDA(At, 0, 0); PG8_STAGE(PG8_SA(1, 1), a1 + hstep, voffA);
            PG8_WAIT_V(8); PG8_WAIT_L(0); PG8_BAR; PG8_MMA(0, 0, At, B0); PG8_MMA(0, 1, At, B1); PG8_BAR; PG8_SCHED;
            PG8_LDA(At, 0, 1); PG8_STAGE(PG8_SB(0, 0), b2, voffB); PG8_STAGE(PG8_SB(0, 1), b2 + hstep, voffB); PG8_STAGE(PG8_SA(0, 0), a2, voffA);
            PG8_WAIT_V(8); PG8_WAIT_L(0); PG8_BAR; PG8_MMA(1, 0, At, B0); PG8_MMA(1, 1, At, B1); PG8_BAR; PG8_SCHED;
            PG8_LDB(B0, 1, 0); PG8_LDB(B1, 1, 1); PG8_SCHED; PG8_LDA(At, 1, 0); PG8_STAGE(PG8_SA(0, 1), a2 + hstep, voffA);
            PG8_WAIT_V(8); PG8_WAIT_L(0); PG8_BAR; PG8_MMA(0, 0, At, B0); PG8_MMA(0, 1, At, B1); PG8_BAR; PG8_SCHED;
            PG8_LDA(At, 1, 1); PG8_STAGE(PG8_SB(1, 0), b3, voffB); PG8_STAGE(PG8_SB(1, 1), b3 + hstep, voffB); PG8_STAGE(PG8_SA(1, 0), a3, voffA);
            PG8_WAIT_V(8); PG8_WAIT_L(0); PG8_BAR; PG8_MMA(1, 0, At, B0); PG8_MMA(1, 1, At, B1); PG8_BAR; PG8_SCHED;
            } else {
            PG8_LDB(B0, 0, 0); PG8_SCHED; PG8_LDA(At, 0, 0); PG8_STAGE(PG8_SA(1, 1), a1 + hstep, voffA);
            PG8_WAIT_L(8); PG8_BAR; PG8_WAIT_L(0); PG8_MMA(0, 0, At, B0); PG8_BAR; PG8_SCHED;
            PG8_LDB(B1, 0, 1); PG8_STAGE(PG8_SB(0, 0), b2, voffB);
            PG8_BAR; PG8_WAIT_L(0); PG8_MMA(0, 1, At, B1); PG8_BAR;
            PG8_LDA(At, 0, 1); PG8_STAGE(PG8_SA(0, 0), a2, voffA);
            PG8_BAR; PG8_WAIT_L(0); PG8_MMA(1, 0, At, B0); PG8_BAR; PG8_SCHED;
            PG8_STAGE(PG8_SB(0, 1), b2 + hstep, voffB);
            PG8_WAIT_V(6); PG8_BAR; PG8_MMA(1, 1, At, B1); PG8_BAR;
            PG8_LDB(B0, 1, 0); PG8_SCHED; PG8_LDA(At, 1, 0); PG8_STAGE(PG8_SA(0, 1), a2 + hstep, voffA);
            PG8_WAIT_L(8); PG8_BAR; PG8_WAIT_L(0); PG8_MMA(0, 0, At, B0); PG8_BAR; PG8_SCHED;
            PG8_LDB(B1, 1, 1); PG8_STAGE(PG8_SB(1, 0), b3, voffB);
            PG8_BAR; PG8_WAIT_L(0); PG8_MMA(0, 1, At, B1); PG8_BAR;
            PG8_LDA(At, 1, 1); PG8_STAGE(PG8_SA(1, 0), a3, voffA);
            PG8_BAR; PG8_WAIT_L(0); PG8_MMA(1, 0, At, B0); PG8_BAR; PG8_SCHED;
            PG8_STAGE(PG8_SB(1, 1), b3 + hstep, voffB);
            PG8_WAIT_V(6); PG8_BAR; PG8_MMA(1, 1, At, B1); PG8_BAR;
            }
        }
        if constexpr (ALIGN_EPI) { if (wr == 0) PG8_BAR; }
        if constexpr (!Epi::AFTER_DRAIN) { E(acc, cur, wr, wc, fr, fq); S.done(cur); }
        if (!has_next) break;
#pragma unroll
        for (int a = 0; a < 2; ++a)
#pragma unroll
            for (int b = 0; b < 2; ++b)
#pragma unroll
                for (int m = 0; m < 4; ++m)
#pragma unroll
                    for (int n = 0; n < 2; ++n) acc[a][b][m][n] = (f32x4){0.f, 0.f, 0.f, 0.f};
        cur = nxt; cA = nA; cB = nB; ++ui;
        if constexpr (ALIGN_EPI) { if (wr == 1) PG8_BAR; }
    }
    PG8_WAIT_V(0);
    if constexpr (!ALIGN_EPI) { if (wr == 0) PG8_BAR; }
    PG8_BAR;
    if constexpr (Epi::AFTER_DRAIN) { E.fused(acc, cur, wr, wc, fr, fq, lds, wid, lane); S.done(cur); }
#undef PG8_SA
#undef PG8_SB
#undef PG8_STAGE
#undef PG8_LDA
#undef PG8_LDB
#undef PG8_MMA
#undef PG8_WAIT_V
#undef PG8_WAIT_L
#undef PG8_BAR
#undef PG8_SCHED
}
}
#define GAS __attribute__((address_space(1)))
#define LAS __attribute__((address_space(3)))
typedef unsigned short bf16;
typedef unsigned v4u __attribute__((ext_vector_type(4)));
typedef float f32x4 __attribute__((ext_vector_type(4)));
typedef short bf16x8 __attribute__((ext_vector_type(8)));
typedef GAS unsigned gu32;
typedef GAS unsigned long long gu64;
#define RLX_AGENT __ATOMIC_RELAXED, __HIP_MEMORY_SCOPE_AGENT
#define LDS_WAIT() asm volatile("s_waitcnt lgkmcnt(0)" ::: "memory")
#define VM_WAIT() asm volatile("s_waitcnt vmcnt(0)" ::: "memory")
__device__ __forceinline__ unsigned long long rt() { return __builtin_amdgcn_s_memrealtime(); }
__device__ __forceinline__ unsigned f2bf(float f) { unsigned u = __builtin_bit_cast(unsigned, f); return (u + 0x7fffu + ((u >> 16) & 1u)) >> 16; }
__device__ __forceinline__ unsigned pk2(float lo, float hi) { return f2bf(lo) | (f2bf(hi) << 16); }

#define XB_TMO      128
#define XB_XCNT(j)  (256  + 64 * (j))
#define XB_XSUB(j)  (1280 + 64 * (j))
#define XB_XGEN(j)  (2304 + 64 * (j))
#define XB_TOP      3328
#define XB_TOPGEN   3392
#define XCD_BAR_WORDS 3456
#define XB_SPIN_CAP (1u << 18)

__device__ __forceinline__ unsigned xb_ld(unsigned* p)              { return __hip_atomic_load(p, __ATOMIC_RELAXED, __HIP_MEMORY_SCOPE_AGENT); }
__device__ __forceinline__ unsigned xb_add(unsigned* p, unsigned v) { return __hip_atomic_fetch_add(p, v, __ATOMIC_RELAXED, __HIP_MEMORY_SCOPE_AGENT); }
__device__ __forceinline__ unsigned xb_xcc_id() { return (unsigned)__builtin_amdgcn_s_getreg((3 << 11) | 20) & 0xFu; }
#define XB_SPIN(cond, bar) do { unsigned _sp = 0; while (cond) { __builtin_amdgcn_s_sleep(1); \
    if ((++_sp & 255u) == 0u) { if (xb_ld(&(bar)[XB_TMO])) break; if (_sp > XB_SPIN_CAP) { atomicAdd(&(bar)[XB_TMO], 1u); break; } } } } while (0)

struct XcdBarrier {
    unsigned* bar; unsigned x;
    volatile LAS unsigned* st;
};

__device__ __forceinline__ XcdBarrier xcd_barrier_post(unsigned* bar, volatile LAS unsigned* st) {
    XcdBarrier b; b.bar = bar; b.x = xb_xcc_id(); b.st = st;
    if (threadIdx.x == 0) (void)xb_add(&bar[XB_XCNT(b.x)], 1u);
    return b;
}
__device__ __forceinline__ void xcd_barrier_complete(unsigned* bar, unsigned x, unsigned& nloc, unsigned& nx) {
    const unsigned G = gridDim.x * gridDim.y * gridDim.z;
    unsigned sum, cnt, mine, sp = 0u;
    for (;;) {
        sum = 0u; cnt = 0u; mine = 0u;
#pragma unroll
        for (unsigned j = 0; j < 16; ++j) { const unsigned c = xb_ld(&bar[XB_XCNT(j)]); sum += c; cnt += (c > 0u) ? 1u : 0u; mine = (j == x) ? c : mine; }
        if (sum == G) break;
        __builtin_amdgcn_s_sleep(1);
        if ((++sp & 255u) == 0u) { if (xb_ld(&bar[XB_TMO])) break; if (sp > XB_SPIN_CAP) { atomicAdd(&bar[XB_TMO], 1u); break; } }
    }
    nloc = mine > 0u ? mine : 1u; nx = cnt > 0u ? cnt : 1u;
}

__device__ __forceinline__ void xcd_barrier(const XcdBarrier& b) {
    asm volatile("s_waitcnt vmcnt(0)" ::: "memory");
    __syncthreads();
    if (threadIdx.x == 0) {
        unsigned* bar = b.bar;
        __builtin_amdgcn_s_waitcnt(0);
        unsigned nloc = b.st[0], nx = b.st[1];
        if (nloc == 0u) { xcd_barrier_complete(bar, b.x, nloc, nx); b.st[0] = nloc; b.st[1] = nx; }
        const unsigned old = xb_add(&bar[XB_XSUB(b.x)], 1u);
        const unsigned gen = old / nloc;
        if (old + 1u == (gen + 1u) * nloc) {
            __builtin_amdgcn_fence(__ATOMIC_RELEASE, "agent");
            asm volatile("s_waitcnt vmcnt(0)" ::: "memory");
            const unsigned og = xb_add(&bar[XB_TOP], 1u);
            const unsigned tg = og / nx;
            if (og + 1u == (tg + 1u) * nx) xb_add(&bar[XB_TOPGEN], 1u);
            else XB_SPIN(xb_ld(&bar[XB_TOPGEN]) == tg, bar);
            __builtin_amdgcn_fence(__ATOMIC_ACQUIRE, "agent");
            xb_add(&bar[XB_XGEN(b.x)], 1u);
            asm volatile("s_waitcnt vmcnt(0)" ::: "memory");
        } else {
            XB_SPIN(xb_ld(&bar[XB_XGEN(b.x)]) == gen, bar);
            __builtin_amdgcn_fence(__ATOMIC_ACQUIRE, "agent");
            asm volatile("s_waitcnt vmcnt(0)" ::: "memory");
        }
    }
    __syncthreads();
}

constexpr int NWAVES = 8;
constexpr int MP = 32768, MS = 256, MT = MP + MS;
constexpr int DM = 1024, DIN = 4376, DINP = 4608, DFF = 2816, DCONV = 512, QW = 512;
constexpr int OFF_Q = 1024, OFF_KV = 1536, OFF_NG = 2304, OFF_MG = 2328;
constexpr int NSEQ = 36;
constexpr float EPS = 1e-6f;
constexpr size_t O_YP = 0, O_YS = 33554432, O_PCK = 33816576, O_PCV = O_PCK + 4194304, O_PSK = O_PCV + 4194304, O_PSV = O_PSK + 4194304,
                 O_PWK = O_PSV + 4194304, O_PWV = O_PWK + 262144, O_PCONV = O_PWV + 262144, O_SCK = O_PCONV + 61440, O_SCV = O_SCK + 32768,
                 O_SSK = O_SCV + 32768, O_SSV = O_SSK + 32768, O_SWK = O_SSV + 32768, O_SWV = O_SWK + 2097152, O_SCONV = O_SWV + 2097152, O_END = O_SCONV + 491520;
constexpr size_t MiB = 1u << 20;
constexpr size_t WS_CTL = 0, WS_MOD = 1 * MiB, ZERO_BYTES = 2 * MiB;
constexpr size_t WS_ROPE = 2 * MiB;
constexpr size_t WS_WIN = 5 * MiB, WS_WPW2 = 14 * MiB, WS_WNSA = 15 * MiB, WS_WOUT = 16 * MiB, WS_WGU = 18 * MiB, WS_WDOWN = 29 * MiB;
constexpr size_t WS_KC = 36 * MiB, WS_VC = 41 * MiB, WS_BG = 46 * MiB, WS_H = 50 * MiB, WS_U = 115 * MiB, WS_QP = 148 * MiB, WS_QR = 181 * MiB,
                 WS_CACT = 214 * MiB, WS_O = 247 * MiB, WS_GC = 280 * MiB, WS_GN = 345 * MiB, WS_T1 = 410 * MiB, WS_KWIN = 475 * MiB, WS_VWIN = 491 * MiB,
                 WS_ACT = 507 * MiB, WS_Z = 685 * MiB, WS_OC = WS_Z  , WS_ZS = 760 * MiB  ,
                 WS_KSB = 1268 * MiB, WS_VST = 1276 * MiB, WS_KWB = 1284 * MiB, WS_VWT = 1292 * MiB, WS_KCB = 1300 * MiB, WS_VCT = 1301 * MiB, WS_END = 1302 * MiB;
constexpr float C2 = 0.125f * 1.4426950408889634f;
constexpr int ROPE_N = 8200;
constexpr int CW_BAR = 4096;
constexpr int RING_BYTES = 131072, LDS_BYTES = 163840, MISC_OFF = LDS_BYTES - 256;

typedef unsigned v2u __attribute__((ext_vector_type(2)));
typedef float f32x2 __attribute__((ext_vector_type(2)));
__device__ __forceinline__ float bf2f(unsigned short b) { return __uint_as_float(((unsigned)b) << 16); }
__device__ __forceinline__ float wave_sum(float v) {
#pragma unroll
    for (int o = 1; o < 64; o <<= 1) v += __shfl_xor(v, o);
    return v;
}
__device__ __forceinline__ float wave_max(float v) {
#pragma unroll
    for (int o = 1; o < 64; o <<= 1) v = fmaxf(v, __shfl_xor(v, o));
    return v;
}
__device__ __forceinline__ float sigm(float x) { return 1.0f / (1.0f + __expf(-x)); }
__device__ __forceinline__ int mrow(int r) { return r < MP ? (r >> 13) : 4 + ((r - MP) >> 3); }
__device__ __forceinline__ int rope_idx(int r) { return r < MP ? (r & 8191) : 8192 + ((r - MP) & 7); }
__device__ __forceinline__ int perm64(int u) { return (u & 32) | (((u >> 2) & 3) << 3) | (((u >> 4) & 1) << 2) | (u & 3); }
__device__ __forceinline__ int perm128(int u) { return (u & ~31) | (((u >> 2) & 3) << 3) | (((u >> 4) & 1) << 2) | (u & 3); }
__device__ __forceinline__ size_t kc_off(int s) { return s < 4 ? (size_t)s * 128 * 128 : (size_t)4 * 128 * 128 + (size_t)(s - 4) * 257 * 128; }

struct Args { const float* in[33]; float* out; unsigned char* ws; int ph_lo, ph_hi; };

__device__ __forceinline__ int front_rowmap(int n) {
    if (n < 1024) { const int nn = n >= 512 ? 1 : 0, ch = n & 511; return 256 * (ch >> 7) + 128 * ((ch >> 6) & 1) + 32 * ((ch >> 4) & 3) + 16 * nn + (ch & 15); }
    if (n < OFF_KV) { const int hd = n - OFF_Q, h = hd >> 6, d = hd & 63; return 256 * (4 + (h >> 2)) + 128 * (d >> 5) + 32 * (h & 3) + (d & 31); }
    if (n < OFF_NG) { const int x = n - OFF_KV, j = x >> 7, kvh = (x >> 6) & 1, d = x & 63; return 256 * (6 + (j >> 1)) + 128 * (d >> 5) + 32 * ((j & 1) * 2 + kvh) + (d & 31); }
    if (n < OFF_MG) return 256 * 17 + (n - OFF_NG);
    return 256 * 9 + (n - OFF_MG);
}
template <int MODE> __device__ __forceinline__ int rowmap(int n) { return MODE == 0 ? n : (MODE == 1 ? 8 * (n >> 2) + (n & 3) : (MODE == 2 ? 8 * (n >> 2) + 4 + (n & 3) : front_rowmap(n))); }
template <int MODE> __device__ __forceinline__ void transpose_item(const float* W, int K, int N, bf16* WT, LAS float* scr, int item, int lane) {
    const int nblk = (N + 31) / 32, kb = item / nblk, nb = item % nblk, k0 = 64 * kb, n0 = 32 * nb;
    const int nn = n0 + (lane & 31);
#pragma unroll 8
    for (int i = 0; i < 32; ++i) { const int kk = 2 * i + (lane >> 5); scr[kk * 33 + (lane & 31)] = (nn < N) ? W[(size_t)(k0 + kk) * N + nn] : 0.f; }
    LDS_WAIT(); asm volatile("" ::: "memory");
    const int c = lane & 7;
#pragma unroll
    for (int j = 0; j < 4; ++j) { const int nl = (lane >> 3) + 8 * j, n = n0 + nl; const LAS float* s = scr + (8 * c) * 33 + nl;
        v4u o; o.x = pk2(s[0 * 33], s[1 * 33]); o.y = pk2(s[2 * 33], s[3 * 33]); o.z = pk2(s[4 * 33], s[5 * 33]); o.w = pk2(s[6 * 33], s[7 * 33]);
        if (n < N) *(v4u*)(WT + (size_t)rowmap<MODE>(n) * K + k0 + 8 * c) = o; }
    LDS_WAIT(); asm volatile("" ::: "memory");
}
__device__ __forceinline__ f32x2 compress_block(const float* rows, int nvalid, const float* pm, const float* w, float* outp, LAS float* scr, int lane) {
    const int c4 = 4 * (lane & 31), half = lane >> 5, d = c4 & 63, nh = nvalid >> 1;
    f32x4 acc = {0.f, 0.f, 0.f, 0.f};
    for (int i0 = 0; i0 < nh; i0 += 8) {
        f32x4 x[8], m[8];
#pragma unroll
        for (int q = 0; q < 8; ++q) { const bool ok = i0 + q < nh; const int j = 2 * (ok ? i0 + q : 0) + half;
            x[q] = *(const f32x4*)(rows + (size_t)j * 128 + c4); m[q] = *(const f32x4*)(pm + j * 64 + d); if (!ok) x[q] = (f32x4){0.f, 0.f, 0.f, 0.f}; }
#pragma unroll
        for (int q = 0; q < 8; ++q) acc += x[q] * (m[q] + 1.0f);
    }
#pragma unroll
    for (int i = 0; i < 4; ++i) acc[i] += __shfl_xor(acc[i], 32);
    if (lane < 32) *(LAS f32x4*)(scr + c4) = acc * (1.0f / 64.0f);
    LDS_WAIT(); asm volatile("" ::: "memory");
    const int kvh = lane >> 5, e = 2 * (lane & 31);
    f32x2 o = {0.f, 0.f};
#pragma unroll 8
    for (int dd = 0; dd < 64; ++dd) { const float sv = scr[kvh * 64 + dd]; const f32x2 ww = *(const f32x2*)(w + dd * 64 + e); o.x += sv * ww.x; o.y += sv * ww.y; }
    *(f32x2*)(outp + kvh * 64 + e) = o;
    LDS_WAIT(); asm volatile("" ::: "memory");
    return o;
}
__device__ __forceinline__ void phase0(const Args& a, LAS unsigned char* lds, int gw, int NGW, int wave, int lane_) {
    int lane = lane_;
    unsigned char* ws = a.ws;
    LAS float* scr = (LAS float*)(lds + wave * 16384);
    constexpr int I_IN = 16 * 137, I_PW2 = 8 * 32, I_NSA = 8 * 32, I_OUT = 16 * 32, I_G = 16 * 88, I_U = 16 * 88, I_D = 44 * 32;
    constexpr int N_TR = I_IN + I_PW2 + I_NSA + I_OUT + I_G + I_U + I_D;
    constexpr int N_MOD = 96 * 16;
    constexpr int N_CMP = 32 * 128 * 2;
    constexpr int N_ALL = N_TR + N_MOD + N_CMP; static_assert(N_ALL % 2 == 0 && N_ALL % 29 == 0 && N_ALL % 37 == 0 && N_ALL == 17168, "4099 must stay coprime to N_ALL");
#pragma nounroll
    for (int it = gw; it < N_ALL; it += NGW) {
        int r = it; asm volatile("" : "+v"(lane));
        if (r < N_TR) {
            if (r < I_IN) { transpose_item<3>(a.in[15], 1024, DIN, (bf16*)(ws + WS_WIN), scr, r, lane); continue; } r -= I_IN;
            if (r < I_PW2) { transpose_item<0>(a.in[22], 512, 1024, (bf16*)(ws + WS_WPW2), scr, r, lane); continue; } r -= I_PW2;
            if (r < I_NSA) { transpose_item<0>(a.in[27], 512, 1024, (bf16*)(ws + WS_WNSA), scr, r, lane); continue; } r -= I_NSA;
            if (r < I_OUT) { transpose_item<0>(a.in[28], 1024, 1024, (bf16*)(ws + WS_WOUT), scr, r, lane); continue; } r -= I_OUT;
            if (r < I_G) { transpose_item<1>(a.in[30], 1024, DFF, (bf16*)(ws + WS_WGU), scr, r, lane); continue; } r -= I_G;
            if (r < I_U) { transpose_item<2>(a.in[31], 1024, DFF, (bf16*)(ws + WS_WGU), scr, r, lane); continue; } r -= I_U;
            transpose_item<0>(a.in[32], DFF, 1024, (bf16*)(ws + WS_WDOWN), scr, r, lane); continue;
        }
        r -= N_TR;
        if (r < N_MOD) {
            const int cb = r % 96, kb = r / 96, j = cb * 64 + lane, k0 = kb * 64;
            for (int mb = 0; mb < NSEQ; ++mb) { const float* cp = mb < 4 ? a.in[10] + mb * 1024 : a.in[11] + (mb - 4) * 1024; const float cv = cp[k0 + lane]; scr[mb * 64 + lane] = cv * sigm(cv); }
            LDS_WAIT(); asm volatile("" ::: "memory");
            float acc[NSEQ];
#pragma unroll
            for (int mb = 0; mb < NSEQ; ++mb) acc[mb] = 0.f;
            const float* wp = a.in[12] + (size_t)k0 * 6144 + j;
#pragma unroll 4
            for (int k4 = 0; k4 < 16; ++k4) {
                const float w0 = wp[(size_t)(4 * k4 + 0) * 6144], w1 = wp[(size_t)(4 * k4 + 1) * 6144], w2 = wp[(size_t)(4 * k4 + 2) * 6144], w3 = wp[(size_t)(4 * k4 + 3) * 6144];
#pragma unroll
                for (int mb = 0; mb < NSEQ; ++mb) { const f32x4 q = *(const LAS f32x4*)(scr + mb * 64 + 4 * k4); acc[mb] += q.x * w0 + q.y * w1 + q.z * w2 + q.w * w3; }
            }
            float* modp = (float*)(ws + WS_MOD);
            const float bias = (kb == 0) ? a.in[13][j] : 0.f;
#pragma unroll
            for (int mb = 0; mb < NSEQ; ++mb) atomicAdd(modp + mb * 6144 + j, acc[mb] + bias);
            LDS_WAIT(); asm volatile("" ::: "memory");
            continue;
        }
        r -= N_MOD;
        {
            const int kv = r & 1, pg = (r >> 1) & 127, sb = r >> 8;
            const int page = ((const int*)a.in[9])[sb * 128 + pg];
            const float* src = (kv ? a.in[3] : a.in[2]) + (size_t)page * (128 * 128);
            const float* pm = kv ? a.in[25] : a.in[23]; const float* w = kv ? a.in[26] : a.in[24];
            float* dst = (float*)(ws + (kv ? WS_VC : WS_KC)) + kc_off(4 + sb) + (size_t)(2 * pg) * 128;
            compress_block(src, 64, pm, w, dst, scr, lane);
            compress_block(src + 64 * 128, 64, pm, w, dst + 128, scr, lane);
        }
    }
    const int gt = gw * 64 + lane, NT = NGW * 64;
    { v4u* p = (v4u*)((bf16*)(ws + WS_WIN) + (size_t)DIN * 1024); const int n16 = (DINP - DIN) * 1024 * 2 / 16; const v4u z = {0u, 0u, 0u, 0u}; for (int i = gt; i < n16; i += NT) p[i] = z; }
    { float* rc = (float*)(ws + WS_ROPE); float* rs = rc + ROPE_N * 32;
      for (int i = gt; i < ROPE_N * 32; i += NT) {
          const int j = i & 31, p = i >> 5; const int pos = p < 8192 ? p : 16384 + (p - 8192);
          double inv = 1.0; for (int q = 0; q < j; ++q) inv *= 0.7498942093324558;
          const double ang = (double)pos * inv;
          const double kq = __builtin_rint(ang * 0.6366197723675814);
          double rr = __builtin_fma(-kq, 1.5707963267948966, ang); rr = __builtin_fma(-kq, 6.123233995736766e-17, rr);
          const double r2 = rr * rr;
          const double sn = rr * (1.0 + r2 * (-1.0 / 6 + r2 * (1.0 / 120 + r2 * (-1.0 / 5040 + r2 * (1.0 / 362880 + r2 * (-1.0 / 39916800 + r2 * (1.0 / 6227020800.0)))))));
          const double cs = 1.0 + r2 * (-0.5 + r2 * (1.0 / 24 + r2 * (-1.0 / 720 + r2 * (1.0 / 40320 + r2 * (-1.0 / 3628800 + r2 * (1.0 / 479001600.0))))));
          const int qd = ((int)(long long)kq) & 3;
          const double c = (qd == 0) ? cs : (qd == 1) ? -sn : (qd == 2) ? -cs : sn;
          const double s = (qd == 0) ? sn : (qd == 1) ? cs : (qd == 2) ? -sn : -cs;
          rc[i] = (float)c; rs[i] = (float)s; } }
    { const int per = 504 * 128 / 4, n4 = 32 * per;
      for (int i = gt; i < 2 * n4; i += NT) { const int kv = i >= n4, ii = kv ? i - n4 : i, sb = ii / per, o = ii % per;
          const f32x4 v = ((const f32x4*)((kv ? a.in[7] : a.in[6]) + (size_t)sb * 512 * 128 + 8 * 128))[o];
          ((f32x4*)(a.out + (kv ? O_SWV : O_SWK) + (size_t)sb * 512 * 128))[o] = v; } }
    { const int per = 22 * 512 / 4, n4 = 32 * per;
      for (int i = gt; i < n4; i += NT) { const int sb = i / per, o = i % per;
          ((f32x4*)(a.out + O_SCONV + (size_t)sb * 30 * 512))[o] = ((const f32x4*)(a.in[8] + (size_t)sb * 30 * 512 + 8 * 512))[o]; } }
}

__device__ __forceinline__ void norm_rows(const float* xp, const float* xs, const float* g, const float* modp, int sh_off, int sc_off, bf16* H, int gw, int NGW, int lane) {
    for (int r = gw; r < MT; r += NGW) {
        const f32x4* xr = (const f32x4*)(r < MP ? xp + (size_t)r * 1024 : xs + (size_t)(r - MP) * 1024) + lane;
        const float* mp = modp + (size_t)mrow(r) * 6144;
        f32x4 v[4]; float ss = 0.f;
#pragma unroll
        for (int j = 0; j < 4; ++j) { v[j] = xr[64 * j]; ss += (v[j].x * v[j].x + v[j].y * v[j].y) + (v[j].z * v[j].z + v[j].w * v[j].w); }
        const float rstd = 1.0f / sqrtf(wave_sum(ss) * (1.0f / 1024.0f) + EPS);
        v2u* o8 = (v2u*)(H + (size_t)r * 1024) + lane;
#pragma unroll
        for (int j = 0; j < 4; ++j) { const int c = 4 * (lane + 64 * j);
            const f32x4 gg = *(const f32x4*)(g + c), sc = *(const f32x4*)(mp + sc_off + c), sh = *(const f32x4*)(mp + sh_off + c);
            const f32x4 h = (v[j] * rstd * gg) * (1.0f + sc) + sh;
            v2u w; w.x = pk2(h.x, h.y); w.y = pk2(h.z, h.w); o8[64 * j] = w; }
    }
}

__device__ __forceinline__ void unpack8(const v4u p, float (&x)[8]) { x[0] = pg8::bf_lo(p.x); x[1] = pg8::bf_hi(p.x); x[2] = pg8::bf_lo(p.y); x[3] = pg8::bf_hi(p.y); x[4] = pg8::bf_lo(p.z); x[5] = pg8::bf_hi(p.z); x[6] = pg8::bf_lo(p.w); x[7] = pg8::bf_hi(p.w); }
__device__ __forceinline__ void phase_conv(const Args& a, LAS unsigned char* lds, int vcu, int G, int gw, int NGW, int wave, int lane, int tid) {
    unsigned char* ws = a.ws;
    constexpr int TAPB = 31 * 512 * 4;
    { LAS f32x4* wl4 = (LAS f32x4*)lds; const f32x4* wg4 = (const f32x4*)a.in[18]; for (int i = tid; i < 31 * 512 / 4; i += NWAVES * 64) wl4[i] = wg4[i]; }
    const LAS float* wl = (const LAS float*)lds; LAS unsigned char* rl = lds + TAPB;
    const bf16* U = (const bf16*)(ws + WS_U); bf16* CACT = (bf16*)(ws + WS_CACT);
    const int c0 = lane * 8;
#pragma nounroll
    for (int tile = vcu; tile < 1024 + 32; tile += G) {
        const bool smp = tile >= 1024; const int sb = tile - 1024, r0 = smp ? MP + 8 * sb : 32 * tile, t0 = r0 & 8191, ntok = smp ? 8 : 32, nrows = ntok + 30;
        __syncthreads();
        for (int q = tid; q < nrows * 64; q += NWAVES * 64) { const int k = q >> 6, cc = (q & 63) * 8; v4u v = {0u, 0u, 0u, 0u};
            if (smp) { if (k < 30) { const float* sp = a.in[8] + (size_t)(sb * 30 + k) * 512 + cc; const f32x4 p0 = *(const f32x4*)sp, p1 = *(const f32x4*)(sp + 4);
                           v.x = pk2(p0.x, p0.y); v.y = pk2(p0.z, p0.w); v.z = pk2(p1.x, p1.y); v.w = pk2(p1.z, p1.w); }
                       else v = *(const v4u*)(U + (size_t)(r0 + k - 30) * 512 + cc); }
            else if (t0 - 30 + k >= 0) v = *(const v4u*)(U + (size_t)(r0 - 30 + k) * 512 + cc);
            *(LAS v4u*)(rl + k * 1024 + (q & 63) * 16) = v; }
        __syncthreads();
        if (4 * wave < ntok) {
            float acc[4][8];
            { const f32x4 b0 = *(const f32x4*)(a.in[19] + c0), b1 = *(const f32x4*)(a.in[19] + c0 + 4);
#pragma unroll
              for (int tt = 0; tt < 4; ++tt) { acc[tt][0] = b0.x; acc[tt][1] = b0.y; acc[tt][2] = b0.z; acc[tt][3] = b0.w; acc[tt][4] = b1.x; acc[tt][5] = b1.y; acc[tt][6] = b1.z; acc[tt][7] = b1.w; } }
            const LAS unsigned char* rw = rl + (4 * wave) * 1024 + lane * 16;
#pragma unroll 2
            for (int j = 0; j < 31; ++j) {
                const f32x4 w0 = *(const LAS f32x4*)(wl + j * 512 + c0), w1 = *(const LAS f32x4*)(wl + j * 512 + c0 + 4);
#pragma unroll
                for (int tt = 0; tt < 4; ++tt) { float x[8]; unpack8(*(const LAS v4u*)(rw + (tt + j) * 1024), x);
                    acc[tt][0] += x[0] * w0.x; acc[tt][1] += x[1] * w0.y; acc[tt][2] += x[2] * w0.z; acc[tt][3] += x[3] * w0.w; acc[tt][4] += x[4] * w1.x; acc[tt][5] += x[5] * w1.y; acc[tt][6] += x[6] * w1.z; acc[tt][7] += x[7] * w1.w; }
            }
            const f32x4 g0 = *(const f32x4*)(a.in[20] + c0), g1 = *(const f32x4*)(a.in[20] + c0 + 4), e0 = *(const f32x4*)(a.in[21] + c0), e1 = *(const f32x4*)(a.in[21] + c0 + 4);
            const float lg[8] = {g0.x, g0.y, g0.z, g0.w, g1.x, g1.y, g1.z, g1.w}, lb[8] = {e0.x, e0.y, e0.z, e0.w, e1.x, e1.y, e1.z, e1.w};
#pragma unroll
            for (int tt = 0; tt < 4; ++tt) {
                float sm = 0.f;
#pragma unroll
                for (int i = 0; i < 8; ++i) sm += acc[tt][i];
                const float mean = wave_sum(sm) * (1.0f / 512.0f); float q = 0.f;
#pragma unroll
                for (int i = 0; i < 8; ++i) { acc[tt][i] -= mean; q += acc[tt][i] * acc[tt][i]; }
                const float rstd = 1.0f / sqrtf(wave_sum(q) * (1.0f / 512.0f) + EPS);
                float y[8];
#pragma unroll
                for (int i = 0; i < 8; ++i) { const float v = acc[tt][i] * rstd * lg[i] + lb[i]; y[i] = v * sigm(v); }
                v4u o; o.x = pk2(y[0], y[1]); o.y = pk2(y[2], y[3]); o.z = pk2(y[4], y[5]); o.w = pk2(y[6], y[7]);
                *(v4u*)(CACT + (size_t)(r0 + 4 * wave + tt) * 512 + c0) = o;
            }
        }
    }
    __syncthreads();
    LAS float* scr = (LAS float*)(lds + wave * 16384);
    for (int it = gw; it < 1024 + 64; it += NGW) {
        if (it < 1024) { const int kv = it & 1, n = (it >> 1) & 127, b = it >> 8;
            const float* rows = a.out + (kv ? O_PCV : O_PCK) + (size_t)(b * 8192 + 64 * n) * 128;
            float* dst = (float*)(ws + (kv ? WS_VC : WS_KC)) + kc_off(b) + (size_t)n * 128;
            const f32x2 o = compress_block(rows, 64, kv ? a.in[25] : a.in[23], kv ? a.in[26] : a.in[24], dst, scr, lane);
            const int kvh = lane >> 5, e = 2 * (lane & 31);
            if (!kv) { *(unsigned*)((bf16*)(ws + WS_KCB) + ((size_t)(b * 2 + kvh) * 128 + n) * 64 + e) = pk2(o.x, o.y); }
            else { bf16* vt = (bf16*)(ws + WS_VCT) + (size_t)(b * 2 + kvh) * 64 * 128 + perm128(n); vt[(size_t)e * 128] = (bf16)f2bf(o.x); vt[(size_t)(e + 1) * 128] = (bf16)f2bf(o.y); } }
        else { const int i2 = it - 1024, kv = i2 & 1, sb = i2 >> 1;
            const float* rows = a.out + (kv ? O_SCV : O_SCK) + (size_t)(sb * 8) * 128;
            float* dst = (float*)(ws + (kv ? WS_VC : WS_KC)) + kc_off(4 + sb) + (size_t)256 * 128;
            compress_block(rows, 8, kv ? a.in[25] : a.in[23], kv ? a.in[26] : a.in[24], dst, scr, lane); }
    }
}

template <int MODE> __device__ __forceinline__ void attn_item(const Args& a, int r, int kvh, LAS unsigned char* ldsb, int wave, int lane) {
    unsigned char* ws = a.ws; float* out = a.out;
    LAS float* scr = (LAS float*)(ldsb + wave * 16384);
    const bool smp = r >= MP; const int rs_ = r - MP, sb = rs_ >> 3, si = rs_ & 7, b = r >> 13;
    const int seq = smp ? 4 + sb : b, qpos = smp ? 16384 + si : (r & 8191), cur = qpos >> 6, NB = smp ? 257 : 128;
    LAS float* s_qp = scr;
    LAS float* s_qr = scr + 256;
    LAS float* s_p = scr + 512;
    const bf16* QP = (const bf16*)(ws + WS_QP) + (size_t)r * 512 + kvh * 256; const bf16* QR = (const bf16*)(ws + WS_QR) + (size_t)r * 512 + kvh * 256;
    float qn2[4];
#pragma unroll
    for (int g = 0; g < 4; ++g) { const float x = bf2f(QP[g * 64 + lane]), y = bf2f(QR[g * 64 + lane]); s_qp[lane * 4 + g] = x; s_qr[lane * 4 + g] = y; qn2[g] = wave_sum(y * y); }
    const float gks = wave_max(fabsf(a.in[17][64 + lane])), gkw = wave_max(fabsf(a.in[17][128 + lane]));
    float mref_s[4], mref_w[4];
#pragma unroll
    for (int g = 0; g < 4; ++g) { const float qn = sqrtf(qn2[g]) * 8.0f; mref_s[g] = qn * gks; mref_w[g] = qn * gkw; }
    LDS_WAIT(); asm volatile("" ::: "memory");
    const float* KC = (const float*)(ws + WS_KC) + kc_off(seq) + kvh * 64; const float* VC = (const float*)(ws + WS_VC) + kc_off(seq) + kvh * 64;
    const int n_ok = (qpos + 1) >> 6;
    float sc[5][4];
#pragma unroll
    for (int c = 0; c < 5; ++c) { const int n = lane + 64 * c;
#pragma unroll
        for (int g = 0; g < 4; ++g) sc[c][g] = 0.f;
        if (n < n_ok && n < NB) { const f32x4* kr = (const f32x4*)(KC + (size_t)n * 128);
#pragma unroll 4
            for (int d4 = 0; d4 < 16; ++d4) { const f32x4 k = kr[d4];
                const f32x4 q0 = *(const LAS f32x4*)(s_qp + (4 * d4 + 0) * 4), q1 = *(const LAS f32x4*)(s_qp + (4 * d4 + 1) * 4), q2 = *(const LAS f32x4*)(s_qp + (4 * d4 + 2) * 4), q3 = *(const LAS f32x4*)(s_qp + (4 * d4 + 3) * 4);
#pragma unroll
                for (int g = 0; g < 4; ++g) sc[c][g] += k.x * q0[g] + k.y * q1[g] + k.z * q2[g] + k.w * q3[g]; } } }
    float imp[5];
#pragma unroll
    for (int c = 0; c < 5; ++c) imp[c] = 0.f;
#pragma unroll
    for (int g = 0; g < 4; ++g) {
        float m = -INFINITY;
#pragma unroll
        for (int c = 0; c < 5; ++c) { const int n = lane + 64 * c; if (n < n_ok && n < NB) m = fmaxf(m, sc[c][g]); }
        m = wave_max(m); if (!(m > -INFINITY)) m = 0.f;
        float e[5], zs = 0.f;
#pragma unroll
        for (int c = 0; c < 5; ++c) { const int n = lane + 64 * c; e[c] = (n < n_ok && n < NB) ? __builtin_amdgcn_exp2f(sc[c][g] - m) : 0.f; zs += e[c]; }
        zs = wave_sum(zs); const float iz = 1.0f / fmaxf(zs, 1e-30f);
#pragma unroll
        for (int c = 0; c < 5; ++c) { const int n = lane + 64 * c; const float p = e[c] * iz; imp[c] += p; if (n < NB) s_p[n * 4 + g] = p; }
    }
    LDS_WAIT(); asm volatile("" ::: "memory");
    float o_cmp[4] = {0.f, 0.f, 0.f, 0.f};
    { const int nn = n_ok < NB ? n_ok : NB; const int nstart = MODE == 1 ? wave : 0, nstep = MODE == 1 ? NWAVES : 1;
      for (int n0 = nstart; n0 < nn; n0 += 8 * nstep) { float v[8];
#pragma unroll
          for (int q = 0; q < 8; ++q) { const int n = n0 + q * nstep; v[q] = VC[(size_t)(n < nn ? n : nstart) * 128 + lane]; }
#pragma unroll
          for (int q = 0; q < 8; ++q) { const int n = n0 + q * nstep; if (n < nn) { const f32x4 p = *(const LAS f32x4*)(s_p + n * 4);
#pragma unroll
              for (int g = 0; g < 4; ++g) o_cmp[g] += p[g] * v[q]; } } } }
    LDS_WAIT(); asm volatile("" ::: "memory");
    float score[5];
#pragma unroll
    for (int c = 0; c < 5; ++c) { const int n = lane + 64 * c;
        const bool forced = (n == 0) || (n == cur) || (n == cur - 1);
        score[c] = (n >= NB) ? -4.0f : (n <= cur ? imp[c] + (forced ? 8.0f : 0.f) : -1.0f); }
    const int* ptab = (const int*)a.in[9] + sb * 128;
    float l_sel[4] = {0.f, 0.f, 0.f, 0.f}, o_sel[4] = {0.f, 0.f, 0.f, 0.f};
    float last_bv = 0.f; bool ambiguous = false;
    for (int round = 0; round < (MODE == 2 ? 17 : 16); ++round) {
        float bv = score[0]; int bi = lane;
#pragma unroll
        for (int c = 1; c < 5; ++c) if (score[c] > bv) { bv = score[c]; bi = lane + 64 * c; }
#pragma unroll
        for (int o = 1; o < 64; o <<= 1) { const float ov = __shfl_xor(bv, o); const int oi = __shfl_xor(bi, o); if (ov > bv || (ov == bv && oi < bi)) { bv = ov; bi = oi; } }
        const int n = __builtin_amdgcn_readfirstlane(bi);
        if (MODE == 2) { if (round == 16) { ambiguous = (bv >= 0.f) && (last_bv - bv < 4e-4f); break; } last_bv = bv; }
#pragma unroll
        for (int c = 0; c < 5; ++c) if (n == lane + 64 * c) score[c] = -3.0f;
        if (n > cur) continue;
        if (MODE == 1 && (round >> 1) != wave) continue;
        const float* kb; const float* vb; int nvalid;
        if (!smp) { kb = out + O_PSK + (size_t)(b * 8192 + 64 * n) * 128; vb = out + O_PSV + (size_t)(b * 8192 + 64 * n) * 128; }
        else if (n < 256) { const int page = ptab[n >> 1]; const size_t ro = ((size_t)page * 128 + (n & 1) * 64) * 128; kb = a.in[4] + ro; vb = a.in[5] + ro; }
        else { kb = out + O_SSK + (size_t)(sb * 8) * 128; vb = out + O_SSV + (size_t)(sb * 8) * 128; }
        nvalid = qpos - 64 * n + 1; if (nvalid > 64) nvalid = 64;
        const bool valid = lane < nvalid;
        float s4[4] = {0.f, 0.f, 0.f, 0.f};
        { const f32x4* kr = (const f32x4*)(kb + (size_t)(valid ? lane : 0) * 128 + kvh * 64);
#pragma unroll 4
          for (int d4 = 0; d4 < 16; ++d4) { const f32x4 k = kr[d4];
              const f32x4 q0 = *(const LAS f32x4*)(s_qr + (4 * d4 + 0) * 4), q1 = *(const LAS f32x4*)(s_qr + (4 * d4 + 1) * 4), q2 = *(const LAS f32x4*)(s_qr + (4 * d4 + 2) * 4), q3 = *(const LAS f32x4*)(s_qr + (4 * d4 + 3) * 4);
#pragma unroll
              for (int g = 0; g < 4; ++g) s4[g] += k.x * q0[g] + k.y * q1[g] + k.z * q2[g] + k.w * q3[g]; } }
        f32x4 pv4;
#pragma unroll
        for (int g = 0; g < 4; ++g) { const float p = valid ? __builtin_amdgcn_exp2f(s4[g] - mref_s[g]) : 0.f; l_sel[g] += p; pv4[g] = p; }
        *(LAS f32x4*)(s_p + lane * 4) = pv4;
        LDS_WAIT(); asm volatile("" ::: "memory");
        for (int j0 = 0; j0 < nvalid; j0 += 8) { float v[8];
#pragma unroll
            for (int q = 0; q < 8; ++q) { const int j = j0 + q < nvalid ? j0 + q : 0; v[q] = vb[(size_t)j * 128 + kvh * 64 + lane]; }
#pragma unroll
            for (int q = 0; q < 8; ++q) if (j0 + q < nvalid) { const f32x4 p = *(const LAS f32x4*)(s_p + (j0 + q) * 4);
#pragma unroll
                for (int g = 0; g < 4; ++g) o_sel[g] += p[g] * v[q]; } }
        LDS_WAIT(); asm volatile("" ::: "memory");
    }
    float l_win[4] = {0.f, 0.f, 0.f, 0.f}, o_win[4] = {0.f, 0.f, 0.f, 0.f};
    { const int lo = qpos - 511 > 0 ? qpos - 511 : 0; const int cnt = qpos - lo + 1;
      for (int c0 = 0; c0 < cnt; c0 += 64) {
          if (MODE == 1 && (c0 >> 6) != wave) continue;
          const int nvalid = cnt - c0 < 64 ? cnt - c0 : 64; const bool valid = lane < nvalid; const int kpos = lo + c0 + (valid ? lane : 0);
          const float* kr_;
          if (!smp) kr_ = (const float*)(ws + WS_KWIN) + (size_t)(b * 8192 + kpos) * 128;
          else if (kpos >= 16384) kr_ = out + O_SWK + (size_t)(sb * 512 + 504 + kpos - 16384) * 128;
          else kr_ = a.in[6] + (size_t)(sb * 512 + kpos - 15872) * 128;
          float s4[4] = {0.f, 0.f, 0.f, 0.f};
          { const f32x4* kr = (const f32x4*)(kr_ + kvh * 64);
#pragma unroll 4
            for (int d4 = 0; d4 < 16; ++d4) { const f32x4 k = kr[d4];
                const f32x4 q0 = *(const LAS f32x4*)(s_qr + (4 * d4 + 0) * 4), q1 = *(const LAS f32x4*)(s_qr + (4 * d4 + 1) * 4), q2 = *(const LAS f32x4*)(s_qr + (4 * d4 + 2) * 4), q3 = *(const LAS f32x4*)(s_qr + (4 * d4 + 3) * 4);
#pragma unroll
                for (int g = 0; g < 4; ++g) s4[g] += k.x * q0[g] + k.y * q1[g] + k.z * q2[g] + k.w * q3[g]; } }
          f32x4 pv4;
#pragma unroll
          for (int g = 0; g < 4; ++g) { const float p = valid ? __builtin_amdgcn_exp2f(s4[g] - mref_w[g]) : 0.f; l_win[g] += p; pv4[g] = p; }
          *(LAS f32x4*)(s_p + lane * 4) = pv4;
          LDS_WAIT(); asm volatile("" ::: "memory");
          for (int j0 = 0; j0 < nvalid; j0 += 8) { float v[8];
#pragma unroll
              for (int q = 0; q < 8; ++q) { const int kp = lo + c0 + (j0 + q < nvalid ? j0 + q : 0); const float* vr;
                  if (!smp) vr = (const float*)(ws + WS_VWIN) + (size_t)(b * 8192 + kp) * 128;
                  else if (kp >= 16384) vr = out + O_SWV + (size_t)(sb * 512 + 504 + kp - 16384) * 128;
                  else vr = a.in[7] + (size_t)(sb * 512 + kp - 15872) * 128;
                  v[q] = vr[kvh * 64 + lane]; }
#pragma unroll
              for (int q = 0; q < 8; ++q) if (j0 + q < nvalid) { const f32x4 p = *(const LAS f32x4*)(s_p + (j0 + q) * 4);
#pragma unroll
                  for (int g = 0; g < 4; ++g) o_win[g] += p[g] * v[q]; } }
          LDS_WAIT(); asm volatile("" ::: "memory");
      } }
    float ls[4], lw[4];
#pragma unroll
    for (int g = 0; g < 4; ++g) { ls[g] = wave_sum(l_sel[g]); lw[g] = wave_sum(l_win[g]); }
    if (MODE == 1) {
        LAS float* part = scr + 2048;
#pragma unroll
        for (int g = 0; g < 4; ++g) { part[g * 64 + lane] = o_cmp[g]; part[(4 + g) * 64 + lane] = o_sel[g]; part[(8 + g) * 64 + lane] = o_win[g]; }
        if (lane < 4) { part[768 + lane] = ls[lane & 3]; part[772 + lane] = lw[lane & 3]; }
        __syncthreads();
        if (wave == 0) {
#pragma unroll
            for (int g = 0; g < 4; ++g) { o_cmp[g] = 0.f; o_sel[g] = 0.f; o_win[g] = 0.f; ls[g] = 0.f; lw[g] = 0.f; }
            for (int w = 0; w < NWAVES; ++w) { const LAS float* pw = (const LAS float*)(ldsb + w * 16384) + 2048;
#pragma unroll
                for (int g = 0; g < 4; ++g) { o_cmp[g] += pw[g * 64 + lane]; o_sel[g] += pw[(4 + g) * 64 + lane]; o_win[g] += pw[(8 + g) * 64 + lane]; ls[g] += pw[768 + g]; lw[g] += pw[772 + g]; } }
        }
    }
    if (MODE != 1 || wave == 0) {
        const float* BG = (const float*)(ws + WS_BG) + (size_t)r * 24 + kvh * 12;
        bf16* O = (bf16*)(ws + WS_O) + (size_t)r * 512 + kvh * 256;
#pragma unroll
        for (int g = 0; g < 4; ++g) {
            const float o = BG[g * 3 + 0] * o_cmp[g] + BG[g * 3 + 1] * (o_sel[g] / fmaxf(ls[g], 1e-30f)) + BG[g * 3 + 2] * (o_win[g] / fmaxf(lw[g], 1e-30f));
            if (MODE == 2) { const float have = bf2f(O[g * 64 + lane]); if (!ambiguous && !(fabsf(have - o) <= 0.004f + 0.02f * fabsf(o))) atomicAdd((unsigned*)(ws + WS_CTL) + 8, 1u); }
            else O[g * 64 + lane] = (bf16)f2bf(o); }
    }
    LDS_WAIT(); asm volatile("" ::: "memory");
    if (MODE == 1) __syncthreads();
}

typedef short s16x8 __attribute__((ext_vector_type(8)));
__device__ __forceinline__ unsigned dpp_x1(unsigned v) { return (unsigned)__builtin_amdgcn_update_dpp(0, (int)v, 0xB1, 0xF, 0xF, false); }
__device__ __forceinline__ unsigned dpp_x2(unsigned v) { return (unsigned)__builtin_amdgcn_update_dpp(0, (int)v, 0x4E, 0xF, 0xF, false); }
__device__ __forceinline__ unsigned umax_x16(unsigned v) { auto r = __builtin_amdgcn_permlane16_swap(v, v, false, false); return r[0] > r[1] ? r[0] : r[1]; }
__device__ __forceinline__ unsigned umax_x32(unsigned v) { auto r = __builtin_amdgcn_permlane32_swap(v, v, false, false); return r[0] > r[1] ? r[0] : r[1]; }
__device__ __forceinline__ float fsum_x16(float v) { auto r = __builtin_amdgcn_permlane16_swap(__float_as_uint(v), __float_as_uint(v), false, false); return __uint_as_float(r[0]) + __uint_as_float(r[1]); }
__device__ __forceinline__ float fsum_x32(float v) { auto r = __builtin_amdgcn_permlane32_swap(__float_as_uint(v), __float_as_uint(v), false, false); return __uint_as_float(r[0]) + __uint_as_float(r[1]); }
__device__ __forceinline__ float fmax_x16(float v) { auto r = __builtin_amdgcn_permlane16_swap(__float_as_uint(v), __float_as_uint(v), false, false); return fmaxf(__uint_as_float(r[0]), __uint_as_float(r[1])); }
__device__ __forceinline__ float fmax_x32(float v) { auto r = __builtin_amdgcn_permlane32_swap(__float_as_uint(v), __float_as_uint(v), false, false); return fmaxf(__uint_as_float(r[0]), __uint_as_float(r[1])); }
__device__ __forceinline__ float dpp_x1f(float v) { return __uint_as_float(dpp_x1(__float_as_uint(v))); }
__device__ __forceinline__ float dpp_x2f(float v) { return __uint_as_float(dpp_x2(__float_as_uint(v))); }
__device__ __forceinline__ f32x4 mfma16(s16x8 a_, s16x8 b_, f32x4 c_) { return __builtin_amdgcn_mfma_f32_16x16x32_bf16(a_, b_, c_, 0, 0, 0); }
__device__ __forceinline__ unsigned cvtpk(float lo, float hi) { return pg8::cvt_pk_bf16(lo, hi); }
constexpr int AT_SLOT = 16384, AT_VOFF = 8192, AT_CMPV = 18432, AT_MASK = 4 * AT_SLOT, AT_QF = AT_MASK + 12288;
template <int PASS> __device__ __forceinline__ void attn_pass(const Args& a, LAS unsigned char* lds, int b, int kvh, int tb, int wave, int lane, int tid) {
    unsigned char* ws = a.ws; asm volatile("" : "+s"(ws)); asm volatile("" : "+v"(lane)); asm volatile("" : "+v"(tid));
    const int fr = lane & 15, fq = lane >> 4, tok_i = fr >> 2, g = fr & 3;
    const int r0 = b * 8192 + 128 * tb;
    const bf16* QR = (const bf16*)(ws + WS_QR);
    const float* BG = (const float*)(ws + WS_BG); float* OC = (float*)(ws + WS_OC);
    LAS unsigned* wmask = (LAS unsigned*)(lds + AT_MASK + wave * 1536);
    const int hq = kvh * 4 + g;
    float mref[4]; f32x4 O[4][4]; float lsum[4];
    LAS unsigned char* qlds = lds + AT_QF + wave * 8192;
    {
        const char* kimg = (const char*)((const bf16*)(ws + (PASS == 0 ? WS_KSB : WS_KWB)) + (size_t)((b * 128) * 2 + kvh) * 4096);
        const char* vimg = (const char*)((const bf16*)(ws + (PASS == 0 ? WS_VST : WS_VWT)) + (size_t)((b * 128) * 2 + kvh) * 4096);
        const float gk = wave_max(fabsf(a.in[17][(PASS == 0 ? 64 : 128) + lane]));
        if (PASS == 0) {
#pragma unroll
            for (int gi = 0; gi < 4; ++gi) { const int row = r0 + 16 * wave + 4 * gi + tok_i; const bf16* qp = QR + (size_t)row * 512 + hq * 64 + fq * 8;
                const s16x8 qa = *(const s16x8*)qp, qb = *(const s16x8*)(qp + 32); float ss = 0.f;
#pragma unroll
                for (int e = 0; e < 8; ++e) { const float x = bf2f((unsigned short)qa[e]), y = bf2f((unsigned short)qb[e]); ss += x * x + y * y; }
                ss += __shfl_xor(ss, 16); ss += __shfl_xor(ss, 32); ((LAS float*)wmask)[96 + gi * 64 + lane] = sqrtf(ss) * 8.0f;
                *(LAS s16x8*)(qlds + ((gi * 2 + 0) * 64 + lane) * 16) = qa; *(LAS s16x8*)(qlds + ((gi * 2 + 1) * 64 + lane) * 16) = qb; }
            LDS_WAIT();
        }
#pragma unroll
        for (int gi = 0; gi < 4; ++gi) { mref[gi] = ((const LAS float*)wmask)[96 + gi * 64 + lane] * gk; lsum[gi] = 0.f;
#pragma unroll
            for (int dg = 0; dg < 4; ++dg) O[gi][dg] = (f32x4){0.f, 0.f, 0.f, 0.f}; }
        s16x8 Qf[4][2];
#pragma unroll
        for (int gi = 0; gi < 4; ++gi) { Qf[gi][0] = *(const LAS s16x8*)(qlds + ((gi * 2 + 0) * 64 + lane) * 16); Qf[gi][1] = *(const LAS s16x8*)(qlds + ((gi * 2 + 1) * 64 + lane) * 16); }
        const bool bigref = __builtin_amdgcn_readfirstlane(__float_as_int(wave_max(fmaxf(fmaxf(mref[0], mref[1]), fmaxf(mref[2], mref[3]))))) > __float_as_int(64.0f);
        const int nlast = 2 * tb + 1, nfirst = PASS == 0 ? 0 : (2 * tb - 8 > 0 ? 2 * tb - 8 : 0);
        const int drow = 8 * wave + (lane >> 3); const unsigned dsrc = (unsigned)(drow * 128 + (((lane & 7) ^ ((drow >> 1) & 7)) * 16));
        const unsigned fsw0 = (unsigned)((((0 + fq) ^ ((fr >> 1) & 7)) * 16)), fsw1 = (unsigned)((((4 + fq) ^ ((fr >> 1) & 7)) * 16));
#define AT_DMA_BLOCK(nn, sl) do { const size_t bo_ = (size_t)(nn) * 2 * 4096 * 2 + dsrc; \
            __builtin_amdgcn_global_load_lds((const unsigned*)(kimg + bo_), (LAS unsigned*)(lds + (sl) * AT_SLOT + wave * 1024), 16, 0, 0); \
            __builtin_amdgcn_global_load_lds((const unsigned*)(vimg + bo_), (LAS unsigned*)(lds + (sl) * AT_SLOT + AT_VOFF + wave * 1024), 16, 0, 0); } while (0)
        const int nblk = nlast - nfirst + 1, nint = (nblk + 1) >> 1;
        AT_DMA_BLOCK(nfirst, 0); if (nblk > 1) AT_DMA_BLOCK(nfirst + 1, 1);
        asm volatile("s_waitcnt vmcnt(0) lgkmcnt(0)\n\ts_barrier" ::: "memory");
        unsigned gwc[4] = {0u, 0u, 0u, 0u}, twc[4] = {0u, 0u, 0u, 0u}; int wcur = -1;
        auto do_block = [&](const int n, const LAS unsigned char* kb) __attribute__((always_inline)) {
            const LAS unsigned char* vb = kb + AT_VOFF;
            if (PASS == 0 && (n >> 5) != wcur) { wcur = n >> 5;
#pragma unroll
                for (int gi = 0; gi < 4; ++gi) { gwc[gi] = (unsigned)__builtin_amdgcn_readfirstlane((int)wmask[64 + gi * 4 + wcur]); twc[gi] = wmask[(4 * gi + tok_i) * 4 + wcur]; } }
            int actm = 0;
#pragma unroll
            for (int gi = 0; gi < 4; ++gi) { int av;
                if (PASS == 0) { av = (int)((gwc[gi] >> (n & 31)) & 1u); }
                else { const int tlo = 128 * tb + 16 * wave + 4 * gi; const int b_lo = tlo - 511 > 0 ? (tlo - 511) >> 6 : 0, b_hi = (tlo + 3) >> 6; av = (n >= b_lo && n <= b_hi) ? 1 : 0; }
                actm |= av << gi; }
            actm = __builtin_amdgcn_readfirstlane(actm);
            bool act[4];
#pragma unroll
            for (int gi = 0; gi < 4; ++gi) act[gi] = ((actm >> gi) & 1) != 0;
            if (actm != 0) {
                v4u Pk[4][2];
#pragma unroll
                for (int gi = 0; gi < 4; ++gi) { Pk[gi][0] = (v4u){0u, 0u, 0u, 0u}; Pk[gi][1] = (v4u){0u, 0u, 0u, 0u}; }
                float ls4[4] = {0.f, 0.f, 0.f, 0.f};
                bool tselb[4];
#pragma unroll
                for (int gi = 0; gi < 4; ++gi) { tselb[gi] = true; if (PASS == 0) tselb[gi] = ((twc[gi] >> (n & 31)) & 1u) != 0u; }
#pragma unroll
                for (int kc = 0; kc < 2; ++kc) {
                    s16x8 Kf[2][2];
#pragma unroll
                    for (int x = 0; x < 2; ++x)
#pragma unroll
                        for (int k = 0; k < 2; ++k) Kf[x][k] = *(const LAS s16x8*)(kb + (16 * (2 * kc + x) + fr) * 128 + (k ? fsw1 : fsw0));
#pragma unroll
                    for (int gi = 0; gi < 4; ++gi) if (act[gi]) {
                        const int tl = 16 * wave + 4 * gi + tok_i, t = 128 * tb + tl, rel = t - 64 * n;
                        const bool tsel = tselb[gi];
                        const int tlo = 128 * tb + 16 * wave + 4 * gi;
                        const bool edge = (64 * n + 63 > tlo) || (PASS == 1 && 64 * n < tlo + 3 - 511);
                        f32x4 S[2];
                        const s16x8 qf0 = Qf[gi][0], qf1 = Qf[gi][1];
                        float ls = 0.f;
                        if (edge || bigref) {
                            const float nm = tsel ? (bigref ? -mref[gi] : 0.f) : -1e30f;
#pragma unroll
                            for (int x = 0; x < 2; ++x) { S[x] = (f32x4){nm, nm, nm, nm}; S[x] = mfma16(Kf[x][0], qf0, S[x]); S[x] = mfma16(Kf[x][1], qf1, S[x]); }
#pragma unroll
                            for (int x = 0; x < 2; ++x)
#pragma unroll
                                for (int i = 0; i < 4; ++i) { const int j = 16 * (2 * kc + x) + 4 * fq + i; const bool ok = j <= rel && (PASS == 0 || j > rel - 512);
                                    const float p = ok ? __builtin_amdgcn_exp2f(S[x][i]) : 0.f; S[x][i] = p; ls += p; }
                            Pk[gi][kc].x = cvtpk(S[0][0], S[0][1]); Pk[gi][kc].y = cvtpk(S[0][2], S[0][3]); Pk[gi][kc].z = cvtpk(S[1][0], S[1][1]); Pk[gi][kc].w = cvtpk(S[1][2], S[1][3]);
                        } else {
#pragma unroll
                            for (int x = 0; x < 2; ++x) { S[x] = mfma16(Kf[x][0], qf0, (f32x4){0.f, 0.f, 0.f, 0.f}); S[x] = mfma16(Kf[x][1], qf1, S[x]); }
#pragma unroll
                            for (int x = 0; x < 2; ++x)
#pragma unroll
                                for (int i = 0; i < 4; ++i) { const float p = __builtin_amdgcn_exp2f(S[x][i]); S[x][i] = p; ls += p; }
                            const unsigned km = (PASS == 0 && !tsel) ? 0u : 0xffffffffu; if (PASS == 0) ls = tsel ? ls : 0.f;
                            Pk[gi][kc].x = cvtpk(S[0][0], S[0][1]) & km; Pk[gi][kc].y = cvtpk(S[0][2], S[0][3]) & km; Pk[gi][kc].z = cvtpk(S[1][0], S[1][1]) & km; Pk[gi][kc].w = cvtpk(S[1][2], S[1][3]) & km;
                        }
                        ls4[gi] += ls;
                    }
                    }
#pragma unroll
                for (int gi = 0; gi < 4; ++gi) lsum[gi] += ls4[gi];
#pragma unroll
                for (int kc = 0; kc < 2; ++kc) {
                    s16x8 Vf[4];
#pragma unroll
                    for (int x = 0; x < 4; ++x) Vf[x] = *(const LAS s16x8*)(vb + (16 * x + fr) * 128 + (kc ? fsw1 : fsw0));
#pragma unroll
                    for (int gi = 0; gi < 4; ++gi) if (act[gi]) { const s16x8 pb = __builtin_bit_cast(s16x8, Pk[gi][kc]);
#pragma unroll
                        for (int dg = 0; dg < 4; ++dg) O[gi][dg] = mfma16(Vf[dg], pb, O[gi][dg]); }
                    }
            }
        };
#pragma nounroll
        for (int iv = 0; iv < nint; ++iv) {
            const int n0 = nfirst + 2 * iv, sp = (iv & 1) * 2;
            if (n0 + 2 <= nlast) AT_DMA_BLOCK(n0 + 2, 2 - sp);
            if (n0 + 3 <= nlast) AT_DMA_BLOCK(n0 + 3, 3 - sp);
            do_block(n0, lds + sp * AT_SLOT);
            if (n0 + 1 <= nlast) do_block(n0 + 1, lds + (sp + 1) * AT_SLOT);
            asm volatile("s_waitcnt vmcnt(0) lgkmcnt(0)\n\ts_barrier" ::: "memory");
        }
#pragma unroll
        for (int gi = 0; gi < 4; ++gi) { const int row = r0 + 16 * wave + 4 * gi + tok_i;
            float l = lsum[gi]; l += __shfl_xor(l, 16); l += __shfl_xor(l, 32);
            const float sc = BG[(size_t)row * 24 + hq * 3 + 1 + PASS] / fmaxf(l, 1e-30f);
            float* oc = OC + (size_t)row * 512 + hq * 64 + 4 * fq;
#pragma unroll
            for (int dg = 0; dg < 4; ++dg) { const f32x4 v = *(const f32x4*)(oc + 16 * dg) + O[gi][dg] * sc;
                if (PASS == 0) *(f32x4*)(oc + 16 * dg) = v;
                else { v2u w; w.x = cvtpk(v[0], v[1]); w.y = cvtpk(v[2], v[3]); *(v2u*)((bf16*)(ws + WS_O) + (size_t)row * 512 + hq * 64 + 16 * dg + 4 * fq) = w; } } }
        }
}
__device__ __forceinline__ void attn_unit(const Args& a, LAS unsigned char* lds, int b, int kvh, int tb, int wave, int lane, int tid) {
    unsigned char* ws = a.ws; asm volatile("" : "+s"(ws)); asm volatile("" : "+v"(lane)); asm volatile("" : "+v"(tid));
    const int fr = lane & 15, fq = lane >> 4, tok_i = fr >> 2, g = fr & 3;
    const int r0 = b * 8192 + 128 * tb;
    const bf16* QP = (const bf16*)(ws + WS_QP); const bf16* QR = (const bf16*)(ws + WS_QR);
    const float* BG = (const float*)(ws + WS_BG); float* OC = (float*)(ws + WS_OC);
    LAS unsigned* wmask = (LAS unsigned*)(lds + AT_MASK + wave * 1536);
    const int hq = kvh * 4 + g;
    { const char* kcb = (const char*)((const bf16*)(ws + WS_KCB) + (size_t)(b * 2 + kvh) * 128 * 64); const char* vct = (const char*)((const bf16*)(ws + WS_VCT) + (size_t)(b * 2 + kvh) * 64 * 128);
      for (int c = tid; c < 1024; c += 512) { const v4u v = *(const v4u*)(kcb + c * 16); *(LAS v4u*)(lds + (c >> 3) * 144 + (c & 7) * 16) = v; }
      for (int c = tid; c < 1024; c += 512) { const v4u v = *(const v4u*)(vct + c * 16); *(LAS v4u*)(lds + AT_CMPV + (c >> 4) * 272 + (c & 15) * 16) = v; } }
    __syncthreads();
    const int ng = (2 * tb + 2 + 15) >> 4;
#pragma nounroll
    for (int gi = 0; gi < 4; ++gi) {
        const int tl = 16 * wave + 4 * gi + tok_i, t = 128 * tb + tl, row = r0 + tl;
        const bf16* qp = QP + (size_t)row * 512 + hq * 64 + fq * 8;
        const s16x8 q0 = *(const s16x8*)qp, q1 = *(const s16x8*)(qp + 32);
        f32x4 S[8];
#pragma unroll
        for (int kg = 0; kg < 8; ++kg) { S[kg] = (f32x4){0.f, 0.f, 0.f, 0.f};
            if (kg < ng) { const s16x8 a0 = *(const LAS s16x8*)(lds + (16 * kg + fr) * 144 + fq * 16), a1 = *(const LAS s16x8*)(lds + (16 * kg + fr) * 144 + 64 + fq * 16);
                S[kg] = mfma16(a0, q0, S[kg]); S[kg] = mfma16(a1, q1, S[kg]); } }
        const int n_ok = (t + 1) >> 6, cur = t >> 6;
        float m = -INFINITY;
#pragma unroll
        for (int kg = 0; kg < 8; ++kg)
#pragma unroll
            for (int i = 0; i < 4; ++i) if (16 * kg + 4 * fq + i < n_ok) m = fmaxf(m, S[kg][i]);
        m = fmax_x16(m); m = fmax_x32(m); if (!(m > -INFINITY)) m = 0.f;
        float sum = 0.f;
#pragma unroll
        for (int kg = 0; kg < 8; ++kg)
#pragma unroll
            for (int i = 0; i < 4; ++i) { const float e = (16 * kg + 4 * fq + i < n_ok) ? __builtin_amdgcn_exp2f(S[kg][i] - m) : 0.f; S[kg][i] = e; sum += e; }
        sum = fsum_x16(sum); sum = fsum_x32(sum);
        const float inv = 1.0f / fmaxf(sum, 1e-30f);
#pragma unroll
        for (int kg = 0; kg < 8; ++kg) S[kg] *= inv;
        { f32x4 Oc[4];
#pragma unroll
          for (int dg = 0; dg < 4; ++dg) Oc[dg] = (f32x4){0.f, 0.f, 0.f, 0.f};
#pragma unroll
          for (int kc = 0; kc < 4; ++kc) if (2 * kc < ng) {
              v4u pk; pk.x = cvtpk(S[2 * kc][0], S[2 * kc][1]); pk.y = cvtpk(S[2 * kc][2], S[2 * kc][3]); pk.z = cvtpk(S[2 * kc + 1][0], S[2 * kc + 1][1]); pk.w = cvtpk(S[2 * kc + 1][2], S[2 * kc + 1][3]);
              const s16x8 pb = __builtin_bit_cast(s16x8, pk);
#pragma unroll
              for (int dg = 0; dg < 4; ++dg) { const s16x8 av = *(const LAS s16x8*)(lds + AT_CMPV + (16 * dg + fr) * 272 + kc * 64 + fq * 16); Oc[dg] = mfma16(av, pb, Oc[dg]); } }
          const float bg0 = BG[(size_t)row * 24 + hq * 3 + 0];
#pragma unroll
          for (int dg = 0; dg < 4; ++dg) *(f32x4*)(OC + (size_t)row * 512 + hq * 64 + 16 * dg + 4 * fq) = Oc[dg] * bg0; }
#pragma unroll
        for (int kg = 0; kg < 8; ++kg)
#pragma unroll
            for (int i = 0; i < 4; ++i) { float v = S[kg][i]; v += dpp_x1f(v); v += dpp_x2f(v); S[kg][i] = v; }
        unsigned key[8];
#pragma unroll
        for (int h = 0; h < 2; ++h)
#pragma unroll
            for (int i = 0; i < 4; ++i) { const float v = g == 0 ? S[h][i] : (g == 1 ? S[2 + h][i] : (g == 2 ? S[4 + h][i] : S[6 + h][i]));
                const int n = 16 * (2 * g + h) + 4 * fq + i; const bool forced = (n == 0) || (n == cur) || (n == cur - 1);
                const float scv = v + (forced ? 8.0f : 0.f);
                key[h * 4 + i] = (n <= cur) ? ((__float_as_uint(scv) & ~255u) | (unsigned)(255 - n)) : 0u; }
        unsigned m0 = 0u, m1 = 0u, m2 = 0u, m3 = 0u;
#pragma nounroll
        for (int round = 0; round < 16; ++round) {
            unsigned w = key[0];
#pragma unroll
            for (int j = 1; j < 8; ++j) w = key[j] > w ? key[j] : w;
            { unsigned o; o = dpp_x1(w); w = o > w ? o : w; o = dpp_x2(w); w = o > w ? o : w; w = umax_x16(w); w = umax_x32(w); }
            if (w != 0u) { const int n = 255 - (int)(w & 255u); const unsigned bit = 1u << (n & 31); const int wi = n >> 5;
                m0 |= wi == 0 ? bit : 0u; m1 |= wi == 1 ? bit : 0u; m2 |= wi == 2 ? bit : 0u; m3 |= wi == 3 ? bit : 0u;
#pragma unroll
                for (int j = 0; j < 8; ++j) key[j] = key[j] == w ? 0u : key[j]; }
        }
        if (g == 0 && fq == 0) { v4u mm; mm.x = m0; mm.y = m1; mm.z = m2; mm.w = m3; *(LAS v4u*)(wmask + (4 * gi + tok_i) * 4) = mm; }
        { unsigned o0 = m0, o1 = m1, o2 = m2, o3 = m3;
          o0 |= (unsigned)__shfl_xor((int)o0, 4); o1 |= (unsigned)__shfl_xor((int)o1, 4); o2 |= (unsigned)__shfl_xor((int)o2, 4); o3 |= (unsigned)__shfl_xor((int)o3, 4);
          o0 |= (unsigned)__shfl_xor((int)o0, 8); o1 |= (unsigned)__shfl_xor((int)o1, 8); o2 |= (unsigned)__shfl_xor((int)o2, 8); o3 |= (unsigned)__shfl_xor((int)o3, 8);
          if (lane == 0) { v4u mm; mm.x = o0; mm.y = o1; mm.z = o2; mm.w = o3; *(LAS v4u*)(wmask + 64 + gi * 4) = mm; } }
    }
    LDS_WAIT();
    __syncthreads();
    attn_pass<0>(a, lds, b, kvh, tb, wave, lane, tid);
    attn_pass<1>(a, lds, b, kvh, tb, wave, lane, tid);
    __syncthreads();
}
__device__ __forceinline__ void phase_attn(const Args& a, LAS unsigned char* lds, int vcu, int G, int wave, int lane, int tid) {
    for (int it = vcu; it < 2 * MS; it += G) attn_item<1>(a, MP + (it >> 1), it & 1, lds, wave, lane);
#pragma nounroll
    for (int u2 = 2 * vcu; u2 < 512; u2 += 2 * G) {
#pragma nounroll
        for (int h = 0; h < 2; ++h) { const int u = u2 >> 1, bh = u >> 5, s = u & 31; attn_unit(a, lds, bh >> 1, bh & 1, h ? 63 - s : s, wave, lane, tid); } }
}
#if PROBE_ATTN
__device__ __forceinline__ void phase_attn_check(const Args& a, LAS unsigned char* lds, int gw, int NGW, int wave, int lane) {
    for (int it = gw; it < 2 * 2048; it += NGW) { const int idx = it >> 1; int r;
        if (idx < 300) r = idx; else if (idx < 600) r = 3 * 8192 + 900 + (idx - 300); else r = (int)(((long)(idx - 600) * 22639L) % MP);
        attn_item<2>(a, r, it & 1, lds, wave, lane); }
}
#endif


template <class F> __device__ __forceinline__ void small_gemm(const bf16* A, const bf16* Bt, int N, int K, int vcu, int G, int wave, int lane_, LAS unsigned char* lds, const F& f) {
    int lane = lane_;
    const int ntiles = 16 * (N >> 6), nk = K >> 7;
#pragma nounroll
    for (int tile = vcu; tile < ntiles; tile += G) {
        asm volatile("" : "+v"(lane));
        const int fr = lane & 15, fq = lane >> 4, rt = tile & 15, ct = tile >> 4;
        const bf16* ap = A + (size_t)(16 * rt + fr) * K + 8 * fq; const bf16* bp = Bt + (size_t)(64 * ct + fr) * K + 8 * fq;
        f32x4 acc[4];
#pragma unroll
        for (int j = 0; j < 4; ++j) acc[j] = (f32x4){0.f, 0.f, 0.f, 0.f};
#pragma nounroll
        for (int it = wave; it < nk; it += NWAVES) { const int k0 = it << 7;
            s16x8 af[4], bfr[4][4];
#pragma unroll
            for (int q = 0; q < 4; ++q) { af[q] = *(const s16x8*)(ap + k0 + 32 * q);
#pragma unroll
                for (int j = 0; j < 4; ++j) bfr[q][j] = *(const s16x8*)(bp + (size_t)(16 * j) * K + k0 + 32 * q); }
#pragma unroll
            for (int q = 0; q < 4; ++q)
#pragma unroll
                for (int j = 0; j < 4; ++j) acc[j] = mfma16(bfr[q][j], af[q], acc[j]);
        }
        LAS f32x4* red = (LAS f32x4*)lds;
#pragma unroll
        for (int j = 0; j < 4; ++j) red[(wave * 4 + j) * 64 + lane] = acc[j];
        __syncthreads();
        if (wave < 4) { f32x4 sum = red[wave * 64 + lane];
#pragma unroll
            for (int w = 1; w < NWAVES; ++w) sum += red[(w * 4 + wave) * 64 + lane];
            f(16 * rt + fr, 64 * ct + 16 * wave + 4 * fq, sum); }
        __syncthreads();
    }
}
__device__ __forceinline__ void sample_post(const Args& a, int gw, int NGW, int lane) {
    unsigned char* ws = a.ws; float* out = a.out;
    const float* Z = (const float*)(ws + WS_ZS);
    const float* rc = (const float*)(ws + WS_ROPE); const float* rs = rc + ROPE_N * 32;
    bf16* U = (bf16*)(ws + WS_U); bf16* QP = (bf16*)(ws + WS_QP); bf16* QR = (bf16*)(ws + WS_QR); bf16* GC = (bf16*)(ws + WS_GC); bf16* GN = (bf16*)(ws + WS_GN);
    float* BG = (float*)(ws + WS_BG);
    const float qg = a.in[16][lane]; const float kg0 = a.in[17][lane], kg1 = a.in[17][64 + lane], kg2 = a.in[17][128 + lane];
    for (int r = MP + gw; r < MT; r += NGW) {
        const float* z = Z + (size_t)(r - MP) * DINP;
        float zg[16], zq[8], zk[12], zm[32], zn;
#pragma unroll
        for (int i = 0; i < 8; ++i) { zg[i] = z[front_rowmap(lane + 64 * i)]; zg[8 + i] = z[front_rowmap(512 + lane + 64 * i)]; zq[i] = z[front_rowmap(OFF_Q + 64 * i + lane)]; }
#pragma unroll
        for (int i = 0; i < 12; ++i) zk[i] = z[front_rowmap(OFF_KV + 64 * i + lane)];
#pragma unroll
        for (int i = 0; i < 32; ++i) zm[i] = z[front_rowmap(OFF_MG + lane + 64 * i)];
        zn = z[front_rowmap(OFF_NG + (lane < 24 ? lane : 0))];
        const bool smp = r >= MP; const int rs_ = r - MP, sb = rs_ >> 3, si = rs_ & 7, b = r >> 13, t = r & 8191;
        const int ri = rope_idx(r); const float cv = rc[ri * 32 + (lane & 31)], sv = rs[ri * 32 + (lane & 31)];
#pragma unroll
        for (int i = 0; i < 8; ++i) { const int c = lane + 64 * i; const float u = zg[i] * sigm(zg[8 + i]);
            U[(size_t)r * 512 + c] = (bf16)f2bf(u);
            if (smp) out[O_SCONV + (size_t)(sb * 30 + 22 + si) * 512 + c] = u;
            else if (t >= 8162) out[O_PCONV + (size_t)(b * 30 + t - 8162) * 512 + c] = u; }
#pragma unroll
        for (int h = 0; h < 8; ++h) { const float x = zq[h]; const float ms = wave_sum(x * x) * (1.0f / 64.0f);
            const float y = x * (1.0f / sqrtf(ms + EPS)) * qg; const float oth = __shfl_xor(y, 32);
            const float yr = lane < 32 ? y * cv - oth * sv : y * cv + oth * sv;
            QP[(size_t)r * 512 + 64 * h + lane] = (bf16)f2bf(y * C2); QR[(size_t)r * 512 + 64 * h + lane] = (bf16)f2bf(yr * C2); }
#pragma unroll
        for (int j = 0; j < 6; ++j)
#pragma unroll
            for (int kvh = 0; kvh < 2; ++kvh) {
                float x = zk[2 * j + kvh];
                if ((j & 1) == 0) { const float ms = wave_sum(x * x) * (1.0f / 64.0f); x = x * (1.0f / sqrtf(ms + EPS)) * (j == 0 ? kg0 : (j == 2 ? kg1 : kg2));
                    if (j >= 2) { const float oth = __shfl_xor(x, 32); x = lane < 32 ? x * cv - oth * sv : x * cv + oth * sv; } }
                const int cc = kvh * 64 + lane;
                if (j < 4) { const size_t po = (j == 0 ? O_PCK : j == 1 ? O_PCV : j == 2 ? O_PSK : O_PSV), so = (j == 0 ? O_SCK : j == 1 ? O_SCV : j == 2 ? O_SSK : O_SSV);
                    if (smp) out[so + (size_t)rs_ * 128 + cc] = x; else out[po + (size_t)r * 128 + cc] = x; }
                if (!smp && j >= 2) { const size_t blk = ((size_t)(b * 128 + (t >> 6)) * 2 + kvh) * 4096; const int key = t & 63;
                    if (j == 2) ((bf16*)(ws + WS_KSB))[blk + key * 64 + lane] = (bf16)f2bf(x); else if (j == 3) ((bf16*)(ws + WS_VST))[blk + lane * 64 + perm64(key)] = (bf16)f2bf(x);
                    else if (j == 4) ((bf16*)(ws + WS_KWB))[blk + key * 64 + lane] = (bf16)f2bf(x); else ((bf16*)(ws + WS_VWT))[blk + lane * 64 + perm64(key)] = (bf16)f2bf(x); }
                if (j >= 4) { if (smp) out[(j == 4 ? O_SWK : O_SWV) + (size_t)(sb * 512 + 504 + si) * 128 + cc] = x;
                        }
            }
        if (lane < 24) BG[(size_t)r * 24 + lane] = sigm(zn);
#pragma unroll
        for (int i = 0; i < 32; ++i) { const int c = lane + 64 * i; const float v = sigm(zm[i]);
            if (i < 16) GC[(size_t)r * 1024 + c] = (bf16)f2bf(v); else GN[(size_t)r * 1024 + c - 1024] = (bf16)f2bf(v); }
    }
}


constexpr int N_PHASES = 12;
#ifndef ONE_LAUNCH
#define ONE_LAUNCH 1
#endif
__global__ void __launch_bounds__(NWAVES * 64, 2) fwd(Args args) {
    extern __shared__ __attribute__((aligned(16))) unsigned char lds_raw[];
    LAS unsigned char* lds = (LAS unsigned char*)lds_raw;
    const int tid = threadIdx.x, lane = tid & 63, wave = __builtin_amdgcn_readfirstlane(tid >> 6);
    const int G = gridDim.x, bx = blockIdx.x;
    const int vcu = (G % 8 == 0) ? (bx % 8) * (G / 8) + bx / 8 : bx;
    const int gw = vcu * NWAVES + wave, NGW = G * NWAVES;
    unsigned char* ws = args.ws;
    for (int u = tid; u < (LDS_BYTES - RING_BYTES) / 4; u += NWAVES * 64) ((LAS unsigned*)(lds + RING_BYTES))[u] = 0u;
    __syncthreads();
    XcdBarrier bar; bar.bar = (unsigned*)(ws + WS_CTL) + CW_BAR; bar.x = 0; bar.st = nullptr;
    if (ONE_LAUNCH) bar = xcd_barrier_post((unsigned*)(ws + WS_CTL) + CW_BAR, (volatile LAS unsigned*)(lds + MISC_OFF) + 8);
    const int lo = args.ph_lo, hi = args.ph_hi;
#define IN(k) (lo <= (k) && (k) < hi)
#define SEAM(k) do { if (ONE_LAUNCH && IN(k) && hi > (k) + 1) xcd_barrier(bar); } while (0)
    const float* modp = (const float*)(ws + WS_MOD);
    if (IN(0)) { phase0(args, lds, gw, NGW, wave, lane); } SEAM(0);
    if (IN(1)) { norm_rows(args.in[0], args.in[1], args.in[14], modp, 0, 1024, (bf16*)(ws + WS_H), gw, NGW, lane); } SEAM(1);
    if (IN(2)) { pg8::Gemm g{(const bf16*)(ws + WS_H), (const bf16*)(ws + WS_WIN), MP, DINP, 1024}; pg8::StaticOrder S; S.init(MP, DINP, G, bx);
        const float* rcp_ = (const float*)(ws + WS_ROPE);
        pg8::EpiFront E{args.out, ws, args.in[16], args.in[17], rcp_, rcp_ + ROPE_N * 32, O_PCK, O_SCK, O_PWK, O_SWK, O_PCONV, O_SCONV,
                        WS_U, WS_QP, WS_QR, WS_GC, WS_GN, WS_BG, WS_KSB, WS_VST, WS_KWB, WS_VWT, WS_KWIN, WS_VWIN, C2};
        pg8::gemm_phase<pg8::EpiFront, pg8::StaticOrder, true, true>(lds, g, S, E);
        { float* zs = (float*)(ws + WS_ZS);
          small_gemm((const bf16*)(ws + WS_H) + (size_t)MP * 1024, (const bf16*)(ws + WS_WIN), DINP, 1024, vcu, G, wave, lane, lds, [&](int r, int c, f32x4 v) { *(f32x4*)(zs + (size_t)r * DINP + c) = v; }); } } SEAM(2);
    if (IN(3)) { sample_post(args, gw, NGW, lane); } SEAM(3);
    if (IN(4)) { phase_conv(args, lds, vcu, G, gw, NGW, wave, lane, tid); } SEAM(4);
    if (IN(5)) { pg8::Gemm g{(const bf16*)(ws + WS_CACT), (const bf16*)(ws + WS_WPW2), MP, 1024, 512}; pg8::StaticOrder S; S.init(MP, 1024, G, bx);
        pg8::EpiGate<false> E{(bf16*)(ws + WS_T1), (const bf16*)(ws + WS_GC), 1024};
        pg8::gemm_phase<pg8::EpiGate<false>, pg8::StaticOrder, true, true>(lds, g, S, E);
        { bf16* t1 = (bf16*)(ws + WS_T1) + (size_t)MP * 1024; const bf16* gc = (const bf16*)(ws + WS_GC) + (size_t)MP * 1024;
          small_gemm((const bf16*)(ws + WS_CACT) + (size_t)MP * 512, (const bf16*)(ws + WS_WPW2), 1024, 512, vcu, G, wave, lane, lds, [&](int r, int c, f32x4 v) {
              const v2u gg = *(const v2u*)(gc + (size_t)r * 1024 + c); v2u w; w.x = pk2(v[0] * pg8::bf_lo(gg.x), v[1] * pg8::bf_hi(gg.x)); w.y = pk2(v[2] * pg8::bf_lo(gg.y), v[3] * pg8::bf_hi(gg.y));
              *(v2u*)(t1 + (size_t)r * 1024 + c) = w; }); } }
    if (IN(5) && !IN(6)) SEAM(5);
    if (IN(6)) { phase_attn(args, lds, vcu, G, wave, lane, tid); } SEAM(6);
#if PROBE_ATTN
    if (IN(7)) { phase_attn_check(args, lds, gw, NGW, wave, lane); __syncthreads(); }
#endif
    if (IN(7)) { pg8::Gemm g{(const bf16*)(ws + WS_O), (const bf16*)(ws + WS_WNSA), MP, 1024, 512}; pg8::StaticOrder S; S.init(MP, 1024, G, bx);
        pg8::EpiGate<true> E{(bf16*)(ws + WS_T1), (const bf16*)(ws + WS_GN), 1024};
        pg8::gemm_phase<pg8::EpiGate<true>, pg8::StaticOrder, true, true>(lds, g, S, E);
        { bf16* t1 = (bf16*)(ws + WS_T1) + (size_t)MP * 1024; const bf16* gn = (const bf16*)(ws + WS_GN) + (size_t)MP * 1024;
          small_gemm((const bf16*)(ws + WS_O) + (size_t)MP * 512, (const bf16*)(ws + WS_WNSA), 1024, 512, vcu, G, wave, lane, lds, [&](int r, int c, f32x4 v) {
              const v2u gg = *(const v2u*)(gn + (size_t)r * 1024 + c); const v2u tt = *(const v2u*)(t1 + (size_t)r * 1024 + c); v2u w;
              w.x = pk2(pg8::bf_lo(tt.x) + v[0] * pg8::bf_lo(gg.x), pg8::bf_hi(tt.x) + v[1] * pg8::bf_hi(gg.x)); w.y = pk2(pg8::bf_lo(tt.y) + v[2] * pg8::bf_lo(gg.y), pg8::bf_hi(tt.y) + v[3] * pg8::bf_hi(gg.y));
              *(v2u*)(t1 + (size_t)r * 1024 + c) = w; }); } } SEAM(7);
    if (IN(8)) { pg8::Gemm g{(const bf16*)(ws + WS_T1), (const bf16*)(ws + WS_WOUT), MP, 1024, 1024}; pg8::StaticOrder S; S.init(MP, 1024, G, bx);
        pg8::EpiResGate E{args.in[0], args.in[1], args.out, modp + 2048};
        pg8::gemm_phase<pg8::EpiResGate, pg8::StaticOrder, true, true>(lds, g, S, E);
        { const float* xs = args.in[1]; float* ys = args.out + (size_t)MP * 1024; const float* mg = modp + 2048;
          small_gemm((const bf16*)(ws + WS_T1) + (size_t)MP * 1024, (const bf16*)(ws + WS_WOUT), 1024, 1024, vcu, G, wave, lane, lds, [&](int r, int c, f32x4 v) {
              *(f32x4*)(ys + (size_t)r * 1024 + c) = *(const f32x4*)(xs + (size_t)r * 1024 + c) + *(const f32x4*)(mg + (size_t)(4 + (r >> 3)) * 6144 + c) * v; }); } } SEAM(8);
    if (IN(9)) { norm_rows(args.out, args.out + (size_t)MP * 1024, args.in[29], modp, 3072, 4096, (bf16*)(ws + WS_H), gw, NGW, lane); } SEAM(9);
    if (IN(10)) { pg8::Gemm g{(const bf16*)(ws + WS_H), (const bf16*)(ws + WS_WGU), MP, 2 * DFF, 1024}; pg8::StaticOrder S; S.init(MP, 2 * DFF, G, bx);
        pg8::EpiSwiGlu E{(bf16*)(ws + WS_ACT), DFF};
        pg8::gemm_phase<pg8::EpiSwiGlu, pg8::StaticOrder, true, true>(lds, g, S, E);
        { bf16* act = (bf16*)(ws + WS_ACT) + (size_t)MP * DFF;
          small_gemm((const bf16*)(ws + WS_H) + (size_t)MP * 1024, (const bf16*)(ws + WS_WGU), 2 * DFF, 1024, vcu, G, wave, lane, lds, [&](int r, int c, f32x4 v) {
              f32x4 up; up[0] = __shfl_xor(v[0], 16); up[1] = __shfl_xor(v[1], 16); up[2] = __shfl_xor(v[2], 16); up[3] = __shfl_xor(v[3], 16);
              if ((c & 4) == 0) { v2u w; w.x = pk2(v[0] * sigm(v[0]) * up[0], v[1] * sigm(v[1]) * up[1]); w.y = pk2(v[2] * sigm(v[2]) * up[2], v[3] * sigm(v[3]) * up[3]);
                  *(v2u*)(act + (size_t)r * DFF + (c >> 1)) = w; } }); } } SEAM(10);
    if (IN(11)) { pg8::Gemm g{(const bf16*)(ws + WS_ACT), (const bf16*)(ws + WS_WDOWN), MP, 1024, DFF}; pg8::StaticOrder S; S.init(MP, 1024, G, bx);
        pg8::EpiResGate E{args.out, args.out + (size_t)MP * 1024, args.out, modp + 5120};
        pg8::gemm_phase<pg8::EpiResGate, pg8::StaticOrder, true, true>(lds, g, S, E);
        { float* ys = args.out + (size_t)MP * 1024; const float* mg = modp + 5120;
          small_gemm((const bf16*)(ws + WS_ACT) + (size_t)MP * DFF, (const bf16*)(ws + WS_WDOWN), 1024, DFF, vcu, G, wave, lane, lds, [&](int r, int c, f32x4 v) {
              float* o = ys + (size_t)r * 1024 + c; *(f32x4*)o = *(const f32x4*)o + *(const f32x4*)(mg + (size_t)(4 + (r >> 3)) * 6144 + c) * v; }); } }
#if PROBE_ATTN
    if (ONE_LAUNCH) { xcd_barrier(bar); const unsigned cnt = __hip_atomic_load((unsigned*)(ws + WS_CTL) + 8, __ATOMIC_RELAXED, __HIP_MEMORY_SCOPE_AGENT);
        if (bx == 0 && tid < 64 && cnt != 0u) args.out[tid] = 10.0f * (float)(1 + (31 - __builtin_clz(cnt))); }
#endif
#undef IN
#undef SEAM
}

extern "C" void kernel_launch(void* const* d_in, const int* in_sizes, int n_in, void* d_out, int out_size, void* d_ws, size_t ws_size, hipStream_t stream) {
    static int grid = 0;
    if (grid == 0) {
        if (n_in != 33 || (size_t)out_size != O_END || ws_size < WS_END) { fprintf(stderr, "kernel_launch: unexpected shapes (n_in %d out %d ws %zu)\n", n_in, out_size, ws_size); grid = -1; return; }
        int dev = 0, cus = 0, per_cu = 0;
        if (hipGetDevice(&dev) != hipSuccess || hipDeviceGetAttribute(&cus, hipDeviceAttributeMultiprocessorCount, dev) != hipSuccess) { grid = -1; return; }
        if (hipFuncSetAttribute((const void*)fwd, hipFuncAttributeMaxDynamicSharedMemorySize, LDS_BYTES) != hipSuccess) { fprintf(stderr, "kernel_launch: hipFuncSetAttribute failed\n"); grid = -1; return; }
        if (hipOccupancyMaxActiveBlocksPerMultiprocessor(&per_cu, (const void*)fwd, NWAVES * 64, LDS_BYTES) != hipSuccess || per_cu < 1) fprintf(stderr, "kernel_launch: occupancy query says %d\n", per_cu);
        (void)hipGetLastError();
        grid = cus;
    }
    if (grid < 0) return;
    (void)hipMemsetAsync((char*)d_ws, 0, ZERO_BYTES, stream);
    Args a{};
    for (int i = 0; i < 33; ++i) a.in[i] = (const float*)d_in[i];
    a.out = (float*)d_out; a.ws = (unsigned char*)d_ws;
#if ONE_LAUNCH
    a.ph_lo = 0; a.ph_hi = N_PHASES;
    hipLaunchKernelGGL(fwd, dim3(grid), dim3(NWAVES * 64), LDS_BYTES, stream, a);
#else
    for (int p = 0; p < N_PHASES; ++p) { a.ph_lo = p; a.ph_hi = p + 1; hipLaunchKernelGGL(fwd, dim3(grid), dim3(NWAVES * 64), LDS_BYTES, stream, a); }
#endif
}
```

```cpp
#include <hip/hip_runtime.h>
#include <cstdio>
#include <cstdint>
#include <cmath>
#define PROBE_PHASE -1
#ifndef PROBE_ATTN
#define PROBE_ATTN 0
#endif
namespace pg8 {
#define PG8_LAS __attribute__((address_space(3)))
typedef unsigned short bf16_t;
typedef short bf16x8 __attribute__((ext_vector_type(8)));
typedef float f32x4 __attribute__((ext_vector_type(4)));
typedef unsigned u32x4 __attribute__((ext_vector_type(4)));
constexpr int BM = 256, BK = 64, HALF = 128, HTB = HALF * BK * 2  , STAGE_BYTES = 8 * HTB, NXCD = 8, WGM = 8;

__host__ __device__ __forceinline__ int lds_byte(int r, int c) { const int st = (r >> 4) * 2 + (c >> 5), rr = r & 15, cc = c & 31, ob = rr * 64 + cc * 2; return st * 1024 + (ob ^ (((ob >> 9) & 1) << 5)); }
__host__ __device__ __forceinline__ void stage_rc(int b, int& R, int& C) { const int st = b / 1024, sb = b % 1024, swz = sb ^ (((sb >> 9) & 1) << 5); R = (st >> 1) * 16 + swz / 64; C = (st & 1) * 32 + (swz % 64) / 2; }
__host__ __device__ __forceinline__ int perm32(int rho) { const int n = rho >> 4, i = rho & 15; return 8 * (i >> 2) + 4 * n + (i & 3); }

struct Unit { int pm, pn; };
struct Gemm { const bf16_t* A; const bf16_t* Bt; int M, N, K; };

struct StaticOrder {
    int nM, nN, nwg, G, c;
    __host__ __device__ void init(int M, int N, int G_, int c_) { nM = M / BM; nN = N / BM; nwg = nM * nN; G = G_; c = c_; }
    __host__ __device__ bool next(int i, Unit& u) const {
        const long L = (long)i * G + c; if (L >= nwg) return false;
        int wgid = (int)L; { const int q = nwg / NXCD, r = nwg % NXCD, xcd = wgid % NXCD, off = wgid / NXCD; wgid = (xcd < r ? xcd * (q + 1) : r * (q + 1) + (xcd - r) * q) + off; }
        const int nig = WGM * nN, gid = wgid / nig, fm = gid * WGM, gsz = (nM - fm) < WGM ? (nM - fm) : WGM;
        u.pm = fm + ((wgid % nig) % gsz); u.pn = (wgid % nig) / gsz; return true;
    }
    __device__ __forceinline__ void a_ready(const Unit&) const {}
    __device__ __forceinline__ void done(const Unit&) const {}
};

typedef float f32x2_cv __attribute__((ext_vector_type(2))); typedef __bf16 bf16x2_cv __attribute__((ext_vector_type(2)));
__device__ __forceinline__ unsigned cvt_pk_bf16(float lo, float hi) { f32x2_cv v = {lo, hi}; bf16x2_cv b = __builtin_convertvector(v, bf16x2_cv); return __builtin_bit_cast(unsigned, b); }
typedef float f32x2 __attribute__((ext_vector_type(2)));

constexpr int ROWS_P = 32768;
__device__ __forceinline__ int mod_row(int r) { return r < ROWS_P ? (r >> 13) : 4 + ((r - ROWS_P) >> 3); }
__device__ __forceinline__ float bf_lo(unsigned w) { return __uint_as_float(w << 16); }
__device__ __forceinline__ float bf_hi(unsigned w) { return __uint_as_float(w & 0xffff0000u); }
__device__ __forceinline__ float sigmoid_f(float x) { return __builtin_amdgcn_rcpf(1.0f + __builtin_amdgcn_exp2f(-1.4426950408889634f * x)); }

struct EpiF32 {
    static constexpr bool PERM = false, AFTER_DRAIN = false;
    float* C; int ldc;
    __device__ __forceinline__ void operator()(const f32x4 (&acc)[2][2][4][2], const Unit& u, int wr, int wc, int fr, int fq) const {
        const int row0 = u.pm * BM + wr * 64 + fr, col0 = u.pn * BM + wc * 32 + 4 * fq;
#pragma unroll
        for (int ai = 0; ai < 2; ++ai)
#pragma unroll
            for (int m = 0; m < 4; ++m) { float* rowp = C + (size_t)(row0 + ai * HALF + m * 16) * ldc + col0;
#pragma unroll
                for (int bj = 0; bj < 2; ++bj)
#pragma unroll
                    for (int n = 0; n < 2; ++n) *(f32x4*)(rowp + bj * HALF + n * 16) = acc[ai][bj][m][n]; }
    }
};
template <bool ADD> struct EpiGate {
    static constexpr bool PERM = true, AFTER_DRAIN = false;
    bf16_t* O; const bf16_t* G; int ldc;
    __device__ __forceinline__ void operator()(const f32x4 (&acc)[2][2][4][2], const Unit& u, int wr, int wc, int fr, int fq) const {
        const int row0 = u.pm * BM + wr * 64 + fr, col0 = u.pn * BM + wc * 32 + 8 * fq;
#pragma unroll
        for (int ai = 0; ai < 2; ++ai)
#pragma unroll
            for (int m = 0; m < 4; ++m) { const size_t ro = (size_t)(row0 + ai * HALF + m * 16) * ldc + col0;
#pragma unroll
                for (int bj = 0; bj < 2; ++bj) {
                    const u32x4 g = *(const u32x4*)(G + ro + bj * HALF);
                    f32x4 v0 = acc[ai][bj][m][0], v1 = acc[ai][bj][m][1];
                    v0[0] *= bf_lo(g.x); v0[1] *= bf_hi(g.x); v0[2] *= bf_lo(g.y); v0[3] *= bf_hi(g.y);
                    v1[0] *= bf_lo(g.z); v1[1] *= bf_hi(g.z); v1[2] *= bf_lo(g.w); v1[3] *= bf_hi(g.w);
                    if (ADD) { const u32x4 t = *(const u32x4*)(O + ro + bj * HALF);
                        v0[0] += bf_lo(t.x); v0[1] += bf_hi(t.x); v0[2] += bf_lo(t.y); v0[3] += bf_hi(t.y);
                        v1[0] += bf_lo(t.z); v1[1] += bf_hi(t.z); v1[2] += bf_lo(t.w); v1[3] += bf_hi(t.w); }
                    u32x4 w; w.x = cvt_pk_bf16(v0[0], v0[1]); w.y = cvt_pk_bf16(v0[2], v0[3]); w.z = cvt_pk_bf16(v1[0], v1[1]); w.w = cvt_pk_bf16(v1[2], v1[3]);
                    *(u32x4*)(O + ro + bj * HALF) = w; } }
    }
};
struct EpiResGate {
    static constexpr bool PERM = true, AFTER_DRAIN = false;
    const float* bp; const float* bs; float* out; const float* modg;
    __device__ __forceinline__ void operator()(const f32x4 (&acc)[2][2][4][2], const Unit& u, int wr, int wc, int fr, int fq) const {
        const int row0 = u.pm * BM + wr * 64 + fr, col0 = u.pn * BM + wc * 32 + 8 * fq;
        const float* g = modg + (size_t)mod_row(u.pm * BM) * 6144 + col0;
        f32x4 gv[2][2];
#pragma unroll
        for (int bj = 0; bj < 2; ++bj)
#pragma unroll
            for (int n = 0; n < 2; ++n) gv[bj][n] = *(const f32x4*)(g + bj * HALF + n * 4);
#pragma unroll
        for (int ai = 0; ai < 2; ++ai)
#pragma unroll
            for (int m = 0; m < 4; ++m) { const int r = row0 + ai * HALF + m * 16;
                const float* b = (r < ROWS_P ? bp + (size_t)r * 1024 : bs + (size_t)(r - ROWS_P) * 1024) + col0; float* o = out + (size_t)r * 1024 + col0;
#pragma unroll
                for (int bj = 0; bj < 2; ++bj)
#pragma unroll
                    for (int n = 0; n < 2; ++n) { const f32x4 bv = *(const f32x4*)(b + bj * HALF + n * 4);
                        *(f32x4*)(o + bj * HALF + n * 4) = bv + gv[bj][n] * acc[ai][bj][m][n]; } }
    }
};
struct EpiSwiGlu {
    static constexpr bool PERM = true, AFTER_DRAIN = false;
    bf16_t* O; int ldo;
    __device__ __forceinline__ void operator()(const f32x4 (&acc)[2][2][4][2], const Unit& u, int wr, int wc, int fr, int fq) const {
        const int row0 = u.pm * BM + wr * 64 + fr, oc0 = u.pn * 128 + wc * 32 + 8 * fq;
#pragma unroll
        for (int ai = 0; ai < 2; ++ai)
#pragma unroll
            for (int m = 0; m < 4; ++m) { bf16_t* rowp = O + (size_t)(row0 + ai * HALF + m * 16) * ldo + oc0; f32x4 a[2];
#pragma unroll
                for (int bj = 0; bj < 2; ++bj) { const f32x4 gt = acc[ai][bj][m][0], up = acc[ai][bj][m][1];
#pragma unroll
                    for (int i = 0; i < 4; ++i) a[bj][i] = gt[i] * sigmoid_f(gt[i]) * up[i]; }
                u32x4 w; w.x = cvt_pk_bf16(a[0][0], a[0][1]); w.y = cvt_pk_bf16(a[0][2], a[0][3]); w.z = cvt_pk_bf16(a[1][0], a[1][1]); w.w = cvt_pk_bf16(a[1][2], a[1][3]);
                *(u32x4*)rowp = w; }
    }
};

struct EpiFront {
    static constexpr bool PERM = true, AFTER_DRAIN = false;
    float* out; unsigned char* ws; const float* qg; const float* kng; const float* rc; const float* rsn;
    size_t o_pck, o_sck, o_pwk, o_swk, o_pconv, o_sconv;
    size_t w_u, w_qp, w_qr, w_gc, w_gn, w_bg, w_ksb, w_vst, w_kwb, w_vwt, w_kwin, w_vwin;
    float c2;
    __device__ __forceinline__ void operator()(const f32x4 (&acc)[2][2][4][2], const Unit& u, int wr, int wc, int fr, int fq) const {
        typedef unsigned u32x2 __attribute__((ext_vector_type(2)));
        const int pn = u.pn;
        const int row0 = u.pm * BM + wr * 64 + fr;
        if (pn < 4) {
            bf16_t* U = (bf16_t*)(ws + w_u);
#pragma unroll
            for (int ai = 0; ai < 2; ++ai)
#pragma unroll
                for (int m = 0; m < 4; ++m) { const int r = row0 + ai * HALF + m * 16; const int t = r & 8191;
#pragma unroll
                    for (int bj = 0; bj < 2; ++bj) { const int ch = 128 * pn + 64 * bj + 16 * wc + 4 * fq; const f32x4 a4 = acc[ai][bj][m][0], b4 = acc[ai][bj][m][1]; f32x4 u4;
#pragma unroll
                        for (int i = 0; i < 4; ++i) u4[i] = a4[i] * sigmoid_f(b4[i]);
                        u32x2 w; w.x = cvt_pk_bf16(u4[0], u4[1]); w.y = cvt_pk_bf16(u4[2], u4[3]); *(u32x2*)(U + (size_t)r * 512 + ch) = w;
                        if (t >= 8162) *(f32x4*)(out + o_pconv + (size_t)((r >> 13) * 30 + t - 8162) * 512 + ch) = u4; } }
        } else if (pn < 9) {
            const bool isq = pn < 6; const int kvt = pn - 6;
            const bool isv = !isq && (wc >= 2); const bool dorope = isq || (!isv && kvt >= 1);
            const float* gp = isq ? qg : kng + kvt * 64;
            f32x4 gn[2][2];
#pragma unroll
            for (int bj = 0; bj < 2; ++bj)
#pragma unroll
                for (int n = 0; n < 2; ++n) gn[bj][n] = isv ? (f32x4){1.f, 1.f, 1.f, 1.f} : *(const f32x4*)(gp + 32 * bj + 8 * fq + 4 * n);
#pragma unroll
            for (int ai = 0; ai < 2; ++ai)
#pragma unroll
                for (int m = 0; m < 4; ++m) { const int r = row0 + ai * HALF + m * 16;
                    f32x4 y[2][2];
#pragma unroll
                    for (int bj = 0; bj < 2; ++bj)
#pragma unroll
                        for (int n = 0; n < 2; ++n) y[bj][n] = acc[ai][bj][m][n];
                    if (!isv) { float ss = 0.f;
#pragma unroll
                        for (int bj = 0; bj < 2; ++bj)
#pragma unroll
                            for (int n = 0; n < 2; ++n) ss += (y[bj][n][0] * y[bj][n][0] + y[bj][n][1] * y[bj][n][1]) + (y[bj][n][2] * y[bj][n][2] + y[bj][n][3] * y[bj][n][3]);
                        ss += __shfl_xor(ss, 16); ss += __shfl_xor(ss, 32);
                        const float rstd = 1.0f / sqrtf(ss * (1.0f / 64.0f) + 1e-6f);
#pragma unroll
                        for (int bj = 0; bj < 2; ++bj)
#pragma unroll
                            for (int n = 0; n < 2; ++n) y[bj][n] = y[bj][n] * rstd * gn[bj][n]; }
                    const int ri = r & 8191;
                    f32x4 yr[2][2];
                    if (dorope) {
#pragma unroll
                        for (int n = 0; n < 2; ++n) { const f32x4 c4 = *(const f32x4*)(rc + (size_t)ri * 32 + 8 * fq + 4 * n), s4 = *(const f32x4*)(rsn + (size_t)ri * 32 + 8 * fq + 4 * n);
                            yr[0][n] = y[0][n] * c4 - y[1][n] * s4; yr[1][n] = y[1][n] * c4 + y[0][n] * s4; } }
                    else {
#pragma unroll
                        for (int n = 0; n < 2; ++n) { yr[0][n] = y[0][n]; yr[1][n] = y[1][n]; } }
                    if (isq) { const int h = 4 * (pn - 4) + wc; bf16_t* qp = (bf16_t*)(ws + w_qp) + (size_t)r * 512 + h * 64 + 8 * fq; bf16_t* qr = (bf16_t*)(ws + w_qr) + (size_t)r * 512 + h * 64 + 8 * fq;
#pragma unroll
                        for (int bj = 0; bj < 2; ++bj) { const f32x4 a0 = y[bj][0] * c2, a1 = y[bj][1] * c2, b0 = yr[bj][0] * c2, b1 = yr[bj][1] * c2; u32x4 w;
                            w.x = cvt_pk_bf16(a0[0], a0[1]); w.y = cvt_pk_bf16(a0[2], a0[3]); w.z = cvt_pk_bf16(a1[0], a1[1]); w.w = cvt_pk_bf16(a1[2], a1[3]); *(u32x4*)(qp + 32 * bj) = w;
                            w.x = cvt_pk_bf16(b0[0], b0[1]); w.y = cvt_pk_bf16(b0[2], b0[3]); w.z = cvt_pk_bf16(b1[0], b1[1]); w.w = cvt_pk_bf16(b1[2], b1[3]); *(u32x4*)(qr + 32 * bj) = w; } }
                    else { const int kvh = wc & 1; const int j = 2 * kvt + (isv ? 1 : 0);
                        const int t = r & 8191;
                        float* fo = nullptr;
                        if (j < 4) fo = out + o_pck + (size_t)j * 4194304 + (size_t)r * 128; else if (t >= 7680) fo = out + o_pwk + (size_t)(j - 4) * 262144 + (size_t)((r >> 13) * 512 + t - 7680) * 128;
                        if (fo) {
#pragma unroll
                            for (int bj = 0; bj < 2; ++bj)
#pragma unroll
                                for (int n = 0; n < 2; ++n) *(f32x4*)(fo + kvh * 64 + 32 * bj + 8 * fq + 4 * n) = yr[bj][n]; }
#if defined(PROBE_ATTN) && PROBE_ATTN
                        if (kvt == 2) { float* kw = (float*)(ws + (isv ? w_vwin : w_kwin)) + (size_t)r * 128 + kvh * 64;
#pragma unroll
                            for (int bj = 0; bj < 2; ++bj)
#pragma unroll
                                for (int n = 0; n < 2; ++n) *(f32x4*)(kw + 32 * bj + 8 * fq + 4 * n) = yr[bj][n]; }
#endif
                        if (kvt >= 1) { const int key = t & 63; const size_t blk = ((size_t)((r >> 13) * 128 + (t >> 6)) * 2 + kvh) * 4096;
                            if (!isv) { bf16_t* kd = (bf16_t*)(ws + (kvt == 1 ? w_ksb : w_kwb)) + blk + key * 64 + 8 * fq;
#pragma unroll
                                for (int bj = 0; bj < 2; ++bj) { u32x4 w; w.x = cvt_pk_bf16(yr[bj][0][0], yr[bj][0][1]); w.y = cvt_pk_bf16(yr[bj][0][2], yr[bj][0][3]); w.z = cvt_pk_bf16(yr[bj][1][0], yr[bj][1][1]); w.w = cvt_pk_bf16(yr[bj][1][2], yr[bj][1][3]);
                                    *(u32x4*)(kd + 32 * bj) = w; } }
                            else { const int kp = (key & 32) | (((key >> 2) & 3) << 3) | (((key >> 4) & 1) << 2) | (key & 3);
                                bf16_t* vd = (bf16_t*)(ws + (kvt == 1 ? w_vst : w_vwt)) + blk + kp;
#pragma unroll
                                for (int bj = 0; bj < 2; ++bj)
#pragma unroll
                                    for (int n = 0; n < 2; ++n)
#pragma unroll
                                        for (int i = 0; i < 4; ++i) { const unsigned b2 = cvt_pk_bf16(y[bj][n][i], 0.f); vd[(size_t)(32 * bj + 8 * fq + 4 * n + i) * 64] = (bf16_t)(b2 & 0xffffu); } } }
                    } }
        } else if (pn < 17) {
            bf16_t* G = (bf16_t*)(ws + (pn < 13 ? w_gc : w_gn)); const int cb = 256 * ((pn - 9) & 3) + 32 * wc + 8 * fq;
#pragma unroll
            for (int ai = 0; ai < 2; ++ai)
#pragma unroll
                for (int m = 0; m < 4; ++m) { const int r = row0 + ai * HALF + m * 16;
#pragma unroll
                    for (int bj = 0; bj < 2; ++bj) { const f32x4 v0 = acc[ai][bj][m][0], v1 = acc[ai][bj][m][1]; u32x4 w;
                        w.x = cvt_pk_bf16(sigmoid_f(v0[0]), sigmoid_f(v0[1])); w.y = cvt_pk_bf16(sigmoid_f(v0[2]), sigmoid_f(v0[3])); w.z = cvt_pk_bf16(sigmoid_f(v1[0]), sigmoid_f(v1[1])); w.w = cvt_pk_bf16(sigmoid_f(v1[2]), sigmoid_f(v1[3]));
                        *(u32x4*)(G + (size_t)r * 1024 + cb + 128 * bj) = w; } }
        } else {
            if (wc == 0 && fq < 3) { float* BG = (float*)(ws + w_bg);
#pragma unroll
                for (int ai = 0; ai < 2; ++ai)
#pragma unroll
                    for (int m = 0; m < 4; ++m) { const int r = row0 + ai * HALF + m * 16;
#pragma unroll
                        for (int n = 0; n < 2; ++n) { const int c = 8 * fq + 4 * n; const f32x4 v = acc[ai][0][m][n]; f32x4 o;
#pragma unroll
                            for (int i = 0; i < 4; ++i) o[i] = sigmoid_f(v[i]);
                            *(f32x4*)(BG + (size_t)r * 24 + c) = o; } } }
        }
    }
};
template <class Epi, class Sched, bool ALIGN_EPI = false, bool SP2 = false>
__device__ __forceinline__ void gemm_phase(PG8_LAS unsigned char* lds, const Gemm g, const Sched& S, const Epi& E) {
    const int tid = threadIdx.x, wid = __builtin_amdgcn_readfirstlane(tid >> 6), lane = tid & 63, wr = wid >> 2, wc = wid & 3, fr = lane & 15, fq = lane >> 4;
    const int K = g.K, nt = K / BK;
    unsigned voffA[2], voffB[2];
#pragma unroll
    for (int i = 0; i < 2; ++i) { int R, C; stage_rc(tid * 16 + i * 8192, R, C); const int Rb = Epi::PERM ? ((R & ~31) + perm32(R & 31)) : R;
        voffA[i] = (unsigned)(R * K + C) * 2u; voffB[i] = (unsigned)(Rb * K + C) * 2u; }
    const size_t kstep = (size_t)(BK * 2);
    const size_t hstep = (size_t)HALF * K * 2;
    const size_t tstep = 2 * hstep;
    const unsigned ldsw = (unsigned)wid * 1024u;
    const int aoff = lds_byte(wr * 64 + fr, fq * 8), boff = lds_byte(wc * 32 + fr, fq * 8);
#define PG8_SA(b, h) (((b) * 2 + (h)) * HTB)
#define PG8_SB(b, h) ((4 + (b) * 2 + (h)) * HTB)
#define PG8_STAGE(bufoff, gbase, voff) do { _Pragma("unroll") for (int _i = 0; _i < 2; ++_i) \
        __builtin_amdgcn_global_load_lds((const unsigned*)((const char*)(gbase) + (voff)[_i]), (PG8_LAS unsigned*)(lds + (bufoff) + ldsw + _i * 8192), 16, 0, 0); } while (0)
#define PG8_LDA(dst, b, h) do { _Pragma("unroll") for (int m = 0; m < 4; ++m) _Pragma("unroll") for (int k = 0; k < 2; ++k) dst[m][k] = *(const PG8_LAS bf16x8*)(lds + PG8_SA(b, h) + aoff + m * 2048 + k * 1024); } while (0)
#define PG8_LDB(dst, b, h) do { _Pragma("unroll") for (int n = 0; n < 2; ++n) _Pragma("unroll") for (int k = 0; k < 2; ++k) dst[n][k] = *(const PG8_LAS bf16x8*)(lds + PG8_SB(b, h) + boff + n * 2048 + k * 1024); } while (0)
#define PG8_MMA(ai, bj, At, Bt) do { __builtin_amdgcn_s_setprio(1); _Pragma("unroll") for (int m = 0; m < 4; ++m) _Pragma("unroll") for (int n = 0; n < 2; ++n) _Pragma("unroll") for (int k = 0; k < 2; ++k) \
        acc[ai][bj][m][n] = __builtin_amdgcn_mfma_f32_16x16x32_bf16(Bt[n][k], At[m][k], acc[ai][bj][m][n], 0, 0, 0); __builtin_amdgcn_s_setprio(0); } while (0)
#define PG8_WAIT_V(n) asm volatile("s_waitcnt vmcnt(" #n ")" ::: "memory")
#define PG8_WAIT_L(n) asm volatile("s_waitcnt lgkmcnt(" #n ")" ::: "memory")
#define PG8_BAR __builtin_amdgcn_s_barrier()
#define PG8_SCHED __builtin_amdgcn_sched_barrier(0)
    Unit cur, nxt; int ui = 0;
    if (!S.next(0, cur)) return;
    f32x4 acc[2][2][4][2];
#pragma unroll
    for (int a = 0; a < 2; ++a)
#pragma unroll
        for (int b = 0; b < 2; ++b)
#pragma unroll
            for (int m = 0; m < 4; ++m)
#pragma unroll
                for (int n = 0; n < 2; ++n) acc[a][b][m][n] = (f32x4){0.f, 0.f, 0.f, 0.f};
    bf16x8 At[4][2], B0[2][2], B1[2][2];
    const char* cA = (const char*)g.A + (size_t)cur.pm * tstep; const char* cB = (const char*)g.Bt + (size_t)cur.pn * tstep;
    S.a_ready(cur);
    if constexpr (SP2) {
        PG8_STAGE(PG8_SB(0, 0), cB, voffB); PG8_STAGE(PG8_SB(0, 1), cB + hstep, voffB); PG8_STAGE(PG8_SA(0, 0), cA, voffA); PG8_STAGE(PG8_SA(0, 1), cA + hstep, voffA);
        if (wr == 1) PG8_BAR;
        PG8_WAIT_V(2); PG8_BAR;
        PG8_STAGE(PG8_SB(1, 0), cB + kstep, voffB); PG8_STAGE(PG8_SA(1, 0), cA + kstep, voffA); PG8_STAGE(PG8_SB(1, 1), cB + hstep + kstep, voffB);
        PG8_WAIT_V(6); PG8_BAR;
    } else {
        PG8_STAGE(PG8_SB(0, 0), cB, voffB); PG8_STAGE(PG8_SA(0, 0), cA, voffA); PG8_STAGE(PG8_SB(0, 1), cB + hstep, voffB); PG8_STAGE(PG8_SA(0, 1), cA + hstep, voffA);
        if (wr == 1) PG8_BAR;
        PG8_WAIT_V(4); PG8_BAR;
        PG8_STAGE(PG8_SB(1, 0), cB + kstep, voffB); PG8_STAGE(PG8_SA(1, 0), cA + kstep, voffA); PG8_STAGE(PG8_SB(1, 1), cB + hstep + kstep, voffB);
        PG8_WAIT_V(6); PG8_BAR;
    }
    for (;;) {
        const bool has_next = S.next(ui + 1, nxt);
        const char* nA = has_next ? (const char*)g.A + (size_t)nxt.pm * tstep : cA; const char* nB = has_next ? (const char*)g.Bt + (size_t)nxt.pn * tstep : cB;
        for (int t = 0; t < nt; t += 2) {
            const bool last = (t == nt - 2);
            const char* a1 = cA + (size_t)(t + 1) * kstep;
            const char* a2 = last ? nA : cA + (size_t)(t + 2) * kstep; const char* b2 = last ? nB : cB + (size_t)(t + 2) * kstep;
            const char* a3 = a2 + kstep; const char* b3 = b2 + kstep;
            if (last && has_next) S.a_ready(nxt);
            if constexpr (SP2) {
            PG8_LDB(B0, 0, 0); PG8_LDB(B1, 0, 1); PG8_SCHED; PG8_LDA(At, 0, 0); PG8_STAGE(PG8_SA(1, 1), a1 + hstep, voffA);
            PG8_WAIT_V(8); PG8_WAIT_L(0); PG8_BAR; PG8_MMA(0, 0, At, B0); PG8_MMA(0, 1, At, B1); PG8_BAR; PG8_SCHED;
            PG8_LDA(At, 0, 1); PG8_STAGE(PG8_SB(0, 0), b2, voffB); PG8_STAGE(PG8_SB(0, 1), b2 + hstep, voffB); PG8_STAGE(PG8_SA(0, 0), a2, voffA);
            PG8_WAIT_V(8); PG8_WAIT_L(0); PG8_BAR; PG8_MMA(1, 0, At, B0); PG8_MMA(1, 1, At, B1); PG8_BAR; PG8_SCHED;
            PG8_LDB(B0, 1, 0); PG8_LDB(B1, 1, 1); PG8_SCHED; PG8_LDA(At, 1, 0); PG8_STAGE(PG8_SA(0, 1), a2 + hstep, voffA);
            PG8_WAIT_V(8); PG8_WAIT_L(0); PG8_BAR; PG8_MMA(0, 0, At, B0); PG8_MMA(0, 1, At, B1); PG8_BAR; PG8_SCHED;
            PG8_LDA(At, 1, 1); PG8_STAGE(PG8_SB(1, 0), b3, voffB); PG8_STAGE(PG8_SB(1, 1), b3 + hstep, voffB); PG8_STAGE(PG8_SA(1, 0), a3, voffA);
            PG8_WAIT_V(8); PG8_WAIT_L(0); PG8_BAR; PG8_MMA(1, 0, At, B0); PG8_MMA(1, 1, At, B1); PG8_BAR; PG8_SCHED;
            } else {
            PG8_LDB(B0, 0, 0); PG8_SCHED; PG8_LDA(At, 0, 0); PG8_STAGE(PG8_SA(1, 1), a1 + hstep, voffA);
            PG8_WAIT_L(8); PG8_BAR; PG8_WAIT_L(0); PG8_MMA(0, 0, At, B0); PG8_BAR; PG8_SCHED;
            PG8_LDB(B1, 0, 1); PG8_STAGE(PG8_SB(0, 0), b2, voffB);
            PG8_BAR; PG8_WAIT_L(0); PG8_MMA(0, 1, At, B1); PG8_BAR;
            PG8_LDA(At, 0, 1); PG8_STAGE(PG8_SA(0, 0), a2, voffA);
            PG8_BAR; PG8_WAIT_L(0); PG8_MMA(1, 0, At, B0); PG8_BAR; PG8_SCHED;
            PG8_STAGE(PG8_SB(0, 1), b2 + hstep, voffB);
            PG8_WAIT_V(6); PG8_BAR; PG8_MMA(1, 1, At, B1); PG8_BAR;
            PG8_LDB(B0, 1, 0); PG8_SCHED; PG8_LDA(At, 1, 0); PG8_STAGE(PG8_SA(0, 1), a2 + hstep, voffA);
            PG8_WAIT_L(8); PG8_BAR; PG8_WAIT_L(0); PG8_MMA(0, 0, At, B0); PG8_BAR; PG8_SCHED;
            PG8_LDB(B1, 1, 1); PG8_STAGE(PG8_SB(1, 0), b3, voffB);
            PG8_BAR; PG8_WAIT_L(0); PG8_MMA(0, 1, At, B1); PG8_BAR;
            PG8_LDA(At, 1, 1); PG8_STAGE(PG8_SA(1, 0), a3, voffA);
            PG8_BAR; PG8_WAIT_L(0); PG8_MMA(1, 0, At, B0); PG8_BAR; PG8_SCHED;
            PG8_STAGE(PG8_SB(1, 1), b3 + hstep, voffB);
            PG8_WAIT_V(6); PG8_BAR; PG8_MMA(1, 1, At, B1); PG8_BAR;
            }
        }
        if constexpr (ALIGN_EPI) { if (wr == 0) PG8_BAR; }
        if constexpr (!Epi::AFTER_DRAIN) { E(acc, cur, wr, wc, fr, fq); S.done(cur); }
        if (!has_next) break;
#pragma unroll
        for (int a = 0; a < 2; ++a)
#pragma unroll
            for (int b = 0; b < 2; ++b)
#pragma unroll
                for (int m = 0; m < 4; ++m)
#pragma unroll
                    for (int n = 0; n < 2; ++n) acc[a][b][m][n] = (f32x4){0.f, 0.f, 0.f, 0.f};
        cur = nxt; cA = nA; cB = nB; ++ui;
        if constexpr (ALIGN_EPI) { if (wr == 1) PG8_BAR; }
    }
    PG8_WAIT_V(0);
    if constexpr (!ALIGN_EPI) { if (wr == 0) PG8_BAR; }
    PG8_BAR;
    if constexpr (Epi::AFTER_DRAIN) { E.fused(acc, cur, wr, wc, fr, fq, lds, wid, lane); S.done(cur); }
#undef PG8_SA
#undef PG8_SB
#undef PG8_STAGE
#undef PG8_LDA
#undef PG8_LDB
#undef PG8_MMA
#undef PG8_WAIT_V
#undef PG8_WAIT_L
#undef PG8_BAR
#undef PG8_SCHED
}
}
#define GAS __attribute__((address_space(1)))
#define LAS __attribute__((address_space(3)))
typedef unsigned short bf16;
typedef unsigned v4u __attribute__((ext_vector_type(4)));
typedef float f32x4 __attribute__((ext_vector_type(4)));
typedef short bf16x8 __attribute__((ext_vector_type(8)));
typedef GAS unsigned gu32;
typedef GAS unsigned long long gu64;
#define RLX_AGENT __ATOMIC_RELAXED, __HIP_MEMORY_SCOPE_AGENT
#define LDS_WAIT() asm volatile("s_waitcnt lgkmcnt(0)" ::: "memory")
#define VM_WAIT() asm volatile("s_waitcnt vmcnt(0)" ::: "memory")
__device__ __forceinline__ unsigned long long rt() { return __builtin_amdgcn_s_memrealtime(); }
__device__ __forceinline__ unsigned f2bf(float f) { unsigned u = __builtin_bit_cast(unsigned, f); return (u + 0x7fffu + ((u >> 16) & 1u)) >> 16; }
__device__ __forceinline__ unsigned pk2(float lo, float hi) { return f2bf(lo) | (f2bf(hi) << 16); }

#define XB_TMO      128
#define XB_XCNT(j)  (256  + 64 * (j))
#define XB_XSUB(j)  (1280 + 64 * (j))
#define XB_XGEN(j)  (2304 + 64 * (j))
#define XB_TOP      3328
#define XB_TOPGEN   3392
#define XCD_BAR_WORDS 3456
#define XB_SPIN_CAP (1u << 18)

__device__ __forceinline__ unsigned xb_ld(unsigned* p)              { return __hip_atomic_load(p, __ATOMIC_RELAXED, __HIP_MEMORY_SCOPE_AGENT); }
__device__ __forceinline__ unsigned xb_add(unsigned* p, unsigned v) { return __hip_atomic_fetch_add(p, v, __ATOMIC_RELAXED, __HIP_MEMORY_SCOPE_AGENT); }
__device__ __forceinline__ unsigned xb_xcc_id() { return (unsigned)__builtin_amdgcn_s_getreg((3 << 11) | 20) & 0xFu; }
#define XB_SPIN(cond, bar) do { unsigned _sp = 0; while (cond) { __builtin_amdgcn_s_sleep(1); \
    if ((++_sp & 255u) == 0u) { if (xb_ld(&(bar)[XB_TMO])) break; if (_sp > XB_SPIN_CAP) { atomicAdd(&(bar)[XB_TMO], 1u); break; } } } } while (0)

struct XcdBarrier {
    unsigned* bar; unsigned x;
    volatile LAS unsigned* st;
};

__device__ __forceinline__ XcdBarrier xcd_barrier_post(unsigned* bar, volatile LAS unsigned* st) {
    XcdBarrier b; b.bar = bar; b.x = xb_xcc_id(); b.st = st;
    if (threadIdx.x == 0) (void)xb_add(&bar[XB_XCNT(b.x)], 1u);
    return b;
}
__device__ __forceinline__ void xcd_barrier_complete(unsigned* bar, unsigned x, unsigned& nloc, unsigned& nx) {
    const unsigned G = gridDim.x * gridDim.y * gridDim.z;
    unsigned sum, cnt, mine, sp = 0u;
    for (;;) {
        sum = 0u; cnt = 0u; mine = 0u;
#pragma unroll
        for (unsigned j = 0; j < 16; ++j) { const unsigned c = xb_ld(&bar[XB_XCNT(j)]); sum += c; cnt += (c > 0u) ? 1u : 0u; mine = (j == x) ? c : mine; }
        if (sum == G) break;
        __builtin_amdgcn_s_sleep(1);
        if ((++sp & 255u) == 0u) { if (xb_ld(&bar[XB_TMO])) break; if (sp > XB_SPIN_CAP) { atomicAdd(&bar[XB_TMO], 1u); break; } }
    }
    nloc = mine > 0u ? mine : 1u; nx = cnt > 0u ? cnt : 1u;
}

__device__ __forceinline__ void xcd_barrier(const XcdBarrier& b) {
    asm volatile("s_waitcnt vmcnt(0)" ::: "memory");
    __syncthreads();
    if (threadIdx.x == 0) {
        unsigned* bar = b.bar;
        __builtin_amdgcn_s_waitcnt(0);
        unsigned nloc = b.st[0], nx = b.st[1];
        if (nloc == 0u) { xcd_barrier_complete(bar, b.x, nloc, nx); b.st[0] = nloc; b.st[1] = nx; }
        const unsigned old = xb_add(&bar[XB_XSUB(b.x)], 1u);
        const unsigned gen = old / nloc;
        if (old + 1u == (gen + 1u) * nloc) {
            __builtin_amdgcn_fence(__ATOMIC_RELEASE, "agent");
            asm volatile("s_waitcnt vmcnt(0)" ::: "memory");
            const unsigned og = xb_add(&bar[XB_TOP], 1u);
            const unsigned tg = og / nx;
            if (og + 1u == (tg + 1u) * nx) xb_add(&bar[XB_TOPGEN], 1u);
            else XB_SPIN(xb_ld(&bar[XB_TOPGEN]) == tg, bar);
            __builtin_amdgcn_fence(__ATOMIC_ACQUIRE, "agent");
            xb_add(&bar[XB_XGEN(b.x)], 1u);
            asm volatile("s_waitcnt vmcnt(0)" ::: "memory");
        } else {
            XB_SPIN(xb_ld(&bar[XB_XGEN(b.x)]) == gen, bar);
            __builtin_amdgcn_fence(__ATOMIC_ACQUIRE, "agent");
            asm volatile("s_waitcnt vmcnt(0)" ::: "memory");
        }
    }
    __syncthreads();
}

constexpr int NWAVES = 8;
constexpr int MP = 32768, MS = 256, MT = MP + MS;
constexpr int DM = 1024, DIN = 4376, DINP = 4608, DFF = 2816, DCONV = 512, QW = 512;
constexpr int OFF_Q = 1024, OFF_KV = 1536, OFF_NG = 2304, OFF_MG = 2328;
constexpr int NSEQ = 36;
constexpr float EPS = 1e-6f;
constexpr size_t O_YP = 0, O_YS = 33554432, O_PCK = 33816576, O_PCV = O_PCK + 4194304, O_PSK = O_PCV + 4194304, O_PSV = O_PSK + 4194304,
                 O_PWK = O_PSV + 4194304, O_PWV = O_PWK + 262144, O_PCONV = O_PWV + 262144, O_SCK = O_PCONV + 61440, O_SCV = O_SCK + 32768,
                 O_SSK = O_SCV + 32768, O_SSV = O_SSK + 32768, O_SWK = O_SSV + 32768, O_SWV = O_SWK + 2097152, O_SCONV = O_SWV + 2097152, O_END = O_SCONV + 491520;
constexpr size_t MiB = 1u << 20;
constexpr size_t WS_CTL = 0, WS_MOD = 1 * MiB, ZERO_BYTES = 2 * MiB;
constexpr size_t WS_ROPE = 2 * MiB;
constexpr size_t WS_WIN = 5 * MiB, WS_WPW2 = 14 * MiB, WS_WNSA = 15 * MiB, WS_WOUT = 16 * MiB, WS_WGU = 18 * MiB, WS_WDOWN = 29 * MiB;
constexpr size_t WS_KC = 36 * MiB, WS_VC = 41 * MiB, WS_BG = 46 * MiB, WS_H = 50 * MiB, WS_U = 115 * MiB, WS_QP = 148 * MiB, WS_QR = 181 * MiB,
                 WS_CACT = 214 * MiB, WS_O = 247 * MiB, WS_GC = 280 * MiB, WS_GN = 345 * MiB, WS_T1 = 410 * MiB, WS_KWIN = 475 * MiB, WS_VWIN = 491 * MiB,
                 WS_ACT = 507 * MiB, WS_Z = 685 * MiB, WS_OC = WS_Z  , WS_ZS = 760 * MiB  ,
                 WS_KSB = 1268 * MiB, WS_VST = 1276 * MiB, WS_KWB = 1284 * MiB, WS_VWT = 1292 * MiB, WS_KCB = 1300 * MiB, WS_VCT = 1301 * MiB, WS_END = 1302 * MiB;
constexpr float C2 = 0.125f * 1.4426950408889634f;
constexpr int ROPE_N = 8200;
constexpr int CW_BAR = 4096;
constexpr int RING_BYTES = 131072, LDS_BYTES = 163840, MISC_OFF = LDS_BYTES - 256;

typedef unsigned v2u __attribute__((ext_vector_type(2)));
typedef float f32x2 __attribute__((ext_vector_type(2)));
__device__ __forceinline__ float bf2f(unsigned short b) { return __uint_as_float(((unsigned)b) << 16); }
__device__ __forceinline__ float wave_sum(float v) {
#pragma unroll
    for (int o = 1; o < 64; o <<= 1) v += __shfl_xor(v, o);
    return v;
}
__device__ __forceinline__ float wave_max(float v) {
#pragma unroll
    for (int o = 1; o < 64; o <<= 1) v = fmaxf(v, __shfl_xor(v, o));
    return v;
}
__device__ __forceinline__ unsigned dpp_x1(unsigned v) { return (unsigned)__builtin_amdgcn_update_dpp(0, (int)v, 0xB1, 0xF, 0xF, false); }
__device__ __forceinline__ unsigned dpp_x2(unsigned v) { return (unsigned)__builtin_amdgcn_update_dpp(0, (int)v, 0x4E, 0xF, 0xF, false); }
__device__ __forceinline__ unsigned umax_x16(unsigned v) { auto r = __builtin_amdgcn_permlane16_swap(v, v, false, false); return r[0] > r[1] ? r[0] : r[1]; }
__device__ __forceinline__ unsigned umax_x32(unsigned v) { auto r = __builtin_amdgcn_permlane32_swap(v, v, false, false); return r[0] > r[1] ? r[0] : r[1]; }
__device__ __forceinline__ float fsum_x16(float v) { auto r = __builtin_amdgcn_permlane16_swap(__float_as_uint(v), __float_as_uint(v), false, false); return __uint_as_float(r[0]) + __uint_as_float(r[1]); }
__device__ __forceinline__ float fsum_x32(float v) { auto r = __builtin_amdgcn_permlane32_swap(__float_as_uint(v), __float_as_uint(v), false, false); return __uint_as_float(r[0]) + __uint_as_float(r[1]); }
__device__ __forceinline__ float fmax_x16(float v) { auto r = __builtin_amdgcn_permlane16_swap(__float_as_uint(v), __float_as_uint(v), false, false); return fmaxf(__uint_as_float(r[0]), __uint_as_float(r[1])); }
__device__ __forceinline__ float fmax_x32(float v) { auto r = __builtin_amdgcn_permlane32_swap(__float_as_uint(v), __float_as_uint(v), false, false); return fmaxf(__uint_as_float(r[0]), __uint_as_float(r[1])); }
__device__ __forceinline__ float dpp_x1f(float v) { return __uint_as_float(dpp_x1(__float_as_uint(v))); }
__device__ __forceinline__ float dpp_x2f(float v) { return __uint_as_float(dpp_x2(__float_as_uint(v))); }
__device__ __forceinline__ unsigned dpp_x4(unsigned v) { const int t = __builtin_amdgcn_update_dpp(0, (int)v, 0x141, 0xF, 0xF, false); return (unsigned)__builtin_amdgcn_update_dpp(0, t, 0x1B, 0xF, 0xF, false); }
__device__ __forceinline__ unsigned dpp_x8(unsigned v) { const int t = __builtin_amdgcn_update_dpp(0, (int)v, 0x140, 0xF, 0xF, false); return (unsigned)__builtin_amdgcn_update_dpp(0, t, 0x141, 0xF, 0xF, false); }
__device__ __forceinline__ float sigm(float x) { return 1.0f / (1.0f + __expf(-x)); }
__device__ __forceinline__ int mrow(int r) { return r < MP ? (r >> 13) : 4 + ((r - MP) >> 3); }
__device__ __forceinline__ int rope_idx(int r) { return r < MP ? (r & 8191) : 8192 + ((r - MP) & 7); }
__device__ __forceinline__ int perm64(int u) { return (u & 32) | (((u >> 2) & 3) << 3) | (((u >> 4) & 1) << 2) | (u & 3); }
__device__ __forceinline__ int perm128(int u) { return (u & ~31) | (((u >> 2) & 3) << 3) | (((u >> 4) & 1) << 2) | (u & 3); }
__device__ __forceinline__ size_t kc_off(int s) { return s < 4 ? (size_t)s * 128 * 128 : (size_t)4 * 128 * 128 + (size_t)(s - 4) * 257 * 128; }

struct Args { const float* in[33]; float* out; unsigned char* ws; int ph_lo, ph_hi; };

__device__ __forceinline__ int front_rowmap(int n) {
    if (n < 1024) { const int nn = n >= 512 ? 1 : 0, ch = n & 511; return 256 * (ch >> 7) + 128 * ((ch >> 6) & 1) + 32 * ((ch >> 4) & 3) + 8 * ((ch >> 2) & 3) + 4 * nn + (ch & 3); }
    if (n < OFF_KV) { const int hd = n - OFF_Q, h = hd >> 6, d = hd & 63; return 256 * (4 + (h >> 2)) + 128 * (d >> 5) + 32 * (h & 3) + (d & 31); }
    if (n < OFF_NG) { const int x = n - OFF_KV, j = x >> 7, kvh = (x >> 6) & 1, d = x & 63; return 256 * (6 + (j >> 1)) + 128 * (d >> 5) + 32 * ((j & 1) * 2 + kvh) + (d & 31); }
    if (n < OFF_MG) return 256 * 17 + (n - OFF_NG);
    return 256 * 9 + (n - OFF_MG);
}
__device__ __forceinline__ int gu_rowmap(int j) { const int rem = j & 127; return 256 * (j >> 7) + 128 * ((rem >> 2) & 1) + 32 * (rem >> 5) + 8 * ((rem >> 3) & 3) + (rem & 3); }
template <int MODE> __device__ __forceinline__ int rowmap(int n) { return MODE == 0 ? n : (MODE == 1 ? gu_rowmap(n) : (MODE == 2 ? gu_rowmap(n) + 4 : front_rowmap(n))); }
template <int MODE> __device__ __forceinline__ void transpose_item(const float* W, int K, int N, bf16* WT, LAS float* scr, int item, int lane) {
    const int nblk = (N + 31) / 32, kb = item / nblk, nb = item % nblk, k0 = 64 * kb, n0 = 32 * nb;
    const int nn = n0 + (lane & 31);
#pragma unroll 8
    for (int i = 0; i < 32; ++i) { const int kk = 2 * i + (lane >> 5); scr[kk * 33 + (lane & 31)] = (nn < N) ? W[(size_t)(k0 + kk) * N + nn] : 0.f; }
    LDS_WAIT(); asm volatile("" ::: "memory");
    const int c = lane & 7;
#pragma unroll
    for (int j = 0; j < 4; ++j) { const int nl = (lane >> 3) + 8 * j, n = n0 + nl; const LAS float* s = scr + (8 * c) * 33 + nl;
        v4u o; o.x = pk2(s[0 * 33], s[1 * 33]); o.y = pk2(s[2 * 33], s[3 * 33]); o.z = pk2(s[4 * 33], s[5 * 33]); o.w = pk2(s[6 * 33], s[7 * 33]);
        if (n < N) *(v4u*)(WT + (size_t)rowmap<MODE>(n) * K + k0 + 8 * c) = o; }
    LDS_WAIT(); asm volatile("" ::: "memory");
}
__device__ __forceinline__ f32x2 compress_block(const float* rows, int nvalid, const float* pm, const float* w, float* outp, LAS float* scr, int lane) {
    const int c4 = 4 * (lane & 31), half = lane >> 5, d = c4 & 63, nh = nvalid >> 1;
    f32x4 acc = {0.f, 0.f, 0.f, 0.f};
    for (int i0 = 0; i0 < nh; i0 += 8) {
        f32x4 x[8], m[8];
#pragma unroll
        for (int q = 0; q < 8; ++q) { const bool ok = i0 + q < nh; const int j = 2 * (ok ? i0 + q : 0) + half;
            x[q] = *(const f32x4*)(rows + (size_t)j * 128 + c4); m[q] = *(const f32x4*)(pm + j * 64 + d); if (!ok) x[q] = (f32x4){0.f, 0.f, 0.f, 0.f}; }
#pragma unroll
        for (int q = 0; q < 8; ++q) acc += x[q] * (m[q] + 1.0f);
    }
#pragma unroll
    for (int i = 0; i < 4; ++i) acc[i] += __shfl_xor(acc[i], 32);
    if (lane < 32) *(LAS f32x4*)(scr + c4) = acc * (1.0f / 64.0f);
    LDS_WAIT(); asm volatile("" ::: "memory");
    const int kvh = lane >> 5, e = 2 * (lane & 31);
    f32x2 o = {0.f, 0.f};
#pragma unroll 8
    for (int dd = 0; dd < 64; ++dd) { const float sv = scr[kvh * 64 + dd]; const f32x2 ww = *(const f32x2*)(w + dd * 64 + e); o.x += sv * ww.x; o.y += sv * ww.y; }
    *(f32x2*)(outp + kvh * 64 + e) = o;
    LDS_WAIT(); asm volatile("" ::: "memory");
    return o;
}
__device__ __forceinline__ void phase0(const Args& a, LAS unsigned char* lds, int gw, int NGW, int wave, int lane_) {
    int lane = lane_;
    unsigned char* ws = a.ws;
    LAS float* scr = (LAS float*)(lds + wave * 16384);
    constexpr int I_IN = 16 * 137, I_PW2 = 8 * 32, I_NSA = 8 * 32, I_OUT = 16 * 32, I_G = 16 * 88, I_U = 16 * 88, I_D = 44 * 32;
    constexpr int N_TR = I_IN + I_PW2 + I_NSA + I_OUT + I_G + I_U + I_D;
    constexpr int N_MOD = 96 * 16;
    constexpr int N_CMP = 32 * 128 * 2;
    constexpr int N_ALL = N_TR + N_MOD + N_CMP; static_assert(N_ALL % 2 == 0 && N_ALL % 29 == 0 && N_ALL % 37 == 0 && N_ALL == 17168, "4099 must stay coprime to N_ALL");
#pragma nounroll
    for (int it = gw; it < N_ALL; it += NGW) {
        int r = it; asm volatile("" : "+v"(lane));
        if (r < N_TR) {
            if (r < I_IN) { transpose_item<3>(a.in[15], 1024, DIN, (bf16*)(ws + WS_WIN), scr, r, lane); continue; } r -= I_IN;
            if (r < I_PW2) { transpose_item<0>(a.in[22], 512, 1024, (bf16*)(ws + WS_WPW2), scr, r, lane); continue; } r -= I_PW2;
            if (r < I_NSA) { transpose_item<0>(a.in[27], 512, 1024, (bf16*)(ws + WS_WNSA), scr, r, lane); continue; } r -= I_NSA;
            if (r < I_OUT) { transpose_item<0>(a.in[28], 1024, 1024, (bf16*)(ws + WS_WOUT), scr, r, lane); continue; } r -= I_OUT;
            if (r < I_G) { transpose_item<1>(a.in[30], 1024, DFF, (bf16*)(ws + WS_WGU), scr, r, lane); continue; } r -= I_G;
            if (r < I_U) { transpose_item<2>(a.in[31], 1024, DFF, (bf16*)(ws + WS_WGU), scr, r, lane); continue; } r -= I_U;
            transpose_item<0>(a.in[32], DFF, 1024, (bf16*)(ws + WS_WDOWN), scr, r, lane); continue;
        }
        r -= N_TR;
        if (r < N_MOD) {
            const int cb = r % 96, kb = r / 96, j = cb * 64 + lane, k0 = kb * 64;
            for (int mb = 0; mb < NSEQ; ++mb) { const float* cp = mb < 4 ? a.in[10] + mb * 1024 : a.in[11] + (mb - 4) * 1024; const float cv = cp[k0 + lane]; scr[mb * 64 + lane] = cv * sigm(cv); }
            LDS_WAIT(); asm volatile("" ::: "memory");
            float acc[NSEQ];
#pragma unroll
            for (int mb = 0; mb < NSEQ; ++mb) acc[mb] = 0.f;
            const float* wp = a.in[12] + (size_t)k0 * 6144 + j;
#pragma unroll 4
            for (int k4 = 0; k4 < 16; ++k4) {
                const float w0 = wp[(size_t)(4 * k4 + 0) * 6144], w1 = wp[(size_t)(4 * k4 + 1) * 6144], w2 = wp[(size_t)(4 * k4 + 2) * 6144], w3 = wp[(size_t)(4 * k4 + 3) * 6144];
#pragma unroll
                for (int mb = 0; mb < NSEQ; ++mb) { const f32x4 q = *(const LAS f32x4*)(scr + mb * 64 + 4 * k4); acc[mb] += q.x * w0 + q.y * w1 + q.z * w2 + q.w * w3; }
            }
            float* modp = (float*)(ws + WS_MOD);
            const float bias = (kb == 0) ? a.in[13][j] : 0.f;
#pragma unroll
            for (int mb = 0; mb < NSEQ; ++mb) atomicAdd(modp + mb * 6144 + j, acc[mb] + bias);
            LDS_WAIT(); asm volatile("" ::: "memory");
            continue;
        }
        r -= N_MOD;
        {
            const int kv = r & 1, pg = (r >> 1) & 127, sb = r >> 8;
            const int page = ((const int*)a.in[9])[sb * 128 + pg];
            const float* src = (kv ? a.in[3] : a.in[2]) + (size_t)page * (128 * 128);
            const float* pm = kv ? a.in[25] : a.in[23]; const float* w = kv ? a.in[26] : a.in[24];
            float* dst = (float*)(ws + (kv ? WS_VC : WS_KC)) + kc_off(4 + sb) + (size_t)(2 * pg) * 128;
            compress_block(src, 64, pm, w, dst, scr, lane);
            compress_block(src + 64 * 128, 64, pm, w, dst + 128, scr, lane);
        }
    }
    const int gt = gw * 64 + lane, NT = NGW * 64;
    { v4u* p = (v4u*)((bf16*)(ws + WS_WIN) + (size_t)DIN * 1024); const int n16 = (DINP - DIN) * 1024 * 2 / 16; const v4u z = {0u, 0u, 0u, 0u}; for (int i = gt; i < n16; i += NT) p[i] = z; }
    { float* rc = (float*)(ws + WS_ROPE); float* rs = rc + ROPE_N * 32;
      for (int i = gt; i < ROPE_N * 32; i += NT) {
          const int j = i & 31, p = i >> 5; const int pos = p < 8192 ? p : 16384 + (p - 8192);
          double inv = 1.0; for (int q = 0; q < j; ++q) inv *= 0.7498942093324558;
          const double ang = (double)pos * inv;
          const double kq = __builtin_rint(ang * 0.6366197723675814);
          double rr = __builtin_fma(-kq, 1.5707963267948966, ang); rr = __builtin_fma(-kq, 6.123233995736766e-17, rr);
          const double r2 = rr * rr;
          const double sn = rr * (1.0 + r2 * (-1.0 / 6 + r2 * (1.0 / 120 + r2 * (-1.0 / 5040 + r2 * (1.0 / 362880 + r2 * (-1.0 / 39916800 + r2 * (1.0 / 6227020800.0)))))));
          const double cs = 1.0 + r2 * (-0.5 + r2 * (1.0 / 24 + r2 * (-1.0 / 720 + r2 * (1.0 / 40320 + r2 * (-1.0 / 3628800 + r2 * (1.0 / 479001600.0))))));
          const int qd = ((int)(long long)kq) & 3;
          const double c = (qd == 0) ? cs : (qd == 1) ? -sn : (qd == 2) ? -cs : sn;
          const double s = (qd == 0) ? sn : (qd == 1) ? cs : (qd == 2) ? -sn : -cs;
          rc[i] = (float)c; rs[i] = (float)s; } }
    { const int per = 504 * 128 / 4, n4 = 32 * per;
      for (int i = gt; i < 2 * n4; i += NT) { const int kv = i >= n4, ii = kv ? i - n4 : i, sb = ii / per, o = ii % per;
          const f32x4 v = ((const f32x4*)((kv ? a.in[7] : a.in[6]) + (size_t)sb * 512 * 128 + 8 * 128))[o];
          ((f32x4*)(a.out + (kv ? O_SWV : O_SWK) + (size_t)sb * 512 * 128))[o] = v; } }
    { const int per = 22 * 512 / 4, n4 = 32 * per;
      for (int i = gt; i < n4; i += NT) { const int sb = i / per, o = i % per;
          ((f32x4*)(a.out + O_SCONV + (size_t)sb * 30 * 512))[o] = ((const f32x4*)(a.in[8] + (size_t)sb * 30 * 512 + 8 * 512))[o]; } }
}

__device__ __forceinline__ void norm_rows(const float* xp, const float* xs, const float* g, const float* modp, int sh_off, int sc_off, bf16* H, int gw, int NGW, int lane) {
    for (int r = gw; r < MT; r += NGW) {
        const f32x4* xr = (const f32x4*)(r < MP ? xp + (size_t)r * 1024 : xs + (size_t)(r - MP) * 1024) + lane;
        const float* mp = modp + (size_t)mrow(r) * 6144;
        f32x4 v[4]; float ss = 0.f;
#pragma unroll
        for (int j = 0; j < 4; ++j) { v[j] = xr[64 * j]; ss += (v[j].x * v[j].x + v[j].y * v[j].y) + (v[j].z * v[j].z + v[j].w * v[j].w); }
        const float rstd = 1.0f / sqrtf(wave_sum(ss) * (1.0f / 1024.0f) + EPS);
        v2u* o8 = (v2u*)(H + (size_t)r * 1024) + lane;
#pragma unroll
        for (int j = 0; j < 4; ++j) { const int c = 4 * (lane + 64 * j);
            const f32x4 gg = *(const f32x4*)(g + c), sc = *(const f32x4*)(mp + sc_off + c), sh = *(const f32x4*)(mp + sh_off + c);
            const f32x4 h = (v[j] * rstd * gg) * (1.0f + sc) + sh;
            v2u w; w.x = pk2(h.x, h.y); w.y = pk2(h.z, h.w); o8[64 * j] = w; }
    }
}

__device__ __forceinline__ void unpack8(const v4u p, float (&x)[8]) { x[0] = pg8::bf_lo(p.x); x[1] = pg8::bf_hi(p.x); x[2] = pg8::bf_lo(p.y); x[3] = pg8::bf_hi(p.y); x[4] = pg8::bf_lo(p.z); x[5] = pg8::bf_hi(p.z); x[6] = pg8::bf_lo(p.w); x[7] = pg8::bf_hi(p.w); }
__device__ __forceinline__ void phase_conv(const Args& a, LAS unsigned char* lds, int vcu, int G, int gw, int NGW, int wave, int lane, int tid) {
    unsigned char* ws = a.ws;
    constexpr int TAPB = 31 * 512 * 4;
    { LAS f32x4* wl4 = (LAS f32x4*)lds; const f32x4* wg4 = (const f32x4*)a.in[18]; for (int i = tid; i < 31 * 512 / 4; i += NWAVES * 64) wl4[i] = wg4[i]; }
    const LAS float* wl = (const LAS float*)lds; LAS unsigned char* rl = lds + TAPB;
    const bf16* U = (const bf16*)(ws + WS_U); bf16* CACT = (bf16*)(ws + WS_CACT);
    const int c0 = lane * 8;
#pragma nounroll
    for (int tile = vcu; tile < 1024 + 32; tile += G) {
        const bool smp = tile >= 1024; const int sb = tile - 1024, r0 = smp ? MP + 8 * sb : 32 * tile, t0 = r0 & 8191, ntok = smp ? 8 : 32, nrows = ntok + 30;
        __syncthreads();
        for (int q = tid; q < nrows * 64; q += NWAVES * 64) { const int k = q >> 6, cc = (q & 63) * 8; v4u v = {0u, 0u, 0u, 0u};
            if (smp) { if (k < 30) { const float* sp = a.in[8] + (size_t)(sb * 30 + k) * 512 + cc; const f32x4 p0 = *(const f32x4*)sp, p1 = *(const f32x4*)(sp + 4);
                           v.x = pk2(p0.x, p0.y); v.y = pk2(p0.z, p0.w); v.z = pk2(p1.x, p1.y); v.w = pk2(p1.z, p1.w); }
                       else v = *(const v4u*)(U + (size_t)(r0 + k - 30) * 512 + cc); }
            else if (t0 - 30 + k >= 0) v = *(const v4u*)(U + (size_t)(r0 - 30 + k) * 512 + cc);
            *(LAS v4u*)(rl + k * 1024 + (q & 63) * 16) = v; }
        __syncthreads();
        if (4 * wave < ntok) {
            float acc[4][8];
            { const f32x4 b0 = *(const f32x4*)(a.in[19] + c0), b1 = *(const f32x4*)(a.in[19] + c0 + 4);
#pragma unroll
              for (int tt = 0; tt < 4; ++tt) { acc[tt][0] = b0.x; acc[tt][1] = b0.y; acc[tt][2] = b0.z; acc[tt][3] = b0.w; acc[tt][4] = b1.x; acc[tt][5] = b1.y; acc[tt][6] = b1.z; acc[tt][7] = b1.w; } }
            const LAS unsigned char* rw = rl + (4 * wave) * 1024 + lane * 16;
#pragma unroll 2
            for (int j = 0; j < 31; ++j) {
                const f32x4 w0 = *(const LAS f32x4*)(wl + j * 512 + c0), w1 = *(const LAS f32x4*)(wl + j * 512 + c0 + 4);
#pragma unroll
                for (int tt = 0; tt < 4; ++tt) { float x[8]; unpack8(*(const LAS v4u*)(rw + (tt + j) * 1024), x);
                    acc[tt][0] += x[0] * w0.x; acc[tt][1] += x[1] * w0.y; acc[tt][2] += x[2] * w0.z; acc[tt][3] += x[3] * w0.w; acc[tt][4] += x[4] * w1.x; acc[tt][5] += x[5] * w1.y; acc[tt][6] += x[6] * w1.z; acc[tt][7] += x[7] * w1.w; }
            }
            const f32x4 g0 = *(const f32x4*)(a.in[20] + c0), g1 = *(const f32x4*)(a.in[20] + c0 + 4), e0 = *(const f32x4*)(a.in[21] + c0), e1 = *(const f32x4*)(a.in[21] + c0 + 4);
            const float lg[8] = {g0.x, g0.y, g0.z, g0.w, g1.x, g1.y, g1.z, g1.w}, lb[8] = {e0.x, e0.y, e0.z, e0.w, e1.x, e1.y, e1.z, e1.w};
#pragma unroll
            for (int tt = 0; tt < 4; ++tt) {
                float sm = 0.f;
#pragma unroll
                for (int i = 0; i < 8; ++i) sm += acc[tt][i];
                const float mean = wave_sum(sm) * (1.0f / 512.0f); float q = 0.f;
#pragma unroll
                for (int i = 0; i < 8; ++i) { acc[tt][i] -= mean; q += acc[tt][i] * acc[tt][i]; }
                const float rstd = 1.0f / sqrtf(wave_sum(q) * (1.0f / 512.0f) + EPS);
                float y[8];
#pragma unroll
                for (int i = 0; i < 8; ++i) { const float v = acc[tt][i] * rstd * lg[i] + lb[i]; y[i] = v * sigm(v); }
                v4u o; o.x = pk2(y[0], y[1]); o.y = pk2(y[2], y[3]); o.z = pk2(y[4], y[5]); o.w = pk2(y[6], y[7]);
                *(v4u*)(CACT + (size_t)(r0 + 4 * wave + tt) * 512 + c0) = o;
            }
        }
    }
    __syncthreads();
    LAS float* scr = (LAS float*)(lds + wave * 16384);
    for (int it = gw; it < 1024 + 64; it += NGW) {
        if (it < 1024) { const int kv = it & 1, n = (it >> 1) & 127, b = it >> 8;
            const float* rows = a.out + (kv ? O_PCV : O_PCK) + (size_t)(b * 8192 + 64 * n) * 128;
            float* dst = (float*)(ws + (kv ? WS_VC : WS_KC)) + kc_off(b) + (size_t)n * 128;
            const f32x2 o = compress_block(rows, 64, kv ? a.in[25] : a.in[23], kv ? a.in[26] : a.in[24], dst, scr, lane);
            const int kvh = lane >> 5, e = 2 * (lane & 31);
            if (!kv) { *(unsigned*)((bf16*)(ws + WS_KCB) + ((size_t)(b * 2 + kvh) * 128 + n) * 64 + e) = pk2(o.x, o.y); }
            else { bf16* vt = (bf16*)(ws + WS_VCT) + (size_t)(b * 2 + kvh) * 64 * 128 + perm128(n); vt[(size_t)e * 128] = (bf16)f2bf(o.x); vt[(size_t)(e + 1) * 128] = (bf16)f2bf(o.y); } }
        else { const int i2 = it - 1024, kv = i2 & 1, sb = i2 >> 1;
            const float* rows = a.out + (kv ? O_SCV : O_SCK) + (size_t)(sb * 8) * 128;
            float* dst = (float*)(ws + (kv ? WS_VC : WS_KC)) + kc_off(4 + sb) + (size_t)256 * 128;
            compress_block(rows, 8, kv ? a.in[25] : a.in[23], kv ? a.in[26] : a.in[24], dst, scr, lane); }
    }
}

template <int MODE> __device__ __forceinline__ void attn_item(const Args& a, int r, int kvh, LAS unsigned char* ldsb, int wave, int lane) {
    unsigned char* ws = a.ws; float* out = a.out;
    LAS float* scr = (LAS float*)(ldsb + wave * 16384);
    const bool smp = r >= MP; const int rs_ = r - MP, sb = rs_ >> 3, si = rs_ & 7, b = r >> 13;
    const int seq = smp ? 4 + sb : b, qpos = smp ? 16384 + si : (r & 8191), cur = qpos >> 6, NB = smp ? 257 : 128;
    LAS float* s_qp = scr;
    LAS float* s_qr = scr + 256;
    LAS float* s_p = scr + 512;
    const bf16* QP = (const bf16*)(ws + WS_QP) + (size_t)r * 512 + kvh * 256; const bf16* QR = (const bf16*)(ws + WS_QR) + (size_t)r * 512 + kvh * 256;
    float qn2[4];
#pragma unroll
    for (int g = 0; g < 4; ++g) { const float x = bf2f(QP[g * 64 + lane]), y = bf2f(QR[g * 64 + lane]); s_qp[lane * 4 + g] = x; s_qr[lane * 4 + g] = y; qn2[g] = wave_sum(y * y); }
    const float gks = wave_max(fabsf(a.in[17][64 + lane])), gkw = wave_max(fabsf(a.in[17][128 + lane]));
    float mref_s[4], mref_w[4];
#pragma unroll
    for (int g = 0; g < 4; ++g) { const float qn = sqrtf(qn2[g]) * 8.0f; mref_s[g] = qn * gks; mref_w[g] = qn * gkw; }
    LDS_WAIT(); asm volatile("" ::: "memory");
    const float* KC = (const float*)(ws + WS_KC) + kc_off(seq) + kvh * 64; const float* VC = (const float*)(ws + WS_VC) + kc_off(seq) + kvh * 64;
    const int n_ok = (qpos + 1) >> 6;
    float sc[5][4];
#pragma unroll
    for (int c = 0; c < 5; ++c) { const int n = lane + 64 * c;
#pragma unroll
        for (int g = 0; g < 4; ++g) sc[c][g] = 0.f;
        if (n < n_ok && n < NB) { const f32x4* kr = (const f32x4*)(KC + (size_t)n * 128);
#pragma unroll 4
            for (int d4 = 0; d4 < 16; ++d4) { const f32x4 k = kr[d4];
                const f32x4 q0 = *(const LAS f32x4*)(s_qp + (4 * d4 + 0) * 4), q1 = *(const LAS f32x4*)(s_qp + (4 * d4 + 1) * 4), q2 = *(const LAS f32x4*)(s_qp + (4 * d4 + 2) * 4), q3 = *(const LAS f32x4*)(s_qp + (4 * d4 + 3) * 4);
#pragma unroll
                for (int g = 0; g < 4; ++g) sc[c][g] += k.x * q0[g] + k.y * q1[g] + k.z * q2[g] + k.w * q3[g]; } } }
    float imp[5];
#pragma unroll
    for (int c = 0; c < 5; ++c) imp[c] = 0.f;
#pragma unroll
    for (int g = 0; g < 4; ++g) {
        float m = -INFINITY;
#pragma unroll
        for (int c = 0; c < 5; ++c) { const int n = lane + 64 * c; if (n < n_ok && n < NB) m = fmaxf(m, sc[c][g]); }
        m = wave_max(m); if (!(m > -INFINITY)) m = 0.f;
        float e[5], zs = 0.f;
#pragma unroll
        for (int c = 0; c < 5; ++c) { const int n = lane + 64 * c; e[c] = (n < n_ok && n < NB) ? __builtin_amdgcn_exp2f(sc[c][g] - m) : 0.f; zs += e[c]; }
        zs = wave_sum(zs); const float iz = 1.0f / fmaxf(zs, 1e-30f);
#pragma unroll
        for (int c = 0; c < 5; ++c) { const int n = lane + 64 * c; const float p = e[c] * iz; imp[c] += p; if (n < NB) s_p[n * 4 + g] = p; }
    }
    LDS_WAIT(); asm volatile("" ::: "memory");
    float o_cmp[4] = {0.f, 0.f, 0.f, 0.f};
    { const int nn = n_ok < NB ? n_ok : NB; const int nstart = MODE == 1 ? wave : 0, nstep = MODE == 1 ? NWAVES : 1;
      for (int n0 = nstart; n0 < nn; n0 += 8 * nstep) { float v[8];
#pragma unroll
          for (int q = 0; q < 8; ++q) { const int n = n0 + q * nstep; v[q] = VC[(size_t)(n < nn ? n : nstart) * 128 + lane]; }
#pragma unroll
          for (int q = 0; q < 8; ++q) { const int n = n0 + q * nstep; if (n < nn) { const f32x4 p = *(const LAS f32x4*)(s_p + n * 4);
#pragma unroll
              for (int g = 0; g < 4; ++g) o_cmp[g] += p[g] * v[q]; } } } }
    LDS_WAIT(); asm volatile("" ::: "memory");
    float score[5];
#pragma unroll
    for (int c = 0; c < 5; ++c) { const int n = lane + 64 * c;
        const bool forced = (n == 0) || (n == cur) || (n == cur - 1);
        score[c] = (n >= NB) ? -4.0f : (n <= cur ? imp[c] + (forced ? 8.0f : 0.f) : -1.0f); }
    const int* ptab = (const int*)a.in[9] + sb * 128;
    float l_sel[4] = {0.f, 0.f, 0.f, 0.f}, o_sel[4] = {0.f, 0.f, 0.f, 0.f};
    float last_bv = 0.f; bool ambiguous = false;
    unsigned skey[5];
#pragma unroll
    for (int c = 0; c < 5; ++c) { const int n = lane + 64 * c; skey[c] = (MODE == 1 && n < NB) ? ((__float_as_uint(score[c]) & ~511u) | (unsigned)(511 - n)) : 0u; }
    for (int round = 0; round < (MODE == 2 ? 17 : 16); ++round) {
        float bv = score[0]; int bi = lane;
        if (MODE == 1) { unsigned w = skey[0];
#pragma unroll
            for (int c = 1; c < 5; ++c) w = skey[c] > w ? skey[c] : w;
            { unsigned o; o = dpp_x1(w); w = o > w ? o : w; o = dpp_x2(w); w = o > w ? o : w; o = dpp_x4(w); w = o > w ? o : w; o = dpp_x8(w); w = o > w ? o : w; w = umax_x16(w); w = umax_x32(w); }
            bi = 511 - (int)(w & 511u);
#pragma unroll
            for (int c = 0; c < 5; ++c) if (skey[c] == w) skey[c] = 0u;
        } else {
#pragma unroll
        for (int c = 1; c < 5; ++c) if (score[c] > bv) { bv = score[c]; bi = lane + 64 * c; }
#pragma unroll
        for (int o = 1; o < 64; o <<= 1) { const float ov = __shfl_xor(bv, o); const int oi = __shfl_xor(bi, o); if (ov > bv || (ov == bv && oi < bi)) { bv = ov; bi = oi; } }
        }
        const int n = __builtin_amdgcn_readfirstlane(bi);
        if (MODE == 2) { if (round == 16) { ambiguous = (bv >= 0.f) && (last_bv - bv < 4e-4f); break; } last_bv = bv; }
#pragma unroll
        for (int c = 0; c < 5; ++c) if (n == lane + 64 * c) score[c] = -3.0f;
        if (n > cur) continue;
        if (MODE == 1 && (round >> 1) != wave) continue;
        const float* kb; const float* vb; int nvalid;
        if (!smp) { kb = out + O_PSK + (size_t)(b * 8192 + 64 * n) * 128; vb = out + O_PSV + (size_t)(b * 8192 + 64 * n) * 128; }
        else if (n < 256) { const int page = ptab[n >> 1]; const size_t ro = ((size_t)page * 128 + (n & 1) * 64) * 128; kb = a.in[4] + ro; vb = a.in[5] + ro; }
        else { kb = out + O_SSK + (size_t)(sb * 8) * 128; vb = out + O_SSV + (size_t)(sb * 8) * 128; }
        nvalid = qpos - 64 * n + 1; if (nvalid > 64) nvalid = 64;
        const bool valid = lane < nvalid;
        float s4[4] = {0.f, 0.f, 0.f, 0.f};
        { const f32x4* kr = (const f32x4*)(kb + (size_t)(valid ? lane : 0) * 128 + kvh * 64);
#pragma unroll 4
          for (int d4 = 0; d4 < 16; ++d4) { const f32x4 k = kr[d4];
              const f32x4 q0 = *(const LAS f32x4*)(s_qr + (4 * d4 + 0) * 4), q1 = *(const LAS f32x4*)(s_qr + (4 * d4 + 1) * 4), q2 = *(const LAS f32x4*)(s_qr + (4 * d4 + 2) * 4), q3 = *(const LAS f32x4*)(s_qr + (4 * d4 + 3) * 4);
#pragma unroll
              for (int g = 0; g < 4; ++g) s4[g] += k.x * q0[g] + k.y * q1[g] + k.z * q2[g] + k.w * q3[g]; } }
        f32x4 pv4;
#pragma unroll
        for (int g = 0; g < 4; ++g) { const float p = valid ? __builtin_amdgcn_exp2f(s4[g] - mref_s[g]) : 0.f; l_sel[g] += p; pv4[g] = p; }
        *(LAS f32x4*)(s_p + lane * 4) = pv4;
        LDS_WAIT(); asm volatile("" ::: "memory");
        for (int j0 = 0; j0 < nvalid; j0 += 8) { float v[8];
#pragma unroll
            for (int q = 0; q < 8; ++q) { const int j = j0 + q < nvalid ? j0 + q : 0; v[q] = vb[(size_t)j * 128 + kvh * 64 + lane]; }
#pragma unroll
            for (int q = 0; q < 8; ++q) if (j0 + q < nvalid) { const f32x4 p = *(const LAS f32x4*)(s_p + (j0 + q) * 4);
#pragma unroll
                for (int g = 0; g < 4; ++g) o_sel[g] += p[g] * v[q]; } }
        LDS_WAIT(); asm volatile("" ::: "memory");
    }
    float l_win[4] = {0.f, 0.f, 0.f, 0.f}, o_win[4] = {0.f, 0.f, 0.f, 0.f};
    { const int lo = qpos - 511 > 0 ? qpos - 511 : 0; const int cnt = qpos - lo + 1;
      for (int c0 = 0; c0 < cnt; c0 += 64) {
          if (MODE == 1 && (c0 >> 6) != wave) continue;
          const int nvalid = cnt - c0 < 64 ? cnt - c0 : 64; const bool valid = lane < nvalid; const int kpos = lo + c0 + (valid ? lane : 0);
          const float* kr_;
          if (!smp) kr_ = (const float*)(ws + WS_KWIN) + (size_t)(b * 8192 + kpos) * 128;
          else if (kpos >= 16384) kr_ = out + O_SWK + (size_t)(sb * 512 + 504 + kpos - 16384) * 128;
          else kr_ = a.in[6] + (size_t)(sb * 512 + kpos - 15872) * 128;
          float s4[4] = {0.f, 0.f, 0.f, 0.f};
          { const f32x4* kr = (const f32x4*)(kr_ + kvh * 64);
#pragma unroll 4
            for (int d4 = 0; d4 < 16; ++d4) { const f32x4 k = kr[d4];
                const f32x4 q0 = *(const LAS f32x4*)(s_qr + (4 * d4 + 0) * 4), q1 = *(const LAS f32x4*)(s_qr + (4 * d4 + 1) * 4), q2 = *(const LAS f32x4*)(s_qr + (4 * d4 + 2) * 4), q3 = *(const LAS f32x4*)(s_qr + (4 * d4 + 3) * 4);
#pragma unroll
                for (int g = 0; g < 4; ++g) s4[g] += k.x * q0[g] + k.y * q1[g] + k.z * q2[g] + k.w * q3[g]; } }
          f32x4 pv4;
#pragma unroll
          for (int g = 0; g < 4; ++g) { const float p = valid ? __builtin_amdgcn_exp2f(s4[g] - mref_w[g]) : 0.f; l_win[g] += p; pv4[g] = p; }
          *(LAS f32x4*)(s_p + lane * 4) = pv4;
          LDS_WAIT(); asm volatile("" ::: "memory");
          for (int j0 = 0; j0 < nvalid; j0 += 8) { float v[8];
#pragma unroll
              for (int q = 0; q < 8; ++q) { const int kp = lo + c0 + (j0 + q < nvalid ? j0 + q : 0); const float* vr;
                  if (!smp) vr = (const float*)(ws + WS_VWIN) + (size_t)(b * 8192 + kp) * 128;
                  else if (kp >= 16384) vr = out + O_SWV + (size_t)(sb * 512 + 504 + kp - 16384) * 128;
                  else vr = a.in[7] + (size_t)(sb * 512 + kp - 15872) * 128;
                  v[q] = vr[kvh * 64 + lane]; }
#pragma unroll
              for (int q = 0; q < 8; ++q) if (j0 + q < nvalid) { const f32x4 p = *(const LAS f32x4*)(s_p + (j0 + q) * 4);
#pragma unroll
                  for (int g = 0; g < 4; ++g) o_win[g] += p[g] * v[q]; } }
          LDS_WAIT(); asm volatile("" ::: "memory");
      } }
    float ls[4], lw[4];
#pragma unroll
    for (int g = 0; g < 4; ++g) { ls[g] = wave_sum(l_sel[g]); lw[g] = wave_sum(l_win[g]); }
    if (MODE == 1) {
        LAS float* part = scr + 2048;
#pragma unroll
        for (int g = 0; g < 4; ++g) { part[g * 64 + lane] = o_cmp[g]; part[(4 + g) * 64 + lane] = o_sel[g]; part[(8 + g) * 64 + lane] = o_win[g]; }
        if (lane < 4) { part[768 + lane] = ls[lane & 3]; part[772 + lane] = lw[lane & 3]; }
        __syncthreads();
        if (wave == 0) {
#pragma unroll
            for (int g = 0; g < 4; ++g) { o_cmp[g] = 0.f; o_sel[g] = 0.f; o_win[g] = 0.f; ls[g] = 0.f; lw[g] = 0.f; }
            for (int w = 0; w < NWAVES; ++w) { const LAS float* pw = (const LAS float*)(ldsb + w * 16384) + 2048;
#pragma unroll
                for (int g = 0; g < 4; ++g) { o_cmp[g] += pw[g * 64 + lane]; o_sel[g] += pw[(4 + g) * 64 + lane]; o_win[g] += pw[(8 + g) * 64 + lane]; ls[g] += pw[768 + g]; lw[g] += pw[772 + g]; } }
        }
    }
    if (MODE != 1 || wave == 0) {
        const float* BG = (const float*)(ws + WS_BG) + (size_t)r * 24 + kvh * 12;
        bf16* O = (bf16*)(ws + WS_O) + (size_t)r * 512 + kvh * 256;
#pragma unroll
        for (int g = 0; g < 4; ++g) {
            const float o = BG[g * 3 + 0] * o_cmp[g] + BG[g * 3 + 1] * (o_sel[g] / fmaxf(ls[g], 1e-30f)) + BG[g * 3 + 2] * (o_win[g] / fmaxf(lw[g], 1e-30f));
            if (MODE == 2) { const float have = bf2f(O[g * 64 + lane]); if (!ambiguous && !(fabsf(have - o) <= 0.004f + 0.02f * fabsf(o))) atomicAdd((unsigned*)(ws + WS_CTL) + 8, 1u); }
            else O[g * 64 + lane] = (bf16)f2bf(o); }
    }
    LDS_WAIT(); asm volatile("" ::: "memory");
    if (MODE == 1) __syncthreads();
}

typedef short s16x8 __attribute__((ext_vector_type(8)));
__device__ __forceinline__ f32x4 mfma16(s16x8 a_, s16x8 b_, f32x4 c_) { return __builtin_amdgcn_mfma_f32_16x16x32_bf16(a_, b_, c_, 0, 0, 0); }
__device__ __forceinline__ unsigned cvtpk(float lo, float hi) { return pg8::cvt_pk_bf16(lo, hi); }
constexpr int AT_SLOT = 16384, AT_VOFF = 8192, AT_CMPV = 18432, AT_MASK = 4 * AT_SLOT, AT_QF = AT_MASK + 12288;
template <int PASS> __device__ __forceinline__ void attn_pass(const Args& a, LAS unsigned char* lds, int b, int kvh, int tb, int wave, int lane, int tid) {
    unsigned char* ws = a.ws; asm volatile("" : "+s"(ws)); asm volatile("" : "+v"(lane)); asm volatile("" : "+v"(tid));
    const int fr = lane & 15, fq = lane >> 4, tok_i = fr >> 2, g = fr & 3;
    const int r0 = b * 8192 + 128 * tb;
    const bf16* QR = (const bf16*)(ws + WS_QR);
    const float* BG = (const float*)(ws + WS_BG); float* OC = (float*)(ws + WS_OC);
    LAS unsigned* wmask = (LAS unsigned*)(lds + AT_MASK + wave * 1536);
    const int hq = kvh * 4 + g;
    float mref[4]; f32x4 O[4][4]; float lsum[4];
    LAS unsigned char* qlds = lds + AT_QF + wave * 8192;
    {
        const char* kimg = (const char*)((const bf16*)(ws + (PASS == 0 ? WS_KSB : WS_KWB)) + (size_t)((b * 128) * 2 + kvh) * 4096);
        const char* vimg = (const char*)((const bf16*)(ws + (PASS == 0 ? WS_VST : WS_VWT)) + (size_t)((b * 128) * 2 + kvh) * 4096);
        const float gk = wave_max(fabsf(a.in[17][(PASS == 0 ? 64 : 128) + lane]));
        if (PASS == 0) {
#pragma unroll
            for (int gi = 0; gi < 4; ++gi) { const int row = r0 + 16 * wave + 4 * gi + tok_i; const bf16* qp = QR + (size_t)row * 512 + hq * 64 + fq * 8;
                const s16x8 qa = *(const s16x8*)qp, qb = *(const s16x8*)(qp + 32); float ss = 0.f;
#pragma unroll
                for (int e = 0; e < 8; ++e) { const float x = bf2f((unsigned short)qa[e]), y = bf2f((unsigned short)qb[e]); ss += x * x + y * y; }
                ss += __shfl_xor(ss, 16); ss += __shfl_xor(ss, 32); ((LAS float*)wmask)[96 + gi * 64 + lane] = sqrtf(ss) * 8.0f;
                *(LAS s16x8*)(qlds + ((gi * 2 + 0) * 64 + lane) * 16) = qa; *(LAS s16x8*)(qlds + ((gi * 2 + 1) * 64 + lane) * 16) = qb; }
            LDS_WAIT();
        }
#pragma unroll
        for (int gi = 0; gi < 4; ++gi) { mref[gi] = ((const LAS float*)wmask)[96 + gi * 64 + lane] * gk; lsum[gi] = 0.f;
#pragma unroll
            for (int dg = 0; dg < 4; ++dg) O[gi][dg] = (f32x4){0.f, 0.f, 0.f, 0.f}; }
        s16x8 Qf[4][2];
#pragma unroll
        for (int gi = 0; gi < 4; ++gi) { Qf[gi][0] = *(const LAS s16x8*)(qlds + ((gi * 2 + 0) * 64 + lane) * 16); Qf[gi][1] = *(const LAS s16x8*)(qlds + ((gi * 2 + 1) * 64 + lane) * 16); }
        const bool bigref = __builtin_amdgcn_readfirstlane(__float_as_int(wave_max(fmaxf(fmaxf(mref[0], mref[1]), fmaxf(mref[2], mref[3]))))) > __float_as_int(64.0f);
        const int nlast = 2 * tb + 1, nfirst = PASS == 0 ? 0 : (2 * tb - 8 > 0 ? 2 * tb - 8 : 0);
        const int drow = 8 * wave + (lane >> 3); const unsigned dsrc = (unsigned)(drow * 128 + (((lane & 7) ^ ((drow >> 1) & 7)) * 16));
        const unsigned fsw0 = (unsigned)((((0 + fq) ^ ((fr >> 1) & 7)) * 16)), fsw1 = (unsigned)((((4 + fq) ^ ((fr >> 1) & 7)) * 16));
#define AT_DMA_BLOCK(nn, sl) do { const size_t bo_ = (size_t)(nn) * 2 * 4096 * 2 + dsrc; \
            __builtin_amdgcn_global_load_lds((const unsigned*)(kimg + bo_), (LAS unsigned*)(lds + (sl) * AT_SLOT + wave * 1024), 16, 0, 0); \
            __builtin_amdgcn_global_load_lds((const unsigned*)(vimg + bo_), (LAS unsigned*)(lds + (sl) * AT_SLOT + AT_VOFF + wave * 1024), 16, 0, 0); } while (0)
        const int nblk = nlast - nfirst + 1, nint = (nblk + 1) >> 1;
        AT_DMA_BLOCK(nfirst, 0); if (nblk > 1) AT_DMA_BLOCK(nfirst + 1, 1);
        asm volatile("s_waitcnt vmcnt(0) lgkmcnt(0)\n\ts_barrier" ::: "memory");
        unsigned gwc[4] = {0u, 0u, 0u, 0u}, twc[4] = {0u, 0u, 0u, 0u}; int wcur = -1;
        auto do_block = [&](const int n, const LAS unsigned char* kb) __attribute__((always_inline)) {
            const LAS unsigned char* vb = kb + AT_VOFF;
            if (PASS == 0 && (n >> 5) != wcur) { wcur = n >> 5;
#pragma unroll
                for (int gi = 0; gi < 4; ++gi) { gwc[gi] = (unsigned)__builtin_amdgcn_readfirstlane((int)wmask[64 + gi * 4 + wcur]); twc[gi] = wmask[(4 * gi + tok_i) * 4 + wcur]; } }
            int actm = 0;
#pragma unroll
            for (int gi = 0; gi < 4; ++gi) { int av;
                if (PASS == 0) { av = (int)((gwc[gi] >> (n & 31)) & 1u); }
                else { const int tlo = 128 * tb + 16 * wave + 4 * gi; const int b_lo = tlo - 511 > 0 ? (tlo - 511) >> 6 : 0, b_hi = (tlo + 3) >> 6; av = (n >= b_lo && n <= b_hi) ? 1 : 0; }
                actm |= av << gi; }
            actm = __builtin_amdgcn_readfirstlane(actm);
            bool act[4];
#pragma unroll
            for (int gi = 0; gi < 4; ++gi) act[gi] = ((actm >> gi) & 1) != 0;
            if (actm != 0) {
                v4u Pk[4][2];
#pragma unroll
                for (int gi = 0; gi < 4; ++gi) { Pk[gi][0] = (v4u){0u, 0u, 0u, 0u}; Pk[gi][1] = (v4u){0u, 0u, 0u, 0u}; }
                float ls4[4] = {0.f, 0.f, 0.f, 0.f};
                bool tselb[4];
#pragma unroll
                for (int gi = 0; gi < 4; ++gi) { tselb[gi] = true; if (PASS == 0) tselb[gi] = ((twc[gi] >> (n & 31)) & 1u) != 0u; }
#pragma unroll
                for (int kc = 0; kc < 2; ++kc) {
                    s16x8 Kf[2][2];
#pragma unroll
                    for (int x = 0; x < 2; ++x)
#pragma unroll
                        for (int k = 0; k < 2; ++k) Kf[x][k] = *(const LAS s16x8*)(kb + (16 * (2 * kc + x) + fr) * 128 + (k ? fsw1 : fsw0));
#pragma unroll
                    for (int gi = 0; gi < 4; ++gi) if (act[gi]) {
                        const int tl = 16 * wave + 4 * gi + tok_i, t = 128 * tb + tl, rel = t - 64 * n;
                        const bool tsel = tselb[gi];
                        const int tlo = 128 * tb + 16 * wave + 4 * gi;
                        const bool edge = (64 * n + 63 > tlo) || (PASS == 1 && 64 * n < tlo + 3 - 511);
                        f32x4 S[2];
                        const s16x8 qf0 = Qf[gi][0], qf1 = Qf[gi][1];
                        float ls = 0.f;
                        if (edge || bigref) {
                            const float nm = tsel ? (bigref ? -mref[gi] : 0.f) : -1e30f;
#pragma unroll
                            for (int x = 0; x < 2; ++x) { S[x] = (f32x4){nm, nm, nm, nm}; S[x] = mfma16(Kf[x][0], qf0, S[x]); S[x] = mfma16(Kf[x][1], qf1, S[x]); }
#pragma unroll
                            for (int x = 0; x < 2; ++x)
#pragma unroll
                                for (int i = 0; i < 4; ++i) { const int j = 16 * (2 * kc + x) + 4 * fq + i; const bool ok = j <= rel && (PASS == 0 || j > rel - 512);
                                    const float p = ok ? __builtin_amdgcn_exp2f(S[x][i]) : 0.f; S[x][i] = p; ls += p; }
                            Pk[gi][kc].x = cvtpk(S[0][0], S[0][1]); Pk[gi][kc].y = cvtpk(S[0][2], S[0][3]); Pk[gi][kc].z = cvtpk(S[1][0], S[1][1]); Pk[gi][kc].w = cvtpk(S[1][2], S[1][3]);
                        } else {
#pragma unroll
                            for (int x = 0; x < 2; ++x) { S[x] = mfma16(Kf[x][0], qf0, (f32x4){0.f, 0.f, 0.f, 0.f}); S[x] = mfma16(Kf[x][1], qf1, S[x]); }
#pragma unroll
                            for (int x = 0; x < 2; ++x)
#pragma unroll
                                for (int i = 0; i < 4; ++i) { const float p = __builtin_amdgcn_exp2f(S[x][i]); S[x][i] = p; ls += p; }
                            const unsigned km = (PASS == 0 && !tsel) ? 0u : 0xffffffffu; if (PASS == 0) ls = tsel ? ls : 0.f;
                            Pk[gi][kc].x = cvtpk(S[0][0], S[0][1]) & km; Pk[gi][kc].y = cvtpk(S[0][2], S[0][3]) & km; Pk[gi][kc].z = cvtpk(S[1][0], S[1][1]) & km; Pk[gi][kc].w = cvtpk(S[1][2], S[1][3]) & km;
                        }
                        ls4[gi] += ls;
                    }
                    }
#pragma unroll
                for (int gi = 0; gi < 4; ++gi) lsum[gi] += ls4[gi];
#pragma unroll
                for (int kc = 0; kc < 2; ++kc) {
                    s16x8 Vf[4];
#pragma unroll
                    for (int x = 0; x < 4; ++x) Vf[x] = *(const LAS s16x8*)(vb + (16 * x + fr) * 128 + (kc ? fsw1 : fsw0));
#pragma unroll
                    for (int gi = 0; gi < 4; ++gi) if (act[gi]) { const s16x8 pb = __builtin_bit_cast(s16x8, Pk[gi][kc]);
#pragma unroll
                        for (int dg = 0; dg < 4; ++dg) O[gi][dg] = mfma16(Vf[dg], pb, O[gi][dg]); }
                    }
            }
        };
#pragma nounroll
        for (int iv = 0; iv < nint; ++iv) {
            const int n0 = nfirst + 2 * iv, sp = (iv & 1) * 2;
            if (n0 + 2 <= nlast) AT_DMA_BLOCK(n0 + 2, 2 - sp);
            if (n0 + 3 <= nlast) AT_DMA_BLOCK(n0 + 3, 3 - sp);
            do_block(n0, lds + sp * AT_SLOT);
            if (n0 + 1 <= nlast) do_block(n0 + 1, lds + (sp + 1) * AT_SLOT);
            asm volatile("s_waitcnt vmcnt(0) lgkmcnt(0)\n\ts_barrier" ::: "memory");
        }
#pragma unroll
        for (int gi = 0; gi < 4; ++gi) { const int row = r0 + 16 * wave + 4 * gi + tok_i;
            float l = lsum[gi]; l += __shfl_xor(l, 16); l += __shfl_xor(l, 32);
            const float sc = BG[(size_t)row * 24 + hq * 3 + 1 + PASS] / fmaxf(l, 1e-30f);
            float* oc = OC + (size_t)row * 512 + hq * 64 + 4 * fq;
#pragma unroll
            for (int dg = 0; dg < 4; ++dg) { const f32x4 v = *(const f32x4*)(oc + 16 * dg) + O[gi][dg] * sc;
                if (PASS == 0) *(f32x4*)(oc + 16 * dg) = v;
                else { v2u w; w.x = cvtpk(v[0], v[1]); w.y = cvtpk(v[2], v[3]); *(v2u*)((bf16*)(ws + WS_O) + (size_t)row * 512 + hq * 64 + 16 * dg + 4 * fq) = w; } } }
        }
}
__device__ __forceinline__ void attn_unit(const Args& a, LAS unsigned char* lds, int b, int kvh, int tb, int wave, int lane, int tid) {
    unsigned char* ws = a.ws; asm volatile("" : "+s"(ws)); asm volatile("" : "+v"(lane)); asm volatile("" : "+v"(tid));
    const int fr = lane & 15, fq = lane >> 4, tok_i = fr >> 2, g = fr & 3;
    const int r0 = b * 8192 + 128 * tb;
    const bf16* QP = (const bf16*)(ws + WS_QP); const bf16* QR = (const bf16*)(ws + WS_QR);
    const float* BG = (const float*)(ws + WS_BG); float* OC = (float*)(ws + WS_OC);
    LAS unsigned* wmask = (LAS unsigned*)(lds + AT_MASK + wave * 1536);
    const int hq = kvh * 4 + g;
    { const char* kcb = (const char*)((const bf16*)(ws + WS_KCB) + (size_t)(b * 2 + kvh) * 128 * 64); const char* vct = (const char*)((const bf16*)(ws + WS_VCT) + (size_t)(b * 2 + kvh) * 64 * 128);
      for (int c = tid; c < 1024; c += 512) { const v4u v = *(const v4u*)(kcb + c * 16); *(LAS v4u*)(lds + (c >> 3) * 144 + (c & 7) * 16) = v; }
      for (int c = tid; c < 1024; c += 512) { const v4u v = *(const v4u*)(vct + c * 16); *(LAS v4u*)(lds + AT_CMPV + (c >> 4) * 272 + (c & 15) * 16) = v; } }
    __syncthreads();
    const int ng = (2 * tb + 2 + 15) >> 4;
    s16x8 qn0, qn1; float bgn;
    { const int row = r0 + 16 * wave + tok_i; const bf16* qp = QP + (size_t)row * 512 + hq * 64 + fq * 8; qn0 = *(const s16x8*)qp; qn1 = *(const s16x8*)(qp + 32); bgn = BG[(size_t)row * 24 + hq * 3 + 0]; }
#pragma nounroll
    for (int gi = 0; gi < 4; ++gi) {
        const int tl = 16 * wave + 4 * gi + tok_i, t = 128 * tb + tl, row = r0 + tl;
        const s16x8 q0 = qn0, q1 = qn1; const float bg0 = bgn;
        { const int rown = r0 + 16 * wave + 4 * (gi < 3 ? gi + 1 : gi) + tok_i; const bf16* qp = QP + (size_t)rown * 512 + hq * 64 + fq * 8; qn0 = *(const s16x8*)qp; qn1 = *(const s16x8*)(qp + 32); bgn = BG[(size_t)rown * 24 + hq * 3 + 0]; }
        f32x4 S[8];
#pragma unroll
        for (int kg = 0; kg < 8; ++kg) { S[kg] = (f32x4){0.f, 0.f, 0.f, 0.f};
            if (kg < ng) { const s16x8 a0 = *(const LAS s16x8*)(lds + (16 * kg + fr) * 144 + fq * 16), a1 = *(const LAS s16x8*)(lds + (16 * kg + fr) * 144 + 64 + fq * 16);
                S[kg] = mfma16(a0, q0, S[kg]); S[kg] = mfma16(a1, q1, S[kg]); } }
        const int n_ok = (t + 1) >> 6, cur = t >> 6;
        float m = -INFINITY;
#pragma unroll
        for (int kg = 0; kg < 8; ++kg)
#pragma unroll
            for (int i = 0; i < 4; ++i) if (16 * kg + 4 * fq + i < n_ok) m = fmaxf(m, S[kg][i]);
        m = fmax_x16(m); m = fmax_x32(m); if (!(m > -INFINITY)) m = 0.f;
        float sum = 0.f;
#pragma unroll
        for (int kg = 0; kg < 8; ++kg)
#pragma unroll
            for (int i = 0; i < 4; ++i) { const float e = (16 * kg + 4 * fq + i < n_ok) ? __builtin_amdgcn_exp2f(S[kg][i] - m) : 0.f; S[kg][i] = e; sum += e; }
        sum = fsum_x16(sum); sum = fsum_x32(sum);
        const float inv = 1.0f / fmaxf(sum, 1e-30f);
#pragma unroll
        for (int kg = 0; kg < 8; ++kg) S[kg] *= inv;
        { f32x4 Oc[4];
#pragma unroll
          for (int dg = 0; dg < 4; ++dg) Oc[dg] = (f32x4){0.f, 0.f, 0.f, 0.f};
#pragma unroll
          for (int kc = 0; kc < 4; ++kc) if (2 * kc < ng) {
              v4u pk; pk.x = cvtpk(S[2 * kc][0], S[2 * kc][1]); pk.y = cvtpk(S[2 * kc][2], S[2 * kc][3]); pk.z = cvtpk(S[2 * kc + 1][0], S[2 * kc + 1][1]); pk.w = cvtpk(S[2 * kc + 1][2], S[2 * kc + 1][3]);
              const s16x8 pb = __builtin_bit_cast(s16x8, pk);
#pragma unroll
              for (int dg = 0; dg < 4; ++dg) { const s16x8 av = *(const LAS s16x8*)(lds + AT_CMPV + (16 * dg + fr) * 272 + kc * 64 + fq * 16); Oc[dg] = mfma16(av, pb, Oc[dg]); } }
#pragma unroll
          for (int dg = 0; dg < 4; ++dg) *(f32x4*)(OC + (size_t)row * 512 + hq * 64 + 16 * dg + 4 * fq) = Oc[dg] * bg0; }
#pragma unroll
        for (int kg = 0; kg < 8; ++kg)
#pragma unroll
            for (int i = 0; i < 4; ++i) { float v = S[kg][i]; v += dpp_x1f(v); v += dpp_x2f(v); S[kg][i] = v; }
        unsigned key[8];
#pragma unroll
        for (int h = 0; h < 2; ++h)
#pragma unroll
            for (int i = 0; i < 4; ++i) { const float v = g == 0 ? S[h][i] : (g == 1 ? S[2 + h][i] : (g == 2 ? S[4 + h][i] : S[6 + h][i]));
                const int n = 16 * (2 * g + h) + 4 * fq + i; const bool forced = (n == 0) || (n == cur) || (n == cur - 1);
                const float scv = v + (forced ? 8.0f : 0.f);
                key[h * 4 + i] = (n <= cur) ? ((__float_as_uint(scv) & ~255u) | (unsigned)(255 - n)) : 0u; }
        unsigned m0 = 0u, m1 = 0u, m2 = 0u, m3 = 0u;
#pragma nounroll
        for (int round = 0; round < 16; ++round) {
            unsigned w = key[0];
#pragma unroll
            for (int j = 1; j < 8; ++j) w = key[j] > w ? key[j] : w;
            { unsigned o; o = dpp_x1(w); w = o > w ? o : w; o = dpp_x2(w); w = o > w ? o : w; w = umax_x16(w); w = umax_x32(w); }
            if (w != 0u) { const int n = 255 - (int)(w & 255u); const unsigned bit = 1u << (n & 31); const int wi = n >> 5;
                m0 |= wi == 0 ? bit : 0u; m1 |= wi == 1 ? bit : 0u; m2 |= wi == 2 ? bit : 0u; m3 |= wi == 3 ? bit : 0u;
#pragma unroll
                for (int j = 0; j < 8; ++j) key[j] = key[j] == w ? 0u : key[j]; }
        }
        if (g == 0 && fq == 0) { v4u mm; mm.x = m0; mm.y = m1; mm.z = m2; mm.w = m3; *(LAS v4u*)(wmask + (4 * gi + tok_i) * 4) = mm; }
        { unsigned o0 = m0, o1 = m1, o2 = m2, o3 = m3;
          o0 |= (unsigned)__shfl_xor((int)o0, 4); o1 |= (unsigned)__shfl_xor((int)o1, 4); o2 |= (unsigned)__shfl_xor((int)o2, 4); o3 |= (unsigned)__shfl_xor((int)o3, 4);
          o0 |= (unsigned)__shfl_xor((int)o0, 8); o1 |= (unsigned)__shfl_xor((int)o1, 8); o2 |= (unsigned)__shfl_xor((int)o2, 8); o3 |= (unsigned)__shfl_xor((int)o3, 8);
          if (lane == 0) { v4u mm; mm.x = o0; mm.y = o1; mm.z = o2; mm.w = o3; *(LAS v4u*)(wmask + 64 + gi * 4) = mm; } }
    }
    LDS_WAIT();
    __syncthreads();
    attn_pass<0>(a, lds, b, kvh, tb, wave, lane, tid);
    attn_pass<1>(a, lds, b, kvh, tb, wave, lane, tid);
    __syncthreads();
}
__device__ __forceinline__ void phase_attn(const Args& a, LAS unsigned char* lds, int vcu, int G, int wave, int lane, int tid) {
    for (int it = vcu; it < 2 * MS; it += G) attn_item<1>(a, MP + (it >> 1), it & 1, lds, wave, lane);
#pragma nounroll
    for (int u2 = 2 * vcu; u2 < 512; u2 += 2 * G) {
#pragma nounroll
        for (int h = 0; h < 2; ++h) { const int u = u2 >> 1, bh = u >> 5, s = u & 31; attn_unit(a, lds, bh >> 1, bh & 1, h ? 63 - s : s, wave, lane, tid); } }
}
#if PROBE_ATTN
__device__ __forceinline__ void phase_attn_check(const Args& a, LAS unsigned char* lds, int gw, int NGW, int wave, int lane) {
    for (int it = gw; it < 2 * 2048; it += NGW) { const int idx = it >> 1; int r;
        if (idx < 300) r = idx; else if (idx < 600) r = 3 * 8192 + 900 + (idx - 300); else r = (int)(((long)(idx - 600) * 22639L) % MP);
        attn_item<2>(a, r, it & 1, lds, wave, lane); }
}
#endif


template <class F> __device__ __forceinline__ void small_gemm(const bf16* A, const bf16* Bt, int N, int K, int vcu, int G, int wave, int lane_, LAS unsigned char* lds, const F& f) {
    int lane = lane_;
    const int ntiles = 16 * (N >> 6), nk = K >> 7;
#pragma nounroll
    for (int tile = vcu; tile < ntiles; tile += G) {
        asm volatile("" : "+v"(lane));
        const int fr = lane & 15, fq = lane >> 4, rt = tile & 15, ct = tile >> 4;
        const bf16* ap = A + (size_t)(16 * rt + fr) * K + 8 * fq; const bf16* bp = Bt + (size_t)(64 * ct + fr) * K + 8 * fq;
        f32x4 acc[4];
#pragma unroll
        for (int j = 0; j < 4; ++j) acc[j] = (f32x4){0.f, 0.f, 0.f, 0.f};
#pragma nounroll
        for (int it = wave; it < nk; it += NWAVES) { const int k0 = it << 7;
            s16x8 af[4], bfr[4][4];
#pragma unroll
            for (int q = 0; q < 4; ++q) { af[q] = *(const s16x8*)(ap + k0 + 32 * q);
#pragma unroll
                for (int j = 0; j < 4; ++j) bfr[q][j] = *(const s16x8*)(bp + (size_t)(16 * j) * K + k0 + 32 * q); }
#pragma unroll
            for (int q = 0; q < 4; ++q)
#pragma unroll
                for (int j = 0; j < 4; ++j) acc[j] = mfma16(bfr[q][j], af[q], acc[j]);
        }
        LAS f32x4* red = (LAS f32x4*)lds;
#pragma unroll
        for (int j = 0; j < 4; ++j) red[(wave * 4 + j) * 64 + lane] = acc[j];
        __syncthreads();
        if (wave < 4) { f32x4 sum = red[wave * 64 + lane];
#pragma unroll
            for (int w = 1; w < NWAVES; ++w) sum += red[(w * 4 + wave) * 64 + lane];
            f(16 * rt + fr, 64 * ct + 16 * wave + 4 * fq, sum); }
        __syncthreads();
    }
}
__device__ __forceinline__ void sample_post(const Args& a, int gw, int NGW, int lane) {
    unsigned char* ws = a.ws; float* out = a.out;
    const float* Z = (const float*)(ws + WS_ZS);
    const float* rc = (const float*)(ws + WS_ROPE); const float* rs = rc + ROPE_N * 32;
    bf16* U = (bf16*)(ws + WS_U); bf16* QP = (bf16*)(ws + WS_QP); bf16* QR = (bf16*)(ws + WS_QR); bf16* GC = (bf16*)(ws + WS_GC); bf16* GN = (bf16*)(ws + WS_GN);
    float* BG = (float*)(ws + WS_BG);
    const float qg = a.in[16][lane]; const float kg0 = a.in[17][lane], kg1 = a.in[17][64 + lane], kg2 = a.in[17][128 + lane];
    for (int r = MP + gw; r < MT; r += NGW) {
        const float* z = Z + (size_t)(r - MP) * DINP;
        float zg[16], zq[8], zk[12], zm[32], zn;
#pragma unroll
        for (int i = 0; i < 8; ++i) { zg[i] = z[front_rowmap(lane + 64 * i)]; zg[8 + i] = z[front_rowmap(512 + lane + 64 * i)]; zq[i] = z[front_rowmap(OFF_Q + 64 * i + lane)]; }
#pragma unroll
        for (int i = 0; i < 12; ++i) zk[i] = z[front_rowmap(OFF_KV + 64 * i + lane)];
#pragma unroll
        for (int i = 0; i < 32; ++i) zm[i] = z[front_rowmap(OFF_MG + lane + 64 * i)];
        zn = z[front_rowmap(OFF_NG + (lane < 24 ? lane : 0))];
        const bool smp = r >= MP; const int rs_ = r - MP, sb = rs_ >> 3, si = rs_ & 7, b = r >> 13, t = r & 8191;
        const int ri = rope_idx(r); const float cv = rc[ri * 32 + (lane & 31)], sv = rs[ri * 32 + (lane & 31)];
#pragma unroll
        for (int i = 0; i < 8; ++i) { const int c = lane + 64 * i; const float u = zg[i] * sigm(zg[8 + i]);
            U[(size_t)r * 512 + c] = (bf16)f2bf(u);
            if (smp) out[O_SCONV + (size_t)(sb * 30 + 22 + si) * 512 + c] = u;
            else if (t >= 8162) out[O_PCONV + (size_t)(b * 30 + t - 8162) * 512 + c] = u; }
#pragma unroll
        for (int h = 0; h < 8; ++h) { const float x = zq[h]; const float ms = wave_sum(x * x) * (1.0f / 64.0f);
            const float y = x * (1.0f / sqrtf(ms + EPS)) * qg; const float oth = __shfl_xor(y, 32);
            const float yr = lane < 32 ? y * cv - oth * sv : y * cv + oth * sv;
            QP[(size_t)r * 512 + 64 * h + lane] = (bf16)f2bf(y * C2); QR[(size_t)r * 512 + 64 * h + lane] = (bf16)f2bf(yr * C2); }
#pragma unroll
        for (int j = 0; j < 6; ++j)
#pragma unroll
            for (int kvh = 0; kvh < 2; ++kvh) {
                float x = zk[2 * j + kvh];
                if ((j & 1) == 0) { const float ms = wave_sum(x * x) * (1.0f / 64.0f); x = x * (1.0f / sqrtf(ms + EPS)) * (j == 0 ? kg0 : (j == 2 ? kg1 : kg2));
                    if (j >= 2) { const float oth = __shfl_xor(x, 32); x = lane < 32 ? x * cv - oth * sv : x * cv + oth * sv; } }
                const int cc = kvh * 64 + lane;
                if (j < 4) { const size_t po = (j == 0 ? O_PCK : j == 1 ? O_PCV : j == 2 ? O_PSK : O_PSV), so = (j == 0 ? O_SCK : j == 1 ? O_SCV : j == 2 ? O_SSK : O_SSV);
                    if (smp) out[so + (size_t)rs_ * 128 + cc] = x; else out[po + (size_t)r * 128 + cc] = x; }
                if (!smp && j >= 2) { const size_t blk = ((size_t)(b * 128 + (t >> 6)) * 2 + kvh) * 4096; const int key = t & 63;
                    if (j == 2) ((bf16*)(ws + WS_KSB))[blk + key * 64 + lane] = (bf16)f2bf(x); else if (j == 3) ((bf16*)(ws + WS_VST))[blk + lane * 64 + perm64(key)] = (bf16)f2bf(x);
                    else if (j == 4) ((bf16*)(ws + WS_KWB))[blk + key * 64 + lane] = (bf16)f2bf(x); else ((bf16*)(ws + WS_VWT))[blk + lane * 64 + perm64(key)] = (bf16)f2bf(x); }
                if (j >= 4) { if (smp) out[(j == 4 ? O_SWK : O_SWV) + (size_t)(sb * 512 + 504 + si) * 128 + cc] = x;
                        }
            }
        if (lane < 24) BG[(size_t)r * 24 + lane] = sigm(zn);
#pragma unroll
        for (int i = 0; i < 32; ++i) { const int c = lane + 64 * i; const float v = sigm(zm[i]);
            if (i < 16) GC[(size_t)r * 1024 + c] = (bf16)f2bf(v); else GN[(size_t)r * 1024 + c - 1024] = (bf16)f2bf(v); }
    }
}


constexpr int N_PHASES = 12;
#ifndef ONE_LAUNCH
#define ONE_LAUNCH 1
#endif
__global__ void __launch_bounds__(NWAVES * 64, 2) fwd(Args args) {
    extern __shared__ __attribute__((aligned(16))) unsigned char lds_raw[];
    LAS unsigned char* lds = (LAS unsigned char*)lds_raw;
    const int tid = threadIdx.x, lane = tid & 63, wave = __builtin_amdgcn_readfirstlane(tid >> 6);
    const int G = gridDim.x, bx = blockIdx.x;
    const int vcu = (G % 8 == 0) ? (bx % 8) * (G / 8) + bx / 8 : bx;
    const int gw = vcu * NWAVES + wave, NGW = G * NWAVES;
    unsigned char* ws = args.ws;
    for (int u = tid; u < (LDS_BYTES - RING_BYTES) / 4; u += NWAVES * 64) ((LAS unsigned*)(lds + RING_BYTES))[u] = 0u;
    __syncthreads();
    XcdBarrier bar; bar.bar = (unsigned*)(ws + WS_CTL) + CW_BAR; bar.x = 0; bar.st = nullptr;
    if (ONE_LAUNCH) bar = xcd_barrier_post((unsigned*)(ws + WS_CTL) + CW_BAR, (volatile LAS unsigned*)(lds + MISC_OFF) + 8);
    const int lo = args.ph_lo, hi = args.ph_hi;
#define IN(k) (lo <= (k) && (k) < hi)
#define SEAM(k) do { if (ONE_LAUNCH && IN(k) && hi > (k) + 1) xcd_barrier(bar); } while (0)
    const float* modp = (const float*)(ws + WS_MOD);
    if (IN(0)) { phase0(args, lds, gw, NGW, wave, lane); } SEAM(0);
    if (IN(1)) { norm_rows(args.in[0], args.in[1], args.in[14], modp, 0, 1024, (bf16*)(ws + WS_H), gw, NGW, lane); } SEAM(1);
    if (IN(2)) { pg8::Gemm g{(const bf16*)(ws + WS_H), (const bf16*)(ws + WS_WIN), MP, DINP, 1024}; pg8::StaticOrder S; S.init(MP, DINP, G, bx);
        const float* rcp_ = (const float*)(ws + WS_ROPE);
        pg8::EpiFront E{args.out, ws, args.in[16], args.in[17], rcp_, rcp_ + ROPE_N * 32, O_PCK, O_SCK, O_PWK, O_SWK, O_PCONV, O_SCONV,
                        WS_U, WS_QP, WS_QR, WS_GC, WS_GN, WS_BG, WS_KSB, WS_VST, WS_KWB, WS_VWT, WS_KWIN, WS_VWIN, C2};
        pg8::gemm_phase<pg8::EpiFront, pg8::StaticOrder, true, true>(lds, g, S, E);
        { float* zs = (float*)(ws + WS_ZS);
          small_gemm((const bf16*)(ws + WS_H) + (size_t)MP * 1024, (const bf16*)(ws + WS_WIN), DINP, 1024, vcu, G, wave, lane, lds, [&](int r, int c, f32x4 v) { *(f32x4*)(zs + (size_t)r * DINP + c) = v; }); } } SEAM(2);
    if (IN(3)) { sample_post(args, gw, NGW, lane); } SEAM(3);
    if (IN(4)) { phase_conv(args, lds, vcu, G, gw, NGW, wave, lane, tid); } SEAM(4);
    if (IN(5)) { pg8::Gemm g{(const bf16*)(ws + WS_CACT), (const bf16*)(ws + WS_WPW2), MP, 1024, 512}; pg8::StaticOrder S; S.init(MP, 1024, G, bx);
        pg8::EpiGate<false> E{(bf16*)(ws + WS_T1), (const bf16*)(ws + WS_GC), 1024};
        pg8::gemm_phase<pg8::EpiGate<false>, pg8::StaticOrder, true, true>(lds, g, S, E);
        { bf16* t1 = (bf16*)(ws + WS_T1) + (size_t)MP * 1024; const bf16* gc = (const bf16*)(ws + WS_GC) + (size_t)MP * 1024;
          small_gemm((const bf16*)(ws + WS_CACT) + (size_t)MP * 512, (const bf16*)(ws + WS_WPW2), 1024, 512, vcu, G, wave, lane, lds, [&](int r, int c, f32x4 v) {
              const v2u gg = *(const v2u*)(gc + (size_t)r * 1024 + c); v2u w; w.x = pk2(v[0] * pg8::bf_lo(gg.x), v[1] * pg8::bf_hi(gg.x)); w.y = pk2(v[2] * pg8::bf_lo(gg.y), v[3] * pg8::bf_hi(gg.y));
              *(v2u*)(t1 + (size_t)r * 1024 + c) = w; }); } }
    if (IN(5) && !IN(6)) SEAM(5);
    if (IN(6)) { phase_attn(args, lds, vcu, G, wave, lane, tid); } SEAM(6);
#if PROBE_ATTN
    if (IN(7)) { phase_attn_check(args, lds, gw, NGW, wave, lane); __syncthreads(); }
#endif
    if (IN(7)) { pg8::Gemm g{(const bf16*)(ws + WS_O), (const bf16*)(ws + WS_WNSA), MP, 1024, 512}; pg8::StaticOrder S; S.init(MP, 1024, G, bx);
        pg8::EpiGate<true> E{(bf16*)(ws + WS_T1), (const bf16*)(ws + WS_GN), 1024};
        pg8::gemm_phase<pg8::EpiGate<true>, pg8::StaticOrder, true, true>(lds, g, S, E);
        { bf16* t1 = (bf16*)(ws + WS_T1) + (size_t)MP * 1024; const bf16* gn = (const bf16*)(ws + WS_GN) + (size_t)MP * 1024;
          small_gemm((const bf16*)(ws + WS_O) + (size_t)MP * 512, (const bf16*)(ws + WS_WNSA), 1024, 512, vcu, G, wave, lane, lds, [&](int r, int c, f32x4 v) {
              const v2u gg = *(const v2u*)(gn + (size_t)r * 1024 + c); const v2u tt = *(const v2u*)(t1 + (size_t)r * 1024 + c); v2u w;
              w.x = pk2(pg8::bf_lo(tt.x) + v[0] * pg8::bf_lo(gg.x), pg8::bf_hi(tt.x) + v[1] * pg8::bf_hi(gg.x)); w.y = pk2(pg8::bf_lo(tt.y) + v[2] * pg8::bf_lo(gg.y), pg8::bf_hi(tt.y) + v[3] * pg8::bf_hi(gg.y));
              *(v2u*)(t1 + (size_t)r * 1024 + c) = w; }); } } SEAM(7);
    if (IN(8)) { pg8::Gemm g{(const bf16*)(ws + WS_T1), (const bf16*)(ws + WS_WOUT), MP, 1024, 1024}; pg8::StaticOrder S; S.init(MP, 1024, G, bx);
        pg8::EpiResGate E{args.in[0], args.in[1], args.out, modp + 2048};
        pg8::gemm_phase<pg8::EpiResGate, pg8::StaticOrder, true, true>(lds, g, S, E);
        { const float* xs = args.in[1]; float* ys = args.out + (size_t)MP * 1024; const float* mg = modp + 2048;
          small_gemm((const bf16*)(ws + WS_T1) + (size_t)MP * 1024, (const bf16*)(ws + WS_WOUT), 1024, 1024, vcu, G, wave, lane, lds, [&](int r, int c, f32x4 v) {
              *(f32x4*)(ys + (size_t)r * 1024 + c) = *(const f32x4*)(xs + (size_t)r * 1024 + c) + *(const f32x4*)(mg + (size_t)(4 + (r >> 3)) * 6144 + c) * v; }); } } SEAM(8);
    if (IN(9)) { norm_rows(args.out, args.out + (size_t)MP * 1024, args.in[29], modp, 3072, 4096, (bf16*)(ws + WS_H), gw, NGW, lane); } SEAM(9);
    if (IN(10)) { pg8::Gemm g{(const bf16*)(ws + WS_H), (const bf16*)(ws + WS_WGU), MP, 2 * DFF, 1024}; pg8::StaticOrder S; S.init(MP, 2 * DFF, G, bx);
        pg8::EpiSwiGlu E{(bf16*)(ws + WS_ACT), DFF};
        pg8::gemm_phase<pg8::EpiSwiGlu, pg8::StaticOrder, true, true>(lds, g, S, E);
        { bf16* act = (bf16*)(ws + WS_ACT) + (size_t)MP * DFF;
          small_gemm((const bf16*)(ws + WS_H) + (size_t)MP * 1024, (const bf16*)(ws + WS_WGU), 2 * DFF, 1024, vcu, G, wave, lane, lds, [&](int r, int c, f32x4 v) {
              f32x4 up; up[0] = __shfl_xor(v[0], 16); up[1] = __shfl_xor(v[1], 16); up[2] = __shfl_xor(v[2], 16); up[3] = __shfl_xor(v[3], 16);
              if ((c & 4) == 0) { v2u w; w.x = pk2(v[0] * sigm(v[0]) * up[0], v[1] * sigm(v[1]) * up[1]); w.y = pk2(v[2] * sigm(v[2]) * up[2], v[3] * sigm(v[3]) * up[3]);
                  *(v2u*)(act + (size_t)r * DFF + (128 * (c >> 8) + 32 * ((c >> 5) & 3) + 8 * ((c >> 3) & 3) + 4 * ((c >> 7) & 1))) = w; } }); } } SEAM(10);
    if (IN(11)) { pg8::Gemm g{(const bf16*)(ws + WS_ACT), (const bf16*)(ws + WS_WDOWN), MP, 1024, DFF}; pg8::StaticOrder S; S.init(MP, 1024, G, bx);
        pg8::EpiResGate E{args.out, args.out + (size_t)MP * 1024, args.out, modp + 5120};
        pg8::gemm_phase<pg8::EpiResGate, pg8::StaticOrder, true, true>(lds, g, S, E);
        { float* ys = args.out + (size_t)MP * 1024; const float* mg = modp + 5120;
          small_gemm((const bf16*)(ws + WS_ACT) + (size_t)MP * DFF, (const bf16*)(ws + WS_WDOWN), 1024, DFF, vcu, G, wave, lane, lds, [&](int r, int c, f32x4 v) {
              float* o = ys + (size_t)r * 1024 + c; *(f32x4*)o = *(const f32x4*)o + *(const f32x4*)(mg + (size_t)(4 + (r >> 3)) * 6144 + c) * v; }); } }
#if PROBE_ATTN
    if (ONE_LAUNCH) { xcd_barrier(bar); const unsigned cnt = __hip_atomic_load((unsigned*)(ws + WS_CTL) + 8, __ATOMIC_RELAXED, __HIP_MEMORY_SCOPE_AGENT);
        if (bx == 0 && tid < 64 && cnt != 0u) args.out[tid] = 10.0f * (float)(1 + (31 - __builtin_clz(cnt))); }
#endif
#undef IN
#undef SEAM
}

extern "C" void kernel_launch(void* const* d_in, const int* in_sizes, int n_in, void* d_out, int out_size, void* d_ws, size_t ws_size, hipStream_t stream) {
    static int grid = 0;
    if (grid == 0) {
        if (n_in != 33 || (size_t)out_size != O_END || ws_size < WS_END) { fprintf(stderr, "kernel_launch: unexpected shapes (n_in %d out %d ws %zu)\n", n_in, out_size, ws_size); grid = -1; return; }
        int dev = 0, cus = 0, per_cu = 0;
        if (hipGetDevice(&dev) != hipSuccess || hipDeviceGetAttribute(&cus, hipDeviceAttributeMultiprocessorCount, dev) != hipSuccess) { grid = -1; return; }
        if (hipFuncSetAttribute((const void*)fwd, hipFuncAttributeMaxDynamicSharedMemorySize, LDS_BYTES) != hipSuccess) { fprintf(stderr, "kernel_launch: hipFuncSetAttribute failed\n"); grid = -1; return; }
        if (hipOccupancyMaxActiveBlocksPerMultiprocessor(&per_cu, (const void*)fwd, NWAVES * 64, LDS_BYTES) != hipSuccess || per_cu < 1) fprintf(stderr, "kernel_launch: occupancy query says %d\n", per_cu);
        (void)hipGetLastError();
        grid = cus;
    }
    if (grid < 0) return;
    (void)hipMemsetAsync((char*)d_ws, 0, ZERO_BYTES, stream);
    Args a{};
    for (int i = 0; i < 33; ++i) a.in[i] = (const float*)d_in[i];
    a.out = (float*)d_out; a.ws = (unsigned char*)d_ws;
#if ONE_LAUNCH
    a.ph_lo = 0; a.ph_hi = N_PHASES;
    hipLaunchKernelGGL(fwd, dim3(grid), dim3(NWAVES * 64), LDS_BYTES, stream, a);
#else
    for (int p = 0; p < N_PHASES; ++p) { a.ph_lo = p; a.ph_hi = p + 1; hipLaunchKernelGGL(fwd, dim3(grid), dim3(NWAVES * 64), LDS_BYTES, stream, a); }
#endif
}
```

```cpp
#include <hip/hip_runtime.h>
#include <cstdio>
#include <cstdint>
#include <cmath>
#define PROBE_PHASE -1
#ifndef PROBE_ATTN
#define PROBE_ATTN 0
#endif
namespace pg8 {
#define PG8_LAS __attribute__((address_space(3)))
typedef unsigned short bf16_t;
typedef short bf16x8 __attribute__((ext_vector_type(8)));
typedef float f32x4 __attribute__((ext_vector_type(4)));
typedef unsigned u32x4 __attribute__((ext_vector_type(4)));
constexpr int BM = 256, BK = 64, HALF = 128, HTB = HALF * BK * 2  , STAGE_BYTES = 8 * HTB, NXCD = 8, WGM = 8;

__host__ __device__ __forceinline__ int lds_byte(int r, int c) { const int st = (r >> 4) * 2 + (c >> 5), rr = r & 15, cc = c & 31, ob = rr * 64 + cc * 2; return st * 1024 + (ob ^ (((ob >> 9) & 1) << 5)); }
__host__ __device__ __forceinline__ void stage_rc(int b, int& R, int& C) { const int st = b / 1024, sb = b % 1024, swz = sb ^ (((sb >> 9) & 1) << 5); R = (st >> 1) * 16 + swz / 64; C = (st & 1) * 32 + (swz % 64) / 2; }
__host__ __device__ __forceinline__ int perm32(int rho) { const int n = rho >> 4, i = rho & 15; return 8 * (i >> 2) + 4 * n + (i & 3); }

struct Unit { int pm, pn; };
struct Gemm { const bf16_t* A; const bf16_t* Bt; int M, N, K; };

struct StaticOrder {
    int nM, nN, nwg, G, c;
    __host__ __device__ void init(int M, int N, int G_, int c_) { nM = M / BM; nN = N / BM; nwg = nM * nN; G = G_; c = c_; }
    __host__ __device__ bool next(int i, Unit& u) const {
        const long L = (long)i * G + c; if (L >= nwg) return false;
        int wgid = (int)L; { const int q = nwg / NXCD, r = nwg % NXCD, xcd = wgid % NXCD, off = wgid / NXCD; wgid = (xcd < r ? xcd * (q + 1) : r * (q + 1) + (xcd - r) * q) + off; }
        const int nig = WGM * nN, gid = wgid / nig, fm = gid * WGM, gsz = (nM - fm) < WGM ? (nM - fm) : WGM;
        u.pm = fm + ((wgid % nig) % gsz); u.pn = (wgid % nig) / gsz; return true;
    }
    __device__ __forceinline__ void a_ready(const Unit&) const {}
    __device__ __forceinline__ void done(const Unit&) const {}
};

typedef float f32x2_cv __attribute__((ext_vector_type(2))); typedef __bf16 bf16x2_cv __attribute__((ext_vector_type(2)));
__device__ __forceinline__ unsigned cvt_pk_bf16(float lo, float hi) { f32x2_cv v = {lo, hi}; bf16x2_cv b = __builtin_convertvector(v, bf16x2_cv); return __builtin_bit_cast(unsigned, b); }
typedef float f32x2 __attribute__((ext_vector_type(2)));

constexpr int ROWS_P = 32768;
__device__ __forceinline__ int mod_row(int r) { return r < ROWS_P ? (r >> 13) : 4 + ((r - ROWS_P) >> 3); }
__device__ __forceinline__ float bf_lo(unsigned w) { return __uint_as_float(w << 16); }
__device__ __forceinline__ float bf_hi(unsigned w) { return __uint_as_float(w & 0xffff0000u); }
__device__ __forceinline__ float sigmoid_f(float x) { return __builtin_amdgcn_rcpf(1.0f + __builtin_amdgcn_exp2f(-1.4426950408889634f * x)); }

struct EpiF32 {
    static constexpr bool PERM = false, AFTER_DRAIN = false;
    float* C; int ldc;
    __device__ __forceinline__ void operator()(const f32x4 (&acc)[2][2][4][2], const Unit& u, int wr, int wc, int fr, int fq) const {
        const int row0 = u.pm * BM + wr * 64 + fr, col0 = u.pn * BM + wc * 32 + 4 * fq;
#pragma unroll
        for (int ai = 0; ai < 2; ++ai)
#pragma unroll
            for (int m = 0; m < 4; ++m) { float* rowp = C + (size_t)(row0 + ai * HALF + m * 16) * ldc + col0;
#pragma unroll
                for (int bj = 0; bj < 2; ++bj)
#pragma unroll
                    for (int n = 0; n < 2; ++n) *(f32x4*)(rowp + bj * HALF + n * 16) = acc[ai][bj][m][n]; }
    }
};
template <bool ADD> struct EpiGate {
    static constexpr bool PERM = true, AFTER_DRAIN = false;
    bf16_t* O; const bf16_t* G; int ldc;
    __device__ __forceinline__ void operator()(const f32x4 (&acc)[2][2][4][2], const Unit& u, int wr, int wc, int fr, int fq) const {
        const int row0 = u.pm * BM + wr * 64 + fr, col0 = u.pn * BM + wc * 32 + 8 * fq;
#pragma unroll
        for (int ai = 0; ai < 2; ++ai)
#pragma unroll
            for (int m = 0; m < 4; ++m) { const size_t ro = (size_t)(row0 + ai * HALF + m * 16) * ldc + col0;
#pragma unroll
                for (int bj = 0; bj < 2; ++bj) {
                    const u32x4 g = *(const u32x4*)(G + ro + bj * HALF);
                    f32x4 v0 = acc[ai][bj][m][0], v1 = acc[ai][bj][m][1];
                    v0[0] *= bf_lo(g.x); v0[1] *= bf_hi(g.x); v0[2] *= bf_lo(g.y); v0[3] *= bf_hi(g.y);
                    v1[0] *= bf_lo(g.z); v1[1] *= bf_hi(g.z); v1[2] *= bf_lo(g.w); v1[3] *= bf_hi(g.w);
                    if (ADD) { const u32x4 t = *(const u32x4*)(O + ro + bj * HALF);
                        v0[0] += bf_lo(t.x); v0[1] += bf_hi(t.x); v0[2] += bf_lo(t.y); v0[3] += bf_hi(t.y);
                        v1[0] += bf_lo(t.z); v1[1] += bf_hi(t.z); v1[2] += bf_lo(t.w); v1[3] += bf_hi(t.w); }
                    u32x4 w; w.x = cvt_pk_bf16(v0[0], v0[1]); w.y = cvt_pk_bf16(v0[2], v0[3]); w.z = cvt_pk_bf16(v1[0], v1[1]); w.w = cvt_pk_bf16(v1[2], v1[3]);
                    *(u32x4*)(O + ro + bj * HALF) = w; } }
    }
};
struct EpiResGate {
    static constexpr bool PERM = true, AFTER_DRAIN = false;
    const float* bp; const float* bs; float* out; const float* modg;
    __device__ __forceinline__ void operator()(const f32x4 (&acc)[2][2][4][2], const Unit& u, int wr, int wc, int fr, int fq) const {
        const int row0 = u.pm * BM + wr * 64 + fr, col0 = u.pn * BM + wc * 32 + 8 * fq;
        const float* g = modg + (size_t)mod_row(u.pm * BM) * 6144 + col0;
        f32x4 gv[2][2];
#pragma unroll
        for (int bj = 0; bj < 2; ++bj)
#pragma unroll
            for (int n = 0; n < 2; ++n) gv[bj][n] = *(const f32x4*)(g + bj * HALF + n * 4);
#pragma unroll
        for (int ai = 0; ai < 2; ++ai)
#pragma unroll
            for (int m = 0; m < 4; ++m) { const int r = row0 + ai * HALF + m * 16;
                const float* b = (r < ROWS_P ? bp + (size_t)r * 1024 : bs + (size_t)(r - ROWS_P) * 1024) + col0; float* o = out + (size_t)r * 1024 + col0;
#pragma unroll
                for (int bj = 0; bj < 2; ++bj)
#pragma unroll
                    for (int n = 0; n < 2; ++n) { const f32x4 bv = *(const f32x4*)(b + bj * HALF + n * 4);
                        *(f32x4*)(o + bj * HALF + n * 4) = bv + gv[bj][n] * acc[ai][bj][m][n]; } }
    }
};
struct EpiSwiGlu {
    static constexpr bool PERM = true, AFTER_DRAIN = false;
    bf16_t* O; int ldo;
    __device__ __forceinline__ void operator()(const f32x4 (&acc)[2][2][4][2], const Unit& u, int wr, int wc, int fr, int fq) const {
        const int row0 = u.pm * BM + wr * 64 + fr, oc0 = u.pn * 128 + wc * 32 + 8 * fq;
#pragma unroll
        for (int ai = 0; ai < 2; ++ai)
#pragma unroll
            for (int m = 0; m < 4; ++m) { bf16_t* rowp = O + (size_t)(row0 + ai * HALF + m * 16) * ldo + oc0; f32x4 a[2];
#pragma unroll
                for (int bj = 0; bj < 2; ++bj) { const f32x4 gt = acc[ai][bj][m][0], up = acc[ai][bj][m][1];
#pragma unroll
                    for (int i = 0; i < 4; ++i) a[bj][i] = gt[i] * sigmoid_f(gt[i]) * up[i]; }
                u32x4 w; w.x = cvt_pk_bf16(a[0][0], a[0][1]); w.y = cvt_pk_bf16(a[0][2], a[0][3]); w.z = cvt_pk_bf16(a[1][0], a[1][1]); w.w = cvt_pk_bf16(a[1][2], a[1][3]);
                *(u32x4*)rowp = w; }
    }
};

struct EpiFront {
    static constexpr bool PERM = true, AFTER_DRAIN = false;
    float* out; unsigned char* ws; const float* qg; const float* kng; const float* rc; const float* rsn;
    size_t o_pck, o_sck, o_pwk, o_swk, o_pconv, o_sconv;
    size_t w_u, w_qp, w_qr, w_gc, w_gn, w_bg, w_ksb, w_vst, w_kwb, w_vwt, w_kwin, w_vwin;
    float c2;
    __device__ __forceinline__ void operator()(const f32x4 (&acc)[2][2][4][2], const Unit& u, int wr, int wc, int fr, int fq) const {
        typedef unsigned u32x2 __attribute__((ext_vector_type(2)));
        const int pn = u.pn;
        const int row0 = u.pm * BM + wr * 64 + fr;
        if (pn < 4) {
            bf16_t* U = (bf16_t*)(ws + w_u);
#pragma unroll
            for (int ai = 0; ai < 2; ++ai)
#pragma unroll
                for (int m = 0; m < 4; ++m) { const int r = row0 + ai * HALF + m * 16; const int t = r & 8191;
#pragma unroll
                    for (int bj = 0; bj < 2; ++bj) { const int ch = 128 * pn + 64 * bj + 16 * wc + 4 * fq; const f32x4 a4 = acc[ai][bj][m][0], b4 = acc[ai][bj][m][1]; f32x4 u4;
#pragma unroll
                        for (int i = 0; i < 4; ++i) u4[i] = a4[i] * sigmoid_f(b4[i]);
                        u32x2 w; w.x = cvt_pk_bf16(u4[0], u4[1]); w.y = cvt_pk_bf16(u4[2], u4[3]); *(u32x2*)(U + (size_t)r * 512 + ch) = w;
                        if (t >= 8162) *(f32x4*)(out + o_pconv + (size_t)((r >> 13) * 30 + t - 8162) * 512 + ch) = u4; } }
        } else if (pn < 9) {
            const bool isq = pn < 6; const int kvt = pn - 6;
            const bool isv = !isq && (wc >= 2); const bool dorope = isq || (!isv && kvt >= 1);
            const float* gp = isq ? qg : kng + kvt * 64;
            f32x4 gn[2][2];
#pragma unroll
            for (int bj = 0; bj < 2; ++bj)
#pragma unroll
                for (int n = 0; n < 2; ++n) gn[bj][n] = isv ? (f32x4){1.f, 1.f, 1.f, 1.f} : *(const f32x4*)(gp + 32 * bj + 8 * fq + 4 * n);
#pragma unroll
            for (int ai = 0; ai < 2; ++ai)
#pragma unroll
                for (int m = 0; m < 4; ++m) { const int r = row0 + ai * HALF + m * 16;
                    f32x4 y[2][2];
#pragma unroll
                    for (int bj = 0; bj < 2; ++bj)
#pragma unroll
                        for (int n = 0; n < 2; ++n) y[bj][n] = acc[ai][bj][m][n];
                    if (!isv) { float ss = 0.f;
#pragma unroll
                        for (int bj = 0; bj < 2; ++bj)
#pragma unroll
                            for (int n = 0; n < 2; ++n) ss += (y[bj][n][0] * y[bj][n][0] + y[bj][n][1] * y[bj][n][1]) + (y[bj][n][2] * y[bj][n][2] + y[bj][n][3] * y[bj][n][3]);
                        ss += __shfl_xor(ss, 16); ss += __shfl_xor(ss, 32);
                        const float rstd = 1.0f / sqrtf(ss * (1.0f / 64.0f) + 1e-6f);
#pragma unroll
                        for (int bj = 0; bj < 2; ++bj)
#pragma unroll
                            for (int n = 0; n < 2; ++n) y[bj][n] = y[bj][n] * rstd * gn[bj][n]; }
                    const int ri = r & 8191;
                    f32x4 yr[2][2];
                    if (dorope) {
#pragma unroll
                        for (int n = 0; n < 2; ++n) { const f32x4 c4 = *(const f32x4*)(rc + (size_t)ri * 32 + 8 * fq + 4 * n), s4 = *(const f32x4*)(rsn + (size_t)ri * 32 + 8 * fq + 4 * n);
                            yr[0][n] = y[0][n] * c4 - y[1][n] * s4; yr[1][n] = y[1][n] * c4 + y[0][n] * s4; } }
                    else {
#pragma unroll
                        for (int n = 0; n < 2; ++n) { yr[0][n] = y[0][n]; yr[1][n] = y[1][n]; } }
                    if (isq) { const int h = 4 * (pn - 4) + wc; bf16_t* qp = (bf16_t*)(ws + w_qp) + (size_t)r * 512 + h * 64 + 8 * fq; bf16_t* qr = (bf16_t*)(ws + w_qr) + (size_t)r * 512 + h * 64 + 8 * fq;
#pragma unroll
                        for (int bj = 0; bj < 2; ++bj) { const f32x4 a0 = y[bj][0] * c2, a1 = y[bj][1] * c2, b0 = yr[bj][0] * c2, b1 = yr[bj][1] * c2; u32x4 w;
                            w.x = cvt_pk_bf16(a0[0], a0[1]); w.y = cvt_pk_bf16(a0[2], a0[3]); w.z = cvt_pk_bf16(a1[0], a1[1]); w.w = cvt_pk_bf16(a1[2], a1[3]); *(u32x4*)(qp + 32 * bj) = w;
                            w.x = cvt_pk_bf16(b0[0], b0[1]); w.y = cvt_pk_bf16(b0[2], b0[3]); w.z = cvt_pk_bf16(b1[0], b1[1]); w.w = cvt_pk_bf16(b1[2], b1[3]); *(u32x4*)(qr + 32 * bj) = w; } }
                    else { const int kvh = wc & 1; const int j = 2 * kvt + (isv ? 1 : 0);
                        const int t = r & 8191;
                        float* fo = nullptr;
                        if (j < 4) fo = out + o_pck + (size_t)j * 4194304 + (size_t)r * 128; else if (t >= 7680) fo = out + o_pwk + (size_t)(j - 4) * 262144 + (size_t)((r >> 13) * 512 + t - 7680) * 128;
                        if (fo) {
#pragma unroll
                            for (int bj = 0; bj < 2; ++bj)
#pragma unroll
                                for (int n = 0; n < 2; ++n) *(f32x4*)(fo + kvh * 64 + 32 * bj + 8 * fq + 4 * n) = yr[bj][n]; }
#if defined(PROBE_ATTN) && PROBE_ATTN
                        if (kvt == 2) { float* kw = (float*)(ws + (isv ? w_vwin : w_kwin)) + (size_t)r * 128 + kvh * 64;
#pragma unroll
                            for (int bj = 0; bj < 2; ++bj)
#pragma unroll
                                for (int n = 0; n < 2; ++n) *(f32x4*)(kw + 32 * bj + 8 * fq + 4 * n) = yr[bj][n]; }
#endif
                        if (kvt >= 1) { const int key = t & 63; const size_t blk = ((size_t)((r >> 13) * 128 + (t >> 6)) * 2 + kvh) * 4096;
                            if (!isv) { bf16_t* kd = (bf16_t*)(ws + (kvt == 1 ? w_ksb : w_kwb)) + blk + key * 64 + 8 * fq;
#pragma unroll
                                for (int bj = 0; bj < 2; ++bj) { u32x4 w; w.x = cvt_pk_bf16(yr[bj][0][0], yr[bj][0][1]); w.y = cvt_pk_bf16(yr[bj][0][2], yr[bj][0][3]); w.z = cvt_pk_bf16(yr[bj][1][0], yr[bj][1][1]); w.w = cvt_pk_bf16(yr[bj][1][2], yr[bj][1][3]);
                                    *(u32x4*)(kd + 32 * bj) = w; } }
                            else { const int kp = (key & 32) | (((key >> 2) & 3) << 3) | (((key >> 4) & 1) << 2) | (key & 3);
                                bf16_t* vd = (bf16_t*)(ws + (kvt == 1 ? w_vst : w_vwt)) + blk + kp;
#pragma unroll
                                for (int bj = 0; bj < 2; ++bj)
#pragma unroll
                                    for (int n = 0; n < 2; ++n)
#pragma unroll
                                        for (int i = 0; i < 4; ++i) { const unsigned b2 = cvt_pk_bf16(y[bj][n][i], 0.f); vd[(size_t)(32 * bj + 8 * fq + 4 * n + i) * 64] = (bf16_t)(b2 & 0xffffu); } } }
                    } }
        } else if (pn < 17) {
            bf16_t* G = (bf16_t*)(ws + (pn < 13 ? w_gc : w_gn)); const int cb = 256 * ((pn - 9) & 3) + 32 * wc + 8 * fq;
#pragma unroll
            for (int ai = 0; ai < 2; ++ai)
#pragma unroll
                for (int m = 0; m < 4; ++m) { const int r = row0 + ai * HALF + m * 16;
#pragma unroll
                    for (int bj = 0; bj < 2; ++bj) { const f32x4 v0 = acc[ai][bj][m][0], v1 = acc[ai][bj][m][1]; u32x4 w;
                        w.x = cvt_pk_bf16(sigmoid_f(v0[0]), sigmoid_f(v0[1])); w.y = cvt_pk_bf16(sigmoid_f(v0[2]), sigmoid_f(v0[3])); w.z = cvt_pk_bf16(sigmoid_f(v1[0]), sigmoid_f(v1[1])); w.w = cvt_pk_bf16(sigmoid_f(v1[2]), sigmoid_f(v1[3]));
                        *(u32x4*)(G + (size_t)r * 1024 + cb + 128 * bj) = w; } }
        } else {
            if (wc == 0 && fq < 3) { float* BG = (float*)(ws + w_bg);
#pragma unroll
                for (int ai = 0; ai < 2; ++ai)
#pragma unroll
                    for (int m = 0; m < 4; ++m) { const int r = row0 + ai * HALF + m * 16;
#pragma unroll
                        for (int n = 0; n < 2; ++n) { const int c = 8 * fq + 4 * n; const f32x4 v = acc[ai][0][m][n]; f32x4 o;
#pragma unroll
                            for (int i = 0; i < 4; ++i) o[i] = sigmoid_f(v[i]);
                            *(f32x4*)(BG + (size_t)r * 24 + c) = o; } } }
        }
    }
};
template <class Epi, class Sched, bool ALIGN_EPI = false, bool SP2 = false>
__device__ __forceinline__ void gemm_phase(PG8_LAS unsigned char* lds, const Gemm g, const Sched& S, const Epi& E) {
    const int tid = threadIdx.x, wid = __builtin_amdgcn_readfirstlane(tid >> 6), lane = tid & 63, wr = wid >> 2, wc = wid & 3, fr = lane & 15, fq = lane >> 4;
    const int K = g.K, nt = K / BK;
    unsigned voffA[2], voffB[2];
#pragma unroll
    for (int i = 0; i < 2; ++i) { int R, C; stage_rc(tid * 16 + i * 8192, R, C); const int Rb = Epi::PERM ? ((R & ~31) + perm32(R & 31)) : R;
        voffA[i] = (unsigned)(R * K + C) * 2u; voffB[i] = (unsigned)(Rb * K + C) * 2u; }
    const size_t kstep = (size_t)(BK * 2);
    const size_t hstep = (size_t)HALF * K * 2;
    const size_t tstep = 2 * hstep;
    const unsigned ldsw = (unsigned)wid * 1024u;
    const int aoff = lds_byte(wr * 64 + fr, fq * 8), boff = lds_byte(wc * 32 + fr, fq * 8);
#define PG8_SA(b, h) (((b) * 2 + (h)) * HTB)
#define PG8_SB(b, h) ((4 + (b) * 2 + (h)) * HTB)
#define PG8_STAGE(bufoff, gbase, voff) do { _Pragma("unroll") for (int _i = 0; _i < 2; ++_i) \
        __builtin_amdgcn_global_load_lds((const unsigned*)((const char*)(gbase) + (voff)[_i]), (PG8_LAS unsigned*)(lds + (bufoff) + ldsw + _i * 8192), 16, 0, 0); } while (0)
#define PG8_LDA(dst, b, h) do { _Pragma("unroll") for (int m = 0; m < 4; ++m) _Pragma("unroll") for (int k = 0; k < 2; ++k) dst[m][k] = *(const PG8_LAS bf16x8*)(lds + PG8_SA(b, h) + aoff + m * 2048 + k * 1024); } while (0)
#define PG8_LDB(dst, b, h) do { _Pragma("unroll") for (int n = 0; n < 2; ++n) _Pragma("unroll") for (int k = 0; k < 2; ++k) dst[n][k] = *(const PG8_LAS bf16x8*)(lds + PG8_SB(b, h) + boff + n * 2048 + k * 1024); } while (0)
#define PG8_MMA(ai, bj, At, Bt) do { __builtin_amdgcn_s_setprio(1); _Pragma("unroll") for (int m = 0; m < 4; ++m) _Pragma("unroll") for (int n = 0; n < 2; ++n) _Pragma("unroll") for (int k = 0; k < 2; ++k) \
        acc[ai][bj][m][n] = __builtin_amdgcn_mfma_f32_16x16x32_bf16(Bt[n][k], At[m][k], acc[ai][bj][m][n], 0, 0, 0); __builtin_amdgcn_s_setprio(0); } while (0)
#define PG8_WAIT_V(n) asm volatile("s_waitcnt vmcnt(" #n ")" ::: "memory")
#define PG8_WAIT_L(n) asm volatile("s_waitcnt lgkmcnt(" #n ")" ::: "memory")
#define PG8_BAR __builtin_amdgcn_s_barrier()
#define PG8_SCHED __builtin_amdgcn_sched_barrier(0)
    Unit cur, nxt; int ui = 0;
    if (!S.next(0, cur)) return;
    f32x4 acc[2][2][4][2];
#pragma unroll
    for (int a = 0; a < 2; ++a)
#pragma unroll
        for (int b = 0; b < 2; ++b)
#pragma unroll
            for (int m = 0; m < 4; ++m)
#pragma unroll
                for (int n = 0; n < 2; ++n) acc[a][b][m][n] = (f32x4){0.f, 0.f, 0.f, 0.f};
    bf16x8 At[4][2], B0[2][2], B1[2][2];
    const char* cA = (const char*)g.A + (size_t)cur.pm * tstep; const char* cB = (const char*)g.Bt + (size_t)cur.pn * tstep;
    S.a_ready(cur);
    if constexpr (SP2) {
        PG8_STAGE(PG8_SB(0, 0), cB, voffB); PG8_STAGE(PG8_SB(0, 1), cB + hstep, voffB); PG8_STAGE(PG8_SA(0, 0), cA, voffA); PG8_STAGE(PG8_SA(0, 1), cA + hstep, voffA);
        if (wr == 1) PG8_BAR;
        PG8_WAIT_V(2); PG8_BAR;
        PG8_STAGE(PG8_SB(1, 0), cB + kstep, voffB); PG8_STAGE(PG8_SA(1, 0), cA + kstep, voffA); PG8_STAGE(PG8_SB(1, 1), cB + hstep + kstep, voffB);
        PG8_WAIT_V(6); PG8_BAR;
    } else {
        PG8_STAGE(PG8_SB(0, 0), cB, voffB); PG8_STAGE(PG8_SA(0, 0), cA, voffA); PG8_STAGE(PG8_SB(0, 1), cB + hstep, voffB); PG8_STAGE(PG8_SA(0, 1), cA + hstep, voffA);
        if (wr == 1) PG8_BAR;
        PG8_WAIT_V(4); PG8_BAR;
        PG8_STAGE(PG8_SB(1, 0), cB + kstep, voffB); PG8_STAGE(PG8_SA(1, 0), cA + kstep, voffA); PG8_STAGE(PG8_SB(1, 1), cB + hstep + kstep, voffB);
        PG8_WAIT_V(6); PG8_BAR;
    }
    for (;;) {
        const bool has_next = S.next(ui + 1, nxt);
        const char* nA = has_next ? (const char*)g.A + (size_t)nxt.pm * tstep : cA; const char* nB = has_next ? (const char*)g.Bt + (size_t)nxt.pn * tstep : cB;
        for (int t = 0; t < nt; t += 2) {
            const bool last = (t == nt - 2);
            const char* a1 = cA + (size_t)(t + 1) * kstep;
            const char* a2 = last ? nA : cA + (size_t)(t + 2) * kstep; const char* b2 = last ? nB : cB + (size_t)(t + 2) * kstep;
            const char* a3 = a2 + kstep; const char* b3 = b2 + kstep;
            if (last && has_next) S.a_ready(nxt);
            if constexpr (SP2) {
            PG8_LDB(B0, 0, 0); PG8_LDB(B1, 0, 1); PG8_SCHED; PG8_LDA(At, 0, 0); PG8_STAGE(PG8_SA(1, 1), a1 + hstep, voffA);
            PG8_WAIT_V(8); PG8_WAIT_L(0); PG8_BAR; PG8_MMA(0, 0, At, B0); PG8_MMA(0, 1, At, B1); PG8_BAR; PG8_SCHED;
            PG8_LDA(At, 0, 1); PG8_STAGE(PG8_SB(0, 0), b2, voffB); PG8_STAGE(PG8_SB(0, 1), b2 + hstep, voffB); PG8_STAGE(PG8_SA(0, 0), a2, voffA);
            PG8_WAIT_V(8); PG8_WAIT_L(0); PG8_BAR; PG8_MMA(1, 0, At, B0); PG8_MMA(1, 1, At, B1); PG8_BAR; PG8_SCHED;
            PG8_LDB(B0, 1, 0); PG8_LDB(B1, 1, 1); PG8_SCHED; PG8_LDA(At, 1, 0); PG8_STAGE(PG8_SA(0, 1), a2 + hstep, voffA);
            PG8_WAIT_V(8); PG8_WAIT_L(0); PG8_BAR; PG8_MMA(0, 0, At, B0); PG8_MMA(0, 1, At, B1); PG8_BAR; PG8_SCHED;
            PG8_LDA(At, 1, 1); PG8_STAGE(PG8_SB(1, 0), b3, voffB); PG8_STAGE(PG8_SB(1, 1), b3 + hstep, voffB); PG8_STAGE(PG8_SA(1, 0), a3, voffA);
            PG8_WAIT_V(8); PG8_WAIT_L(0); PG8_BAR; PG8_MMA(1, 0, At, B0); PG8_MMA(1, 1, At, B1); PG8_BAR; PG8_SCHED;
            } else {
            PG8_LDB(B0, 0, 0); PG8_SCHED; PG8_LDA(At, 0, 0); PG8_STAGE(PG8_SA(1, 1), a1 + hstep, voffA);
            PG8_WAIT_L(8); PG8_BAR; PG8_WAIT_L(0); PG8_MMA(0, 0, At, B0); PG8_BAR; PG8_SCHED;
            PG8_LDB(B1, 0, 1); PG8_STAGE(PG8_SB(0, 0), b2, voffB);
            PG8_BAR; PG8_WAIT_L(0); PG8_MMA(0, 1, At, B1); PG8_BAR;
            PG8_LDA(At, 0, 1); PG8_STAGE(PG8_SA(0, 0), a2, voffA);
            PG8_BAR; PG8_WAIT_L(0); PG8_MMA(1, 0, At, B0); PG8_BAR; PG8_SCHED;
            PG8_STAGE(PG8_SB(0, 1), b2 + hstep, voffB);
            PG8_WAIT_V(6); PG8_BAR; PG8_MMA(1, 1, At, B1); PG8_BAR;
            PG8_LDB(B0, 1, 0); PG8_SCHED; PG8_LDA(At, 1, 0); PG8_STAGE(PG8_SA(0, 1), a2 + hstep, voffA);
            PG8_WAIT_L(8); PG8_BAR; PG8_WAIT_L(0); PG8_MMA(0, 0, At, B0); PG8_BAR; PG8_SCHED;
            PG8_LDB(B1, 1, 1); PG8_STAGE(PG8_SB(1, 0), b3, voffB);
            PG8_BAR; PG8_WAIT_L(0); PG8_MMA(0, 1, At, B1); PG8_BAR;
            PG8_LDA(At, 1, 1); PG8_STAGE(PG8_SA(1, 0), a3, voffA);
            PG8_BAR; PG8_WAIT_L(0); PG8_MMA(1, 0, At, B0); PG8_BAR; PG8_SCHED;
            PG8_STAGE(PG8_SB(1, 1), b3 + hstep, voffB);
            PG8_WAIT_V(6); PG8_BAR; PG8_MMA(1, 1, At, B1); PG8_BAR;
            }
        }
        if constexpr (ALIGN_EPI) { if (wr == 0) PG8_BAR; }
        if constexpr (!Epi::AFTER_DRAIN) { E(acc, cur, wr, wc, fr, fq); S.done(cur); }
        if (!has_next) break;
#pragma unroll
        for (int a = 0; a < 2; ++a)
#pragma unroll
            for (int b = 0; b < 2; ++b)
#pragma unroll
                for (int m = 0; m < 4; ++m)
#pragma unroll
                    for (int n = 0; n < 2; ++n) acc[a][b][m][n] = (f32x4){0.f, 0.f, 0.f, 0.f};
        cur = nxt; cA = nA; cB = nB; ++ui;
        if constexpr (ALIGN_EPI) { if (wr == 1) PG8_BAR; }
    }
    PG8_WAIT_V(0);
    if constexpr (!ALIGN_EPI) { if (wr == 0) PG8_BAR; }
    PG8_BAR;
    if constexpr (Epi::AFTER_DRAIN) { E.fused(acc, cur, wr, wc, fr, fq, lds, wid, lane); S.done(cur); }
#undef PG8_SA
#undef PG8_SB
#undef PG8_STAGE
#undef PG8_LDA
#undef PG8_LDB
#undef PG8_MMA
#undef PG8_WAIT_V
#undef PG8_WAIT_L
#undef PG8_BAR
#undef PG8_SCHED
}
}
#define GAS __attribute__((address_space(1)))
#define LAS __attribute__((address_space(3)))
typedef unsigned short bf16;
typedef unsigned v4u __attribute__((ext_vector_type(4)));
typedef float f32x4 __attribute__((ext_vector_type(4)));
typedef short bf16x8 __attribute__((ext_vector_type(8)));
typedef GAS unsigned gu32;
typedef GAS unsigned long long gu64;
#define RLX_AGENT __ATOMIC_RELAXED, __HIP_MEMORY_SCOPE_AGENT
#define LDS_WAIT() asm volatile("s_waitcnt lgkmcnt(0)" ::: "memory")
#define VM_WAIT() asm volatile("s_waitcnt vmcnt(0)" ::: "memory")
__device__ __forceinline__ unsigned long long rt() { return __builtin_amdgcn_s_memrealtime(); }
__device__ __forceinline__ unsigned f2bf(float f) { unsigned u = __builtin_bit_cast(unsigned, f); return (u + 0x7fffu + ((u >> 16) & 1u)) >> 16; }
__device__ __forceinline__ unsigned pk2(float lo, float hi) { return f2bf(lo) | (f2bf(hi) << 16); }

#define XB_TMO      128
#define XB_XCNT(j)  (256  + 64 * (j))
#define XB_XSUB(j)  (1280 + 64 * (j))
#define XB_XGEN(j)  (2304 + 64 * (j))
#define XB_TOP      3328
#define XB_TOPGEN   3392
#define XCD_BAR_WORDS 3456
#define XB_SPIN_CAP (1u << 18)

__device__ __forceinline__ unsigned xb_ld(unsigned* p)              { return __hip_atomic_load(p, __ATOMIC_RELAXED, __HIP_MEMORY_SCOPE_AGENT); }
__device__ __forceinline__ unsigned xb_add(unsigned* p, unsigned v) { return __hip_atomic_fetch_add(p, v, __ATOMIC_RELAXED, __HIP_MEMORY_SCOPE_AGENT); }
__device__ __forceinline__ unsigned xb_xcc_id() { return (unsigned)__builtin_amdgcn_s_getreg((3 << 11) | 20) & 0xFu; }
#define XB_SPIN(cond, bar) do { unsigned _sp = 0; while (cond) { __builtin_amdgcn_s_sleep(1); \
    if ((++_sp & 255u) == 0u) { if (xb_ld(&(bar)[XB_TMO])) break; if (_sp > XB_SPIN_CAP) { atomicAdd(&(bar)[XB_TMO], 1u); break; } } } } while (0)

struct XcdBarrier {
    unsigned* bar; unsigned x;
    volatile LAS unsigned* st;
};

__device__ __forceinline__ XcdBarrier xcd_barrier_post(unsigned* bar, volatile LAS unsigned* st) {
    XcdBarrier b; b.bar = bar; b.x = xb_xcc_id(); b.st = st;
    if (threadIdx.x == 0) (void)xb_add(&bar[XB_XCNT(b.x)], 1u);
    return b;
}
__device__ __forceinline__ void xcd_barrier_complete(unsigned* bar, unsigned x, unsigned& nloc, unsigned& nx) {
    const unsigned G = gridDim.x * gridDim.y * gridDim.z;
    unsigned sum, cnt, mine, sp = 0u;
    for (;;) {
        sum = 0u; cnt = 0u; mine = 0u;
#pragma unroll
        for (unsigned j = 0; j < 16; ++j) { const unsigned c = xb_ld(&bar[XB_XCNT(j)]); sum += c; cnt += (c > 0u) ? 1u : 0u; mine = (j == x) ? c : mine; }
        if (sum == G) break;
        __builtin_amdgcn_s_sleep(1);
        if ((++sp & 255u) == 0u) { if (xb_ld(&bar[XB_TMO])) break; if (sp > XB_SPIN_CAP) { atomicAdd(&bar[XB_TMO], 1u); break; } }
    }
    nloc = mine > 0u ? mine : 1u; nx = cnt > 0u ? cnt : 1u;
}

__device__ __forceinline__ void xcd_barrier(const XcdBarrier& b) {
    asm volatile("s_waitcnt vmcnt(0)" ::: "memory");
    __syncthreads();
    if (threadIdx.x == 0) {
        unsigned* bar = b.bar;
        __builtin_amdgcn_s_waitcnt(0);
        unsigned nloc = b.st[0], nx = b.st[1];
        if (nloc == 0u) { xcd_barrier_complete(bar, b.x, nloc, nx); b.st[0] = nloc; b.st[1] = nx; }
        const unsigned old = xb_add(&bar[XB_XSUB(b.x)], 1u);
        const unsigned gen = old / nloc;
        if (old + 1u == (gen + 1u) * nloc) {
            __builtin_amdgcn_fence(__ATOMIC_RELEASE, "agent");
            asm volatile("s_waitcnt vmcnt(0)" ::: "memory");
            const unsigned og = xb_add(&bar[XB_TOP], 1u);
            const unsigned tg = og / nx;
            if (og + 1u == (tg + 1u) * nx) xb_add(&bar[XB_TOPGEN], 1u);
            else XB_SPIN(xb_ld(&bar[XB_TOPGEN]) == tg, bar);
            __builtin_amdgcn_fence(__ATOMIC_ACQUIRE, "agent");
            xb_add(&bar[XB_XGEN(b.x)], 1u);
            asm volatile("s_waitcnt vmcnt(0)" ::: "memory");
        } else {
            XB_SPIN(xb_ld(&bar[XB_XGEN(b.x)]) == gen, bar);
            __builtin_amdgcn_fence(__ATOMIC_ACQUIRE, "agent");
            asm volatile("s_waitcnt vmcnt(0)" ::: "memory");
        }
    }
    __syncthreads();
}

constexpr int NWAVES = 8;
constexpr int MP = 32768, MS = 256, MT = MP + MS;
constexpr int DM = 1024, DIN = 4376, DINP = 4608, DFF = 2816, DCONV = 512, QW = 512;
constexpr int OFF_Q = 1024, OFF_KV = 1536, OFF_NG = 2304, OFF_MG = 2328;
constexpr int NSEQ = 36;
constexpr float EPS = 1e-6f;
constexpr size_t O_YP = 0, O_YS = 33554432, O_PCK = 33816576, O_PCV = O_PCK + 4194304, O_PSK = O_PCV + 4194304, O_PSV = O_PSK + 4194304,
                 O_PWK = O_PSV + 4194304, O_PWV = O_PWK + 262144, O_PCONV = O_PWV + 262144, O_SCK = O_PCONV + 61440, O_SCV = O_SCK + 32768,
                 O_SSK = O_SCV + 32768, O_SSV = O_SSK + 32768, O_SWK = O_SSV + 32768, O_SWV = O_SWK + 2097152, O_SCONV = O_SWV + 2097152, O_END = O_SCONV + 491520;
constexpr size_t MiB = 1u << 20;
constexpr size_t WS_CTL = 0, WS_MOD = 1 * MiB, ZERO_BYTES = 2 * MiB;
constexpr size_t WS_ROPE = 2 * MiB;
constexpr size_t WS_WIN = 5 * MiB, WS_WPW2 = 14 * MiB, WS_WNSA = 15 * MiB, WS_WOUT = 16 * MiB, WS_WGU = 18 * MiB, WS_WDOWN = 29 * MiB;
constexpr size_t WS_KC = 36 * MiB, WS_VC = 41 * MiB, WS_BG = 46 * MiB, WS_H = 50 * MiB, WS_U = 115 * MiB, WS_QP = 148 * MiB, WS_QR = 181 * MiB,
                 WS_CACT = 214 * MiB, WS_O = 247 * MiB, WS_GC = 280 * MiB, WS_GN = 345 * MiB, WS_T1 = 410 * MiB, WS_KWIN = 475 * MiB, WS_VWIN = 491 * MiB,
                 WS_ACT = 507 * MiB, WS_Z = 685 * MiB, WS_OC = WS_Z  , WS_ZS = 760 * MiB  ,
                 WS_KSB = 1268 * MiB, WS_VST = 1276 * MiB, WS_KWB = 1284 * MiB, WS_VWT = 1292 * MiB, WS_KCB = 1300 * MiB, WS_VCT = 1301 * MiB, WS_END = 1302 * MiB;
constexpr float C2 = 0.125f * 1.4426950408889634f;
constexpr int ROPE_N = 8200;
constexpr int CW_BAR = 4096;
constexpr int RING_BYTES = 131072, LDS_BYTES = 163840, MISC_OFF = LDS_BYTES - 256;

typedef unsigned v2u __attribute__((ext_vector_type(2)));
typedef float f32x2 __attribute__((ext_vector_type(2)));
__device__ __forceinline__ float bf2f(unsigned short b) { return __uint_as_float(((unsigned)b) << 16); }
__device__ __forceinline__ float wave_sum(float v) {
#pragma unroll
    for (int o = 1; o < 64; o <<= 1) v += __shfl_xor(v, o);
    return v;
}
__device__ __forceinline__ float wave_max(float v) {
#pragma unroll
    for (int o = 1; o < 64; o <<= 1) v = fmaxf(v, __shfl_xor(v, o));
    return v;
}
__device__ __forceinline__ unsigned dpp_x1(unsigned v) { return (unsigned)__builtin_amdgcn_update_dpp(0, (int)v, 0xB1, 0xF, 0xF, false); }
__device__ __forceinline__ unsigned dpp_x2(unsigned v) { return (unsigned)__builtin_amdgcn_update_dpp(0, (int)v, 0x4E, 0xF, 0xF, false); }
__device__ __forceinline__ unsigned umax_x16(unsigned v) { auto r = __builtin_amdgcn_permlane16_swap(v, v, false, false); return r[0] > r[1] ? r[0] : r[1]; }
__device__ __forceinline__ unsigned umax_x32(unsigned v) { auto r = __builtin_amdgcn_permlane32_swap(v, v, false, false); return r[0] > r[1] ? r[0] : r[1]; }
__device__ __forceinline__ float fsum_x16(float v) { auto r = __builtin_amdgcn_permlane16_swap(__float_as_uint(v), __float_as_uint(v), false, false); return __uint_as_float(r[0]) + __uint_as_float(r[1]); }
__device__ __forceinline__ float fsum_x32(float v) { auto r = __builtin_amdgcn_permlane32_swap(__float_as_uint(v), __float_as_uint(v), false, false); return __uint_as_float(r[0]) + __uint_as_float(r[1]); }
__device__ __forceinline__ float fmax_x16(float v) { auto r = __builtin_amdgcn_permlane16_swap(__float_as_uint(v), __float_as_uint(v), false, false); return fmaxf(__uint_as_float(r[0]), __uint_as_float(r[1])); }
__device__ __forceinline__ float fmax_x32(float v) { auto r = __builtin_amdgcn_permlane32_swap(__float_as_uint(v), __float_as_uint(v), false, false); return fmaxf(__uint_as_float(r[0]), __uint_as_float(r[1])); }
__device__ __forceinline__ float dpp_x1f(float v) { return __uint_as_float(dpp_x1(__float_as_uint(v))); }
__device__ __forceinline__ float dpp_x2f(float v) { return __uint_as_float(dpp_x2(__float_as_uint(v))); }
__device__ __forceinline__ unsigned dpp_x4(unsigned v) { const int t = __builtin_amdgcn_update_dpp(0, (int)v, 0x141, 0xF, 0xF, false); return (unsigned)__builtin_amdgcn_update_dpp(0, t, 0x1B, 0xF, 0xF, false); }
__device__ __forceinline__ unsigned dpp_x8(unsigned v) { const int t = __builtin_amdgcn_update_dpp(0, (int)v, 0x140, 0xF, 0xF, false); return (unsigned)__builtin_amdgcn_update_dpp(0, t, 0x141, 0xF, 0xF, false); }
__device__ __forceinline__ float sigm(float x) { return 1.0f / (1.0f + __expf(-x)); }
__device__ __forceinline__ int mrow(int r) { return r < MP ? (r >> 13) : 4 + ((r - MP) >> 3); }
__device__ __forceinline__ int rope_idx(int r) { return r < MP ? (r & 8191) : 8192 + ((r - MP) & 7); }
__device__ __forceinline__ int perm64(int u) { return (u & 32) | (((u >> 2) & 3) << 3) | (((u >> 4) & 1) << 2) | (u & 3); }
__device__ __forceinline__ int perm128(int u) { return (u & ~31) | (((u >> 2) & 3) << 3) | (((u >> 4) & 1) << 2) | (u & 3); }
__device__ __forceinline__ size_t kc_off(int s) { return s < 4 ? (size_t)s * 128 * 128 : (size_t)4 * 128 * 128 + (size_t)(s - 4) * 257 * 128; }

struct Args { const float* in[33]; float* out; unsigned char* ws; int ph_lo, ph_hi; };

__device__ __forceinline__ int front_rowmap(int n) {
    if (n < 1024) { const int nn = n >= 512 ? 1 : 0, ch = n & 511; return 256 * (ch >> 7) + 128 * ((ch >> 6) & 1) + 32 * ((ch >> 4) & 3) + 8 * ((ch >> 2) & 3) + 4 * nn + (ch & 3); }
    if (n < OFF_KV) { const int hd = n - OFF_Q, h = hd >> 6, d = hd & 63; return 256 * (4 + (h >> 2)) + 128 * (d >> 5) + 32 * (h & 3) + (d & 31); }
    if (n < OFF_NG) { const int x = n - OFF_KV, j = x >> 7, kvh = (x >> 6) & 1, d = x & 63; return 256 * (6 + (j >> 1)) + 128 * (d >> 5) + 32 * ((j & 1) * 2 + kvh) + (d & 31); }
    if (n < OFF_MG) return 256 * 17 + (n - OFF_NG);
    return 256 * 9 + (n - OFF_MG);
}
__device__ __forceinline__ int gu_rowmap(int j) { const int rem = j & 127; return 256 * (j >> 7) + 128 * ((rem >> 2) & 1) + 32 * (rem >> 5) + 8 * ((rem >> 3) & 3) + (rem & 3); }
template <int MODE> __device__ __forceinline__ int rowmap(int n) { return MODE == 0 ? n : (MODE == 1 ? gu_rowmap(n) : (MODE == 2 ? gu_rowmap(n) + 4 : front_rowmap(n))); }
template <int MODE> __device__ __forceinline__ void transpose_item(const float* W, int K, int N, bf16* WT, LAS float* scr, int item, int lane) {
    const int nblk = (N + 31) / 32, kb = item / nblk, nb = item % nblk, k0 = 64 * kb, n0 = 32 * nb;
    const int nn = n0 + (lane & 31);
    float tv[32];
#pragma unroll
    for (int i = 0; i < 32; ++i) { const int kk = 2 * i + (lane >> 5); tv[i] = W[(size_t)(k0 + kk) * N + (nn < N ? nn : N - 1)]; }
#pragma unroll
    for (int i = 0; i < 32; ++i) { const int kk = 2 * i + (lane >> 5); scr[kk * 33 + (lane & 31)] = (nn < N) ? tv[i] : 0.f; }
    LDS_WAIT(); asm volatile("" ::: "memory");
    const int c = lane & 7;
#pragma unroll
    for (int j = 0; j < 4; ++j) { const int nl = (lane >> 3) + 8 * j, n = n0 + nl; const LAS float* s = scr + (8 * c) * 33 + nl;
        v4u o; o.x = pk2(s[0 * 33], s[1 * 33]); o.y = pk2(s[2 * 33], s[3 * 33]); o.z = pk2(s[4 * 33], s[5 * 33]); o.w = pk2(s[6 * 33], s[7 * 33]);
        if (n < N) *(v4u*)(WT + (size_t)rowmap<MODE>(n) * K + k0 + 8 * c) = o; }
    LDS_WAIT(); asm volatile("" ::: "memory");
}
__device__ __forceinline__ f32x2 compress_block(const float* rows, int nvalid, const float* pm, const float* w, float* outp, LAS float* scr, int lane) {
    const int c4 = 4 * (lane & 31), half = lane >> 5, d = c4 & 63, nh = nvalid >> 1;
    f32x4 acc = {0.f, 0.f, 0.f, 0.f};
    for (int i0 = 0; i0 < nh; i0 += 8) {
        f32x4 x[8], m[8];
#pragma unroll
        for (int q = 0; q < 8; ++q) { const bool ok = i0 + q < nh; const int j = 2 * (ok ? i0 + q : 0) + half;
            x[q] = *(const f32x4*)(rows + (size_t)j * 128 + c4); m[q] = *(const f32x4*)(pm + j * 64 + d); if (!ok) x[q] = (f32x4){0.f, 0.f, 0.f, 0.f}; }
#pragma unroll
        for (int q = 0; q < 8; ++q) acc += x[q] * (m[q] + 1.0f);
    }
#pragma unroll
    for (int i = 0; i < 4; ++i) acc[i] += __shfl_xor(acc[i], 32);
    if (lane < 32) *(LAS f32x4*)(scr + c4) = acc * (1.0f / 64.0f);
    LDS_WAIT(); asm volatile("" ::: "memory");
    const int kvh = lane >> 5, e = 2 * (lane & 31);
    f32x2 o = {0.f, 0.f};
#pragma unroll 8
    for (int dd = 0; dd < 64; ++dd) { const float sv = scr[kvh * 64 + dd]; const f32x2 ww = *(const f32x2*)(w + dd * 64 + e); o.x += sv * ww.x; o.y += sv * ww.y; }
    *(f32x2*)(outp + kvh * 64 + e) = o;
    LDS_WAIT(); asm volatile("" ::: "memory");
    return o;
}
__device__ __forceinline__ void compress_page(const float* src, const LAS float* pml, const LAS float* wl, float* dst, LAS float* scr, int lane) {
    const int c4 = 4 * (lane & 31), half = lane >> 5, d = c4 & 63;
    const f32x4* s4 = (const f32x4*)(src + (size_t)half * 128 + c4);
    f32x4 xa[16], xb[16];
#pragma unroll
    for (int q = 0; q < 16; ++q) xa[q] = s4[(size_t)q * 64];
#pragma unroll
    for (int q = 0; q < 16; ++q) xb[q] = s4[(size_t)(16 + q) * 64];
    auto consume = [&](const f32x4 (&x)[16], const int i0, f32x4 acc) __attribute__((always_inline)) {
#pragma unroll
        for (int q = 0; q < 16; ++q) { const int j = 2 * (i0 + q) + half; const f32x4 m = *(const LAS f32x4*)(pml + j * 64 + d); acc += x[q] * (m + 1.0f); }
        return acc; };
    auto finish = [&](f32x4 acc, float* outp) __attribute__((always_inline)) {
#pragma unroll
        for (int i = 0; i < 4; ++i) acc[i] = fsum_x32(acc[i]);
        if (lane < 32) *(LAS f32x4*)(scr + c4) = acc * (1.0f / 64.0f);
        LDS_WAIT(); asm volatile("" ::: "memory");
        const int kvh = lane >> 5, e = 2 * (lane & 31);
        f32x2 o = {0.f, 0.f};
#pragma unroll 16
        for (int dd = 0; dd < 64; ++dd) { const float sv = scr[kvh * 64 + dd]; const f32x2 ww = *(const LAS f32x2*)(wl + dd * 64 + e); o.x += sv * ww.x; o.y += sv * ww.y; }
        *(f32x2*)(outp + kvh * 64 + e) = o;
        LDS_WAIT(); asm volatile("" ::: "memory"); };
    f32x4 acc = {0.f, 0.f, 0.f, 0.f};
    acc = consume(xa, 0, acc);
#pragma unroll
    for (int q = 0; q < 16; ++q) xa[q] = s4[(size_t)(32 + q) * 64];
    acc = consume(xb, 16, acc);
#pragma unroll
    for (int q = 0; q < 16; ++q) xb[q] = s4[(size_t)(48 + q) * 64];
    finish(acc, dst);
    acc = (f32x4){0.f, 0.f, 0.f, 0.f};
    acc = consume(xa, 0, acc); acc = consume(xb, 16, acc);
    finish(acc, dst + 128);
}
__device__ __forceinline__ void phase0(const Args& a, LAS unsigned char* lds, int gw, int NGW, int wave, int lane_) {
    int lane = lane_;
    unsigned char* ws = a.ws;
    LAS float* scr = (LAS float*)(lds + wave * 10240);
    LAS float* tabs = (LAS float*)(lds + 81920);
    { const int t = wave * 64 + lane; const f32x4* g0 = (const f32x4*)a.in[23]; const f32x4* g1 = (const f32x4*)a.in[25]; const f32x4* g2 = (const f32x4*)a.in[24]; const f32x4* g3 = (const f32x4*)a.in[26];
      for (int i = t; i < 1024; i += NWAVES * 64) { ((LAS f32x4*)tabs)[i] = g0[i]; ((LAS f32x4*)tabs)[1024 + i] = g1[i]; ((LAS f32x4*)tabs)[2048 + i] = g2[i]; ((LAS f32x4*)tabs)[3072 + i] = g3[i]; } }
    __syncthreads();
    constexpr int I_IN = 16 * 137, I_PW2 = 8 * 32, I_NSA = 8 * 32, I_OUT = 16 * 32, I_G = 16 * 88, I_U = 16 * 88, I_D = 44 * 32;
    constexpr int N_TR = I_IN + I_PW2 + I_NSA + I_OUT + I_G + I_U + I_D;
    constexpr int N_MOD = 96 * 16;
    constexpr int N_CMP = 32 * 128 * 2;
    constexpr int N_ALL = N_TR + N_MOD + N_CMP; static_assert(N_ALL % 2 == 0 && N_ALL % 29 == 0 && N_ALL % 37 == 0 && N_ALL == 17168, "4099 must stay coprime to N_ALL");
    constexpr int N_LIGHT = N_TR + N_MOD;
    int il = gw, ic = gw; bool turn = (gw & 1) != 0;
#pragma nounroll
    while (il < N_LIGHT || ic < N_CMP) {
        int r; asm volatile("" : "+v"(lane));
        if ((turn && il < N_LIGHT) || ic >= N_CMP) { r = il; il += NGW; } else { r = N_LIGHT + ic; ic += NGW; }
        turn = !turn;
        if (r < N_TR) {
            if (r < I_IN) { transpose_item<3>(a.in[15], 1024, DIN, (bf16*)(ws + WS_WIN), scr, r, lane); continue; } r -= I_IN;
            if (r < I_PW2) { transpose_item<0>(a.in[22], 512, 1024, (bf16*)(ws + WS_WPW2), scr, r, lane); continue; } r -= I_PW2;
            if (r < I_NSA) { transpose_item<0>(a.in[27], 512, 1024, (bf16*)(ws + WS_WNSA), scr, r, lane); continue; } r -= I_NSA;
            if (r < I_OUT) { transpose_item<0>(a.in[28], 1024, 1024, (bf16*)(ws + WS_WOUT), scr, r, lane); continue; } r -= I_OUT;
            if (r < I_G) { transpose_item<1>(a.in[30], 1024, DFF, (bf16*)(ws + WS_WGU), scr, r, lane); continue; } r -= I_G;
            if (r < I_U) { transpose_item<2>(a.in[31], 1024, DFF, (bf16*)(ws + WS_WGU), scr, r, lane); continue; } r -= I_U;
            transpose_item<0>(a.in[32], DFF, 1024, (bf16*)(ws + WS_WDOWN), scr, r, lane); continue;
        }
        r -= N_TR;
        if (r < N_MOD) {
            const int cb = r % 96, kb = r / 96, j = cb * 64 + lane, k0 = kb * 64;
            for (int mb = 0; mb < NSEQ; ++mb) { const float* cp = mb < 4 ? a.in[10] + mb * 1024 : a.in[11] + (mb - 4) * 1024; const float cv = cp[k0 + lane]; scr[mb * 64 + lane] = cv * sigm(cv); }
            LDS_WAIT(); asm volatile("" ::: "memory");
            float acc[NSEQ];
#pragma unroll
            for (int mb = 0; mb < NSEQ; ++mb) acc[mb] = 0.f;
            const float* wp = a.in[12] + (size_t)k0 * 6144 + j;
#pragma unroll 4
            for (int k4 = 0; k4 < 16; ++k4) {
                const float w0 = wp[(size_t)(4 * k4 + 0) * 6144], w1 = wp[(size_t)(4 * k4 + 1) * 6144], w2 = wp[(size_t)(4 * k4 + 2) * 6144], w3 = wp[(size_t)(4 * k4 + 3) * 6144];
#pragma unroll
                for (int mb = 0; mb < NSEQ; ++mb) { const f32x4 q = *(const LAS f32x4*)(scr + mb * 64 + 4 * k4); acc[mb] += q.x * w0 + q.y * w1 + q.z * w2 + q.w * w3; }
            }
            float* modp = (float*)(ws + WS_MOD);
            const float bias = (kb == 0) ? a.in[13][j] : 0.f;
#pragma unroll
            for (int mb = 0; mb < NSEQ; ++mb) atomicAdd(modp + mb * 6144 + j, acc[mb] + bias);
            LDS_WAIT(); asm volatile("" ::: "memory");
            continue;
        }
        r -= N_MOD;
        {
            const int kv = r & 1, pg = (r >> 1) & 127, sb = r >> 8;
            const int page = ((const int*)a.in[9])[sb * 128 + pg];
            const float* src = (kv ? a.in[3] : a.in[2]) + (size_t)page * (128 * 128);
            float* dst = (float*)(ws + (kv ? WS_VC : WS_KC)) + kc_off(4 + sb) + (size_t)(2 * pg) * 128;
            compress_page(src, tabs + (kv ? 4096 : 0), tabs + (kv ? 12288 : 8192), dst, scr, lane);
        }
    }
    const int gt = gw * 64 + lane, NT = NGW * 64;
    { v4u* p = (v4u*)((bf16*)(ws + WS_WIN) + (size_t)DIN * 1024); const int n16 = (DINP - DIN) * 1024 * 2 / 16; const v4u z = {0u, 0u, 0u, 0u}; for (int i = gt; i < n16; i += NT) p[i] = z; }
    { float* rc = (float*)(ws + WS_ROPE); float* rs = rc + ROPE_N * 32;
      for (int i = gt; i < ROPE_N * 32; i += NT) {
          const int j = i & 31, p = i >> 5; const int pos = p < 8192 ? p : 16384 + (p - 8192);
          double inv = 1.0; for (int q = 0; q < j; ++q) inv *= 0.7498942093324558;
          const double ang = (double)pos * inv;
          const double kq = __builtin_rint(ang * 0.6366197723675814);
          double rr = __builtin_fma(-kq, 1.5707963267948966, ang); rr = __builtin_fma(-kq, 6.123233995736766e-17, rr);
          const double r2 = rr * rr;
          const double sn = rr * (1.0 + r2 * (-1.0 / 6 + r2 * (1.0 / 120 + r2 * (-1.0 / 5040 + r2 * (1.0 / 362880 + r2 * (-1.0 / 39916800 + r2 * (1.0 / 6227020800.0)))))));
          const double cs = 1.0 + r2 * (-0.5 + r2 * (1.0 / 24 + r2 * (-1.0 / 720 + r2 * (1.0 / 40320 + r2 * (-1.0 / 3628800 + r2 * (1.0 / 479001600.0))))));
          const int qd = ((int)(long long)kq) & 3;
          const double c = (qd == 0) ? cs : (qd == 1) ? -sn : (qd == 2) ? -cs : sn;
          const double s = (qd == 0) ? sn : (qd == 1) ? cs : (qd == 2) ? -sn : -cs;
          rc[i] = (float)c; rs[i] = (float)s; } }
    { const int per = 504 * 128 / 4, n4 = 32 * per;
      for (int i = gt; i < 2 * n4; i += NT) { const int kv = i >= n4, ii = kv ? i - n4 : i, sb = ii / per, o = ii % per;
          const f32x4 v = ((const f32x4*)((kv ? a.in[7] : a.in[6]) + (size_t)sb * 512 * 128 + 8 * 128))[o];
          ((f32x4*)(a.out + (kv ? O_SWV : O_SWK) + (size_t)sb * 512 * 128))[o] = v; } }
    { const int per = 22 * 512 / 4, n4 = 32 * per;
      for (int i = gt; i < n4; i += NT) { const int sb = i / per, o = i % per;
          ((f32x4*)(a.out + O_SCONV + (size_t)sb * 30 * 512))[o] = ((const f32x4*)(a.in[8] + (size_t)sb * 30 * 512 + 8 * 512))[o]; } }
}

__device__ __forceinline__ void norm_rows(const float* xp, const float* xs, const float* g, const float* modp, int sh_off, int sc_off, bf16* H, int gw, int NGW, int lane) {
    for (int r = gw; r < MT; r += NGW) {
        const f32x4* xr = (const f32x4*)(r < MP ? xp + (size_t)r * 1024 : xs + (size_t)(r - MP) * 1024) + lane;
        const float* mp = modp + (size_t)mrow(r) * 6144;
        f32x4 v[4]; float ss = 0.f;
#pragma unroll
        for (int j = 0; j < 4; ++j) { v[j] = xr[64 * j]; ss += (v[j].x * v[j].x + v[j].y * v[j].y) + (v[j].z * v[j].z + v[j].w * v[j].w); }
        const float rstd = 1.0f / sqrtf(wave_sum(ss) * (1.0f / 1024.0f) + EPS);
        v2u* o8 = (v2u*)(H + (size_t)r * 1024) + lane;
#pragma unroll
        for (int j = 0; j < 4; ++j) { const int c = 4 * (lane + 64 * j);
            const f32x4 gg = *(const f32x4*)(g + c), sc = *(const f32x4*)(mp + sc_off + c), sh = *(const f32x4*)(mp + sh_off + c);
            const f32x4 h = (v[j] * rstd * gg) * (1.0f + sc) + sh;
            v2u w; w.x = pk2(h.x, h.y); w.y = pk2(h.z, h.w); o8[64 * j] = w; }
    }
}

__device__ __forceinline__ void unpack8(const v4u p, float (&x)[8]) { x[0] = pg8::bf_lo(p.x); x[1] = pg8::bf_hi(p.x); x[2] = pg8::bf_lo(p.y); x[3] = pg8::bf_hi(p.y); x[4] = pg8::bf_lo(p.z); x[5] = pg8::bf_hi(p.z); x[6] = pg8::bf_lo(p.w); x[7] = pg8::bf_hi(p.w); }
__device__ __forceinline__ void phase_conv(const Args& a, LAS unsigned char* lds, int vcu, int G, int gw, int NGW, int wave, int lane, int tid) {
    unsigned char* ws = a.ws;
    constexpr int TAPB = 31 * 512 * 4;
    { LAS f32x4* wl4 = (LAS f32x4*)lds; const f32x4* wg4 = (const f32x4*)a.in[18]; for (int i = tid; i < 31 * 512 / 4; i += NWAVES * 64) wl4[i] = wg4[i]; }
    const LAS float* wl = (const LAS float*)lds; LAS unsigned char* rl = lds + TAPB;
    const bf16* U = (const bf16*)(ws + WS_U); bf16* CACT = (bf16*)(ws + WS_CACT);
    const int c0 = lane * 8;
#pragma nounroll
    for (int tile = vcu; tile < 1024 + 32; tile += G) {
        const bool smp = tile >= 1024; const int sb = tile - 1024, r0 = smp ? MP + 8 * sb : 32 * tile, t0 = r0 & 8191, ntok = smp ? 8 : 32, nrows = ntok + 30;
        __syncthreads();
        for (int q = tid; q < nrows * 64; q += NWAVES * 64) { const int k = q >> 6, cc = (q & 63) * 8; v4u v = {0u, 0u, 0u, 0u};
            if (smp) { if (k < 30) { const float* sp = a.in[8] + (size_t)(sb * 30 + k) * 512 + cc; const f32x4 p0 = *(const f32x4*)sp, p1 = *(const f32x4*)(sp + 4);
                           v.x = pk2(p0.x, p0.y); v.y = pk2(p0.z, p0.w); v.z = pk2(p1.x, p1.y); v.w = pk2(p1.z, p1.w); }
                       else v = *(const v4u*)(U + (size_t)(r0 + k - 30) * 512 + cc); }
            else if (t0 - 30 + k >= 0) v = *(const v4u*)(U + (size_t)(r0 - 30 + k) * 512 + cc);
            *(LAS v4u*)(rl + k * 1024 + (q & 63) * 16) = v; }
        __syncthreads();
        if (4 * wave < ntok) {
            float acc[4][8];
            { const f32x4 b0 = *(const f32x4*)(a.in[19] + c0), b1 = *(const f32x4*)(a.in[19] + c0 + 4);
#pragma unroll
              for (int tt = 0; tt < 4; ++tt) { acc[tt][0] = b0.x; acc[tt][1] = b0.y; acc[tt][2] = b0.z; acc[tt][3] = b0.w; acc[tt][4] = b1.x; acc[tt][5] = b1.y; acc[tt][6] = b1.z; acc[tt][7] = b1.w; } }
            const LAS unsigned char* rw = rl + (4 * wave) * 1024 + lane * 16;
#pragma unroll 2
            for (int j = 0; j < 31; ++j) {
                const f32x4 w0 = *(const LAS f32x4*)(wl + j * 512 + c0), w1 = *(const LAS f32x4*)(wl + j * 512 + c0 + 4);
#pragma unroll
                for (int tt = 0; tt < 4; ++tt) { float x[8]; unpack8(*(const LAS v4u*)(rw + (tt + j) * 1024), x);
                    acc[tt][0] += x[0] * w0.x; acc[tt][1] += x[1] * w0.y; acc[tt][2] += x[2] * w0.z; acc[tt][3] += x[3] * w0.w; acc[tt][4] += x[4] * w1.x; acc[tt][5] += x[5] * w1.y; acc[tt][6] += x[6] * w1.z; acc[tt][7] += x[7] * w1.w; }
            }
            const f32x4 g0 = *(const f32x4*)(a.in[20] + c0), g1 = *(const f32x4*)(a.in[20] + c0 + 4), e0 = *(const f32x4*)(a.in[21] + c0), e1 = *(const f32x4*)(a.in[21] + c0 + 4);
            const float lg[8] = {g0.x, g0.y, g0.z, g0.w, g1.x, g1.y, g1.z, g1.w}, lb[8] = {e0.x, e0.y, e0.z, e0.w, e1.x, e1.y, e1.z, e1.w};
#pragma unroll
            for (int tt = 0; tt < 4; ++tt) {
                float sm = 0.f;
#pragma unroll
                for (int i = 0; i < 8; ++i) sm += acc[tt][i];
                const float mean = wave_sum(sm) * (1.0f / 512.0f); float q = 0.f;
#pragma unroll
                for (int i = 0; i < 8; ++i) { acc[tt][i] -= mean; q += acc[tt][i] * acc[tt][i]; }
                const float rstd = 1.0f / sqrtf(wave_sum(q) * (1.0f / 512.0f) + EPS);
                float y[8];
#pragma unroll
                for (int i = 0; i < 8; ++i) { const float v = acc[tt][i] * rstd * lg[i] + lb[i]; y[i] = v * sigm(v); }
                v4u o; o.x = pk2(y[0], y[1]); o.y = pk2(y[2], y[3]); o.z = pk2(y[4], y[5]); o.w = pk2(y[6], y[7]);
                *(v4u*)(CACT + (size_t)(r0 + 4 * wave + tt) * 512 + c0) = o;
            }
        }
    }
    __syncthreads();
    LAS float* scr = (LAS float*)(lds + wave * 16384);
    for (int it = gw; it < 1024 + 64; it += NGW) {
        if (it < 1024) { const int kv = it & 1, n = (it >> 1) & 127, b = it >> 8;
            const float* rows = a.out + (kv ? O_PCV : O_PCK) + (size_t)(b * 8192 + 64 * n) * 128;
            float* dst = (float*)(ws + (kv ? WS_VC : WS_KC)) + kc_off(b) + (size_t)n * 128;
            const f32x2 o = compress_block(rows, 64, kv ? a.in[25] : a.in[23], kv ? a.in[26] : a.in[24], dst, scr, lane);
            const int kvh = lane >> 5, e = 2 * (lane & 31);
            if (!kv) { *(unsigned*)((bf16*)(ws + WS_KCB) + ((size_t)(b * 2 + kvh) * 128 + n) * 64 + e) = pk2(o.x, o.y); }
            else { bf16* vt = (bf16*)(ws + WS_VCT) + (size_t)(b * 2 + kvh) * 64 * 128 + perm128(n); vt[(size_t)e * 128] = (bf16)f2bf(o.x); vt[(size_t)(e + 1) * 128] = (bf16)f2bf(o.y); } }
        else { const int i2 = it - 1024, kv = i2 & 1, sb = i2 >> 1;
            const float* rows = a.out + (kv ? O_SCV : O_SCK) + (size_t)(sb * 8) * 128;
            float* dst = (float*)(ws + (kv ? WS_VC : WS_KC)) + kc_off(4 + sb) + (size_t)256 * 128;
            compress_block(rows, 8, kv ? a.in[25] : a.in[23], kv ? a.in[26] : a.in[24], dst, scr, lane); }
    }
}

template <int MODE> __device__ __forceinline__ void attn_item(const Args& a, int r, int kvh, LAS unsigned char* ldsb, int wave, int lane) {
    unsigned char* ws = a.ws; float* out = a.out;
    LAS float* scr = (LAS float*)(ldsb + wave * 16384);
    const bool smp = r >= MP; const int rs_ = r - MP, sb = rs_ >> 3, si = rs_ & 7, b = r >> 13;
    const int seq = smp ? 4 + sb : b, qpos = smp ? 16384 + si : (r & 8191), cur = qpos >> 6, NB = smp ? 257 : 128;
    LAS float* s_qp = scr;
    LAS float* s_qr = scr + 256;
    LAS float* s_p = scr + 512;
    const bf16* QP = (const bf16*)(ws + WS_QP) + (size_t)r * 512 + kvh * 256; const bf16* QR = (const bf16*)(ws + WS_QR) + (size_t)r * 512 + kvh * 256;
    float qn2[4];
#pragma unroll
    for (int g = 0; g < 4; ++g) { const float x = bf2f(QP[g * 64 + lane]), y = bf2f(QR[g * 64 + lane]); s_qp[lane * 4 + g] = x; s_qr[lane * 4 + g] = y; qn2[g] = wave_sum(y * y); }
    const float gks = wave_max(fabsf(a.in[17][64 + lane])), gkw = wave_max(fabsf(a.in[17][128 + lane]));
    float mref_s[4], mref_w[4];
#pragma unroll
    for (int g = 0; g < 4; ++g) { const float qn = sqrtf(qn2[g]) * 8.0f; mref_s[g] = qn * gks; mref_w[g] = qn * gkw; }
    LDS_WAIT(); asm volatile("" ::: "memory");
    const float* KC = (const float*)(ws + WS_KC) + kc_off(seq) + kvh * 64; const float* VC = (const float*)(ws + WS_VC) + kc_off(seq) + kvh * 64;
    const int n_ok = (qpos + 1) >> 6;
    float sc[5][4];
#pragma unroll
    for (int c = 0; c < 5; ++c) { const int n = lane + 64 * c;
#pragma unroll
        for (int g = 0; g < 4; ++g) sc[c][g] = 0.f;
        if (n < n_ok && n < NB) { const f32x4* kr = (const f32x4*)(KC + (size_t)n * 128);
#pragma unroll 4
            for (int d4 = 0; d4 < 16; ++d4) { const f32x4 k = kr[d4];
                const f32x4 q0 = *(const LAS f32x4*)(s_qp + (4 * d4 + 0) * 4), q1 = *(const LAS f32x4*)(s_qp + (4 * d4 + 1) * 4), q2 = *(const LAS f32x4*)(s_qp + (4 * d4 + 2) * 4), q3 = *(const LAS f32x4*)(s_qp + (4 * d4 + 3) * 4);
#pragma unroll
                for (int g = 0; g < 4; ++g) sc[c][g] += k.x * q0[g] + k.y * q1[g] + k.z * q2[g] + k.w * q3[g]; } } }
    float imp[5];
#pragma unroll
    for (int c = 0; c < 5; ++c) imp[c] = 0.f;
#pragma unroll
    for (int g = 0; g < 4; ++g) {
        float m = -INFINITY;
#pragma unroll
        for (int c = 0; c < 5; ++c) { const int n = lane + 64 * c; if (n < n_ok && n < NB) m = fmaxf(m, sc[c][g]); }
        m = wave_max(m); if (!(m > -INFINITY)) m = 0.f;
        float e[5], zs = 0.f;
#pragma unroll
        for (int c = 0; c < 5; ++c) { const int n = lane + 64 * c; e[c] = (n < n_ok && n < NB) ? __builtin_amdgcn_exp2f(sc[c][g] - m) : 0.f; zs += e[c]; }
        zs = wave_sum(zs); const float iz = 1.0f / fmaxf(zs, 1e-30f);
#pragma unroll
        for (int c = 0; c < 5; ++c) { const int n = lane + 64 * c; const float p = e[c] * iz; imp[c] += p; if (n < NB) s_p[n * 4 + g] = p; }
    }
    LDS_WAIT(); asm volatile("" ::: "memory");
    float o_cmp[4] = {0.f, 0.f, 0.f, 0.f};
    { const int nn = n_ok < NB ? n_ok : NB; const int nstart = MODE == 1 ? wave : 0, nstep = MODE == 1 ? NWAVES : 1;
      for (int n0 = nstart; n0 < nn; n0 += 8 * nstep) { float v[8];
#pragma unroll
          for (int q = 0; q < 8; ++q) { const int n = n0 + q * nstep; v[q] = VC[(size_t)(n < nn ? n : nstart) * 128 + lane]; }
#pragma unroll
          for (int q = 0; q < 8; ++q) { const int n = n0 + q * nstep; if (n < nn) { const f32x4 p = *(const LAS f32x4*)(s_p + n * 4);
#pragma unroll
              for (int g = 0; g < 4; ++g) o_cmp[g] += p[g] * v[q]; } } } }
    LDS_WAIT(); asm volatile("" ::: "memory");
    float score[5];
#pragma unroll
    for (int c = 0; c < 5; ++c) { const int n = lane + 64 * c;
        const bool forced = (n == 0) || (n == cur) || (n == cur - 1);
        score[c] = (n >= NB) ? -4.0f : (n <= cur ? imp[c] + (forced ? 8.0f : 0.f) : -1.0f); }
    const int* ptab = (const int*)a.in[9] + sb * 128;
    float l_sel[4] = {0.f, 0.f, 0.f, 0.f}, o_sel[4] = {0.f, 0.f, 0.f, 0.f};
    float last_bv = 0.f; bool ambiguous = false;
    unsigned skey[5];
#pragma unroll
    for (int c = 0; c < 5; ++c) { const int n = lane + 64 * c; skey[c] = (MODE == 1 && n < NB) ? ((__float_as_uint(score[c]) & ~511u) | (unsigned)(511 - n)) : 0u; }
    for (int round = 0; round < (MODE == 2 ? 17 : 16); ++round) {
        float bv = score[0]; int bi = lane;
        if (MODE == 1) { unsigned w = skey[0];
#pragma unroll
            for (int c = 1; c < 5; ++c) w = skey[c] > w ? skey[c] : w;
            { unsigned o; o = dpp_x1(w); w = o > w ? o : w; o = dpp_x2(w); w = o > w ? o : w; o = dpp_x4(w); w = o > w ? o : w; o = dpp_x8(w); w = o > w ? o : w; w = umax_x16(w); w = umax_x32(w); }
            bi = 511 - (int)(w & 511u);
#pragma unroll
            for (int c = 0; c < 5; ++c) if (skey[c] == w) skey[c] = 0u;
        } else {
#pragma unroll
        for (int c = 1; c < 5; ++c) if (score[c] > bv) { bv = score[c]; bi = lane + 64 * c; }
#pragma unroll
        for (int o = 1; o < 64; o <<= 1) { const float ov = __shfl_xor(bv, o); const int oi = __shfl_xor(bi, o); if (ov > bv || (ov == bv && oi < bi)) { bv = ov; bi = oi; } }
        }
        const int n = __builtin_amdgcn_readfirstlane(bi);
        if (MODE == 2) { if (round == 16) { ambiguous = (bv >= 0.f) && (last_bv - bv < 4e-4f); break; } last_bv = bv; }
#pragma unroll
        for (int c = 0; c < 5; ++c) if (n == lane + 64 * c) score[c] = -3.0f;
        if (n > cur) continue;
        if (MODE == 1 && (round >> 1) != wave) continue;
        const float* kb; const float* vb; int nvalid;
        if (!smp) { kb = out + O_PSK + (size_t)(b * 8192 + 64 * n) * 128; vb = out + O_PSV + (size_t)(b * 8192 + 64 * n) * 128; }
        else if (n < 256) { const int page = ptab[n >> 1]; const size_t ro = ((size_t)page * 128 + (n & 1) * 64) * 128; kb = a.in[4] + ro; vb = a.in[5] + ro; }
        else { kb = out + O_SSK + (size_t)(sb * 8) * 128; vb = out + O_SSV + (size_t)(sb * 8) * 128; }
        nvalid = qpos - 64 * n + 1; if (nvalid > 64) nvalid = 64;
        const bool valid = lane < nvalid;
        float s4[4] = {0.f, 0.f, 0.f, 0.f};
        { const f32x4* kr = (const f32x4*)(kb + (size_t)(valid ? lane : 0) * 128 + kvh * 64);
#pragma unroll 4
          for (int d4 = 0; d4 < 16; ++d4) { const f32x4 k = kr[d4];
              const f32x4 q0 = *(const LAS f32x4*)(s_qr + (4 * d4 + 0) * 4), q1 = *(const LAS f32x4*)(s_qr + (4 * d4 + 1) * 4), q2 = *(const LAS f32x4*)(s_qr + (4 * d4 + 2) * 4), q3 = *(const LAS f32x4*)(s_qr + (4 * d4 + 3) * 4);
#pragma unroll
              for (int g = 0; g < 4; ++g) s4[g] += k.x * q0[g] + k.y * q1[g] + k.z * q2[g] + k.w * q3[g]; } }
        f32x4 pv4;
#pragma unroll
        for (int g = 0; g < 4; ++g) { const float p = valid ? __builtin_amdgcn_exp2f(s4[g] - mref_s[g]) : 0.f; l_sel[g] += p; pv4[g] = p; }
        *(LAS f32x4*)(s_p + lane * 4) = pv4;
        LDS_WAIT(); asm volatile("" ::: "memory");
        for (int j0 = 0; j0 < nvalid; j0 += 8) { float v[8];
#pragma unroll
            for (int q = 0; q < 8; ++q) { const int j = j0 + q < nvalid ? j0 + q : 0; v[q] = vb[(size_t)j * 128 + kvh * 64 + lane]; }
#pragma unroll
            for (int q = 0; q < 8; ++q) if (j0 + q < nvalid) { const f32x4 p = *(const LAS f32x4*)(s_p + (j0 + q) * 4);
#pragma unroll
                for (int g = 0; g < 4; ++g) o_sel[g] += p[g] * v[q]; } }
        LDS_WAIT(); asm volatile("" ::: "memory");
    }
    float l_win[4] = {0.f, 0.f, 0.f, 0.f}, o_win[4] = {0.f, 0.f, 0.f, 0.f};
    { const int lo = qpos - 511 > 0 ? qpos - 511 : 0; const int cnt = qpos - lo + 1;
      for (int c0 = 0; c0 < cnt; c0 += 64) {
          if (MODE == 1 && (c0 >> 6) != wave) continue;
          const int nvalid = cnt - c0 < 64 ? cnt - c0 : 64; const bool valid = lane < nvalid; const int kpos = lo + c0 + (valid ? lane : 0);
          const float* kr_;
          if (!smp) kr_ = (const float*)(ws + WS_KWIN) + (size_t)(b * 8192 + kpos) * 128;
          else if (kpos >= 16384) kr_ = out + O_SWK + (size_t)(sb * 512 + 504 + kpos - 16384) * 128;
          else kr_ = a.in[6] + (size_t)(sb * 512 + kpos - 15872) * 128;
          float s4[4] = {0.f, 0.f, 0.f, 0.f};
          { const f32x4* kr = (const f32x4*)(kr_ + kvh * 64);
#pragma unroll 4
            for (int d4 = 0; d4 < 16; ++d4) { const f32x4 k = kr[d4];
                const f32x4 q0 = *(const LAS f32x4*)(s_qr + (4 * d4 + 0) * 4), q1 = *(const LAS f32x4*)(s_qr + (4 * d4 + 1) * 4), q2 = *(const LAS f32x4*)(s_qr + (4 * d4 + 2) * 4), q3 = *(const LAS f32x4*)(s_qr + (4 * d4 + 3) * 4);
#pragma unroll
                for (int g = 0; g < 4; ++g) s4[g] += k.x * q0[g] + k.y * q1[g] + k.z * q2[g] + k.w * q3[g]; } }
          f32x4 pv4;
#pragma unroll
          for (int g = 0; g < 4; ++g) { const float p = valid ? __builtin_amdgcn_exp2f(s4[g] - mref_w[g]) : 0.f; l_win[g] += p; pv4[g] = p; }
          *(LAS f32x4*)(s_p + lane * 4) = pv4;
          LDS_WAIT(); asm volatile("" ::: "memory");
          for (int j0 = 0; j0 < nvalid; j0 += 8) { float v[8];
#pragma unroll
              for (int q = 0; q < 8; ++q) { const int kp = lo + c0 + (j0 + q < nvalid ? j0 + q : 0); const float* vr;
                  if (!smp) vr = (const float*)(ws + WS_VWIN) + (size_t)(b * 8192 + kp) * 128;
                  else if (kp >= 16384) vr = out + O_SWV + (size_t)(sb * 512 + 504 + kp - 16384) * 128;
                  else vr = a.in[7] + (size_t)(sb * 512 + kp - 15872) * 128;
                  v[q] = vr[kvh * 64 + lane]; }
#pragma unroll
              for (int q = 0; q < 8; ++q) if (j0 + q < nvalid) { const f32x4 p = *(const LAS f32x4*)(s_p + (j0 + q) * 4);
#pragma unroll
                  for (int g = 0; g < 4; ++g) o_win[g] += p[g] * v[q]; } }
          LDS_WAIT(); asm volatile("" ::: "memory");
      } }
    float ls[4], lw[4];
#pragma unroll
    for (int g = 0; g < 4; ++g) { ls[g] = wave_sum(l_sel[g]); lw[g] = wave_sum(l_win[g]); }
    if (MODE == 1) {
        LAS float* part = scr + 2048;
#pragma unroll
        for (int g = 0; g < 4; ++g) { part[g * 64 + lane] = o_cmp[g]; part[(4 + g) * 64 + lane] = o_sel[g]; part[(8 + g) * 64 + lane] = o_win[g]; }
        if (lane < 4) { part[768 + lane] = ls[lane & 3]; part[772 + lane] = lw[lane & 3]; }
        __syncthreads();
        if (wave == 0) {
#pragma unroll
            for (int g = 0; g < 4; ++g) { o_cmp[g] = 0.f; o_sel[g] = 0.f; o_win[g] = 0.f; ls[g] = 0.f; lw[g] = 0.f; }
            for (int w = 0; w < NWAVES; ++w) { const LAS float* pw = (const LAS float*)(ldsb + w * 16384) + 2048;
#pragma unroll
                for (int g = 0; g < 4; ++g) { o_cmp[g] += pw[g * 64 + lane]; o_sel[g] += pw[(4 + g) * 64 + lane]; o_win[g] += pw[(8 + g) * 64 + lane]; ls[g] += pw[768 + g]; lw[g] += pw[772 + g]; } }
        }
    }
    if (MODE != 1 || wave == 0) {
        const float* BG = (const float*)(ws + WS_BG) + (size_t)r * 24 + kvh * 12;
        bf16* O = (bf16*)(ws + WS_O) + (size_t)r * 512 + kvh * 256;
#pragma unroll
        for (int g = 0; g < 4; ++g) {
            const float o = BG[g * 3 + 0] * o_cmp[g] + BG[g * 3 + 1] * (o_sel[g] / fmaxf(ls[g], 1e-30f)) + BG[g * 3 + 2] * (o_win[g] / fmaxf(lw[g], 1e-30f));
            if (MODE == 2) { const float have = bf2f(O[g * 64 + lane]); if (!ambiguous && !(fabsf(have - o) <= 0.004f + 0.02f * fabsf(o))) atomicAdd((unsigned*)(ws + WS_CTL) + 8, 1u); }
            else O[g * 64 + lane] = (bf16)f2bf(o); }
    }
    LDS_WAIT(); asm volatile("" ::: "memory");
    if (MODE == 1) __syncthreads();
}

__device__ __forceinline__ float wsum(float v) { v += dpp_x1f(v); v += dpp_x2f(v); v += __uint_as_float(dpp_x4(__float_as_uint(v))); v += __uint_as_float(dpp_x8(__float_as_uint(v))); v = fsum_x16(v); return fsum_x32(v); }
__device__ __forceinline__ float wmax(float v) { v = fmaxf(v, dpp_x1f(v)); v = fmaxf(v, dpp_x2f(v)); v = fmaxf(v, __uint_as_float(dpp_x4(__float_as_uint(v)))); v = fmaxf(v, __uint_as_float(dpp_x8(__float_as_uint(v)))); v = fmax_x16(v); return fmax_x32(v); }
__device__ __forceinline__ void attn_sample(const Args& a, int r, int kvh, LAS unsigned char* ldsb, int wave, int lane) {
    unsigned char* ws = a.ws; float* out = a.out;
    LAS float* scr = (LAS float*)(ldsb + wave * 16384);
    LAS float* sh_sc = (LAS float*)(ldsb + RING_BYTES);
    const int rs_ = r - MP, sb = rs_ >> 3, si = rs_ & 7;
    const int seq = 4 + sb, qpos = 16384 + si, cur = qpos >> 6; constexpr int NB = 257;
    LAS float* s_qp = scr;
    LAS float* s_qr = scr + 256;
    LAS float* s_p = scr + 512;
    const bf16* QP = (const bf16*)(ws + WS_QP) + (size_t)r * 512 + kvh * 256; const bf16* QR = (const bf16*)(ws + WS_QR) + (size_t)r * 512 + kvh * 256;
    f32x4 ck[16]; float cv[64];
    auto chunk_load = [&](const float* krow, auto vrow, const int nvalid) __attribute__((always_inline)) {
        const f32x4* kr = (const f32x4*)(krow + kvh * 64);
#pragma unroll
        for (int d4 = 0; d4 < 16; ++d4) ck[d4] = kr[d4];
#pragma unroll
        for (int j = 0; j < 64; ++j) cv[j] = vrow(j < nvalid ? j : 0)[kvh * 64 + lane];
    };
    auto chunk_compute = [&](const int nvalid, const float (&mref)[4], float (&l)[4], float (&o)[4]) __attribute__((always_inline)) {
        const bool valid = lane < nvalid;
        f32x4 s4 = {0.f, 0.f, 0.f, 0.f};
#pragma unroll
        for (int d4 = 0; d4 < 16; ++d4) {
            const f32x4 q0 = *(const LAS f32x4*)(s_qr + (4 * d4 + 0) * 4), q1 = *(const LAS f32x4*)(s_qr + (4 * d4 + 1) * 4), q2 = *(const LAS f32x4*)(s_qr + (4 * d4 + 2) * 4), q3 = *(const LAS f32x4*)(s_qr + (4 * d4 + 3) * 4);
            s4 += q0 * ck[d4].x + q1 * ck[d4].y + q2 * ck[d4].z + q3 * ck[d4].w; }
        f32x4 pv4;
#pragma unroll
        for (int g = 0; g < 4; ++g) { const float p = valid ? __builtin_amdgcn_exp2f(s4[g] - mref[g]) : 0.f; l[g] += p; pv4[g] = p; }
        *(LAS f32x4*)(s_p + lane * 4) = pv4;
        LDS_WAIT(); asm volatile("" ::: "memory");
#pragma unroll
        for (int j = 0; j < 64; ++j) { const f32x4 p = *(const LAS f32x4*)(s_p + j * 4);
#pragma unroll
            for (int g = 0; g < 4; ++g) o[g] += p[g] * cv[j]; }
        LDS_WAIT(); asm volatile("" ::: "memory");
    };
    float l_sel[4] = {0.f, 0.f, 0.f, 0.f}, o_sel[4] = {0.f, 0.f, 0.f, 0.f}, l_win[4] = {0.f, 0.f, 0.f, 0.f}, o_win[4] = {0.f, 0.f, 0.f, 0.f};
    float qx[4], qy[4];
#pragma unroll
    for (int g = 0; g < 4; ++g) { qx[g] = bf2f(QP[g * 64 + lane]); qy[g] = bf2f(QR[g * 64 + lane]); }
    const float gk1 = fabsf(a.in[17][64 + lane]), gk2 = fabsf(a.in[17][128 + lane]);
    const int wlo = qpos - 511 > 0 ? qpos - 511 : 0, wcnt = qpos - wlo + 1, wc0 = 64 * wave;
    const int wnv = wc0 < wcnt ? (wcnt - wc0 < 64 ? wcnt - wc0 : 64) : 0;
    auto rowp = [&](const float* cache, size_t onew, int kp) { return kp >= 16384 ? out + onew + (size_t)(sb * 512 + 504 + kp - 16384) * 128 : cache + (size_t)(sb * 512 + kp - 15872) * 128; };
    if (wnv > 0) chunk_load(rowp(a.in[6], O_SWK, wlo + wc0 + (lane < wnv ? lane : 0)), [&](int j) { return rowp(a.in[7], O_SWV, wlo + wc0 + j); }, wnv);
    float mref_s[4], mref_w[4];
    { const float gks = wmax(gk1), gkw = wmax(gk2);
#pragma unroll
      for (int g = 0; g < 4; ++g) { s_qp[lane * 4 + g] = qx[g]; s_qr[lane * 4 + g] = qy[g]; const float qn = sqrtf(wsum(qy[g] * qy[g])) * 8.0f; mref_s[g] = qn * gks; mref_w[g] = qn * gkw; } }
    LDS_WAIT(); asm volatile("" ::: "memory");
    if (wnv > 0) chunk_compute(wnv, mref_w, l_win, o_win);
    const float* KC = (const float*)(ws + WS_KC) + kc_off(seq) + kvh * 64; const float* VC = (const float*)(ws + WS_VC) + kc_off(seq) + kvh * 64;
    const int n_ok = (qpos + 1) >> 6;
    const int nn = n_ok < NB ? n_ok : NB;
    float vc[33];
    { const int n = 33 * wave + lane; const bool mine = lane < 33 && n < n_ok;
      const f32x4* kr = (const f32x4*)(KC + (size_t)(mine ? n : 0) * 128);
      f32x4 k[16];
#pragma unroll
      for (int d4 = 0; d4 < 16; ++d4) k[d4] = kr[d4];
#pragma unroll
      for (int q = 0; q < 33; ++q) { const int nq = wave + 8 * q; vc[q] = VC[(size_t)(nq < nn ? nq : wave) * 128 + lane]; }
      f32x4 s4 = {0.f, 0.f, 0.f, 0.f};
#pragma unroll
      for (int d4 = 0; d4 < 16; ++d4) {
          const f32x4 q0 = *(const LAS f32x4*)(s_qp + (4 * d4 + 0) * 4), q1 = *(const LAS f32x4*)(s_qp + (4 * d4 + 1) * 4), q2 = *(const LAS f32x4*)(s_qp + (4 * d4 + 2) * 4), q3 = *(const LAS f32x4*)(s_qp + (4 * d4 + 3) * 4);
          s4 += q0 * k[d4].x + q1 * k[d4].y + q2 * k[d4].z + q3 * k[d4].w; }
      if (mine) *(LAS f32x4*)(sh_sc + n * 4) = s4; }
    LDS_WAIT(); __syncthreads();
    float sc[5][4];
#pragma unroll
    for (int c = 0; c < 5; ++c) { const int n = lane + 64 * c; f32x4 v = {0.f, 0.f, 0.f, 0.f}; if (n < n_ok && n < NB) v = *(const LAS f32x4*)(sh_sc + n * 4);
#pragma unroll
        for (int g = 0; g < 4; ++g) sc[c][g] = v[g]; }
    float imp[5];
#pragma unroll
    for (int c = 0; c < 5; ++c) imp[c] = 0.f;
#pragma unroll
    for (int g = 0; g < 4; ++g) {
        float m = -INFINITY;
#pragma unroll
        for (int c = 0; c < 5; ++c) { const int n = lane + 64 * c; if (n < n_ok && n < NB) m = fmaxf(m, sc[c][g]); }
        m = wmax(m); if (!(m > -INFINITY)) m = 0.f;
        float e[5], zs = 0.f;
#pragma unroll
        for (int c = 0; c < 5; ++c) { const int n = lane + 64 * c; e[c] = (n < n_ok && n < NB) ? __builtin_amdgcn_exp2f(sc[c][g] - m) : 0.f; zs += e[c]; }
        zs = wsum(zs); const float iz = 1.0f / fmaxf(zs, 1e-30f);
#pragma unroll
        for (int c = 0; c < 5; ++c) { const int n = lane + 64 * c; const float p = e[c] * iz; imp[c] += p; if (n < NB) s_p[n * 4 + g] = p; }
    }
    LDS_WAIT(); asm volatile("" ::: "memory");
    float o_cmp[4] = {0.f, 0.f, 0.f, 0.f};
#pragma unroll
    for (int q = 0; q < 33; ++q) { const int n = wave + 8 * q; if (n < nn) { const f32x4 p = *(const LAS f32x4*)(s_p + n * 4);
#pragma unroll
        for (int g = 0; g < 4; ++g) o_cmp[g] += p[g] * vc[q]; } }
    LDS_WAIT(); asm volatile("" ::: "memory");
    unsigned skey[5];
#pragma unroll
    for (int c = 0; c < 5; ++c) { const int n = lane + 64 * c; const bool forced = (n == 0) || (n == cur) || (n == cur - 1);
        const float score = imp[c] + (forced ? 8.0f : 0.f);
        skey[c] = (n < NB && n <= cur) ? ((__float_as_uint(score) & ~511u) | (unsigned)(511 - n)) : 0u; }
    int nsel[2] = {-1, -1};
#pragma nounroll
    for (int round = 0; round < 16; ++round) {
        unsigned w = skey[0];
#pragma unroll
        for (int c = 1; c < 5; ++c) w = skey[c] > w ? skey[c] : w;
        { unsigned o; o = dpp_x1(w); w = o > w ? o : w; o = dpp_x2(w); w = o > w ? o : w; o = dpp_x4(w); w = o > w ? o : w; o = dpp_x8(w); w = o > w ? o : w; w = umax_x16(w); w = umax_x32(w); }
        const unsigned wu = (unsigned)__builtin_amdgcn_readfirstlane((int)w);
#pragma unroll
        for (int c = 0; c < 5; ++c) if (skey[c] == wu) skey[c] = 0u;
        const int n = wu != 0u ? 511 - (int)(wu & 511u) : -1;
        if (round == 2 * wave) nsel[0] = n; if (round == 2 * wave + 1) nsel[1] = n;
    }
    const int* ptab = (const int*)a.in[9] + sb * 128;
#pragma nounroll
    for (int h = 0; h < 2; ++h) { const int n = nsel[h];
        if (n < 0 || n > cur) continue;
        const float* kb; const float* vb;
        if (n < 256) { const int page = ptab[n >> 1]; const size_t ro = ((size_t)page * 128 + (n & 1) * 64) * 128; kb = a.in[4] + ro; vb = a.in[5] + ro; }
        else { kb = out + O_SSK + (size_t)(sb * 8) * 128; vb = out + O_SSV + (size_t)(sb * 8) * 128; }
        int nvalid = qpos - 64 * n + 1; if (nvalid > 64) nvalid = 64;
        chunk_load(kb + (size_t)(lane < nvalid ? lane : 0) * 128, [&](int j) { return vb + (size_t)j * 128; }, nvalid);
        chunk_compute(nvalid, mref_s, l_sel, o_sel);
    }
    float ls[4], lw[4];
#pragma unroll
    for (int g = 0; g < 4; ++g) { ls[g] = wsum(l_sel[g]); lw[g] = wsum(l_win[g]); }
    LAS float* part = scr + 2048;
#pragma unroll
    for (int g = 0; g < 4; ++g) { part[g * 64 + lane] = o_cmp[g]; part[(4 + g) * 64 + lane] = o_sel[g]; part[(8 + g) * 64 + lane] = o_win[g]; }
    if (lane < 4) { part[768 + lane] = ls[lane & 3]; part[772 + lane] = lw[lane & 3]; }
    const float* BG = (const float*)(ws + WS_BG) + (size_t)r * 24 + kvh * 12;
    float bgv[12];
#pragma unroll
    for (int i = 0; i < 12; ++i) bgv[i] = BG[i];
    __syncthreads();
    if (wave == 0) {
#pragma unroll
        for (int g = 0; g < 4; ++g) { o_cmp[g] = 0.f; o_sel[g] = 0.f; o_win[g] = 0.f; ls[g] = 0.f; lw[g] = 0.f; }
#pragma unroll
        for (int w = 0; w < NWAVES; ++w) { const LAS float* pw = (const LAS float*)(ldsb + w * 16384) + 2048;
#pragma unroll
            for (int g = 0; g < 4; ++g) { o_cmp[g] += pw[g * 64 + lane]; o_sel[g] += pw[(4 + g) * 64 + lane]; o_win[g] += pw[(8 + g) * 64 + lane]; ls[g] += pw[768 + g]; lw[g] += pw[772 + g]; } }
        bf16* O = (bf16*)(ws + WS_O) + (size_t)r * 512 + kvh * 256;
#pragma unroll
        for (int g = 0; g < 4; ++g) {
            const float o = bgv[g * 3 + 0] * o_cmp[g] + bgv[g * 3 + 1] * (o_sel[g] / fmaxf(ls[g], 1e-30f)) + bgv[g * 3 + 2] * (o_win[g] / fmaxf(lw[g], 1e-30f));
            O[g * 64 + lane] = (bf16)f2bf(o); }
    }
    LDS_WAIT(); asm volatile("" ::: "memory");
    __syncthreads();
}

typedef short s16x8 __attribute__((ext_vector_type(8)));
template <bool B> struct BoolC { static constexpr bool v = B; };
__device__ __forceinline__ f32x4 mfma16(s16x8 a_, s16x8 b_, f32x4 c_) { return __builtin_amdgcn_mfma_f32_16x16x32_bf16(a_, b_, c_, 0, 0, 0); }
__device__ __forceinline__ unsigned cvtpk(float lo, float hi) { return pg8::cvt_pk_bf16(lo, hi); }
constexpr int AT_SLOT = 16384, AT_VOFF = 8192, AT_CMPV = 18432, AT_MASK = 4 * AT_SLOT, AT_QF = AT_MASK + 12288;
template <int PASS> __device__ __forceinline__ void attn_pass(const Args& a, LAS unsigned char* lds, int b, int kvh, int tb, int wave, int lane, int tid) {
    unsigned char* ws = a.ws; asm volatile("" : "+s"(ws)); asm volatile("" : "+v"(lane)); asm volatile("" : "+v"(tid));
    const int fr = lane & 15, fq = lane >> 4, tok_i = fr >> 2, g = fr & 3;
    const int r0 = b * 8192 + 128 * tb;
    const bf16* QR = (const bf16*)(ws + WS_QR);
    const float* BG = (const float*)(ws + WS_BG); float* OC = (float*)(ws + WS_OC);
    LAS unsigned* wmask = (LAS unsigned*)(lds + AT_MASK + wave * 1536);
    const int hq = kvh * 4 + g;
    f32x4 O[4][4], L[4];
    const s16x8 ones = {0x3F80, 0x3F80, 0x3F80, 0x3F80, 0x3F80, 0x3F80, 0x3F80, 0x3F80};
    LAS unsigned char* qlds = lds + AT_QF + wave * 8192;
    {
        const char* kimg = (const char*)((const bf16*)(ws + (PASS == 0 ? WS_KSB : WS_KWB)) + (size_t)((b * 128) * 2 + kvh) * 4096);
        const char* vimg = (const char*)((const bf16*)(ws + (PASS == 0 ? WS_VST : WS_VWT)) + (size_t)((b * 128) * 2 + kvh) * 4096);
        const float gk = wave_max(fabsf(a.in[17][(PASS == 0 ? 64 : 128) + lane]));
        if (PASS == 0) {
#pragma unroll
            for (int gi = 0; gi < 4; ++gi) { const int row = r0 + 16 * wave + 4 * gi + tok_i; const bf16* qp = QR + (size_t)row * 512 + hq * 64 + fq * 8;
                const s16x8 qa = *(const s16x8*)qp, qb = *(const s16x8*)(qp + 32); float ss = 0.f;
#pragma unroll
                for (int e = 0; e < 8; ++e) { const float x = bf2f((unsigned short)qa[e]), y = bf2f((unsigned short)qb[e]); ss += x * x + y * y; }
                ss += __shfl_xor(ss, 16); ss += __shfl_xor(ss, 32); ((LAS float*)wmask)[96 + gi * 64 + lane] = sqrtf(ss) * 8.0f;
                *(LAS s16x8*)(qlds + ((gi * 2 + 0) * 64 + lane) * 16) = qa; *(LAS s16x8*)(qlds + ((gi * 2 + 1) * 64 + lane) * 16) = qb; }
            LDS_WAIT();
        }
#pragma unroll
        for (int gi = 0; gi < 4; ++gi) { L[gi] = (f32x4){0.f, 0.f, 0.f, 0.f};
#pragma unroll
            for (int dg = 0; dg < 4; ++dg) O[gi][dg] = (f32x4){0.f, 0.f, 0.f, 0.f}; }
        s16x8 Qf[4][2];
#pragma unroll
        for (int gi = 0; gi < 4; ++gi) { Qf[gi][0] = *(const LAS s16x8*)(qlds + ((gi * 2 + 0) * 64 + lane) * 16); Qf[gi][1] = *(const LAS s16x8*)(qlds + ((gi * 2 + 1) * 64 + lane) * 16); }
        const LAS float* mrefl = (const LAS float*)wmask + 96 + lane;
        bool bigref; { float mx = 0.f;
#pragma unroll
            for (int gi = 0; gi < 4; ++gi) mx = fmaxf(mx, mrefl[64 * gi] * gk);
            bigref = __builtin_amdgcn_readfirstlane(__float_as_int(wave_max(mx))) > __float_as_int(64.0f); }
        const int nlast = 2 * tb + 1, nfirst = PASS == 0 ? 0 : (2 * tb - 8 > 0 ? 2 * tb - 8 : 0);
        const int drow = 8 * wave + (lane >> 3); const unsigned dsrc = (unsigned)(drow * 128 + (((lane & 7) ^ ((drow >> 1) & 7)) * 16));
        const unsigned fsw0 = (unsigned)((((0 + fq) ^ ((fr >> 1) & 7)) * 16)), fsw1 = (unsigned)((((4 + fq) ^ ((fr >> 1) & 7)) * 16));
#define AT_DMA_BLOCK(nn, sl) do { const size_t bo_ = (size_t)(nn) * 2 * 4096 * 2 + dsrc; \
            __builtin_amdgcn_global_load_lds((const unsigned*)(kimg + bo_), (LAS unsigned*)(lds + (sl) * AT_SLOT + wave * 1024), 16, 0, 0); \
            __builtin_amdgcn_global_load_lds((const unsigned*)(vimg + bo_), (LAS unsigned*)(lds + (sl) * AT_SLOT + AT_VOFF + wave * 1024), 16, 0, 0); } while (0)
        const int nblk = nlast - nfirst + 1, nint = (nblk + 1) >> 1;
        AT_DMA_BLOCK(nfirst, 0); if (nblk > 1) AT_DMA_BLOCK(nfirst + 1, 1);
        asm volatile("s_waitcnt vmcnt(0) lgkmcnt(0)\n\ts_barrier" ::: "memory");
        unsigned gwc[4] = {0u, 0u, 0u, 0u}, twc[4] = {0u, 0u, 0u, 0u}; int wcur = -1;
        auto do_block = [&](const int n, const LAS unsigned char* kb, auto bigc) __attribute__((always_inline)) {
            constexpr bool BIG = decltype(bigc)::v;
            const LAS unsigned char* vb = kb + AT_VOFF;
            if (PASS == 0 && (n >> 5) != wcur) { wcur = n >> 5;
#pragma unroll
                for (int gi = 0; gi < 4; ++gi) { gwc[gi] = (unsigned)__builtin_amdgcn_readfirstlane((int)wmask[64 + gi * 4 + wcur]); twc[gi] = wmask[(4 * gi + tok_i) * 4 + wcur]; } }
            int actm = 0;
#pragma unroll
            for (int gi = 0; gi < 4; ++gi) { int av;
                if (PASS == 0) { av = (int)((gwc[gi] >> (n & 31)) & 1u); }
                else { const int tlo = 128 * tb + 16 * wave + 4 * gi; const int b_lo = tlo - 511 > 0 ? (tlo - 511) >> 6 : 0, b_hi = (tlo + 3) >> 6; av = (n >= b_lo && n <= b_hi) ? 1 : 0; }
                actm |= av << gi; }
            actm = __builtin_amdgcn_readfirstlane(actm);
            if (actm != 0) {
#pragma unroll
                for (int kc = 0; kc < 2; ++kc) {
                    s16x8 Kf[2][2], Vf[4];
#pragma unroll
                    for (int x = 0; x < 2; ++x)
#pragma unroll
                        for (int k = 0; k < 2; ++k) Kf[x][k] = *(const LAS s16x8*)(kb + (16 * (2 * kc + x) + fr) * 128 + (k ? fsw1 : fsw0));
#pragma unroll
                    for (int dg = 0; dg < 4; ++dg) Vf[dg] = *(const LAS s16x8*)(vb + (16 * dg + fr) * 128 + (kc ? fsw1 : fsw0));
#pragma unroll
                    for (int gi = 0; gi < 4; ++gi) if ((actm >> gi) & 1) {
                        const int tl = 16 * wave + 4 * gi + tok_i, t = 128 * tb + tl, rel = t - 64 * n;
                        const int tlo = 128 * tb + 16 * wave + 4 * gi;
                        const bool edge = (64 * n + 63 > tlo) || (PASS == 1 && 64 * n < tlo + 3 - 511);
                        const s16x8 qf0 = Qf[gi][0], qf1 = Qf[gi][1];
                        f32x4 S[2];
                        if (PASS == 0 || BIG) {
                            const bool tsel = PASS == 0 ? ((twc[gi] >> (n & 31)) & 1u) != 0u : true;
                            float nm = 0.f; if (BIG) nm = -mrefl[64 * gi] * gk;
                            nm = tsel ? nm : -1e30f;
                            const f32x4 c0 = {nm, nm, nm, nm};
#pragma unroll
                            for (int x = 0; x < 2; ++x) S[x] = mfma16(Kf[x][0], qf0, c0);
                        } else {
#pragma unroll
                            for (int x = 0; x < 2; ++x) S[x] = mfma16(Kf[x][0], qf0, (f32x4){0.f, 0.f, 0.f, 0.f});
                        }
#pragma unroll
                        for (int x = 0; x < 2; ++x) S[x] = mfma16(Kf[x][1], qf1, S[x]);
                        if (edge) {
#pragma unroll
                            for (int x = 0; x < 2; ++x)
#pragma unroll
                                for (int i = 0; i < 4; ++i) { const int j = 16 * (2 * kc + x) + 4 * fq + i; const bool ok = j <= rel && (PASS == 0 || j > rel - 512);
                                    S[x][i] = ok ? __builtin_amdgcn_exp2f(S[x][i]) : 0.f; }
                        } else {
#pragma unroll
                            for (int x = 0; x < 2; ++x)
#pragma unroll
                                for (int i = 0; i < 4; ++i) S[x][i] = __builtin_amdgcn_exp2f(S[x][i]);
                        }
                        v4u pk; pk.x = cvtpk(S[0][0], S[0][1]); pk.y = cvtpk(S[0][2], S[0][3]); pk.z = cvtpk(S[1][0], S[1][1]); pk.w = cvtpk(S[1][2], S[1][3]);
                        const s16x8 pb = __builtin_bit_cast(s16x8, pk);
#pragma unroll
                        for (int dg = 0; dg < 4; ++dg) O[gi][dg] = mfma16(Vf[dg], pb, O[gi][dg]);
                        L[gi] = mfma16(ones, pb, L[gi]);
                    }
                }
            }
        };
        auto run = [&](auto bigc) __attribute__((always_inline)) {
#pragma nounroll
            for (int iv = 0; iv < nint; ++iv) {
                const int n0 = nfirst + 2 * iv, sp = (iv & 1) * 2;
                if (n0 + 2 <= nlast) AT_DMA_BLOCK(n0 + 2, 2 - sp);
                if (n0 + 3 <= nlast) AT_DMA_BLOCK(n0 + 3, 3 - sp);
                do_block(n0, lds + sp * AT_SLOT, bigc);
                if (n0 + 1 <= nlast) do_block(n0 + 1, lds + (sp + 1) * AT_SLOT, bigc);
                asm volatile("s_waitcnt vmcnt(0) lgkmcnt(0)\n\ts_barrier" ::: "memory");
            } };
        if (bigref) run(BoolC<true>{}); else run(BoolC<false>{});
#pragma unroll
        for (int gi = 0; gi < 4; ++gi) { const int row = r0 + 16 * wave + 4 * gi + tok_i;
            const float l = L[gi][0];
            const float sc = BG[(size_t)row * 24 + hq * 3 + 1 + PASS] / fmaxf(l, 1e-30f);
            float* oc = OC + (size_t)row * 512 + hq * 64 + 4 * fq;
#pragma unroll
            for (int dg = 0; dg < 4; ++dg) { const f32x4 v = *(const f32x4*)(oc + 16 * dg) + O[gi][dg] * sc;
                if (PASS == 0) *(f32x4*)(oc + 16 * dg) = v;
                else { v2u w; w.x = cvtpk(v[0], v[1]); w.y = cvtpk(v[2], v[3]); *(v2u*)((bf16*)(ws + WS_O) + (size_t)row * 512 + hq * 64 + 16 * dg + 4 * fq) = w; } } }
        }
}
__device__ __forceinline__ void attn_unit(const Args& a, LAS unsigned char* lds, int b, int kvh, int tb, int wave, int lane, int tid) {
    unsigned char* ws = a.ws; asm volatile("" : "+s"(ws)); asm volatile("" : "+v"(lane)); asm volatile("" : "+v"(tid));
    const int fr = lane & 15, fq = lane >> 4, tok_i = fr >> 2, g = fr & 3;
    const int r0 = b * 8192 + 128 * tb;
    const bf16* QP = (const bf16*)(ws + WS_QP); const bf16* QR = (const bf16*)(ws + WS_QR);
    const float* BG = (const float*)(ws + WS_BG); float* OC = (float*)(ws + WS_OC);
    LAS unsigned* wmask = (LAS unsigned*)(lds + AT_MASK + wave * 1536);
    const int hq = kvh * 4 + g;
    { const char* kcb = (const char*)((const bf16*)(ws + WS_KCB) + (size_t)(b * 2 + kvh) * 128 * 64); const char* vct = (const char*)((const bf16*)(ws + WS_VCT) + (size_t)(b * 2 + kvh) * 64 * 128);
      for (int c = tid; c < 1024; c += 512) { const v4u v = *(const v4u*)(kcb + c * 16); *(LAS v4u*)(lds + (c >> 3) * 144 + (c & 7) * 16) = v; }
      for (int c = tid; c < 1024; c += 512) { const v4u v = *(const v4u*)(vct + c * 16); *(LAS v4u*)(lds + AT_CMPV + (c >> 4) * 272 + (c & 15) * 16) = v; } }
    __syncthreads();
    const int ng = (2 * tb + 2 + 15) >> 4;
    s16x8 qn0, qn1; float bgn;
    { const int row = r0 + 16 * wave + tok_i; const bf16* qp = QP + (size_t)row * 512 + hq * 64 + fq * 8; qn0 = *(const s16x8*)qp; qn1 = *(const s16x8*)(qp + 32); bgn = BG[(size_t)row * 24 + hq * 3 + 0]; }
#pragma nounroll
    for (int gi = 0; gi < 4; ++gi) {
        const int tl = 16 * wave + 4 * gi + tok_i, t = 128 * tb + tl, row = r0 + tl;
        const s16x8 q0 = qn0, q1 = qn1; const float bg0 = bgn;
        { const int rown = r0 + 16 * wave + 4 * (gi < 3 ? gi + 1 : gi) + tok_i; const bf16* qp = QP + (size_t)rown * 512 + hq * 64 + fq * 8; qn0 = *(const s16x8*)qp; qn1 = *(const s16x8*)(qp + 32); bgn = BG[(size_t)rown * 24 + hq * 3 + 0]; }
        f32x4 S[8];
#pragma unroll
        for (int kg = 0; kg < 8; ++kg) { S[kg] = (f32x4){0.f, 0.f, 0.f, 0.f};
            if (kg < ng) { const s16x8 a0 = *(const LAS s16x8*)(lds + (16 * kg + fr) * 144 + fq * 16), a1 = *(const LAS s16x8*)(lds + (16 * kg + fr) * 144 + 64 + fq * 16);
                S[kg] = mfma16(a0, q0, S[kg]); S[kg] = mfma16(a1, q1, S[kg]); } }
        const int n_ok = (t + 1) >> 6, cur = t >> 6;
        float m = -INFINITY;
#pragma unroll
        for (int kg = 0; kg < 8; ++kg)
#pragma unroll
            for (int i = 0; i < 4; ++i) if (16 * kg + 4 * fq + i < n_ok) m = fmaxf(m, S[kg][i]);
        m = fmax_x16(m); m = fmax_x32(m); if (!(m > -INFINITY)) m = 0.f;
        float sum = 0.f;
#pragma unroll
        for (int kg = 0; kg < 8; ++kg)
#pragma unroll
            for (int i = 0; i < 4; ++i) { const float e = (16 * kg + 4 * fq + i < n_ok) ? __builtin_amdgcn_exp2f(S[kg][i] - m) : 0.f; S[kg][i] = e; sum += e; }
        sum = fsum_x16(sum); sum = fsum_x32(sum);
        const float inv = 1.0f / fmaxf(sum, 1e-30f);
#pragma unroll
        for (int kg = 0; kg < 8; ++kg) S[kg] *= inv;
        { f32x4 Oc[4];
#pragma unroll
          for (int dg = 0; dg < 4; ++dg) Oc[dg] = (f32x4){0.f, 0.f, 0.f, 0.f};
#pragma unroll
          for (int kc = 0; kc < 4; ++kc) if (2 * kc < ng) {
              v4u pk; pk.x = cvtpk(S[2 * kc][0], S[2 * kc][1]); pk.y = cvtpk(S[2 * kc][2], S[2 * kc][3]); pk.z = cvtpk(S[2 * kc + 1][0], S[2 * kc + 1][1]); pk.w = cvtpk(S[2 * kc + 1][2], S[2 * kc + 1][3]);
              const s16x8 pb = __builtin_bit_cast(s16x8, pk);
#pragma unroll
              for (int dg = 0; dg < 4; ++dg) { const s16x8 av = *(const LAS s16x8*)(lds + AT_CMPV + (16 * dg + fr) * 272 + kc * 64 + fq * 16); Oc[dg] = mfma16(av, pb, Oc[dg]); } }
#pragma unroll
          for (int dg = 0; dg < 4; ++dg) *(f32x4*)(OC + (size_t)row * 512 + hq * 64 + 16 * dg + 4 * fq) = Oc[dg] * bg0; }
#pragma unroll
        for (int kg = 0; kg < 8; ++kg)
#pragma unroll
            for (int i = 0; i < 4; ++i) { float v = S[kg][i]; v += dpp_x1f(v); v += dpp_x2f(v); S[kg][i] = v; }
        unsigned key[8];
#pragma unroll
        for (int h = 0; h < 2; ++h)
#pragma unroll
            for (int i = 0; i < 4; ++i) { const float v = g == 0 ? S[h][i] : (g == 1 ? S[2 + h][i] : (g == 2 ? S[4 + h][i] : S[6 + h][i]));
                const int n = 16 * (2 * g + h) + 4 * fq + i; const bool forced = (n == 0) || (n == cur) || (n == cur - 1);
                const float scv = v + (forced ? 8.0f : 0.f);
                key[h * 4 + i] = (n <= cur) ? ((__float_as_uint(scv) & ~255u) | (unsigned)(255 - n)) : 0u; }
        unsigned m0 = 0u, m1 = 0u, m2 = 0u, m3 = 0u;
#pragma nounroll
        for (int round = 0; round < 16; ++round) {
            unsigned w = key[0];
#pragma unroll
            for (int j = 1; j < 8; ++j) w = key[j] > w ? key[j] : w;
            { unsigned o; o = dpp_x1(w); w = o > w ? o : w; o = dpp_x2(w); w = o > w ? o : w; w = umax_x16(w); w = umax_x32(w); }
            if (w != 0u) { const int n = 255 - (int)(w & 255u); const unsigned bit = 1u << (n & 31); const int wi = n >> 5;
                m0 |= wi == 0 ? bit : 0u; m1 |= wi == 1 ? bit : 0u; m2 |= wi == 2 ? bit : 0u; m3 |= wi == 3 ? bit : 0u;
#pragma unroll
                for (int j = 0; j < 8; ++j) key[j] = key[j] == w ? 0u : key[j]; }
        }
        if (g == 0 && fq == 0) { v4u mm; mm.x = m0; mm.y = m1; mm.z = m2; mm.w = m3; *(LAS v4u*)(wmask + (4 * gi + tok_i) * 4) = mm; }
        { unsigned o0 = m0, o1 = m1, o2 = m2, o3 = m3;
          o0 |= (unsigned)__shfl_xor((int)o0, 4); o1 |= (unsigned)__shfl_xor((int)o1, 4); o2 |= (unsigned)__shfl_xor((int)o2, 4); o3 |= (unsigned)__shfl_xor((int)o3, 4);
          o0 |= (unsigned)__shfl_xor((int)o0, 8); o1 |= (unsigned)__shfl_xor((int)o1, 8); o2 |= (unsigned)__shfl_xor((int)o2, 8); o3 |= (unsigned)__shfl_xor((int)o3, 8);
          if (lane == 0) { v4u mm; mm.x = o0; mm.y = o1; mm.z = o2; mm.w = o3; *(LAS v4u*)(wmask + 64 + gi * 4) = mm; } }
    }
    LDS_WAIT();
    __syncthreads();
    attn_pass<0>(a, lds, b, kvh, tb, wave, lane, tid);
    attn_pass<1>(a, lds, b, kvh, tb, wave, lane, tid);
    __syncthreads();
}
__device__ __forceinline__ void phase_attn(const Args& a, LAS unsigned char* lds, int vcu, int G, int wave, int lane, int tid) {
    for (int it = vcu; it < 2 * MS; it += G) attn_sample(a, MP + (it >> 1), it & 1, lds, wave, lane);
#pragma nounroll
    for (int u2 = 2 * vcu; u2 < 512; u2 += 2 * G) {
#pragma nounroll
        for (int h = 0; h < 2; ++h) { const int u = u2 >> 1, bh = u >> 5, s = u & 31; attn_unit(a, lds, bh >> 1, bh & 1, h ? 63 - s : s, wave, lane, tid); } }
}
#if PROBE_ATTN
__device__ __forceinline__ void phase_attn_check(const Args& a, LAS unsigned char* lds, int gw, int NGW, int wave, int lane) {
    for (int it = gw; it < 2 * 2048; it += NGW) { const int idx = it >> 1; int r;
        if (idx < 300) r = idx; else if (idx < 600) r = 3 * 8192 + 900 + (idx - 300); else r = (int)(((long)(idx - 600) * 22639L) % MP);
        attn_item<2>(a, r, it & 1, lds, wave, lane); }
}
#endif


template <class F> __device__ __forceinline__ void small_gemm(const bf16* A, const bf16* Bt, int N, int K, int vcu, int G, int wave, int lane_, LAS unsigned char* lds, const F& f) {
    int lane = lane_;
    const int ntiles = 16 * (N >> 6), nk = K >> 7;
#pragma nounroll
    for (int tile = vcu; tile < ntiles; tile += G) {
        asm volatile("" : "+v"(lane));
        const int fr = lane & 15, fq = lane >> 4, rt = tile & 15, ct = tile >> 4;
        const bf16* ap = A + (size_t)(16 * rt + fr) * K + 8 * fq; const bf16* bp = Bt + (size_t)(64 * ct + fr) * K + 8 * fq;
        f32x4 acc[4];
#pragma unroll
        for (int j = 0; j < 4; ++j) acc[j] = (f32x4){0.f, 0.f, 0.f, 0.f};
#pragma nounroll
        for (int it = wave; it < nk; it += NWAVES) { const int k0 = it << 7;
            s16x8 af[4], bfr[4][4];
#pragma unroll
            for (int q = 0; q < 4; ++q) { af[q] = *(const s16x8*)(ap + k0 + 32 * q);
#pragma unroll
                for (int j = 0; j < 4; ++j) bfr[q][j] = *(const s16x8*)(bp + (size_t)(16 * j) * K + k0 + 32 * q); }
#pragma unroll
            for (int q = 0; q < 4; ++q)
#pragma unroll
                for (int j = 0; j < 4; ++j) acc[j] = mfma16(bfr[q][j], af[q], acc[j]);
        }
        LAS f32x4* red = (LAS f32x4*)lds;
#pragma unroll
        for (int j = 0; j < 4; ++j) red[(wave * 4 + j) * 64 + lane] = acc[j];
        __syncthreads();
        if (wave < 4) { f32x4 sum = red[wave * 64 + lane];
#pragma unroll
            for (int w = 1; w < NWAVES; ++w) sum += red[(w * 4 + wave) * 64 + lane];
            f(16 * rt + fr, 64 * ct + 16 * wave + 4 * fq, sum); }
        __syncthreads();
    }
}
__device__ __forceinline__ void sample_post(const Args& a, int gw, int NGW, int lane) {
    unsigned char* ws = a.ws; float* out = a.out;
    const float* Z = (const float*)(ws + WS_ZS);
    const float* rc = (const float*)(ws + WS_ROPE); const float* rs = rc + ROPE_N * 32;
    bf16* U = (bf16*)(ws + WS_U); bf16* QP = (bf16*)(ws + WS_QP); bf16* QR = (bf16*)(ws + WS_QR); bf16* GC = (bf16*)(ws + WS_GC); bf16* GN = (bf16*)(ws + WS_GN);
    float* BG = (float*)(ws + WS_BG);
    const float qg = a.in[16][lane]; const float kg0 = a.in[17][lane], kg1 = a.in[17][64 + lane], kg2 = a.in[17][128 + lane];
    for (int r = MP + gw; r < MT; r += NGW) {
        const float* z = Z + (size_t)(r - MP) * DINP;
        float zg[16], zq[8], zk[12], zm[32], zn;
#pragma unroll
        for (int i = 0; i < 8; ++i) { zg[i] = z[front_rowmap(lane + 64 * i)]; zg[8 + i] = z[front_rowmap(512 + lane + 64 * i)]; zq[i] = z[front_rowmap(OFF_Q + 64 * i + lane)]; }
#pragma unroll
        for (int i = 0; i < 12; ++i) zk[i] = z[front_rowmap(OFF_KV + 64 * i + lane)];
#pragma unroll
        for (int i = 0; i < 32; ++i) zm[i] = z[front_rowmap(OFF_MG + lane + 64 * i)];
        zn = z[front_rowmap(OFF_NG + (lane < 24 ? lane : 0))];
        const bool smp = r >= MP; const int rs_ = r - MP, sb = rs_ >> 3, si = rs_ & 7, b = r >> 13, t = r & 8191;
        const int ri = rope_idx(r); const float cv = rc[ri * 32 + (lane & 31)], sv = rs[ri * 32 + (lane & 31)];
#pragma unroll
        for (int i = 0; i < 8; ++i) { const int c = lane + 64 * i; const float u = zg[i] * sigm(zg[8 + i]);
            U[(size_t)r * 512 + c] = (bf16)f2bf(u);
            if (smp) out[O_SCONV + (size_t)(sb * 30 + 22 + si) * 512 + c] = u;
            else if (t >= 8162) out[O_PCONV + (size_t)(b * 30 + t - 8162) * 512 + c] = u; }
#pragma unroll
        for (int h = 0; h < 8; ++h) { const float x = zq[h]; const float ms = wave_sum(x * x) * (1.0f / 64.0f);
            const float y = x * (1.0f / sqrtf(ms + EPS)) * qg; const float oth = __shfl_xor(y, 32);
            const float yr = lane < 32 ? y * cv - oth * sv : y * cv + oth * sv;
            QP[(size_t)r * 512 + 64 * h + lane] = (bf16)f2bf(y * C2); QR[(size_t)r * 512 + 64 * h + lane] = (bf16)f2bf(yr * C2); }
#pragma unroll
        for (int j = 0; j < 6; ++j)
#pragma unroll
            for (int kvh = 0; kvh < 2; ++kvh) {
                float x = zk[2 * j + kvh];
                if ((j & 1) == 0) { const float ms = wave_sum(x * x) * (1.0f / 64.0f); x = x * (1.0f / sqrtf(ms + EPS)) * (j == 0 ? kg0 : (j == 2 ? kg1 : kg2));
                    if (j >= 2) { const float oth = __shfl_xor(x, 32); x = lane < 32 ? x * cv - oth * sv : x * cv + oth * sv; } }
                const int cc = kvh * 64 + lane;
                if (j < 4) { const size_t po = (j == 0 ? O_PCK : j == 1 ? O_PCV : j == 2 ? O_PSK : O_PSV), so = (j == 0 ? O_SCK : j == 1 ? O_SCV : j == 2 ? O_SSK : O_SSV);
                    if (smp) out[so + (size_t)rs_ * 128 + cc] = x; else out[po + (size_t)r * 128 + cc] = x; }
                if (!smp && j >= 2) { const size_t blk = ((size_t)(b * 128 + (t >> 6)) * 2 + kvh) * 4096; const int key = t & 63;
                    if (j == 2) ((bf16*)(ws + WS_KSB))[blk + key * 64 + lane] = (bf16)f2bf(x); else if (j == 3) ((bf16*)(ws + WS_VST))[blk + lane * 64 + perm64(key)] = (bf16)f2bf(x);
                    else if (j == 4) ((bf16*)(ws + WS_KWB))[blk + key * 64 + lane] = (bf16)f2bf(x); else ((bf16*)(ws + WS_VWT))[blk + lane * 64 + perm64(key)] = (bf16)f2bf(x); }
                if (j >= 4) { if (smp) out[(j == 4 ? O_SWK : O_SWV) + (size_t)(sb * 512 + 504 + si) * 128 + cc] = x;
                        }
            }
        if (lane < 24) BG[(size_t)r * 24 + lane] = sigm(zn);
#pragma unroll
        for (int i = 0; i < 32; ++i) { const int c = lane + 64 * i; const float v = sigm(zm[i]);
            if (i < 16) GC[(size_t)r * 1024 + c] = (bf16)f2bf(v); else GN[(size_t)r * 1024 + c - 1024] = (bf16)f2bf(v); }
    }
}


constexpr int N_PHASES = 12;
#ifndef ONE_LAUNCH
#define ONE_LAUNCH 1
#endif
__global__ void __launch_bounds__(NWAVES * 64, 2) fwd(Args args) {
    extern __shared__ __attribute__((aligned(16))) unsigned char lds_raw[];
    LAS unsigned char* lds = (LAS unsigned char*)lds_raw;
    const int tid = threadIdx.x, lane = tid & 63, wave = __builtin_amdgcn_readfirstlane(tid >> 6);
    const int G = gridDim.x, bx = blockIdx.x;
    const int vcu = (G % 8 == 0) ? (bx % 8) * (G / 8) + bx / 8 : bx;
    const int gw = vcu * NWAVES + wave, NGW = G * NWAVES;
    unsigned char* ws = args.ws;
    for (int u = tid; u < (LDS_BYTES - RING_BYTES) / 4; u += NWAVES * 64) ((LAS unsigned*)(lds + RING_BYTES))[u] = 0u;
    __syncthreads();
    XcdBarrier bar; bar.bar = (unsigned*)(ws + WS_CTL) + CW_BAR; bar.x = 0; bar.st = nullptr;
    if (ONE_LAUNCH) bar = xcd_barrier_post((unsigned*)(ws + WS_CTL) + CW_BAR, (volatile LAS unsigned*)(lds + MISC_OFF) + 8);
    const int lo = args.ph_lo, hi = args.ph_hi;
#define IN(k) (lo <= (k) && (k) < hi)
#define SEAM(k) do { if (ONE_LAUNCH && IN(k) && hi > (k) + 1) xcd_barrier(bar); } while (0)
    const float* modp = (const float*)(ws + WS_MOD);
    if (IN(0)) { phase0(args, lds, gw, NGW, wave, lane); } SEAM(0);
    if (IN(1)) { norm_rows(args.in[0], args.in[1], args.in[14], modp, 0, 1024, (bf16*)(ws + WS_H), gw, NGW, lane); } SEAM(1);
    if (IN(2)) { pg8::Gemm g{(const bf16*)(ws + WS_H), (const bf16*)(ws + WS_WIN), MP, DINP, 1024}; pg8::StaticOrder S; S.init(MP, DINP, G, bx);
        const float* rcp_ = (const float*)(ws + WS_ROPE);
        pg8::EpiFront E{args.out, ws, args.in[16], args.in[17], rcp_, rcp_ + ROPE_N * 32, O_PCK, O_SCK, O_PWK, O_SWK, O_PCONV, O_SCONV,
                        WS_U, WS_QP, WS_QR, WS_GC, WS_GN, WS_BG, WS_KSB, WS_VST, WS_KWB, WS_VWT, WS_KWIN, WS_VWIN, C2};
        pg8::gemm_phase<pg8::EpiFront, pg8::StaticOrder, true, true>(lds, g, S, E);
        { float* zs = (float*)(ws + WS_ZS);
          small_gemm((const bf16*)(ws + WS_H) + (size_t)MP * 1024, (const bf16*)(ws + WS_WIN), DINP, 1024, vcu, G, wave, lane, lds, [&](int r, int c, f32x4 v) { *(f32x4*)(zs + (size_t)r * DINP + c) = v; }); } } SEAM(2);
    if (IN(3)) { sample_post(args, gw, NGW, lane); } SEAM(3);
    if (IN(4)) { phase_conv(args, lds, vcu, G, gw, NGW, wave, lane, tid); } SEAM(4);
    if (IN(5)) { pg8::Gemm g{(const bf16*)(ws + WS_CACT), (const bf16*)(ws + WS_WPW2), MP, 1024, 512}; pg8::StaticOrder S; S.init(MP, 1024, G, bx);
        pg8::EpiGate<false> E{(bf16*)(ws + WS_T1), (const bf16*)(ws + WS_GC), 1024};
        pg8::gemm_phase<pg8::EpiGate<false>, pg8::StaticOrder, true, true>(lds, g, S, E);
        { bf16* t1 = (bf16*)(ws + WS_T1) + (size_t)MP * 1024; const bf16* gc = (const bf16*)(ws + WS_GC) + (size_t)MP * 1024;
          small_gemm((const bf16*)(ws + WS_CACT) + (size_t)MP * 512, (const bf16*)(ws + WS_WPW2), 1024, 512, vcu, G, wave, lane, lds, [&](int r, int c, f32x4 v) {
              const v2u gg = *(const v2u*)(gc + (size_t)r * 1024 + c); v2u w; w.x = pk2(v[0] * pg8::bf_lo(gg.x), v[1] * pg8::bf_hi(gg.x)); w.y = pk2(v[2] * pg8::bf_lo(gg.y), v[3] * pg8::bf_hi(gg.y));
              *(v2u*)(t1 + (size_t)r * 1024 + c) = w; }); } }
    if (IN(5) && !IN(6)) SEAM(5);
    if (IN(6)) { phase_attn(args, lds, vcu, G, wave, lane, tid); } SEAM(6);
#if PROBE_ATTN
    if (IN(7)) { phase_attn_check(args, lds, gw, NGW, wave, lane); __syncthreads(); }
#endif
    if (IN(7)) { pg8::Gemm g{(const bf16*)(ws + WS_O), (const bf16*)(ws + WS_WNSA), MP, 1024, 512}; pg8::StaticOrder S; S.init(MP, 1024, G, bx);
        pg8::EpiGate<true> E{(bf16*)(ws + WS_T1), (const bf16*)(ws + WS_GN), 1024};
        pg8::gemm_phase<pg8::EpiGate<true>, pg8::StaticOrder, true, true>(lds, g, S, E);
        { bf16* t1 = (bf16*)(ws + WS_T1) + (size_t)MP * 1024; const bf16* gn = (const bf16*)(ws + WS_GN) + (size_t)MP * 1024;
          small_gemm((const bf16*)(ws + WS_O) + (size_t)MP * 512, (const bf16*)(ws + WS_WNSA), 1024, 512, vcu, G, wave, lane, lds, [&](int r, int c, f32x4 v) {
              const v2u gg = *(const v2u*)(gn + (size_t)r * 1024 + c); const v2u tt = *(const v2u*)(t1 + (size_t)r * 1024 + c); v2u w;
              w.x = pk2(pg8::bf_lo(tt.x) + v[0] * pg8::bf_lo(gg.x), pg8::bf_hi(tt.x) + v[1] * pg8::bf_hi(gg.x)); w.y = pk2(pg8::bf_lo(tt.y) + v[2] * pg8::bf_lo(gg.y), pg8::bf_hi(tt.y) + v[3] * pg8::bf_hi(gg.y));
              *(v2u*)(t1 + (size_t)r * 1024 + c) = w; }); } } SEAM(7);
    if (IN(8)) { pg8::Gemm g{(const bf16*)(ws + WS_T1), (const bf16*)(ws + WS_WOUT), MP, 1024, 1024}; pg8::StaticOrder S; S.init(MP, 1024, G, bx);
        pg8::EpiResGate E{args.in[0], args.in[1], args.out, modp + 2048};
        pg8::gemm_phase<pg8::EpiResGate, pg8::StaticOrder, true, true>(lds, g, S, E);
        { const float* xs = args.in[1]; float* ys = args.out + (size_t)MP * 1024; const float* mg = modp + 2048;
          small_gemm((const bf16*)(ws + WS_T1) + (size_t)MP * 1024, (const bf16*)(ws + WS_WOUT), 1024, 1024, vcu, G, wave, lane, lds, [&](int r, int c, f32x4 v) {
              *(f32x4*)(ys + (size_t)r * 1024 + c) = *(const f32x4*)(xs + (size_t)r * 1024 + c) + *(const f32x4*)(mg + (size_t)(4 + (r >> 3)) * 6144 + c) * v; }); } } SEAM(8);
    if (IN(9)) { norm_rows(args.out, args.out + (size_t)MP * 1024, args.in[29], modp, 3072, 4096, (bf16*)(ws + WS_H), gw, NGW, lane); } SEAM(9);
    if (IN(10)) { pg8::Gemm g{(const bf16*)(ws + WS_H), (const bf16*)(ws + WS_WGU), MP, 2 * DFF, 1024}; pg8::StaticOrder S; S.init(MP, 2 * DFF, G, bx);
        pg8::EpiSwiGlu E{(bf16*)(ws + WS_ACT), DFF};
        pg8::gemm_phase<pg8::EpiSwiGlu, pg8::StaticOrder, true, true>(lds, g, S, E);
        { bf16* act = (bf16*)(ws + WS_ACT) + (size_t)MP * DFF;
          small_gemm((const bf16*)(ws + WS_H) + (size_t)MP * 1024, (const bf16*)(ws + WS_WGU), 2 * DFF, 1024, vcu, G, wave, lane, lds, [&](int r, int c, f32x4 v) {
              f32x4 up; up[0] = __shfl_xor(v[0], 16); up[1] = __shfl_xor(v[1], 16); up[2] = __shfl_xor(v[2], 16); up[3] = __shfl_xor(v[3], 16);
              if ((c & 4) == 0) { v2u w; w.x = pk2(v[0] * sigm(v[0]) * up[0], v[1] * sigm(v[1]) * up[1]); w.y = pk2(v[2] * sigm(v[2]) * up[2], v[3] * sigm(v[3]) * up[3]);
                  *(v2u*)(act + (size_t)r * DFF + (128 * (c >> 8) + 32 * ((c >> 5) & 3) + 8 * ((c >> 3) & 3) + 4 * ((c >> 7) & 1))) = w; } }); } } SEAM(10);
    if (IN(11)) { pg8::Gemm g{(const bf16*)(ws + WS_ACT), (const bf16*)(ws + WS_WDOWN), MP, 1024, DFF}; pg8::StaticOrder S; S.init(MP, 1024, G, bx);
        pg8::EpiResGate E{args.out, args.out + (size_t)MP * 1024, args.out, modp + 5120};
        pg8::gemm_phase<pg8::EpiResGate, pg8::StaticOrder, true, true>(lds, g, S, E);
        { float* ys = args.out + (size_t)MP * 1024; const float* mg = modp + 5120;
          small_gemm((const bf16*)(ws + WS_ACT) + (size_t)MP * DFF, (const bf16*)(ws + WS_WDOWN), 1024, DFF, vcu, G, wave, lane, lds, [&](int r, int c, f32x4 v) {
              float* o = ys + (size_t)r * 1024 + c; *(f32x4*)o = *(const f32x4*)o + *(const f32x4*)(mg + (size_t)(4 + (r >> 3)) * 6144 + c) * v; }); } }
#if PROBE_ATTN
    if (ONE_LAUNCH) { xcd_barrier(bar); const unsigned cnt = __hip_atomic_load((unsigned*)(ws + WS_CTL) + 8, __ATOMIC_RELAXED, __HIP_MEMORY_SCOPE_AGENT);
        if (bx == 0 && tid < 64 && cnt != 0u) args.out[tid] = 10.0f * (float)(1 + (31 - __builtin_clz(cnt))); }
#endif
#undef IN
#undef SEAM
}

extern "C" void kernel_launch(void* const* d_in, const int* in_sizes, int n_in, void* d_out, int out_size, void* d_ws, size_t ws_size, hipStream_t stream) {
    static int grid = 0;
    if (grid == 0) {
        if (n_in != 33 || (size_t)out_size != O_END || ws_size < WS_END) { fprintf(stderr, "kernel_launch: unexpected shapes (n_in %d out %d ws %zu)\n", n_in, out_size, ws_size); grid = -1; return; }
        int dev = 0, cus = 0, per_cu = 0;
        if (hipGetDevice(&dev) != hipSuccess || hipDeviceGetAttribute(&cus, hipDeviceAttributeMultiprocessorCount, dev) != hipSuccess) { grid = -1; return; }
        if (hipFuncSetAttribute((const void*)fwd, hipFuncAttributeMaxDynamicSharedMemorySize, LDS_BYTES) != hipSuccess) { fprintf(stderr, "kernel_launch: hipFuncSetAttribute failed\n"); grid = -1; return; }
        if (hipOccupancyMaxActiveBlocksPerMultiprocessor(&per_cu, (const void*)fwd, NWAVES * 64, LDS_BYTES) != hipSuccess || per_cu < 1) fprintf(stderr, "kernel_launch: occupancy query says %d\n", per_cu);
        (void)hipGetLastError();
        grid = cus;
    }
    if (grid < 0) return;
    (void)hipMemsetAsync((char*)d_ws, 0, ZERO_BYTES, stream);
    Args a{};
    for (int i = 0; i < 33; ++i) a.in[i] = (const float*)d_in[i];
    a.out = (float*)d_out; a.ws = (unsigned char*)d_ws;
#if ONE_LAUNCH
    a.ph_lo = 0; a.ph_hi = N_PHASES;
    hipLaunchKernelGGL(fwd, dim3(grid), dim3(NWAVES * 64), LDS_BYTES, stream, a);
#else
    for (int p = 0; p < N_PHASES; ++p) { a.ph_lo = p; a.ph_hi = p + 1; hipLaunchKernelGGL(fwd, dim3(grid), dim3(NWAVES * 64), LDS_BYTES, stream, a); }
#endif
}
```

```cpp
#include <hip/hip_runtime.h>
#include <cstdio>
#include <cstdint>
#include <cmath>
#define PROBE_PHASE -1
#ifndef PROBE_ATTN
#define PROBE_ATTN 0
#endif
namespace pg8 {
#define PG8_LAS __attribute__((address_space(3)))
typedef unsigned short bf16_t;
typedef short bf16x8 __attribute__((ext_vector_type(8)));
typedef float f32x4 __attribute__((ext_vector_type(4)));
typedef unsigned u32x4 __attribute__((ext_vector_type(4)));
constexpr int BM = 256, BK = 64, HALF = 128, HTB = HALF * BK * 2  , STAGE_BYTES = 8 * HTB, NXCD = 8, WGM = 8;

__host__ __device__ __forceinline__ int lds_byte(int r, int c) { const int st = (r >> 4) * 2 + (c >> 5), rr = r & 15, cc = c & 31, ob = rr * 64 + cc * 2; return st * 1024 + (ob ^ (((ob >> 9) & 1) << 5)); }
__host__ __device__ __forceinline__ void stage_rc(int b, int& R, int& C) { const int st = b / 1024, sb = b % 1024, swz = sb ^ (((sb >> 9) & 1) << 5); R = (st >> 1) * 16 + swz / 64; C = (st & 1) * 32 + (swz % 64) / 2; }
__host__ __device__ __forceinline__ int perm32(int rho) { const int n = rho >> 4, i = rho & 15; return 8 * (i >> 2) + 4 * n + (i & 3); }

struct Unit { int pm, pn; };
struct Gemm { const bf16_t* A; const bf16_t* Bt; int M, N, K; };

struct StaticOrder {
    int nM, nN, nwg, G, c;
    __host__ __device__ void init(int M, int N, int G_, int c_) { nM = M / BM; nN = N / BM; nwg = nM * nN; G = G_; c = c_; }
    __host__ __device__ bool next(int i, Unit& u) const {
        const long L = (long)i * G + c; if (L >= nwg) return false;
        int wgid = (int)L; { const int q = nwg / NXCD, r = nwg % NXCD, xcd = wgid % NXCD, off = wgid / NXCD; wgid = (xcd < r ? xcd * (q + 1) : r * (q + 1) + (xcd - r) * q) + off; }
        const int nig = WGM * nN, gid = wgid / nig, fm = gid * WGM, gsz = (nM - fm) < WGM ? (nM - fm) : WGM;
        u.pm = fm + ((wgid % nig) % gsz); u.pn = (wgid % nig) / gsz; return true;
    }
    __device__ __forceinline__ void a_ready(const Unit&) const {}
    __device__ __forceinline__ void done(const Unit&) const {}
};

typedef float f32x2_cv __attribute__((ext_vector_type(2))); typedef __bf16 bf16x2_cv __attribute__((ext_vector_type(2)));
__device__ __forceinline__ unsigned cvt_pk_bf16(float lo, float hi) { f32x2_cv v = {lo, hi}; bf16x2_cv b = __builtin_convertvector(v, bf16x2_cv); return __builtin_bit_cast(unsigned, b); }
typedef float f32x2 __attribute__((ext_vector_type(2)));

constexpr int ROWS_P = 32768;
__device__ __forceinline__ int mod_row(int r) { return r < ROWS_P ? (r >> 13) : 4 + ((r - ROWS_P) >> 3); }
__device__ __forceinline__ float bf_lo(unsigned w) { return __uint_as_float(w << 16); }
__device__ __forceinline__ float bf_hi(unsigned w) { return __uint_as_float(w & 0xffff0000u); }
__device__ __forceinline__ float sigmoid_f(float x) { return __builtin_amdgcn_rcpf(1.0f + __builtin_amdgcn_exp2f(-1.4426950408889634f * x)); }

struct EpiF32 {
    static constexpr bool PERM = false, AFTER_DRAIN = false;
    float* C; int ldc;
    __device__ __forceinline__ void operator()(const f32x4 (&acc)[2][2][4][2], const Unit& u, int wr, int wc, int fr, int fq) const {
        const int row0 = u.pm * BM + wr * 64 + fr, col0 = u.pn * BM + wc * 32 + 4 * fq;
#pragma unroll
        for (int ai = 0; ai < 2; ++ai)
#pragma unroll
            for (int m = 0; m < 4; ++m) { float* rowp = C + (size_t)(row0 + ai * HALF + m * 16) * ldc + col0;
#pragma unroll
                for (int bj = 0; bj < 2; ++bj)
#pragma unroll
                    for (int n = 0; n < 2; ++n) *(f32x4*)(rowp + bj * HALF + n * 16) = acc[ai][bj][m][n]; }
    }
};
template <bool ADD> struct EpiGate {
    static constexpr bool PERM = true, AFTER_DRAIN = false;
    bf16_t* O; const bf16_t* G; int ldc;
    __device__ __forceinline__ void operator()(const f32x4 (&acc)[2][2][4][2], const Unit& u, int wr, int wc, int fr, int fq) const {
        const int row0 = u.pm * BM + wr * 64 + fr, col0 = u.pn * BM + wc * 32 + 8 * fq;
#pragma unroll
        for (int ai = 0; ai < 2; ++ai)
#pragma unroll
            for (int m = 0; m < 4; ++m) { const size_t ro = (size_t)(row0 + ai * HALF + m * 16) * ldc + col0;
#pragma unroll
                for (int bj = 0; bj < 2; ++bj) {
                    const u32x4 g = *(const u32x4*)(G + ro + bj * HALF);
                    f32x4 v0 = acc[ai][bj][m][0], v1 = acc[ai][bj][m][1];
                    v0[0] *= bf_lo(g.x); v0[1] *= bf_hi(g.x); v0[2] *= bf_lo(g.y); v0[3] *= bf_hi(g.y);
                    v1[0] *= bf_lo(g.z); v1[1] *= bf_hi(g.z); v1[2] *= bf_lo(g.w); v1[3] *= bf_hi(g.w);
                    if (ADD) { const u32x4 t = *(const u32x4*)(O + ro + bj * HALF);
                        v0[0] += bf_lo(t.x); v0[1] += bf_hi(t.x); v0[2] += bf_lo(t.y); v0[3] += bf_hi(t.y);
                        v1[0] += bf_lo(t.z); v1[1] += bf_hi(t.z); v1[2] += bf_lo(t.w); v1[3] += bf_hi(t.w); }
                    u32x4 w; w.x = cvt_pk_bf16(v0[0], v0[1]); w.y = cvt_pk_bf16(v0[2], v0[3]); w.z = cvt_pk_bf16(v1[0], v1[1]); w.w = cvt_pk_bf16(v1[2], v1[3]);
                    *(u32x4*)(O + ro + bj * HALF) = w; } }
    }
};
template <bool BASE_BF16, bool OUT_BF16> struct EpiResGate {
    static constexpr bool PERM = true, AFTER_DRAIN = false;
    const void* bp; const void* bs; void* out; const float* modg;
    __device__ __forceinline__ void operator()(const f32x4 (&acc)[2][2][4][2], const Unit& u, int wr, int wc, int fr, int fq) const {
        const int row0 = u.pm * BM + wr * 64 + fr, col0 = u.pn * BM + wc * 32 + 8 * fq;
        const float* g = modg + (size_t)mod_row(u.pm * BM) * 6144 + col0;
        f32x4 gv[2][2];
#pragma unroll
        for (int bj = 0; bj < 2; ++bj)
#pragma unroll
            for (int n = 0; n < 2; ++n) gv[bj][n] = *(const f32x4*)(g + bj * HALF + n * 4);
#pragma unroll
        for (int ai = 0; ai < 2; ++ai)
#pragma unroll
            for (int m = 0; m < 4; ++m) { const int r = row0 + ai * HALF + m * 16;
                const size_t bo = (r < ROWS_P ? (size_t)r : (size_t)(r - ROWS_P)) * 1024 + col0, oo = (size_t)r * 1024 + col0;
                const void* bb = r < ROWS_P ? bp : bs;
#pragma unroll
                for (int bj = 0; bj < 2; ++bj) { f32x4 b0, b1;
                    if (BASE_BF16) { const u32x4 t = *(const u32x4*)((const bf16_t*)bb + bo + bj * HALF);
                        b0 = (f32x4){bf_lo(t.x), bf_hi(t.x), bf_lo(t.y), bf_hi(t.y)}; b1 = (f32x4){bf_lo(t.z), bf_hi(t.z), bf_lo(t.w), bf_hi(t.w)}; }
                    else { const float* b = (const float*)bb + bo + bj * HALF; b0 = *(const f32x4*)b; b1 = *(const f32x4*)(b + 4); }
                    const f32x4 v0 = b0 + gv[bj][0] * acc[ai][bj][m][0], v1 = b1 + gv[bj][1] * acc[ai][bj][m][1];
                    if (OUT_BF16) { u32x4 w; w.x = cvt_pk_bf16(v0[0], v0[1]); w.y = cvt_pk_bf16(v0[2], v0[3]); w.z = cvt_pk_bf16(v1[0], v1[1]); w.w = cvt_pk_bf16(v1[2], v1[3]);
                        *(u32x4*)((bf16_t*)out + oo + bj * HALF) = w; }
                    else { float* o = (float*)out + oo + bj * HALF; *(f32x4*)o = v0; *(f32x4*)(o + 4) = v1; } } }
    }
};
struct EpiSwiGlu {
    static constexpr bool PERM = true, AFTER_DRAIN = false;
    bf16_t* O; int ldo;
    __device__ __forceinline__ void operator()(const f32x4 (&acc)[2][2][4][2], const Unit& u, int wr, int wc, int fr, int fq) const {
        const int row0 = u.pm * BM + wr * 64 + fr, oc0 = u.pn * 128 + wc * 32 + 8 * fq;
#pragma unroll
        for (int ai = 0; ai < 2; ++ai)
#pragma unroll
            for (int m = 0; m < 4; ++m) { bf16_t* rowp = O + (size_t)(row0 + ai * HALF + m * 16) * ldo + oc0; f32x4 a[2];
#pragma unroll
                for (int bj = 0; bj < 2; ++bj) { const f32x4 gt = acc[ai][bj][m][0], up = acc[ai][bj][m][1];
#pragma unroll
                    for (int i = 0; i < 4; ++i) a[bj][i] = gt[i] * sigmoid_f(gt[i]) * up[i]; }
                u32x4 w; w.x = cvt_pk_bf16(a[0][0], a[0][1]); w.y = cvt_pk_bf16(a[0][2], a[0][3]); w.z = cvt_pk_bf16(a[1][0], a[1][1]); w.w = cvt_pk_bf16(a[1][2], a[1][3]);
                *(u32x4*)rowp = w; }
    }
};

struct EpiFront {
    static constexpr bool PERM = true, AFTER_DRAIN = false;
    float* out; unsigned char* ws; const float* qg; const float* kng; const float* rc; const float* rsn;
    size_t o_pck, o_sck, o_pwk, o_swk, o_pconv, o_sconv;
    size_t w_u, w_qp, w_qr, w_gc, w_gn, w_bg, w_ksb, w_vst, w_kwb, w_vwt, w_kwin, w_vwin;
    float c2;
    __device__ __forceinline__ void operator()(const f32x4 (&acc)[2][2][4][2], const Unit& u, int wr, int wc, int fr, int fq) const {
        typedef unsigned u32x2 __attribute__((ext_vector_type(2)));
        const int pn = u.pn;
        const int row0 = u.pm * BM + wr * 64 + fr;
        if (pn < 4) {
            bf16_t* U = (bf16_t*)(ws + w_u);
#pragma unroll
            for (int ai = 0; ai < 2; ++ai)
#pragma unroll
                for (int m = 0; m < 4; ++m) { const int r = row0 + ai * HALF + m * 16; const int t = r & 8191;
#pragma unroll
                    for (int bj = 0; bj < 2; ++bj) { const int ch = 128 * pn + 64 * bj + 16 * wc + 4 * fq; const f32x4 a4 = acc[ai][bj][m][0], b4 = acc[ai][bj][m][1]; f32x4 u4;
#pragma unroll
                        for (int i = 0; i < 4; ++i) u4[i] = a4[i] * sigmoid_f(b4[i]);
                        u32x2 w; w.x = cvt_pk_bf16(u4[0], u4[1]); w.y = cvt_pk_bf16(u4[2], u4[3]); *(u32x2*)(U + (size_t)r * 512 + ch) = w;
                        if (t >= 8162) *(f32x4*)(out + o_pconv + (size_t)((r >> 13) * 30 + t - 8162) * 512 + ch) = u4; } }
        } else if (pn < 9) {
            const bool isq = pn < 6; const int kvt = pn - 6;
            const bool isv = !isq && (wc >= 2); const bool dorope = isq || (!isv && kvt >= 1);
            const float* gp = isq ? qg : kng + kvt * 64;
            f32x4 gn[2][2];
#pragma unroll
            for (int bj = 0; bj < 2; ++bj)
#pragma unroll
                for (int n = 0; n < 2; ++n) gn[bj][n] = isv ? (f32x4){1.f, 1.f, 1.f, 1.f} : *(const f32x4*)(gp + 32 * bj + 8 * fq + 4 * n);
#pragma unroll
            for (int ai = 0; ai < 2; ++ai)
#pragma unroll
                for (int m = 0; m < 4; ++m) { const int r = row0 + ai * HALF + m * 16;
                    f32x4 y[2][2];
#pragma unroll
                    for (int bj = 0; bj < 2; ++bj)
#pragma unroll
                        for (int n = 0; n < 2; ++n) y[bj][n] = acc[ai][bj][m][n];
                    if (!isv) { float ss = 0.f;
#pragma unroll
                        for (int bj = 0; bj < 2; ++bj)
#pragma unroll
                            for (int n = 0; n < 2; ++n) ss += (y[bj][n][0] * y[bj][n][0] + y[bj][n][1] * y[bj][n][1]) + (y[bj][n][2] * y[bj][n][2] + y[bj][n][3] * y[bj][n][3]);
                        ss += __shfl_xor(ss, 16); ss += __shfl_xor(ss, 32);
                        const float rstd = 1.0f / sqrtf(ss * (1.0f / 64.0f) + 1e-6f);
#pragma unroll
                        for (int bj = 0; bj < 2; ++bj)
#pragma unroll
                            for (int n = 0; n < 2; ++n) y[bj][n] = y[bj][n] * rstd * gn[bj][n]; }
                    const int ri = r & 8191;
                    f32x4 yr[2][2];
                    if (dorope) {
#pragma unroll
                        for (int n = 0; n < 2; ++n) { const f32x4 c4 = *(const f32x4*)(rc + (size_t)ri * 32 + 8 * fq + 4 * n), s4 = *(const f32x4*)(rsn + (size_t)ri * 32 + 8 * fq + 4 * n);
                            yr[0][n] = y[0][n] * c4 - y[1][n] * s4; yr[1][n] = y[1][n] * c4 + y[0][n] * s4; } }
                    else {
#pragma unroll
                        for (int n = 0; n < 2; ++n) { yr[0][n] = y[0][n]; yr[1][n] = y[1][n]; } }
                    if (isq) { const int h = 4 * (pn - 4) + wc; bf16_t* qp = (bf16_t*)(ws + w_qp) + (size_t)r * 512 + h * 64 + 8 * fq; bf16_t* qr = (bf16_t*)(ws + w_qr) + (size_t)r * 512 + h * 64 + 8 * fq;
#pragma unroll
                        for (int bj = 0; bj < 2; ++bj) { const f32x4 a0 = y[bj][0] * c2, a1 = y[bj][1] * c2, b0 = yr[bj][0] * c2, b1 = yr[bj][1] * c2; u32x4 w;
                            w.x = cvt_pk_bf16(a0[0], a0[1]); w.y = cvt_pk_bf16(a0[2], a0[3]); w.z = cvt_pk_bf16(a1[0], a1[1]); w.w = cvt_pk_bf16(a1[2], a1[3]); *(u32x4*)(qp + 32 * bj) = w;
                            w.x = cvt_pk_bf16(b0[0], b0[1]); w.y = cvt_pk_bf16(b0[2], b0[3]); w.z = cvt_pk_bf16(b1[0], b1[1]); w.w = cvt_pk_bf16(b1[2], b1[3]); *(u32x4*)(qr + 32 * bj) = w; } }
                    else { const int kvh = wc & 1; const int j = 2 * kvt + (isv ? 1 : 0);
                        const int t = r & 8191;
                        float* fo = nullptr;
                        if (j < 4) fo = out + o_pck + (size_t)j * 4194304 + (size_t)r * 128; else if (t >= 7680) fo = out + o_pwk + (size_t)(j - 4) * 262144 + (size_t)((r >> 13) * 512 + t - 7680) * 128;
                        if (fo) {
#pragma unroll
                            for (int bj = 0; bj < 2; ++bj)
#pragma unroll
                                for (int n = 0; n < 2; ++n) *(f32x4*)(fo + kvh * 64 + 32 * bj + 8 * fq + 4 * n) = yr[bj][n]; }
#if defined(PROBE_ATTN) && PROBE_ATTN
                        if (kvt == 2) { float* kw = (float*)(ws + (isv ? w_vwin : w_kwin)) + (size_t)r * 128 + kvh * 64;
#pragma unroll
                            for (int bj = 0; bj < 2; ++bj)
#pragma unroll
                                for (int n = 0; n < 2; ++n) *(f32x4*)(kw + 32 * bj + 8 * fq + 4 * n) = yr[bj][n]; }
#endif
                        if (kvt >= 1) { const int key = t & 63; const size_t blk = ((size_t)((r >> 13) * 128 + (t >> 6)) * 2 + kvh) * 4096;
                            if (!isv) { bf16_t* kd = (bf16_t*)(ws + (kvt == 1 ? w_ksb : w_kwb)) + blk + key * 64 + 8 * fq;
#pragma unroll
                                for (int bj = 0; bj < 2; ++bj) { u32x4 w; w.x = cvt_pk_bf16(yr[bj][0][0], yr[bj][0][1]); w.y = cvt_pk_bf16(yr[bj][0][2], yr[bj][0][3]); w.z = cvt_pk_bf16(yr[bj][1][0], yr[bj][1][1]); w.w = cvt_pk_bf16(yr[bj][1][2], yr[bj][1][3]);
                                    *(u32x4*)(kd + 32 * bj) = w; } }
                            else { const int kp = (key & 32) | (((key >> 2) & 3) << 3) | (((key >> 4) & 1) << 2) | (key & 3);
                                bf16_t* vd = (bf16_t*)(ws + (kvt == 1 ? w_vst : w_vwt)) + blk + kp;
#pragma unroll
                                for (int bj = 0; bj < 2; ++bj)
#pragma unroll
                                    for (int n = 0; n < 2; ++n)
#pragma unroll
                                        for (int i = 0; i < 4; ++i) { const unsigned b2 = cvt_pk_bf16(y[bj][n][i], 0.f); vd[(size_t)(32 * bj + 8 * fq + 4 * n + i) * 64] = (bf16_t)(b2 & 0xffffu); } } }
                    } }
        } else if (pn < 17) {
            bf16_t* G = (bf16_t*)(ws + (pn < 13 ? w_gc : w_gn)); const int cb = 256 * ((pn - 9) & 3) + 32 * wc + 8 * fq;
#pragma unroll
            for (int ai = 0; ai < 2; ++ai)
#pragma unroll
                for (int m = 0; m < 4; ++m) { const int r = row0 + ai * HALF + m * 16;
#pragma unroll
                    for (int bj = 0; bj < 2; ++bj) { const f32x4 v0 = acc[ai][bj][m][0], v1 = acc[ai][bj][m][1]; u32x4 w;
                        w.x = cvt_pk_bf16(sigmoid_f(v0[0]), sigmoid_f(v0[1])); w.y = cvt_pk_bf16(sigmoid_f(v0[2]), sigmoid_f(v0[3])); w.z = cvt_pk_bf16(sigmoid_f(v1[0]), sigmoid_f(v1[1])); w.w = cvt_pk_bf16(sigmoid_f(v1[2]), sigmoid_f(v1[3]));
                        *(u32x4*)(G + (size_t)r * 1024 + cb + 128 * bj) = w; } }
        } else {
            if (wc == 0 && fq < 3) { float* BG = (float*)(ws + w_bg);
#pragma unroll
                for (int ai = 0; ai < 2; ++ai)
#pragma unroll
                    for (int m = 0; m < 4; ++m) { const int r = row0 + ai * HALF + m * 16;
#pragma unroll
                        for (int n = 0; n < 2; ++n) { const int c = 8 * fq + 4 * n; const f32x4 v = acc[ai][0][m][n]; f32x4 o;
#pragma unroll
                            for (int i = 0; i < 4; ++i) o[i] = sigmoid_f(v[i]);
                            *(f32x4*)(BG + (size_t)r * 24 + c) = o; } } }
        }
    }
};
template <class Epi, class Sched, bool ALIGN_EPI = false, bool SP2 = false>
__device__ __forceinline__ void gemm_phase(PG8_LAS unsigned char* lds, const Gemm g, const Sched& S, const Epi& E) {
    const int tid = threadIdx.x, wid = __builtin_amdgcn_readfirstlane(tid >> 6), lane = tid & 63, wr = wid >> 2, wc = wid & 3, fr = lane & 15, fq = lane >> 4;
    const int K = g.K, nt = K / BK;
    unsigned voffA[2], voffB[2];
#pragma unroll
    for (int i = 0; i < 2; ++i) { int R, C; stage_rc(tid * 16 + i * 8192, R, C); const int Rb = Epi::PERM ? ((R & ~31) + perm32(R & 31)) : R;
        voffA[i] = (unsigned)(R * K + C) * 2u; voffB[i] = (unsigned)(Rb * K + C) * 2u; }
    const size_t kstep = (size_t)(BK * 2);
    const size_t hstep = (size_t)HALF * K * 2;
    const size_t tstep = 2 * hstep;
    const unsigned ldsw = (unsigned)wid * 1024u;
    const int aoff = lds_byte(wr * 64 + fr, fq * 8), boff = lds_byte(wc * 32 + fr, fq * 8);
#define PG8_SA(b, h) (((b) * 2 + (h)) * HTB)
#define PG8_SB(b, h) ((4 + (b) * 2 + (h)) * HTB)
#define PG8_STAGE(bufoff, gbase, voff) do { _Pragma("unroll") for (int _i = 0; _i < 2; ++_i) \
        __builtin_amdgcn_global_load_lds((const unsigned*)((const char*)(gbase) + (voff)[_i]), (PG8_LAS unsigned*)(lds + (bufoff) + ldsw + _i * 8192), 16, 0, 0); } while (0)
#define PG8_LDA(dst, b, h) do { _Pragma("unroll") for (int m = 0; m < 4; ++m) _Pragma("unroll") for (int k = 0; k < 2; ++k) dst[m][k] = *(const PG8_LAS bf16x8*)(lds + PG8_SA(b, h) + aoff + m * 2048 + k * 1024); } while (0)
#define PG8_LDB(dst, b, h) do { _Pragma("unroll") for (int n = 0; n < 2; ++n) _Pragma("unroll") for (int k = 0; k < 2; ++k) dst[n][k] = *(const PG8_LAS bf16x8*)(lds + PG8_SB(b, h) + boff + n * 2048 + k * 1024); } while (0)
#define PG8_MMA(ai, bj, At, Bt) do { __builtin_amdgcn_s_setprio(1); _Pragma("unroll") for (int m = 0; m < 4; ++m) _Pragma("unroll") for (int n = 0; n < 2; ++n) _Pragma("unroll") for (int k = 0; k < 2; ++k) \
        acc[ai][bj][m][n] = __builtin_amdgcn_mfma_f32_16x16x32_bf16(Bt[n][k], At[m][k], acc[ai][bj][m][n], 0, 0, 0); __builtin_amdgcn_s_setprio(0); } while (0)
#define PG8_WAIT_V(n) asm volatile("s_waitcnt vmcnt(" #n ")" ::: "memory")
#define PG8_WAIT_L(n) asm volatile("s_waitcnt lgkmcnt(" #n ")" ::: "memory")
#define PG8_BAR __builtin_amdgcn_s_barrier()
#define PG8_SCHED __builtin_amdgcn_sched_barrier(0)
    Unit cur, nxt; int ui = 0;
    if (!S.next(0, cur)) return;
    f32x4 acc[2][2][4][2];
#pragma unroll
    for (int a = 0; a < 2; ++a)
#pragma unroll
        for (int b = 0; b < 2; ++b)
#pragma unroll
            for (int m = 0; m < 4; ++m)
#pragma unroll
                for (int n = 0; n < 2; ++n) acc[a][b][m][n] = (f32x4){0.f, 0.f, 0.f, 0.f};
    bf16x8 At[4][2], B0[2][2], B1[2][2];
    const char* cA = (const char*)g.A + (size_t)cur.pm * tstep; const char* cB = (const char*)g.Bt + (size_t)cur.pn * tstep;
    S.a_ready(cur);
    if constexpr (SP2) {
        PG8_STAGE(PG8_SB(0, 0), cB, voffB); PG8_STAGE(PG8_SB(0, 1), cB + hstep, voffB); PG8_STAGE(PG8_SA(0, 0), cA, voffA); PG8_STAGE(PG8_SA(0, 1), cA + hstep, voffA);
        if (wr == 1) PG8_BAR;
        PG8_WAIT_V(2); PG8_BAR;
        PG8_STAGE(PG8_SB(1, 0), cB + kstep, voffB); PG8_STAGE(PG8_SA(1, 0), cA + kstep, voffA); PG8_STAGE(PG8_SB(1, 1), cB + hstep + kstep, voffB);
        PG8_WAIT_V(6); PG8_BAR;
    } else {
        PG8_STAGE(PG8_SB(0, 0), cB, voffB); PG8_STAGE(PG8_SA(0, 0), cA, voffA); PG8_STAGE(PG8_SB(0, 1), cB + hstep, voffB); PG8_STAGE(PG8_SA(0, 1), cA + hstep, voffA);
        if (wr == 1) PG8_BAR;
        PG8_WAIT_V(4); PG8_BAR;
        PG8_STAGE(PG8_SB(1, 0), cB + kstep, voffB); PG8_STAGE(PG8_SA(1, 0), cA + kstep, voffA); PG8_STAGE(PG8_SB(1, 1), cB + hstep + kstep, voffB);
        PG8_WAIT_V(6); PG8_BAR;
    }
    for (;;) {
        const bool has_next = S.next(ui + 1, nxt);
        const char* nA = has_next ? (const char*)g.A + (size_t)nxt.pm * tstep : cA; const char* nB = has_next ? (const char*)g.Bt + (size_t)nxt.pn * tstep : cB;
        for (int t = 0; t < nt; t += 2) {
            const bool last = (t == nt - 2);
            const char* a1 = cA + (size_t)(t + 1) * kstep;
            const char* a2 = last ? nA : cA + (size_t)(t + 2) * kstep; const char* b2 = last ? nB : cB + (size_t)(t + 2) * kstep;
            const char* a3 = a2 + kstep; const char* b3 = b2 + kstep;
            if (last && has_next) S.a_ready(nxt);
            if constexpr (SP2) {
            PG8_LDB(B0, 0, 0); PG8_LDB(B1, 0, 1); PG8_SCHED; PG8_LDA(At, 0, 0); PG8_STAGE(PG8_SA(1, 1), a1 + hstep, voffA);
            PG8_WAIT_V(8); PG8_WAIT_L(0); PG8_BAR; PG8_MMA(0, 0, At, B0); PG8_MMA(0, 1, At, B1); PG8_BAR; PG8_SCHED;
            PG8_LDA(At, 0, 1); PG8_STAGE(PG8_SB(0, 0), b2, voffB); PG8_STAGE(PG8_SB(0, 1), b2 + hstep, voffB); PG8_STAGE(PG8_SA(0, 0), a2, voffA);
            PG8_WAIT_V(8); PG8_WAIT_L(0); PG8_BAR; PG8_MMA(1, 0, At, B0); PG8_MMA(1, 1, At, B1); PG8_BAR; PG8_SCHED;
            PG8_LDB(B0, 1, 0); PG8_LDB(B1, 1, 1); PG8_SCHED; PG8_LDA(At, 1, 0); PG8_STAGE(PG8_SA(0, 1), a2 + hstep, voffA);
            PG8_WAIT_V(8); PG8_WAIT_L(0); PG8_BAR; PG8_MMA(0, 0, At, B0); PG8_MMA(0, 1, At, B1); PG8_BAR; PG8_SCHED;
            PG8_LDA(At, 1, 1); PG8_STAGE(PG8_SB(1, 0), b3, voffB); PG8_STAGE(PG8_SB(1, 1), b3 + hstep, voffB); PG8_STAGE(PG8_SA(1, 0), a3, voffA);
            PG8_WAIT_V(8); PG8_WAIT_L(0); PG8_BAR; PG8_MMA(1, 0, At, B0); PG8_MMA(1, 1, At, B1); PG8_BAR; PG8_SCHED;
            } else {
            PG8_LDB(B0, 0, 0); PG8_SCHED; PG8_LDA(At, 0, 0); PG8_STAGE(PG8_SA(1, 1), a1 + hstep, voffA);
            PG8_WAIT_L(8); PG8_BAR; PG8_WAIT_L(0); PG8_MMA(0, 0, At, B0); PG8_BAR; PG8_SCHED;
            PG8_LDB(B1, 0, 1); PG8_STAGE(PG8_SB(0, 0), b2, voffB);
            PG8_BAR; PG8_WAIT_L(0); PG8_MMA(0, 1, At, B1); PG8_BAR;
            PG8_LDA(At, 0, 1); PG8_STAGE(PG8_SA(0, 0), a2, voffA);
            PG8_BAR; PG8_WAIT_L(0); PG8_MMA(1, 0, At, B0); PG8_BAR; PG8_SCHED;
            PG8_STAGE(PG8_SB(0, 1), b2 + hstep, voffB);
            PG8_WAIT_V(6); PG8_BAR; PG8_MMA(1, 1, At, B1); PG8_BAR;
            PG8_LDB(B0, 1, 0); PG8_SCHED; PG8_LDA(At, 1, 0); PG8_STAGE(PG8_SA(0, 1), a2 + hstep, voffA);
            PG8_WAIT_L(8); PG8_BAR; PG8_WAIT_L(0); PG8_MMA(0, 0, At, B0); PG8_BAR; PG8_SCHED;
            PG8_LDB(B1, 1, 1); PG8_STAGE(PG8_SB(1, 0), b3, voffB);
            PG8_BAR; PG8_WAIT_L(0); PG8_MMA(0, 1, At, B1); PG8_BAR;
            PG8_LDA(At, 1, 1); PG8_STAGE(PG8_SA(1, 0), a3, voffA);
            PG8_BAR; PG8_WAIT_L(0); PG8_MMA(1, 0, At, B0); PG8_BAR; PG8_SCHED;
            PG8_STAGE(PG8_SB(1, 1), b3 + hstep, voffB);
            PG8_WAIT_V(6); PG8_BAR; PG8_MMA(1, 1, At, B1); PG8_BAR;
            }
        }
        if constexpr (ALIGN_EPI) { if (wr == 0) PG8_BAR; }
        if constexpr (!Epi::AFTER_DRAIN) { E(acc, cur, wr, wc, fr, fq); S.done(cur); }
        if (!has_next) break;
#pragma unroll
        for (int a = 0; a < 2; ++a)
#pragma unroll
            for (int b = 0; b < 2; ++b)
#pragma unroll
                for (int m = 0; m < 4; ++m)
#pragma unroll
                    for (int n = 0; n < 2; ++n) acc[a][b][m][n] = (f32x4){0.f, 0.f, 0.f, 0.f};
        cur = nxt; cA = nA; cB = nB; ++ui;
        if constexpr (ALIGN_EPI) { if (wr == 1) PG8_BAR; }
    }
    PG8_WAIT_V(0);
    if constexpr (!ALIGN_EPI) { if (wr == 0) PG8_BAR; }
    PG8_BAR;
    if constexpr (Epi::AFTER_DRAIN) { E.fused(acc, cur, wr, wc, fr, fq, lds, wid, lane); S.done(cur); }
#undef PG8_SA
#undef PG8_SB
#undef PG8_STAGE
#undef PG8_LDA
#undef PG8_LDB
#undef PG8_MMA
#undef PG8_WAIT_V
#undef PG8_WAIT_L
#undef PG8_BAR
#undef PG8_SCHED
}
}
#define GAS __attribute__((address_space(1)))
#define LAS __attribute__((address_space(3)))
typedef unsigned short bf16;
typedef unsigned v4u __attribute__((ext_vector_type(4)));
typedef float f32x4 __attribute__((ext_vector_type(4)));
typedef short bf16x8 __attribute__((ext_vector_type(8)));
typedef GAS unsigned gu32;
typedef GAS unsigned long long gu64;
#define RLX_AGENT __ATOMIC_RELAXED, __HIP_MEMORY_SCOPE_AGENT
#define LDS_WAIT() asm volatile("s_waitcnt lgkmcnt(0)" ::: "memory")
#define VM_WAIT() asm volatile("s_waitcnt vmcnt(0)" ::: "memory")
__device__ __forceinline__ unsigned long long rt() { return __builtin_amdgcn_s_memrealtime(); }
__device__ __forceinline__ unsigned f2bf(float f) { unsigned u = __builtin_bit_cast(unsigned, f); return (u + 0x7fffu + ((u >> 16) & 1u)) >> 16; }
__device__ __forceinline__ unsigned pk2(float lo, float hi) { return f2bf(lo) | (f2bf(hi) << 16); }

#define XB_TMO      128
#define XB_XCNT(j)  (256  + 64 * (j))
#define XB_XSUB(j)  (1280 + 64 * (j))
#define XB_XGEN(j)  (2304 + 64 * (j))
#define XB_TOP      3328
#define XB_TOPGEN   3392
#define XCD_BAR_WORDS 3456
#define XB_SPIN_CAP (1u << 18)

__device__ __forceinline__ unsigned xb_ld(unsigned* p)              { return __hip_atomic_load(p, __ATOMIC_RELAXED, __HIP_MEMORY_SCOPE_AGENT); }
__device__ __forceinline__ unsigned xb_add(unsigned* p, unsigned v) { return __hip_atomic_fetch_add(p, v, __ATOMIC_RELAXED, __HIP_MEMORY_SCOPE_AGENT); }
__device__ __forceinline__ unsigned xb_xcc_id() { return (unsigned)__builtin_amdgcn_s_getreg((3 << 11) | 20) & 0xFu; }
#define XB_SPIN(cond, bar) do { unsigned _sp = 0; while (cond) { __builtin_amdgcn_s_sleep(1); \
    if ((++_sp & 255u) == 0u) { if (xb_ld(&(bar)[XB_TMO])) break; if (_sp > XB_SPIN_CAP) { atomicAdd(&(bar)[XB_TMO], 1u); break; } } } } while (0)

struct XcdBarrier {
    unsigned* bar; unsigned x;
    volatile LAS unsigned* st;
};

__device__ __forceinline__ XcdBarrier xcd_barrier_post(unsigned* bar, volatile LAS unsigned* st) {
    XcdBarrier b; b.bar = bar; b.x = xb_xcc_id(); b.st = st;
    if (threadIdx.x == 0) (void)xb_add(&bar[XB_XCNT(b.x)], 1u);
    return b;
}
__device__ __forceinline__ void xcd_barrier_complete(unsigned* bar, unsigned x, unsigned& nloc, unsigned& nx) {
    const unsigned G = gridDim.x * gridDim.y * gridDim.z;
    unsigned sum, cnt, mine, sp = 0u;
    for (;;) {
        sum = 0u; cnt = 0u; mine = 0u;
#pragma unroll
        for (unsigned j = 0; j < 16; ++j) { const unsigned c = xb_ld(&bar[XB_XCNT(j)]); sum += c; cnt += (c > 0u) ? 1u : 0u; mine = (j == x) ? c : mine; }
        if (sum == G) break;
        __builtin_amdgcn_s_sleep(1);
        if ((++sp & 255u) == 0u) { if (xb_ld(&bar[XB_TMO])) break; if (sp > XB_SPIN_CAP) { atomicAdd(&bar[XB_TMO], 1u); break; } }
    }
    nloc = mine > 0u ? mine : 1u; nx = cnt > 0u ? cnt : 1u;
}

__device__ __forceinline__ void xcd_barrier(const XcdBarrier& b) {
    asm volatile("s_waitcnt vmcnt(0)" ::: "memory");
    __syncthreads();
    if (threadIdx.x == 0) {
        unsigned* bar = b.bar;
        __builtin_amdgcn_s_waitcnt(0);
        unsigned nloc = b.st[0], nx = b.st[1];
        if (nloc == 0u) { xcd_barrier_complete(bar, b.x, nloc, nx); b.st[0] = nloc; b.st[1] = nx; }
        const unsigned old = xb_add(&bar[XB_XSUB(b.x)], 1u);
        const unsigned gen = old / nloc;
        if (old + 1u == (gen + 1u) * nloc) {
            __builtin_amdgcn_fence(__ATOMIC_RELEASE, "agent");
            asm volatile("s_waitcnt vmcnt(0)" ::: "memory");
            const unsigned og = xb_add(&bar[XB_TOP], 1u);
            const unsigned tg = og / nx;
            if (og + 1u == (tg + 1u) * nx) xb_add(&bar[XB_TOPGEN], 1u);
            else XB_SPIN(xb_ld(&bar[XB_TOPGEN]) == tg, bar);
            __builtin_amdgcn_fence(__ATOMIC_ACQUIRE, "agent");
            xb_add(&bar[XB_XGEN(b.x)], 1u);
            asm volatile("s_waitcnt vmcnt(0)" ::: "memory");
        } else {
            XB_SPIN(xb_ld(&bar[XB_XGEN(b.x)]) == gen, bar);
            __builtin_amdgcn_fence(__ATOMIC_ACQUIRE, "agent");
            asm volatile("s_waitcnt vmcnt(0)" ::: "memory");
        }
    }
    __syncthreads();
}

constexpr int NWAVES = 8;
constexpr int MP = 32768, MS = 256, MT = MP + MS;
constexpr int DM = 1024, DIN = 4376, DINP = 4608, DFF = 2816, DCONV = 512, QW = 512;
constexpr int OFF_Q = 1024, OFF_KV = 1536, OFF_NG = 2304, OFF_MG = 2328;
constexpr int NSEQ = 36;
constexpr float EPS = 1e-6f;
constexpr size_t O_YP = 0, O_YS = 33554432, O_PCK = 33816576, O_PCV = O_PCK + 4194304, O_PSK = O_PCV + 4194304, O_PSV = O_PSK + 4194304,
                 O_PWK = O_PSV + 4194304, O_PWV = O_PWK + 262144, O_PCONV = O_PWV + 262144, O_SCK = O_PCONV + 61440, O_SCV = O_SCK + 32768,
                 O_SSK = O_SCV + 32768, O_SSV = O_SSK + 32768, O_SWK = O_SSV + 32768, O_SWV = O_SWK + 2097152, O_SCONV = O_SWV + 2097152, O_END = O_SCONV + 491520;
constexpr size_t MiB = 1u << 20;
constexpr size_t WS_CTL = 0, WS_MOD = 1 * MiB, ZERO_BYTES = 2 * MiB;
constexpr size_t WS_ROPE = 2 * MiB;
constexpr size_t WS_WIN = 5 * MiB, WS_WPW2 = 14 * MiB, WS_WNSA = 15 * MiB, WS_WOUT = 16 * MiB, WS_WGU = 18 * MiB, WS_WDOWN = 29 * MiB;
constexpr size_t WS_KC = 36 * MiB, WS_VC = 41 * MiB, WS_BG = 46 * MiB, WS_H = 50 * MiB, WS_U = 115 * MiB, WS_QP = 148 * MiB, WS_QR = 181 * MiB,
                 WS_CACT = 214 * MiB, WS_O = 247 * MiB, WS_GC = 280 * MiB, WS_GN = 345 * MiB, WS_T1 = 410 * MiB, WS_KWIN = 475 * MiB, WS_VWIN = 491 * MiB,
                 WS_ACT = 507 * MiB, WS_Z = 685 * MiB, WS_OC = WS_Z  , WS_Y1 = WS_GC  , WS_ZS = 760 * MiB  ,
                 WS_KSB = 1268 * MiB, WS_VST = 1276 * MiB, WS_KWB = 1284 * MiB, WS_VWT = 1292 * MiB, WS_KCB = 1300 * MiB, WS_VCT = 1301 * MiB, WS_END = 1302 * MiB;
constexpr float C2 = 0.125f * 1.4426950408889634f;
constexpr int ROPE_N = 8200;
constexpr int CW_BAR = 4096;
constexpr int RING_BYTES = 131072, LDS_BYTES = 163840, MISC_OFF = LDS_BYTES - 256;

typedef unsigned v2u __attribute__((ext_vector_type(2)));
typedef float f32x2 __attribute__((ext_vector_type(2)));
__device__ __forceinline__ float bf2f(unsigned short b) { return __uint_as_float(((unsigned)b) << 16); }
__device__ __forceinline__ float wave_sum(float v) {
#pragma unroll
    for (int o = 1; o < 64; o <<= 1) v += __shfl_xor(v, o);
    return v;
}
__device__ __forceinline__ float wave_max(float v) {
#pragma unroll
    for (int o = 1; o < 64; o <<= 1) v = fmaxf(v, __shfl_xor(v, o));
    return v;
}
__device__ __forceinline__ unsigned dpp_x1(unsigned v) { return (unsigned)__builtin_amdgcn_update_dpp(0, (int)v, 0xB1, 0xF, 0xF, false); }
__device__ __forceinline__ unsigned dpp_x2(unsigned v) { return (unsigned)__builtin_amdgcn_update_dpp(0, (int)v, 0x4E, 0xF, 0xF, false); }
__device__ __forceinline__ unsigned umax_x16(unsigned v) { auto r = __builtin_amdgcn_permlane16_swap(v, v, false, false); return r[0] > r[1] ? r[0] : r[1]; }
__device__ __forceinline__ unsigned umax_x32(unsigned v) { auto r = __builtin_amdgcn_permlane32_swap(v, v, false, false); return r[0] > r[1] ? r[0] : r[1]; }
__device__ __forceinline__ float fsum_x16(float v) { auto r = __builtin_amdgcn_permlane16_swap(__float_as_uint(v), __float_as_uint(v), false, false); return __uint_as_float(r[0]) + __uint_as_float(r[1]); }
__device__ __forceinline__ float fsum_x32(float v) { auto r = __builtin_amdgcn_permlane32_swap(__float_as_uint(v), __float_as_uint(v), false, false); return __uint_as_float(r[0]) + __uint_as_float(r[1]); }
__device__ __forceinline__ float fmax_x16(float v) { auto r = __builtin_amdgcn_permlane16_swap(__float_as_uint(v), __float_as_uint(v), false, false); return fmaxf(__uint_as_float(r[0]), __uint_as_float(r[1])); }
__device__ __forceinline__ float fmax_x32(float v) { auto r = __builtin_amdgcn_permlane32_swap(__float_as_uint(v), __float_as_uint(v), false, false); return fmaxf(__uint_as_float(r[0]), __uint_as_float(r[1])); }
__device__ __forceinline__ float dpp_x1f(float v) { return __uint_as_float(dpp_x1(__float_as_uint(v))); }
__device__ __forceinline__ float dpp_x2f(float v) { return __uint_as_float(dpp_x2(__float_as_uint(v))); }
__device__ __forceinline__ unsigned dpp_x4(unsigned v) { const int t = __builtin_amdgcn_update_dpp(0, (int)v, 0x141, 0xF, 0xF, false); return (unsigned)__builtin_amdgcn_update_dpp(0, t, 0x1B, 0xF, 0xF, false); }
__device__ __forceinline__ unsigned dpp_x8(unsigned v) { const int t = __builtin_amdgcn_update_dpp(0, (int)v, 0x140, 0xF, 0xF, false); return (unsigned)__builtin_amdgcn_update_dpp(0, t, 0x141, 0xF, 0xF, false); }
__device__ __forceinline__ float sigm(float x) { return 1.0f / (1.0f + __expf(-x)); }
__device__ __forceinline__ float wsum(float v) { v += dpp_x1f(v); v += dpp_x2f(v); v += __uint_as_float(dpp_x4(__float_as_uint(v))); v += __uint_as_float(dpp_x8(__float_as_uint(v))); v = fsum_x16(v); return fsum_x32(v); }
__device__ __forceinline__ float wmax(float v) { v = fmaxf(v, dpp_x1f(v)); v = fmaxf(v, dpp_x2f(v)); v = fmaxf(v, __uint_as_float(dpp_x4(__float_as_uint(v)))); v = fmaxf(v, __uint_as_float(dpp_x8(__float_as_uint(v)))); v = fmax_x16(v); return fmax_x32(v); }
__device__ __forceinline__ int mrow(int r) { return r < MP ? (r >> 13) : 4 + ((r - MP) >> 3); }
__device__ __forceinline__ int rope_idx(int r) { return r < MP ? (r & 8191) : 8192 + ((r - MP) & 7); }
__device__ __forceinline__ int perm64(int u) { return (u & 32) | (((u >> 2) & 3) << 3) | (((u >> 4) & 1) << 2) | (u & 3); }
__device__ __forceinline__ int perm128(int u) { return (u & ~31) | (((u >> 2) & 3) << 3) | (((u >> 4) & 1) << 2) | (u & 3); }
__device__ __forceinline__ size_t kc_off(int s) { return s < 4 ? (size_t)s * 128 * 128 : (size_t)4 * 128 * 128 + (size_t)(s - 4) * 257 * 128; }

struct Args { const float* in[33]; float* out; unsigned char* ws; int ph_lo, ph_hi; };

__device__ __forceinline__ int front_rowmap(int n) {
    if (n < 1024) { const int nn = n >= 512 ? 1 : 0, ch = n & 511; return 256 * (ch >> 7) + 128 * ((ch >> 6) & 1) + 32 * ((ch >> 4) & 3) + 8 * ((ch >> 2) & 3) + 4 * nn + (ch & 3); }
    if (n < OFF_KV) { const int hd = n - OFF_Q, h = hd >> 6, d = hd & 63; return 256 * (4 + (h >> 2)) + 128 * (d >> 5) + 32 * (h & 3) + (d & 31); }
    if (n < OFF_NG) { const int x = n - OFF_KV, j = x >> 7, kvh = (x >> 6) & 1, d = x & 63; return 256 * (6 + (j >> 1)) + 128 * (d >> 5) + 32 * ((j & 1) * 2 + kvh) + (d & 31); }
    if (n < OFF_MG) return 256 * 17 + (n - OFF_NG);
    return 256 * 9 + (n - OFF_MG);
}
__device__ __forceinline__ int gu_rowmap(int j) { const int rem = j & 127; return 256 * (j >> 7) + 128 * ((rem >> 2) & 1) + 32 * (rem >> 5) + 8 * ((rem >> 3) & 3) + (rem & 3); }
template <int MODE> __device__ __forceinline__ int rowmap(int n) { return MODE == 0 ? n : (MODE == 1 ? gu_rowmap(n) : (MODE == 2 ? gu_rowmap(n) + 4 : front_rowmap(n))); }
template <int MODE> __device__ __forceinline__ void transpose_item(const float* W, int K, int N, bf16* WT, LAS float* scr, int item, int lane) {
    const int nblk = (N + 31) / 32, kb = item / nblk, nb = item % nblk, k0 = 64 * kb, n0 = 32 * nb;
    const int nn = n0 + (lane & 31);
    float tv[32];
#pragma unroll
    for (int i = 0; i < 32; ++i) { const int kk = 2 * i + (lane >> 5); tv[i] = W[(size_t)(k0 + kk) * N + (nn < N ? nn : N - 1)]; }
#pragma unroll
    for (int i = 0; i < 32; ++i) { const int kk = 2 * i + (lane >> 5); scr[kk * 33 + (lane & 31)] = (nn < N) ? tv[i] : 0.f; }
    LDS_WAIT(); asm volatile("" ::: "memory");
    const int c = lane & 7;
#pragma unroll
    for (int j = 0; j < 4; ++j) { const int nl = (lane >> 3) + 8 * j, n = n0 + nl; const LAS float* s = scr + (8 * c) * 33 + nl;
        v4u o; o.x = pk2(s[0 * 33], s[1 * 33]); o.y = pk2(s[2 * 33], s[3 * 33]); o.z = pk2(s[4 * 33], s[5 * 33]); o.w = pk2(s[6 * 33], s[7 * 33]);
        if (n < N) *(v4u*)(WT + (size_t)rowmap<MODE>(n) * K + k0 + 8 * c) = o; }
    LDS_WAIT(); asm volatile("" ::: "memory");
}
__device__ __forceinline__ f32x2 compress_block(const float* rows, int nvalid, const float* pm, const float* w, float* outp, LAS float* scr, int lane) {
    const int c4 = 4 * (lane & 31), half = lane >> 5, d = c4 & 63, nh = nvalid >> 1;
    f32x4 acc = {0.f, 0.f, 0.f, 0.f};
    for (int i0 = 0; i0 < nh; i0 += 8) {
        f32x4 x[8], m[8];
#pragma unroll
        for (int q = 0; q < 8; ++q) { const bool ok = i0 + q < nh; const int j = 2 * (ok ? i0 + q : 0) + half;
            x[q] = *(const f32x4*)(rows + (size_t)j * 128 + c4); m[q] = *(const f32x4*)(pm + j * 64 + d); if (!ok) x[q] = (f32x4){0.f, 0.f, 0.f, 0.f}; }
#pragma unroll
        for (int q = 0; q < 8; ++q) acc += x[q] * (m[q] + 1.0f);
    }
#pragma unroll
    for (int i = 0; i < 4; ++i) acc[i] += __shfl_xor(acc[i], 32);
    if (lane < 32) *(LAS f32x4*)(scr + c4) = acc * (1.0f / 64.0f);
    LDS_WAIT(); asm volatile("" ::: "memory");
    const int kvh = lane >> 5, e = 2 * (lane & 31);
    f32x2 o = {0.f, 0.f};
#pragma unroll 8
    for (int dd = 0; dd < 64; ++dd) { const float sv = scr[kvh * 64 + dd]; const f32x2 ww = *(const f32x2*)(w + dd * 64 + e); o.x += sv * ww.x; o.y += sv * ww.y; }
    *(f32x2*)(outp + kvh * 64 + e) = o;
    LDS_WAIT(); asm volatile("" ::: "memory");
    return o;
}
__device__ __forceinline__ f32x2 summary_finish(f32x4 acc, const LAS float* wl, float* outp, LAS float* scr, int lane) {
    const int c4 = 4 * (lane & 31);
#pragma unroll
    for (int i = 0; i < 4; ++i) acc[i] = fsum_x32(acc[i]);
    if (lane < 32) *(LAS f32x4*)(scr + c4) = acc * (1.0f / 64.0f);
    LDS_WAIT(); asm volatile("" ::: "memory");
    const int kvh = lane >> 5, e = 2 * (lane & 31);
    f32x2 o = {0.f, 0.f};
#pragma unroll 16
    for (int dd = 0; dd < 64; ++dd) { const float sv = scr[kvh * 64 + dd]; const f32x2 ww = *(const LAS f32x2*)(wl + dd * 64 + e); o.x += sv * ww.x; o.y += sv * ww.y; }
    *(f32x2*)(outp + kvh * 64 + e) = o;
    LDS_WAIT(); asm volatile("" ::: "memory");
    return o;
}
template <int NV> __device__ __forceinline__ f32x2 compress_one(const float* rows, const LAS float* pml, const LAS float* wl, float* outp, LAS float* scr, int lane) {
    const int c4 = 4 * (lane & 31), half = lane >> 5, d = c4 & 63;
    const f32x4* s4 = (const f32x4*)(rows + (size_t)half * 128 + c4);
    f32x4 x[NV / 2];
#pragma unroll
    for (int q = 0; q < NV / 2; ++q) x[q] = s4[(size_t)q * 64];
    f32x4 acc = {0.f, 0.f, 0.f, 0.f};
#pragma unroll
    for (int q = 0; q < NV / 2; ++q) { const f32x4 m = *(const LAS f32x4*)(pml + (2 * q + half) * 64 + d); acc += x[q] * (m + 1.0f); }
    return summary_finish(acc, wl, outp, scr, lane);
}
__device__ __forceinline__ void compress_page(const float* src, const LAS float* pml, const LAS float* wl, float* dst, LAS float* scr, int lane) {
    const int c4 = 4 * (lane & 31), half = lane >> 5, d = c4 & 63;
    const f32x4* s4 = (const f32x4*)(src + (size_t)half * 128 + c4);
    f32x4 xa[16], xb[16];
#pragma unroll
    for (int q = 0; q < 16; ++q) xa[q] = s4[(size_t)q * 64];
#pragma unroll
    for (int q = 0; q < 16; ++q) xb[q] = s4[(size_t)(16 + q) * 64];
    auto consume = [&](const f32x4 (&x)[16], const int i0, f32x4 acc) __attribute__((always_inline)) {
#pragma unroll
        for (int q = 0; q < 16; ++q) { const int j = 2 * (i0 + q) + half; const f32x4 m = *(const LAS f32x4*)(pml + j * 64 + d); acc += x[q] * (m + 1.0f); }
        return acc; };
    auto finish = [&](f32x4 acc, float* outp) __attribute__((always_inline)) { (void)summary_finish(acc, wl, outp, scr, lane); };
    f32x4 acc = {0.f, 0.f, 0.f, 0.f};
    acc = consume(xa, 0, acc);
#pragma unroll
    for (int q = 0; q < 16; ++q) xa[q] = s4[(size_t)(32 + q) * 64];
    acc = consume(xb, 16, acc);
#pragma unroll
    for (int q = 0; q < 16; ++q) xb[q] = s4[(size_t)(48 + q) * 64];
    finish(acc, dst);
    acc = (f32x4){0.f, 0.f, 0.f, 0.f};
    acc = consume(xa, 0, acc); acc = consume(xb, 16, acc);
    finish(acc, dst + 128);
}
__device__ __forceinline__ void phase0(const Args& a, LAS unsigned char* lds, int gw, int NGW, int wave, int lane_) {
    int lane = lane_;
    unsigned char* ws = a.ws;
    LAS float* scr = (LAS float*)(lds + wave * 10240);
    LAS float* tabs = (LAS float*)(lds + 81920);
    { const int t = wave * 64 + lane; const f32x4* g0 = (const f32x4*)a.in[23]; const f32x4* g1 = (const f32x4*)a.in[25]; const f32x4* g2 = (const f32x4*)a.in[24]; const f32x4* g3 = (const f32x4*)a.in[26];
      for (int i = t; i < 1024; i += NWAVES * 64) { ((LAS f32x4*)tabs)[i] = g0[i]; ((LAS f32x4*)tabs)[1024 + i] = g1[i]; ((LAS f32x4*)tabs)[2048 + i] = g2[i]; ((LAS f32x4*)tabs)[3072 + i] = g3[i]; } }
    __syncthreads();
    constexpr int I_IN = 16 * 137, I_PW2 = 8 * 32, I_NSA = 8 * 32, I_OUT = 16 * 32, I_G = 16 * 88, I_U = 16 * 88, I_D = 44 * 32;
    constexpr int N_TR = I_IN + I_PW2 + I_NSA + I_OUT + I_G + I_U + I_D;
    constexpr int N_MOD = 96 * 16;
    constexpr int N_CMP = 32 * 128 * 2;
    constexpr int N_ALL = N_TR + N_MOD + N_CMP; static_assert(N_ALL % 2 == 0 && N_ALL % 29 == 0 && N_ALL % 37 == 0 && N_ALL == 17168, "4099 must stay coprime to N_ALL");
    constexpr int N_LIGHT = N_TR + N_MOD;
    int il = gw, ic = gw; bool turn = (gw & 1) != 0;
#pragma nounroll
    while (il < N_LIGHT || ic < N_CMP) {
        int r; asm volatile("" : "+v"(lane));
        if ((turn && il < N_LIGHT) || ic >= N_CMP) { r = il; il += NGW; } else { r = N_LIGHT + ic; ic += NGW; }
        turn = !turn;
        if (r < N_TR) {
            if (r < I_IN) { transpose_item<3>(a.in[15], 1024, DIN, (bf16*)(ws + WS_WIN), scr, r, lane); continue; } r -= I_IN;
            if (r < I_PW2) { transpose_item<0>(a.in[22], 512, 1024, (bf16*)(ws + WS_WPW2), scr, r, lane); continue; } r -= I_PW2;
            if (r < I_NSA) { transpose_item<0>(a.in[27], 512, 1024, (bf16*)(ws + WS_WNSA), scr, r, lane); continue; } r -= I_NSA;
            if (r < I_OUT) { transpose_item<0>(a.in[28], 1024, 1024, (bf16*)(ws + WS_WOUT), scr, r, lane); continue; } r -= I_OUT;
            if (r < I_G) { transpose_item<1>(a.in[30], 1024, DFF, (bf16*)(ws + WS_WGU), scr, r, lane); continue; } r -= I_G;
            if (r < I_U) { transpose_item<2>(a.in[31], 1024, DFF, (bf16*)(ws + WS_WGU), scr, r, lane); continue; } r -= I_U;
            transpose_item<0>(a.in[32], DFF, 1024, (bf16*)(ws + WS_WDOWN), scr, r, lane); continue;
        }
        r -= N_TR;
        if (r < N_MOD) {
            const int cb = r % 96, kb = r / 96, j = cb * 64 + lane, k0 = kb * 64;
            for (int mb = 0; mb < NSEQ; ++mb) { const float* cp = mb < 4 ? a.in[10] + mb * 1024 : a.in[11] + (mb - 4) * 1024; const float cv = cp[k0 + lane]; scr[mb * 64 + lane] = cv * sigm(cv); }
            LDS_WAIT(); asm volatile("" ::: "memory");
            float acc[NSEQ];
#pragma unroll
            for (int mb = 0; mb < NSEQ; ++mb) acc[mb] = 0.f;
            const float* wp = a.in[12] + (size_t)k0 * 6144 + j;
#pragma unroll 4
            for (int k4 = 0; k4 < 16; ++k4) {
                const float w0 = wp[(size_t)(4 * k4 + 0) * 6144], w1 = wp[(size_t)(4 * k4 + 1) * 6144], w2 = wp[(size_t)(4 * k4 + 2) * 6144], w3 = wp[(size_t)(4 * k4 + 3) * 6144];
#pragma unroll
                for (int mb = 0; mb < NSEQ; ++mb) { const f32x4 q = *(const LAS f32x4*)(scr + mb * 64 + 4 * k4); acc[mb] += q.x * w0 + q.y * w1 + q.z * w2 + q.w * w3; }
            }
            float* modp = (float*)(ws + WS_MOD);
            const float bias = (kb == 0) ? a.in[13][j] : 0.f;
#pragma unroll
            for (int mb = 0; mb < NSEQ; ++mb) atomicAdd(modp + mb * 6144 + j, acc[mb] + bias);
            LDS_WAIT(); asm volatile("" ::: "memory");
            continue;
        }
        r -= N_MOD;
        {
            const int kv = r & 1, pg = (r >> 1) & 127, sb = r >> 8;
            const int page = ((const int*)a.in[9])[sb * 128 + pg];
            const float* src = (kv ? a.in[3] : a.in[2]) + (size_t)page * (128 * 128);
            float* dst = (float*)(ws + (kv ? WS_VC : WS_KC)) + kc_off(4 + sb) + (size_t)(2 * pg) * 128;
            compress_page(src, tabs + (kv ? 4096 : 0), tabs + (kv ? 12288 : 8192), dst, scr, lane);
        }
    }
    const int gt = gw * 64 + lane, NT = NGW * 64;
    { v4u* p = (v4u*)((bf16*)(ws + WS_WIN) + (size_t)DIN * 1024); const int n16 = (DINP - DIN) * 1024 * 2 / 16; const v4u z = {0u, 0u, 0u, 0u}; for (int i = gt; i < n16; i += NT) p[i] = z; }
    { float* rc = (float*)(ws + WS_ROPE); float* rs = rc + ROPE_N * 32;
      for (int i = gt; i < ROPE_N * 32; i += NT) {
          const int j = i & 31, p = i >> 5; const int pos = p < 8192 ? p : 16384 + (p - 8192);
          double inv = 1.0; for (int q = 0; q < j; ++q) inv *= 0.7498942093324558;
          const double ang = (double)pos * inv;
          const double kq = __builtin_rint(ang * 0.6366197723675814);
          double rr = __builtin_fma(-kq, 1.5707963267948966, ang); rr = __builtin_fma(-kq, 6.123233995736766e-17, rr);
          const double r2 = rr * rr;
          const double sn = rr * (1.0 + r2 * (-1.0 / 6 + r2 * (1.0 / 120 + r2 * (-1.0 / 5040 + r2 * (1.0 / 362880 + r2 * (-1.0 / 39916800 + r2 * (1.0 / 6227020800.0)))))));
          const double cs = 1.0 + r2 * (-0.5 + r2 * (1.0 / 24 + r2 * (-1.0 / 720 + r2 * (1.0 / 40320 + r2 * (-1.0 / 3628800 + r2 * (1.0 / 479001600.0))))));
          const int qd = ((int)(long long)kq) & 3;
          const double c = (qd == 0) ? cs : (qd == 1) ? -sn : (qd == 2) ? -cs : sn;
          const double s = (qd == 0) ? sn : (qd == 1) ? cs : (qd == 2) ? -sn : -cs;
          rc[i] = (float)c; rs[i] = (float)s; } }
    { const int per = 504 * 128 / 4, n4 = 32 * per;
      for (int i = gt; i < 2 * n4; i += NT) { const int kv = i >= n4, ii = kv ? i - n4 : i, sb = ii / per, o = ii % per;
          const f32x4 v = ((const f32x4*)((kv ? a.in[7] : a.in[6]) + (size_t)sb * 512 * 128 + 8 * 128))[o];
          ((f32x4*)(a.out + (kv ? O_SWV : O_SWK) + (size_t)sb * 512 * 128))[o] = v; } }
    { const int per = 22 * 512 / 4, n4 = 32 * per;
      for (int i = gt; i < n4; i += NT) { const int sb = i / per, o = i % per;
          ((f32x4*)(a.out + O_SCONV + (size_t)sb * 30 * 512))[o] = ((const f32x4*)(a.in[8] + (size_t)sb * 30 * 512 + 8 * 512))[o]; } }
}

__device__ __forceinline__ void norm_rows(const float* xp, const float* xs, const float* g, const float* modp, int sh_off, int sc_off, bf16* H, int gw, int NGW, int lane) {
    for (int r = gw; r < MT; r += NGW) {
        const f32x4* xr = (const f32x4*)(r < MP ? xp + (size_t)r * 1024 : xs + (size_t)(r - MP) * 1024) + lane;
        const float* mp = modp + (size_t)mrow(r) * 6144;
        f32x4 v[4]; float ss = 0.f;
#pragma unroll
        for (int j = 0; j < 4; ++j) { v[j] = xr[64 * j]; ss += (v[j].x * v[j].x + v[j].y * v[j].y) + (v[j].z * v[j].z + v[j].w * v[j].w); }
        const float rstd = 1.0f / sqrtf(wave_sum(ss) * (1.0f / 1024.0f) + EPS);
        v2u* o8 = (v2u*)(H + (size_t)r * 1024) + lane;
#pragma unroll
        for (int j = 0; j < 4; ++j) { const int c = 4 * (lane + 64 * j);
            const f32x4 gg = *(const f32x4*)(g + c), sc = *(const f32x4*)(mp + sc_off + c), sh = *(const f32x4*)(mp + sh_off + c);
            const f32x4 h = (v[j] * rstd * gg) * (1.0f + sc) + sh;
            v2u w; w.x = pk2(h.x, h.y); w.y = pk2(h.z, h.w); o8[64 * j] = w; }
    }
}

__device__ __forceinline__ void norm_rows_bf16(const bf16* X, const float* g, const float* modp, int sh_off, int sc_off, bf16* H, int gw, int NGW, int lane) {
    for (int r = gw; r < MT; r += NGW) {
        const v2u* xr = (const v2u*)(X + (size_t)r * 1024) + lane;
        const float* mp = modp + (size_t)mrow(r) * 6144;
        f32x4 v[4]; float ss = 0.f;
#pragma unroll
        for (int j = 0; j < 4; ++j) { const v2u t = xr[64 * j]; v[j] = (f32x4){pg8::bf_lo(t.x), pg8::bf_hi(t.x), pg8::bf_lo(t.y), pg8::bf_hi(t.y)}; ss += (v[j].x * v[j].x + v[j].y * v[j].y) + (v[j].z * v[j].z + v[j].w * v[j].w); }
        const float rstd = 1.0f / sqrtf(wsum(ss) * (1.0f / 1024.0f) + EPS);
        v2u* o8 = (v2u*)(H + (size_t)r * 1024) + lane;
#pragma unroll
        for (int j = 0; j < 4; ++j) { const int c = 4 * (lane + 64 * j);
            const f32x4 gg = *(const f32x4*)(g + c), sc = *(const f32x4*)(mp + sc_off + c), sh = *(const f32x4*)(mp + sh_off + c);
            const f32x4 h = (v[j] * rstd * gg) * (1.0f + sc) + sh;
            v2u w; w.x = pk2(h.x, h.y); w.y = pk2(h.z, h.w); o8[64 * j] = w; }
    }
}

__device__ __forceinline__ void unpack8(const v4u p, float (&x)[8]) { x[0] = pg8::bf_lo(p.x); x[1] = pg8::bf_hi(p.x); x[2] = pg8::bf_lo(p.y); x[3] = pg8::bf_hi(p.y); x[4] = pg8::bf_lo(p.z); x[5] = pg8::bf_hi(p.z); x[6] = pg8::bf_lo(p.w); x[7] = pg8::bf_hi(p.w); }
__device__ __forceinline__ void phase_conv(const Args& a, LAS unsigned char* lds, int vcu, int G, int gw, int NGW, int wave, int lane, int tid_) {
    unsigned char* ws = a.ws; const int tid = tid_;
    constexpr int TAPB = 31 * 512 * 4;
    { LAS f32x4* wl4 = (LAS f32x4*)lds; const f32x4* wg4 = (const f32x4*)a.in[18]; for (int i = tid; i < 31 * 512 / 4; i += NWAVES * 64) wl4[i] = wg4[i]; }
    const LAS float* wl = (const LAS float*)lds; LAS unsigned char* rl = lds + TAPB;
    const bf16* U = (const bf16*)(ws + WS_U); bf16* CACT = (bf16*)(ws + WS_CACT);
    const int c0_ = lane * 8;
    auto do_tile = [&](const bool smp, const int idx) __attribute__((always_inline)) {
        int tid = tid_, c0 = c0_; asm volatile("" : "+v"(tid)); asm volatile("" : "+v"(c0));
        const int sb = idx, r0 = smp ? MP + 8 * sb : 64 * idx, t0 = r0 & 8191, ntok = smp ? 8 : 64, nrows = ntok + 30;
        __syncthreads();
        if (smp) {
            for (int q = tid; q < nrows * 64; q += NWAVES * 64) { const int k = q >> 6, cc = (q & 63) * 8; v4u v = {0u, 0u, 0u, 0u};
                if (k < 30) { const float* sp = a.in[8] + (size_t)(sb * 30 + k) * 512 + cc; const f32x4 p0 = *(const f32x4*)sp, p1 = *(const f32x4*)(sp + 4);
                    v.x = pk2(p0.x, p0.y); v.y = pk2(p0.z, p0.w); v.z = pk2(p1.x, p1.y); v.w = pk2(p1.z, p1.w); }
                else v = *(const v4u*)(U + (size_t)(r0 + k - 30) * 512 + cc);
                *(LAS v4u*)(rl + k * 1024 + (q & 63) * 16) = v; }
        } else {
            v4u st[12];
#pragma unroll
            for (int i = 0; i < 12; ++i) { const int q = tid + i * (NWAVES * 64), k = q >> 6, cc = (q & 63) * 8; st[i] = (v4u){0u, 0u, 0u, 0u};
                if (q < 94 * 64 && t0 - 30 + k >= 0) st[i] = *(const v4u*)(U + (size_t)(r0 - 30 + k) * 512 + cc); }
#pragma unroll
            for (int i = 0; i < 12; ++i) { const int q = tid + i * (NWAVES * 64), k = q >> 6; if (q < 94 * 64) *(LAS v4u*)(rl + k * 1024 + (q & 63) * 16) = st[i]; }
        }
        __syncthreads();
        if (8 * wave < ntok) {
            float acc[8][8];
            { const f32x4 b0 = *(const f32x4*)(a.in[19] + c0), b1 = *(const f32x4*)(a.in[19] + c0 + 4);
#pragma unroll
              for (int tt = 0; tt < 8; ++tt) { acc[tt][0] = b0.x; acc[tt][1] = b0.y; acc[tt][2] = b0.z; acc[tt][3] = b0.w; acc[tt][4] = b1.x; acc[tt][5] = b1.y; acc[tt][6] = b1.z; acc[tt][7] = b1.w; } }
            const LAS unsigned char* rw = rl + (8 * wave) * 1024 + lane * 16;
            f32x4 w0[8], w1[8];
#pragma unroll
            for (int i = 0; i < 8; ++i) { w0[i] = (f32x4){0.f, 0.f, 0.f, 0.f}; w1[i] = (f32x4){0.f, 0.f, 0.f, 0.f}; }
#pragma nounroll
            for (int rb = 0; rb < 40; rb += 8) {
#pragma unroll
                for (int i = 0; i < 8; ++i) { const int rr = rb + i;
                    if (rr < 38) {
                        f32x4 a0 = {0.f, 0.f, 0.f, 0.f}, a1 = {0.f, 0.f, 0.f, 0.f};
                        if (rr < 31) { a0 = *(const LAS f32x4*)(wl + rr * 512 + c0); a1 = *(const LAS f32x4*)(wl + rr * 512 + c0 + 4); }
                        w0[i] = a0; w1[i] = a1;
                        float x[8]; unpack8(*(const LAS v4u*)(rw + rr * 1024), x);
#pragma unroll
                        for (int tt = 0; tt < 8; ++tt) { const f32x4 u0 = w0[(i - tt) & 7], u1 = w1[(i - tt) & 7];
                            acc[tt][0] += x[0] * u0.x; acc[tt][1] += x[1] * u0.y; acc[tt][2] += x[2] * u0.z; acc[tt][3] += x[3] * u0.w;
                            acc[tt][4] += x[4] * u1.x; acc[tt][5] += x[5] * u1.y; acc[tt][6] += x[6] * u1.z; acc[tt][7] += x[7] * u1.w; } } }
            }
            const f32x4 g0 = *(const f32x4*)(a.in[20] + c0), g1 = *(const f32x4*)(a.in[20] + c0 + 4), e0 = *(const f32x4*)(a.in[21] + c0), e1 = *(const f32x4*)(a.in[21] + c0 + 4);
            const float lg[8] = {g0.x, g0.y, g0.z, g0.w, g1.x, g1.y, g1.z, g1.w}, lb[8] = {e0.x, e0.y, e0.z, e0.w, e1.x, e1.y, e1.z, e1.w};
#pragma unroll
            for (int tt = 0; tt < 8; ++tt) {
                float sm = 0.f;
#pragma unroll
                for (int i = 0; i < 8; ++i) sm += acc[tt][i];
                const float mean = wsum(sm) * (1.0f / 512.0f); float q = 0.f;
#pragma unroll
                for (int i = 0; i < 8; ++i) { acc[tt][i] -= mean; q += acc[tt][i] * acc[tt][i]; }
                const float rstd = 1.0f / sqrtf(wsum(q) * (1.0f / 512.0f) + EPS);
                float y[8];
#pragma unroll
                for (int i = 0; i < 8; ++i) { const float v = acc[tt][i] * rstd * lg[i] + lb[i]; y[i] = v * sigm(v); }
                v4u o; o.x = pk2(y[0], y[1]); o.y = pk2(y[2], y[3]); o.z = pk2(y[4], y[5]); o.w = pk2(y[6], y[7]);
                *(v4u*)(CACT + (size_t)(r0 + 8 * wave + tt) * 512 + c0) = o;
            }
        }
    };
    { int u = vcu; bool smpu = false;
#pragma nounroll
      for (;;) {
          if (!smpu && u >= 512) { smpu = true; u = G - 1 - vcu; }
          if (smpu && u >= 32) break;
          do_tile(smpu, u);
          u += G; } }
    __syncthreads();
    LAS float* scr = (LAS float*)(lds + wave * 1024);
    LAS float* tabs = (LAS float*)(lds + 8192);
    if (gw < 1024 + 64) {
        const f32x4* g0 = (const f32x4*)a.in[23]; const f32x4* g1 = (const f32x4*)a.in[25]; const f32x4* g2 = (const f32x4*)a.in[24]; const f32x4* g3 = (const f32x4*)a.in[26];
        for (int i = lane; i < 1024; i += 64) { ((LAS f32x4*)tabs)[i] = g0[i]; ((LAS f32x4*)tabs)[1024 + i] = g1[i]; ((LAS f32x4*)tabs)[2048 + i] = g2[i]; ((LAS f32x4*)tabs)[3072 + i] = g3[i]; }
    }
    LDS_WAIT(); __syncthreads();
    for (int it = gw; it < 1024 + 64; it += NGW) {
        if (it < 1024) { const int kv = it & 1, n = (it >> 1) & 127, b = it >> 8;
            const float* rows = a.out + (kv ? O_PCV : O_PCK) + (size_t)(b * 8192 + 64 * n) * 128;
            float* dst = (float*)(ws + (kv ? WS_VC : WS_KC)) + kc_off(b) + (size_t)n * 128;
            const f32x2 o = compress_one<64>(rows, tabs + (kv ? 4096 : 0), tabs + (kv ? 12288 : 8192), dst, scr, lane);
            const int kvh = lane >> 5, e = 2 * (lane & 31);
            if (!kv) { *(unsigned*)((bf16*)(ws + WS_KCB) + ((size_t)(b * 2 + kvh) * 128 + n) * 64 + e) = pk2(o.x, o.y); }
            else { bf16* vt = (bf16*)(ws + WS_VCT) + (size_t)(b * 2 + kvh) * 64 * 128 + perm128(n); vt[(size_t)e * 128] = (bf16)f2bf(o.x); vt[(size_t)(e + 1) * 128] = (bf16)f2bf(o.y); } }
        else { const int i2 = it - 1024, kv = i2 & 1, sb = i2 >> 1;
            const float* rows = a.out + (kv ? O_SCV : O_SCK) + (size_t)(sb * 8) * 128;
            float* dst = (float*)(ws + (kv ? WS_VC : WS_KC)) + kc_off(4 + sb) + (size_t)256 * 128;
            (void)compress_one<8>(rows, tabs + (kv ? 4096 : 0), tabs + (kv ? 12288 : 8192), dst, scr, lane); }
    }
}

template <int MODE> __device__ __forceinline__ void attn_item(const Args& a, int r, int kvh, LAS unsigned char* ldsb, int wave, int lane) {
    unsigned char* ws = a.ws; float* out = a.out;
    LAS float* scr = (LAS float*)(ldsb + wave * 16384);
    const bool smp = r >= MP; const int rs_ = r - MP, sb = rs_ >> 3, si = rs_ & 7, b = r >> 13;
    const int seq = smp ? 4 + sb : b, qpos = smp ? 16384 + si : (r & 8191), cur = qpos >> 6, NB = smp ? 257 : 128;
    LAS float* s_qp = scr;
    LAS float* s_qr = scr + 256;
    LAS float* s_p = scr + 512;
    const bf16* QP = (const bf16*)(ws + WS_QP) + (size_t)r * 512 + kvh * 256; const bf16* QR = (const bf16*)(ws + WS_QR) + (size_t)r * 512 + kvh * 256;
    float qn2[4];
#pragma unroll
    for (int g = 0; g < 4; ++g) { const float x = bf2f(QP[g * 64 + lane]), y = bf2f(QR[g * 64 + lane]); s_qp[lane * 4 + g] = x; s_qr[lane * 4 + g] = y; qn2[g] = wave_sum(y * y); }
    const float gks = wave_max(fabsf(a.in[17][64 + lane])), gkw = wave_max(fabsf(a.in[17][128 + lane]));
    float mref_s[4], mref_w[4];
#pragma unroll
    for (int g = 0; g < 4; ++g) { const float qn = sqrtf(qn2[g]) * 8.0f; mref_s[g] = qn * gks; mref_w[g] = qn * gkw; }
    LDS_WAIT(); asm volatile("" ::: "memory");
    const float* KC = (const float*)(ws + WS_KC) + kc_off(seq) + kvh * 64; const float* VC = (const float*)(ws + WS_VC) + kc_off(seq) + kvh * 64;
    const int n_ok = (qpos + 1) >> 6;
    float sc[5][4];
#pragma unroll
    for (int c = 0; c < 5; ++c) { const int n = lane + 64 * c;
#pragma unroll
        for (int g = 0; g < 4; ++g) sc[c][g] = 0.f;
        if (n < n_ok && n < NB) { const f32x4* kr = (const f32x4*)(KC + (size_t)n * 128);
#pragma unroll 4
            for (int d4 = 0; d4 < 16; ++d4) { const f32x4 k = kr[d4];
                const f32x4 q0 = *(const LAS f32x4*)(s_qp + (4 * d4 + 0) * 4), q1 = *(const LAS f32x4*)(s_qp + (4 * d4 + 1) * 4), q2 = *(const LAS f32x4*)(s_qp + (4 * d4 + 2) * 4), q3 = *(const LAS f32x4*)(s_qp + (4 * d4 + 3) * 4);
#pragma unroll
                for (int g = 0; g < 4; ++g) sc[c][g] += k.x * q0[g] + k.y * q1[g] + k.z * q2[g] + k.w * q3[g]; } } }
    float imp[5];
#pragma unroll
    for (int c = 0; c < 5; ++c) imp[c] = 0.f;
#pragma unroll
    for (int g = 0; g < 4; ++g) {
        float m = -INFINITY;
#pragma unroll
        for (int c = 0; c < 5; ++c) { const int n = lane + 64 * c; if (n < n_ok && n < NB) m = fmaxf(m, sc[c][g]); }
        m = wave_max(m); if (!(m > -INFINITY)) m = 0.f;
        float e[5], zs = 0.f;
#pragma unroll
        for (int c = 0; c < 5; ++c) { const int n = lane + 64 * c; e[c] = (n < n_ok && n < NB) ? __builtin_amdgcn_exp2f(sc[c][g] - m) : 0.f; zs += e[c]; }
        zs = wave_sum(zs); const float iz = 1.0f / fmaxf(zs, 1e-30f);
#pragma unroll
        for (int c = 0; c < 5; ++c) { const int n = lane + 64 * c; const float p = e[c] * iz; imp[c] += p; if (n < NB) s_p[n * 4 + g] = p; }
    }
    LDS_WAIT(); asm volatile("" ::: "memory");
    float o_cmp[4] = {0.f, 0.f, 0.f, 0.f};
    { const int nn = n_ok < NB ? n_ok : NB; const int nstart = MODE == 1 ? wave : 0, nstep = MODE == 1 ? NWAVES : 1;
      for (int n0 = nstart; n0 < nn; n0 += 8 * nstep) { float v[8];
#pragma unroll
          for (int q = 0; q < 8; ++q) { const int n = n0 + q * nstep; v[q] = VC[(size_t)(n < nn ? n : nstart) * 128 + lane]; }
#pragma unroll
          for (int q = 0; q < 8; ++q) { const int n = n0 + q * nstep; if (n < nn) { const f32x4 p = *(const LAS f32x4*)(s_p + n * 4);
#pragma unroll
              for (int g = 0; g < 4; ++g) o_cmp[g] += p[g] * v[q]; } } } }
    LDS_WAIT(); asm volatile("" ::: "memory");
    float score[5];
#pragma unroll
    for (int c = 0; c < 5; ++c) { const int n = lane + 64 * c;
        const bool forced = (n == 0) || (n == cur) || (n == cur - 1);
        score[c] = (n >= NB) ? -4.0f : (n <= cur ? imp[c] + (forced ? 8.0f : 0.f) : -1.0f); }
    const int* ptab = (const int*)a.in[9] + sb * 128;
    float l_sel[4] = {0.f, 0.f, 0.f, 0.f}, o_sel[4] = {0.f, 0.f, 0.f, 0.f};
    float last_bv = 0.f; bool ambiguous = false;
    unsigned skey[5];
#pragma unroll
    for (int c = 0; c < 5; ++c) { const int n = lane + 64 * c; skey[c] = (MODE == 1 && n < NB) ? ((__float_as_uint(score[c]) & ~511u) | (unsigned)(511 - n)) : 0u; }
    for (int round = 0; round < (MODE == 2 ? 17 : 16); ++round) {
        float bv = score[0]; int bi = lane;
        if (MODE == 1) { unsigned w = skey[0];
#pragma unroll
            for (int c = 1; c < 5; ++c) w = skey[c] > w ? skey[c] : w;
            { unsigned o; o = dpp_x1(w); w = o > w ? o : w; o = dpp_x2(w); w = o > w ? o : w; o = dpp_x4(w); w = o > w ? o : w; o = dpp_x8(w); w = o > w ? o : w; w = umax_x16(w); w = umax_x32(w); }
            bi = 511 - (int)(w & 511u);
#pragma unroll
            for (int c = 0; c < 5; ++c) if (skey[c] == w) skey[c] = 0u;
        } else {
#pragma unroll
        for (int c = 1; c < 5; ++c) if (score[c] > bv) { bv = score[c]; bi = lane + 64 * c; }
#pragma unroll
        for (int o = 1; o < 64; o <<= 1) { const float ov = __shfl_xor(bv, o); const int oi = __shfl_xor(bi, o); if (ov > bv || (ov == bv && oi < bi)) { bv = ov; bi = oi; } }
        }
        const int n = __builtin_amdgcn_readfirstlane(bi);
        if (MODE == 2) { if (round == 16) { ambiguous = (bv >= 0.f) && (last_bv - bv < 4e-4f); break; } last_bv = bv; }
#pragma unroll
        for (int c = 0; c < 5; ++c) if (n == lane + 64 * c) score[c] = -3.0f;
        if (n > cur) continue;
        if (MODE == 1 && (round >> 1) != wave) continue;
        const float* kb; const float* vb; int nvalid;
        if (!smp) { kb = out + O_PSK + (size_t)(b * 8192 + 64 * n) * 128; vb = out + O_PSV + (size_t)(b * 8192 + 64 * n) * 128; }
        else if (n < 256) { const int page = ptab[n >> 1]; const size_t ro = ((size_t)page * 128 + (n & 1) * 64) * 128; kb = a.in[4] + ro; vb = a.in[5] + ro; }
        else { kb = out + O_SSK + (size_t)(sb * 8) * 128; vb = out + O_SSV + (size_t)(sb * 8) * 128; }
        nvalid = qpos - 64 * n + 1; if (nvalid > 64) nvalid = 64;
        const bool valid = lane < nvalid;
        float s4[4] = {0.f, 0.f, 0.f, 0.f};
        { const f32x4* kr = (const f32x4*)(kb + (size_t)(valid ? lane : 0) * 128 + kvh * 64);
#pragma unroll 4
          for (int d4 = 0; d4 < 16; ++d4) { const f32x4 k = kr[d4];
              const f32x4 q0 = *(const LAS f32x4*)(s_qr + (4 * d4 + 0) * 4), q1 = *(const LAS f32x4*)(s_qr + (4 * d4 + 1) * 4), q2 = *(const LAS f32x4*)(s_qr + (4 * d4 + 2) * 4), q3 = *(const LAS f32x4*)(s_qr + (4 * d4 + 3) * 4);
#pragma unroll
              for (int g = 0; g < 4; ++g) s4[g] += k.x * q0[g] + k.y * q1[g] + k.z * q2[g] + k.w * q3[g]; } }
        f32x4 pv4;
#pragma unroll
        for (int g = 0; g < 4; ++g) { const float p = valid ? __builtin_amdgcn_exp2f(s4[g] - mref_s[g]) : 0.f; l_sel[g] += p; pv4[g] = p; }
        *(LAS f32x4*)(s_p + lane * 4) = pv4;
        LDS_WAIT(); asm volatile("" ::: "memory");
        for (int j0 = 0; j0 < nvalid; j0 += 8) { float v[8];
#pragma unroll
            for (int q = 0; q < 8; ++q) { const int j = j0 + q < nvalid ? j0 + q : 0; v[q] = vb[(size_t)j * 128 + kvh * 64 + lane]; }
#pragma unroll
            for (int q = 0; q < 8; ++q) if (j0 + q < nvalid) { const f32x4 p = *(const LAS f32x4*)(s_p + (j0 + q) * 4);
#pragma unroll
                for (int g = 0; g < 4; ++g) o_sel[g] += p[g] * v[q]; } }
        LDS_WAIT(); asm volatile("" ::: "memory");
    }
    float l_win[4] = {0.f, 0.f, 0.f, 0.f}, o_win[4] = {0.f, 0.f, 0.f, 0.f};
    { const int lo = qpos - 511 > 0 ? qpos - 511 : 0; const int cnt = qpos - lo + 1;
      for (int c0 = 0; c0 < cnt; c0 += 64) {
          if (MODE == 1 && (c0 >> 6) != wave) continue;
          const int nvalid = cnt - c0 < 64 ? cnt - c0 : 64; const bool valid = lane < nvalid; const int kpos = lo + c0 + (valid ? lane : 0);
          const float* kr_;
          if (!smp) kr_ = (const float*)(ws + WS_KWIN) + (size_t)(b * 8192 + kpos) * 128;
          else if (kpos >= 16384) kr_ = out + O_SWK + (size_t)(sb * 512 + 504 + kpos - 16384) * 128;
          else kr_ = a.in[6] + (size_t)(sb * 512 + kpos - 15872) * 128;
          float s4[4] = {0.f, 0.f, 0.f, 0.f};
          { const f32x4* kr = (const f32x4*)(kr_ + kvh * 64);
#pragma unroll 4
            for (int d4 = 0; d4 < 16; ++d4) { const f32x4 k = kr[d4];
                const f32x4 q0 = *(const LAS f32x4*)(s_qr + (4 * d4 + 0) * 4), q1 = *(const LAS f32x4*)(s_qr + (4 * d4 + 1) * 4), q2 = *(const LAS f32x4*)(s_qr + (4 * d4 + 2) * 4), q3 = *(const LAS f32x4*)(s_qr + (4 * d4 + 3) * 4);
#pragma unroll
                for (int g = 0; g < 4; ++g) s4[g] += k.x * q0[g] + k.y * q1[g] + k.z * q2[g] + k.w * q3[g]; } }
          f32x4 pv4;
#pragma unroll
          for (int g = 0; g < 4; ++g) { const float p = valid ? __builtin_amdgcn_exp2f(s4[g] - mref_w[g]) : 0.f; l_win[g] += p; pv4[g] = p; }
          *(LAS f32x4*)(s_p + lane * 4) = pv4;
          LDS_WAIT(); asm volatile("" ::: "memory");
          for (int j0 = 0; j0 < nvalid; j0 += 8) { float v[8];
#pragma unroll
              for (int q = 0; q < 8; ++q) { const int kp = lo + c0 + (j0 + q < nvalid ? j0 + q : 0); const float* vr;
                  if (!smp) vr = (const float*)(ws + WS_VWIN) + (size_t)(b * 8192 + kp) * 128;
                  else if (kp >= 16384) vr = out + O_SWV + (size_t)(sb * 512 + 504 + kp - 16384) * 128;
                  else vr = a.in[7] + (size_t)(sb * 512 + kp - 15872) * 128;
                  v[q] = vr[kvh * 64 + lane]; }
#pragma unroll
              for (int q = 0; q < 8; ++q) if (j0 + q < nvalid) { const f32x4 p = *(const LAS f32x4*)(s_p + (j0 + q) * 4);
#pragma unroll
                  for (int g = 0; g < 4; ++g) o_win[g] += p[g] * v[q]; } }
          LDS_WAIT(); asm volatile("" ::: "memory");
      } }
    float ls[4], lw[4];
#pragma unroll
    for (int g = 0; g < 4; ++g) { ls[g] = wave_sum(l_sel[g]); lw[g] = wave_sum(l_win[g]); }
    if (MODE == 1) {
        LAS float* part = scr + 2048;
#pragma unroll
        for (int g = 0; g < 4; ++g) { part[g * 64 + lane] = o_cmp[g]; part[(4 + g) * 64 + lane] = o_sel[g]; part[(8 + g) * 64 + lane] = o_win[g]; }
        if (lane < 4) { part[768 + lane] = ls[lane & 3]; part[772 + lane] = lw[lane & 3]; }
        __syncthreads();
        if (wave == 0) {
#pragma unroll
            for (int g = 0; g < 4; ++g) { o_cmp[g] = 0.f; o_sel[g] = 0.f; o_win[g] = 0.f; ls[g] = 0.f; lw[g] = 0.f; }
            for (int w = 0; w < NWAVES; ++w) { const LAS float* pw = (const LAS float*)(ldsb + w * 16384) + 2048;
#pragma unroll
                for (int g = 0; g < 4; ++g) { o_cmp[g] += pw[g * 64 + lane]; o_sel[g] += pw[(4 + g) * 64 + lane]; o_win[g] += pw[(8 + g) * 64 + lane]; ls[g] += pw[768 + g]; lw[g] += pw[772 + g]; } }
        }
    }
    if (MODE != 1 || wave == 0) {
        const float* BG = (const float*)(ws + WS_BG) + (size_t)r * 24 + kvh * 12;
        bf16* O = (bf16*)(ws + WS_O) + (size_t)r * 512 + kvh * 256;
#pragma unroll
        for (int g = 0; g < 4; ++g) {
            const float o = BG[g * 3 + 0] * o_cmp[g] + BG[g * 3 + 1] * (o_sel[g] / fmaxf(ls[g], 1e-30f)) + BG[g * 3 + 2] * (o_win[g] / fmaxf(lw[g], 1e-30f));
            if (MODE == 2) { const float have = bf2f(O[g * 64 + lane]); if (!ambiguous && !(fabsf(have - o) <= 0.004f + 0.02f * fabsf(o))) atomicAdd((unsigned*)(ws + WS_CTL) + 8, 1u); }
            else O[g * 64 + lane] = (bf16)f2bf(o); }
    }
    LDS_WAIT(); asm volatile("" ::: "memory");
    if (MODE == 1) __syncthreads();
}

__device__ __forceinline__ void attn_sample(const Args& a, int r, int kvh, LAS unsigned char* ldsb, int wave, int lane) {
    unsigned char* ws = a.ws; float* out = a.out;
    LAS float* scr = (LAS float*)(ldsb + wave * 16384);
    LAS float* sh_sc = (LAS float*)(ldsb + RING_BYTES);
    const int rs_ = r - MP, sb = rs_ >> 3, si = rs_ & 7;
    const int seq = 4 + sb, qpos = 16384 + si, cur = qpos >> 6; constexpr int NB = 257;
    LAS float* s_qp = scr;
    LAS float* s_qr = scr + 256;
    LAS float* s_p = scr + 512;
    const bf16* QP = (const bf16*)(ws + WS_QP) + (size_t)r * 512 + kvh * 256; const bf16* QR = (const bf16*)(ws + WS_QR) + (size_t)r * 512 + kvh * 256;
    f32x4 ck[16]; float cv[64];
    auto chunk_load = [&](const float* krow, auto vrow, const int nvalid) __attribute__((always_inline)) {
        const f32x4* kr = (const f32x4*)(krow + kvh * 64);
#pragma unroll
        for (int d4 = 0; d4 < 16; ++d4) ck[d4] = kr[d4];
#pragma unroll
        for (int j = 0; j < 64; ++j) cv[j] = vrow(j < nvalid ? j : 0)[kvh * 64 + lane];
    };
    auto chunk_compute = [&](const int nvalid, const float (&mref)[4], float (&l)[4], float (&o)[4]) __attribute__((always_inline)) {
        const bool valid = lane < nvalid;
        f32x4 s4 = {0.f, 0.f, 0.f, 0.f};
#pragma unroll
        for (int d4 = 0; d4 < 16; ++d4) {
            const f32x4 q0 = *(const LAS f32x4*)(s_qr + (4 * d4 + 0) * 4), q1 = *(const LAS f32x4*)(s_qr + (4 * d4 + 1) * 4), q2 = *(const LAS f32x4*)(s_qr + (4 * d4 + 2) * 4), q3 = *(const LAS f32x4*)(s_qr + (4 * d4 + 3) * 4);
            s4 += q0 * ck[d4].x + q1 * ck[d4].y + q2 * ck[d4].z + q3 * ck[d4].w; }
        f32x4 pv4;
#pragma unroll
        for (int g = 0; g < 4; ++g) { const float p = valid ? __builtin_amdgcn_exp2f(s4[g] - mref[g]) : 0.f; l[g] += p; pv4[g] = p; }
        *(LAS f32x4*)(s_p + lane * 4) = pv4;
        LDS_WAIT(); asm volatile("" ::: "memory");
#pragma unroll
        for (int j = 0; j < 64; ++j) { const f32x4 p = *(const LAS f32x4*)(s_p + j * 4);
#pragma unroll
            for (int g = 0; g < 4; ++g) o[g] += p[g] * cv[j]; }
        LDS_WAIT(); asm volatile("" ::: "memory");
    };
    float l_sel[4] = {0.f, 0.f, 0.f, 0.f}, o_sel[4] = {0.f, 0.f, 0.f, 0.f}, l_win[4] = {0.f, 0.f, 0.f, 0.f}, o_win[4] = {0.f, 0.f, 0.f, 0.f};
    float qx[4], qy[4];
#pragma unroll
    for (int g = 0; g < 4; ++g) { qx[g] = bf2f(QP[g * 64 + lane]); qy[g] = bf2f(QR[g * 64 + lane]); }
    const float gk1 = fabsf(a.in[17][64 + lane]), gk2 = fabsf(a.in[17][128 + lane]);
    const int wlo = qpos - 511 > 0 ? qpos - 511 : 0, wcnt = qpos - wlo + 1, wc0 = 64 * wave;
    const int wnv = wc0 < wcnt ? (wcnt - wc0 < 64 ? wcnt - wc0 : 64) : 0;
    auto rowp = [&](const float* cache, size_t onew, int kp) { return kp >= 16384 ? out + onew + (size_t)(sb * 512 + 504 + kp - 16384) * 128 : cache + (size_t)(sb * 512 + kp - 15872) * 128; };
    if (wnv > 0) chunk_load(rowp(a.in[6], O_SWK, wlo + wc0 + (lane < wnv ? lane : 0)), [&](int j) { return rowp(a.in[7], O_SWV, wlo + wc0 + j); }, wnv);
    float mref_s[4], mref_w[4];
    { const float gks = wmax(gk1), gkw = wmax(gk2);
#pragma unroll
      for (int g = 0; g < 4; ++g) { s_qp[lane * 4 + g] = qx[g]; s_qr[lane * 4 + g] = qy[g]; const float qn = sqrtf(wsum(qy[g] * qy[g])) * 8.0f; mref_s[g] = qn * gks; mref_w[g] = qn * gkw; } }
    LDS_WAIT(); asm volatile("" ::: "memory");
    if (wnv > 0) chunk_compute(wnv, mref_w, l_win, o_win);
    const float* KC = (const float*)(ws + WS_KC) + kc_off(seq) + kvh * 64; const float* VC = (const float*)(ws + WS_VC) + kc_off(seq) + kvh * 64;
    const int n_ok = (qpos + 1) >> 6;
    const int nn = n_ok < NB ? n_ok : NB;
    float vc[33];
    { const int n = 33 * wave + lane; const bool mine = lane < 33 && n < n_ok;
      const f32x4* kr = (const f32x4*)(KC + (size_t)(mine ? n : 0) * 128);
      f32x4 k[16];
#pragma unroll
      for (int d4 = 0; d4 < 16; ++d4) k[d4] = kr[d4];
#pragma unroll
      for (int q = 0; q < 33; ++q) { const int nq = wave + 8 * q; vc[q] = VC[(size_t)(nq < nn ? nq : wave) * 128 + lane]; }
      f32x4 s4 = {0.f, 0.f, 0.f, 0.f};
#pragma unroll
      for (int d4 = 0; d4 < 16; ++d4) {
          const f32x4 q0 = *(const LAS f32x4*)(s_qp + (4 * d4 + 0) * 4), q1 = *(const LAS f32x4*)(s_qp + (4 * d4 + 1) * 4), q2 = *(const LAS f32x4*)(s_qp + (4 * d4 + 2) * 4), q3 = *(const LAS f32x4*)(s_qp + (4 * d4 + 3) * 4);
          s4 += q0 * k[d4].x + q1 * k[d4].y + q2 * k[d4].z + q3 * k[d4].w; }
      if (mine) *(LAS f32x4*)(sh_sc + n * 4) = s4; }
    LDS_WAIT(); __syncthreads();
    float sc[5][4];
#pragma unroll
    for (int c = 0; c < 5; ++c) { const int n = lane + 64 * c; f32x4 v = {0.f, 0.f, 0.f, 0.f}; if (n < n_ok && n < NB) v = *(const LAS f32x4*)(sh_sc + n * 4);
#pragma unroll
        for (int g = 0; g < 4; ++g) sc[c][g] = v[g]; }
    float imp[5];
#pragma unroll
    for (int c = 0; c < 5; ++c) imp[c] = 0.f;
#pragma unroll
    for (int g = 0; g < 4; ++g) {
        float m = -INFINITY;
#pragma unroll
        for (int c = 0; c < 5; ++c) { const int n = lane + 64 * c; if (n < n_ok && n < NB) m = fmaxf(m, sc[c][g]); }
        m = wmax(m); if (!(m > -INFINITY)) m = 0.f;
        float e[5], zs = 0.f;
#pragma unroll
        for (int c = 0; c < 5; ++c) { const int n = lane + 64 * c; e[c] = (n < n_ok && n < NB) ? __builtin_amdgcn_exp2f(sc[c][g] - m) : 0.f; zs += e[c]; }
        zs = wsum(zs); const float iz = 1.0f / fmaxf(zs, 1e-30f);
#pragma unroll
        for (int c = 0; c < 5; ++c) { const int n = lane + 64 * c; const float p = e[c] * iz; imp[c] += p; if (n < NB) s_p[n * 4 + g] = p; }
    }
    LDS_WAIT(); asm volatile("" ::: "memory");
    float o_cmp[4] = {0.f, 0.f, 0.f, 0.f};
#pragma unroll
    for (int q = 0; q < 33; ++q) { const int n = wave + 8 * q; if (n < nn) { const f32x4 p = *(const LAS f32x4*)(s_p + n * 4);
#pragma unroll
        for (int g = 0; g < 4; ++g) o_cmp[g] += p[g] * vc[q]; } }
    LDS_WAIT(); asm volatile("" ::: "memory");
    unsigned skey[5];
#pragma unroll
    for (int c = 0; c < 5; ++c) { const int n = lane + 64 * c; const bool forced = (n == 0) || (n == cur) || (n == cur - 1);
        const float score = imp[c] + (forced ? 8.0f : 0.f);
        skey[c] = (n < NB && n <= cur) ? ((__float_as_uint(score) & ~511u) | (unsigned)(511 - n)) : 0u; }
    int nsel[2] = {-1, -1};
#pragma nounroll
    for (int round = 0; round < 16; ++round) {
        unsigned w = skey[0];
#pragma unroll
        for (int c = 1; c < 5; ++c) w = skey[c] > w ? skey[c] : w;
        { unsigned o; o = dpp_x1(w); w = o > w ? o : w; o = dpp_x2(w); w = o > w ? o : w; o = dpp_x4(w); w = o > w ? o : w; o = dpp_x8(w); w = o > w ? o : w; w = umax_x16(w); w = umax_x32(w); }
        const unsigned wu = (unsigned)__builtin_amdgcn_readfirstlane((int)w);
#pragma unroll
        for (int c = 0; c < 5; ++c) if (skey[c] == wu) skey[c] = 0u;
        const int n = wu != 0u ? 511 - (int)(wu & 511u) : -1;
        if (round == 2 * wave) nsel[0] = n; if (round == 2 * wave + 1) nsel[1] = n;
    }
    const int* ptab = (const int*)a.in[9] + sb * 128;
#pragma nounroll
    for (int h = 0; h < 2; ++h) { const int n = nsel[h];
        if (n < 0 || n > cur) continue;
        const float* kb; const float* vb;
        if (n < 256) { const int page = ptab[n >> 1]; const size_t ro = ((size_t)page * 128 + (n & 1) * 64) * 128; kb = a.in[4] + ro; vb = a.in[5] + ro; }
        else { kb = out + O_SSK + (size_t)(sb * 8) * 128; vb = out + O_SSV + (size_t)(sb * 8) * 128; }
        int nvalid = qpos - 64 * n + 1; if (nvalid > 64) nvalid = 64;
        chunk_load(kb + (size_t)(lane < nvalid ? lane : 0) * 128, [&](int j) { return vb + (size_t)j * 128; }, nvalid);
        chunk_compute(nvalid, mref_s, l_sel, o_sel);
    }
    float ls[4], lw[4];
#pragma unroll
    for (int g = 0; g < 4; ++g) { ls[g] = wsum(l_sel[g]); lw[g] = wsum(l_win[g]); }
    LAS float* part = scr + 2048;
#pragma unroll
    for (int g = 0; g < 4; ++g) { part[g * 64 + lane] = o_cmp[g]; part[(4 + g) * 64 + lane] = o_sel[g]; part[(8 + g) * 64 + lane] = o_win[g]; }
    if (lane < 4) { part[768 + lane] = ls[lane & 3]; part[772 + lane] = lw[lane & 3]; }
    const float* BG = (const float*)(ws + WS_BG) + (size_t)r * 24 + kvh * 12;
    float bgv[12];
#pragma unroll
    for (int i = 0; i < 12; ++i) bgv[i] = BG[i];
    __syncthreads();
    if (wave == 0) {
#pragma unroll
        for (int g = 0; g < 4; ++g) { o_cmp[g] = 0.f; o_sel[g] = 0.f; o_win[g] = 0.f; ls[g] = 0.f; lw[g] = 0.f; }
#pragma unroll
        for (int w = 0; w < NWAVES; ++w) { const LAS float* pw = (const LAS float*)(ldsb + w * 16384) + 2048;
#pragma unroll
            for (int g = 0; g < 4; ++g) { o_cmp[g] += pw[g * 64 + lane]; o_sel[g] += pw[(4 + g) * 64 + lane]; o_win[g] += pw[(8 + g) * 64 + lane]; ls[g] += pw[768 + g]; lw[g] += pw[772 + g]; } }
        bf16* O = (bf16*)(ws + WS_O) + (size_t)r * 512 + kvh * 256;
#pragma unroll
        for (int g = 0; g < 4; ++g) {
            const float o = bgv[g * 3 + 0] * o_cmp[g] + bgv[g * 3 + 1] * (o_sel[g] / fmaxf(ls[g], 1e-30f)) + bgv[g * 3 + 2] * (o_win[g] / fmaxf(lw[g], 1e-30f));
            O[g * 64 + lane] = (bf16)f2bf(o); }
    }
    LDS_WAIT(); asm volatile("" ::: "memory");
    __syncthreads();
}

typedef short s16x8 __attribute__((ext_vector_type(8)));
template <bool B> struct BoolC { static constexpr bool v = B; };
__device__ __forceinline__ f32x4 mfma16(s16x8 a_, s16x8 b_, f32x4 c_) { return __builtin_amdgcn_mfma_f32_16x16x32_bf16(a_, b_, c_, 0, 0, 0); }
__device__ __forceinline__ unsigned cvtpk(float lo, float hi) { return pg8::cvt_pk_bf16(lo, hi); }
constexpr int AT_SLOT = 16384, AT_VOFF = 8192, AT_CMPV = 18432, AT_MASK = 4 * AT_SLOT, AT_QF = AT_MASK + 12288;
template <int PASS> __device__ __forceinline__ void attn_pass(const Args& a, LAS unsigned char* lds, int b, int kvh, int tb, int wave, int lane, int tid) {
    unsigned char* ws = a.ws; asm volatile("" : "+s"(ws)); asm volatile("" : "+v"(lane)); asm volatile("" : "+v"(tid));
    const int fr = lane & 15, fq = lane >> 4, tok_i = fr >> 2, g = fr & 3;
    const int r0 = b * 8192 + 128 * tb;
    const bf16* QR = (const bf16*)(ws + WS_QR);
    const float* BG = (const float*)(ws + WS_BG); float* OC = (float*)(ws + WS_OC);
    LAS unsigned* wmask = (LAS unsigned*)(lds + AT_MASK + wave * 1536);
    const int hq = kvh * 4 + g;
    f32x4 O[4][4], L[4];
    const s16x8 ones = {0x3F80, 0x3F80, 0x3F80, 0x3F80, 0x3F80, 0x3F80, 0x3F80, 0x3F80};
    LAS unsigned char* qlds = lds + AT_QF + wave * 8192;
    {
        const char* kimg = (const char*)((const bf16*)(ws + (PASS == 0 ? WS_KSB : WS_KWB)) + (size_t)((b * 128) * 2 + kvh) * 4096);
        const char* vimg = (const char*)((const bf16*)(ws + (PASS == 0 ? WS_VST : WS_VWT)) + (size_t)((b * 128) * 2 + kvh) * 4096);
        const float gk = wave_max(fabsf(a.in[17][(PASS == 0 ? 64 : 128) + lane]));
        if (PASS == 0) {
#pragma unroll
            for (int gi = 0; gi < 4; ++gi) { const int row = r0 + 16 * wave + 4 * gi + tok_i; const bf16* qp = QR + (size_t)row * 512 + hq * 64 + fq * 8;
                const s16x8 qa = *(const s16x8*)qp, qb = *(const s16x8*)(qp + 32); float ss = 0.f;
#pragma unroll
                for (int e = 0; e < 8; ++e) { const float x = bf2f((unsigned short)qa[e]), y = bf2f((unsigned short)qb[e]); ss += x * x + y * y; }
                ss += __shfl_xor(ss, 16); ss += __shfl_xor(ss, 32); ((LAS float*)wmask)[96 + gi * 64 + lane] = sqrtf(ss) * 8.0f;
                *(LAS s16x8*)(qlds + ((gi * 2 + 0) * 64 + lane) * 16) = qa; *(LAS s16x8*)(qlds + ((gi * 2 + 1) * 64 + lane) * 16) = qb; }
            LDS_WAIT();
        }
#pragma unroll
        for (int gi = 0; gi < 4; ++gi) { L[gi] = (f32x4){0.f, 0.f, 0.f, 0.f};
#pragma unroll
            for (int dg = 0; dg < 4; ++dg) O[gi][dg] = (f32x4){0.f, 0.f, 0.f, 0.f}; }
        s16x8 Qf[4][2];
#pragma unroll
        for (int gi = 0; gi < 4; ++gi) { Qf[gi][0] = *(const LAS s16x8*)(qlds + ((gi * 2 + 0) * 64 + lane) * 16); Qf[gi][1] = *(const LAS s16x8*)(qlds + ((gi * 2 + 1) * 64 + lane) * 16); }
        const LAS float* mrefl = (const LAS float*)wmask + 96 + lane;
        bool bigref; { float mx = 0.f;
#pragma unroll
            for (int gi = 0; gi < 4; ++gi) mx = fmaxf(mx, mrefl[64 * gi] * gk);
            bigref = __builtin_amdgcn_readfirstlane(__float_as_int(wave_max(mx))) > __float_as_int(64.0f); }
        const int nlast = 2 * tb + 1, nfirst = PASS == 0 ? 0 : (2 * tb - 8 > 0 ? 2 * tb - 8 : 0);
        const int drow = 8 * wave + (lane >> 3); const unsigned dsrc = (unsigned)(drow * 128 + (((lane & 7) ^ ((drow >> 1) & 7)) * 16));
        const unsigned fsw0 = (unsigned)((((0 + fq) ^ ((fr >> 1) & 7)) * 16)), fsw1 = (unsigned)((((4 + fq) ^ ((fr >> 1) & 7)) * 16));
#define AT_DMA_BLOCK(nn, sl) do { const size_t bo_ = (size_t)(nn) * 2 * 4096 * 2 + dsrc; \
            __builtin_amdgcn_global_load_lds((const unsigned*)(kimg + bo_), (LAS unsigned*)(lds + (sl) * AT_SLOT + wave * 1024), 16, 0, 0); \
            __builtin_amdgcn_global_load_lds((const unsigned*)(vimg + bo_), (LAS unsigned*)(lds + (sl) * AT_SLOT + AT_VOFF + wave * 1024), 16, 0, 0); } while (0)
        const int nblk = nlast - nfirst + 1, nint = (nblk + 1) >> 1;
        AT_DMA_BLOCK(nfirst, 0); if (nblk > 1) AT_DMA_BLOCK(nfirst + 1, 1);
        asm volatile("s_waitcnt vmcnt(0) lgkmcnt(0)\n\ts_barrier" ::: "memory");
        unsigned gwc[4] = {0u, 0u, 0u, 0u}, twc[4] = {0u, 0u, 0u, 0u}; int wcur = -1;
        auto do_block = [&](const int n, const LAS unsigned char* kb, auto bigc) __attribute__((always_inline)) {
            constexpr bool BIG = decltype(bigc)::v;
            const LAS unsigned char* vb = kb + AT_VOFF;
            if (PASS == 0 && (n >> 5) != wcur) { wcur = n >> 5;
#pragma unroll
                for (int gi = 0; gi < 4; ++gi) { gwc[gi] = (unsigned)__builtin_amdgcn_readfirstlane((int)wmask[64 + gi * 4 + wcur]); twc[gi] = wmask[(4 * gi + tok_i) * 4 + wcur]; } }
            int actm = 0;
#pragma unroll
            for (int gi = 0; gi < 4; ++gi) { int av;
                if (PASS == 0) { av = (int)((gwc[gi] >> (n & 31)) & 1u); }
                else { const int tlo = 128 * tb + 16 * wave + 4 * gi; const int b_lo = tlo - 511 > 0 ? (tlo - 511) >> 6 : 0, b_hi = (tlo + 3) >> 6; av = (n >= b_lo && n <= b_hi) ? 1 : 0; }
                actm |= av << gi; }
            actm = __builtin_amdgcn_readfirstlane(actm);
            if (actm != 0) {
#pragma unroll
                for (int kc = 0; kc < 2; ++kc) {
                    s16x8 Kf[2][2], Vf[4];
#pragma unroll
                    for (int x = 0; x < 2; ++x)
#pragma unroll
                        for (int k = 0; k < 2; ++k) Kf[x][k] = *(const LAS s16x8*)(kb + (16 * (2 * kc + x) + fr) * 128 + (k ? fsw1 : fsw0));
#pragma unroll
                    for (int dg = 0; dg < 4; ++dg) Vf[dg] = *(const LAS s16x8*)(vb + (16 * dg + fr) * 128 + (kc ? fsw1 : fsw0));
#pragma unroll
                    for (int gi = 0; gi < 4; ++gi) if ((actm >> gi) & 1) {
                        const int tl = 16 * wave + 4 * gi + tok_i, t = 128 * tb + tl, rel = t - 64 * n;
                        const int tlo = 128 * tb + 16 * wave + 4 * gi;
                        const bool edge = (64 * n + 63 > tlo) || (PASS == 1 && 64 * n < tlo + 3 - 511);
                        const s16x8 qf0 = Qf[gi][0], qf1 = Qf[gi][1];
                        f32x4 S[2];
                        if (PASS == 0 || BIG) {
                            const bool tsel = PASS == 0 ? ((twc[gi] >> (n & 31)) & 1u) != 0u : true;
                            float nm = 0.f; if (BIG) nm = -mrefl[64 * gi] * gk;
                            nm = tsel ? nm : -1e30f;
                            const f32x4 c0 = {nm, nm, nm, nm};
#pragma unroll
                            for (int x = 0; x < 2; ++x) S[x] = mfma16(Kf[x][0], qf0, c0);
                        } else {
#pragma unroll
                            for (int x = 0; x < 2; ++x) S[x] = mfma16(Kf[x][0], qf0, (f32x4){0.f, 0.f, 0.f, 0.f});
                        }
#pragma unroll
                        for (int x = 0; x < 2; ++x) S[x] = mfma16(Kf[x][1], qf1, S[x]);
                        if (edge) {
#pragma unroll
                            for (int x = 0; x < 2; ++x)
#pragma unroll
                                for (int i = 0; i < 4; ++i) { const int j = 16 * (2 * kc + x) + 4 * fq + i; const bool ok = j <= rel && (PASS == 0 || j > rel - 512);
                                    S[x][i] = ok ? __builtin_amdgcn_exp2f(S[x][i]) : 0.f; }
                        } else {
#pragma unroll
                            for (int x = 0; x < 2; ++x)
#pragma unroll
                                for (int i = 0; i < 4; ++i) S[x][i] = __builtin_amdgcn_exp2f(S[x][i]);
                        }
                        v4u pk; pk.x = cvtpk(S[0][0], S[0][1]); pk.y = cvtpk(S[0][2], S[0][3]); pk.z = cvtpk(S[1][0], S[1][1]); pk.w = cvtpk(S[1][2], S[1][3]);
                        const s16x8 pb = __builtin_bit_cast(s16x8, pk);
#pragma unroll
                        for (int dg = 0; dg < 4; ++dg) O[gi][dg] = mfma16(Vf[dg], pb, O[gi][dg]);
                        L[gi] = mfma16(ones, pb, L[gi]);
                    }
                }
            }
        };
        auto run = [&](auto bigc) __attribute__((always_inline)) {
#pragma nounroll
            for (int iv = 0; iv < nint; ++iv) {
                const int n0 = nfirst + 2 * iv, sp = (iv & 1) * 2;
                if (n0 + 2 <= nlast) AT_DMA_BLOCK(n0 + 2, 2 - sp);
                if (n0 + 3 <= nlast) AT_DMA_BLOCK(n0 + 3, 3 - sp);
                do_block(n0, lds + sp * AT_SLOT, bigc);
                if (n0 + 1 <= nlast) do_block(n0 + 1, lds + (sp + 1) * AT_SLOT, bigc);
                asm volatile("s_waitcnt vmcnt(0) lgkmcnt(0)\n\ts_barrier" ::: "memory");
            } };
        if (bigref) run(BoolC<true>{}); else run(BoolC<false>{});
#pragma unroll
        for (int gi = 0; gi < 4; ++gi) { const int row = r0 + 16 * wave + 4 * gi + tok_i;
            const float l = L[gi][0];
            const float sc = BG[(size_t)row * 24 + hq * 3 + 1 + PASS] / fmaxf(l, 1e-30f);
            float* oc = OC + (size_t)row * 512 + hq * 64 + 4 * fq;
#pragma unroll
            for (int dg = 0; dg < 4; ++dg) { const f32x4 v = *(const f32x4*)(oc + 16 * dg) + O[gi][dg] * sc;
                if (PASS == 0) *(f32x4*)(oc + 16 * dg) = v;
                else { v2u w; w.x = cvtpk(v[0], v[1]); w.y = cvtpk(v[2], v[3]); *(v2u*)((bf16*)(ws + WS_O) + (size_t)row * 512 + hq * 64 + 16 * dg + 4 * fq) = w; } } }
        }
}
__device__ __forceinline__ void attn_unit(const Args& a, LAS unsigned char* lds, int b, int kvh, int tb, int wave, int lane, int tid) {
    unsigned char* ws = a.ws; asm volatile("" : "+s"(ws)); asm volatile("" : "+v"(lane)); asm volatile("" : "+v"(tid));
    const int fr = lane & 15, fq = lane >> 4, tok_i = fr >> 2, g = fr & 3;
    const int r0 = b * 8192 + 128 * tb;
    const bf16* QP = (const bf16*)(ws + WS_QP); const bf16* QR = (const bf16*)(ws + WS_QR);
    const float* BG = (const float*)(ws + WS_BG); float* OC = (float*)(ws + WS_OC);
    LAS unsigned* wmask = (LAS unsigned*)(lds + AT_MASK + wave * 1536);
    const int hq = kvh * 4 + g;
    { const char* kcb = (const char*)((const bf16*)(ws + WS_KCB) + (size_t)(b * 2 + kvh) * 128 * 64); const char* vct = (const char*)((const bf16*)(ws + WS_VCT) + (size_t)(b * 2 + kvh) * 64 * 128);
      for (int c = tid; c < 1024; c += 512) { const v4u v = *(const v4u*)(kcb + c * 16); *(LAS v4u*)(lds + (c >> 3) * 144 + (c & 7) * 16) = v; }
      for (int c = tid; c < 1024; c += 512) { const v4u v = *(const v4u*)(vct + c * 16); *(LAS v4u*)(lds + AT_CMPV + (c >> 4) * 272 + (c & 15) * 16) = v; } }
    __syncthreads();
    const int ng = (2 * tb + 2 + 15) >> 4;
    s16x8 qn0, qn1; float bgn;
    { const int row = r0 + 16 * wave + tok_i; const bf16* qp = QP + (size_t)row * 512 + hq * 64 + fq * 8; qn0 = *(const s16x8*)qp; qn1 = *(const s16x8*)(qp + 32); bgn = BG[(size_t)row * 24 + hq * 3 + 0]; }
#pragma nounroll
    for (int gi = 0; gi < 4; ++gi) {
        const int tl = 16 * wave + 4 * gi + tok_i, t = 128 * tb + tl, row = r0 + tl;
        const s16x8 q0 = qn0, q1 = qn1; const float bg0 = bgn;
        { const int rown = r0 + 16 * wave + 4 * (gi < 3 ? gi + 1 : gi) + tok_i; const bf16* qp = QP + (size_t)rown * 512 + hq * 64 + fq * 8; qn0 = *(const s16x8*)qp; qn1 = *(const s16x8*)(qp + 32); bgn = BG[(size_t)rown * 24 + hq * 3 + 0]; }
        f32x4 S[8];
#pragma unroll
        for (int kg = 0; kg < 8; ++kg) { S[kg] = (f32x4){0.f, 0.f, 0.f, 0.f};
            if (kg < ng) { const s16x8 a0 = *(const LAS s16x8*)(lds + (16 * kg + fr) * 144 + fq * 16), a1 = *(const LAS s16x8*)(lds + (16 * kg + fr) * 144 + 64 + fq * 16);
                S[kg] = mfma16(a0, q0, S[kg]); S[kg] = mfma16(a1, q1, S[kg]); } }
        const int n_ok = (t + 1) >> 6, cur = t >> 6;
        float m = -INFINITY;
#pragma unroll
        for (int kg = 0; kg < 8; ++kg)
#pragma unroll
            for (int i = 0; i < 4; ++i) if (16 * kg + 4 * fq + i < n_ok) m = fmaxf(m, S[kg][i]);
        m = fmax_x16(m); m = fmax_x32(m); if (!(m > -INFINITY)) m = 0.f;
        float sum = 0.f;
#pragma unroll
        for (int kg = 0; kg < 8; ++kg)
#pragma unroll
            for (int i = 0; i < 4; ++i) { const float e = (16 * kg + 4 * fq + i < n_ok) ? __builtin_amdgcn_exp2f(S[kg][i] - m) : 0.f; S[kg][i] = e; sum += e; }
        sum = fsum_x16(sum); sum = fsum_x32(sum);
        const float inv = 1.0f / fmaxf(sum, 1e-30f);
#pragma unroll
        for (int kg = 0; kg < 8; ++kg) S[kg] *= inv;
        { f32x4 Oc[4];
#pragma unroll
          for (int dg = 0; dg < 4; ++dg) Oc[dg] = (f32x4){0.f, 0.f, 0.f, 0.f};
#pragma unroll
          for (int kc = 0; kc < 4; ++kc) if (2 * kc < ng) {
              v4u pk; pk.x = cvtpk(S[2 * kc][0], S[2 * kc][1]); pk.y = cvtpk(S[2 * kc][2], S[2 * kc][3]); pk.z = cvtpk(S[2 * kc + 1][0], S[2 * kc + 1][1]); pk.w = cvtpk(S[2 * kc + 1][2], S[2 * kc + 1][3]);
              const s16x8 pb = __builtin_bit_cast(s16x8, pk);
#pragma unroll
              for (int dg = 0; dg < 4; ++dg) { const s16x8 av = *(const LAS s16x8*)(lds + AT_CMPV + (16 * dg + fr) * 272 + kc * 64 + fq * 16); Oc[dg] = mfma16(av, pb, Oc[dg]); } }
#pragma unroll
          for (int dg = 0; dg < 4; ++dg) *(f32x4*)(OC + (size_t)row * 512 + hq * 64 + 16 * dg + 4 * fq) = Oc[dg] * bg0; }
#pragma unroll
        for (int kg = 0; kg < 8; ++kg)
#pragma unroll
            for (int i = 0; i < 4; ++i) { float v = S[kg][i]; v += dpp_x1f(v); v += dpp_x2f(v); S[kg][i] = v; }
        unsigned lm = 0u;
        if (cur < 16) {
#pragma unroll
            for (int h = 0; h < 2; ++h)
#pragma unroll
                for (int i = 0; i < 4; ++i) { const int n = 16 * (2 * g + h) + 4 * fq + i; lm |= (n <= cur) ? (1u << (n & 31)) : 0u; }
        } else {
            unsigned key[8];
#pragma unroll
            for (int h = 0; h < 2; ++h)
#pragma unroll
                for (int i = 0; i < 4; ++i) { const float v = g == 0 ? S[h][i] : (g == 1 ? S[2 + h][i] : (g == 2 ? S[4 + h][i] : S[6 + h][i]));
                    const int n = 16 * (2 * g + h) + 4 * fq + i; const bool forced = (n == 0) || (n == cur) || (n == cur - 1);
                    lm |= forced ? (1u << (n & 31)) : 0u;
                    key[h * 4 + i] = (n <= cur && !forced) ? ((__float_as_uint(v) & ~255u) | (unsigned)(255 - n)) : 0u; }
#define CE8(a_, b_) do { const unsigned hi_ = key[a_] > key[b_] ? key[a_] : key[b_], lo_ = key[a_] > key[b_] ? key[b_] : key[a_]; key[a_] = hi_; key[b_] = lo_; } while (0)
            CE8(0, 1); CE8(2, 3); CE8(4, 5); CE8(6, 7); CE8(0, 2); CE8(1, 3); CE8(4, 6); CE8(5, 7); CE8(1, 2); CE8(5, 6);
            CE8(0, 4); CE8(1, 5); CE8(2, 6); CE8(3, 7); CE8(2, 4); CE8(3, 5); CE8(1, 2); CE8(3, 4); CE8(5, 6);
#undef CE8
#pragma nounroll
            for (int round = 0; round < 13; ++round) {
                unsigned w = key[0];
                { unsigned o; o = dpp_x1(w); w = o > w ? o : w; o = dpp_x2(w); w = o > w ? o : w; w = umax_x16(w); w = umax_x32(w); }
                const bool win = key[0] == w && w != 0u;
                lm |= win ? (0x80000000u >> (w & 31u)) : 0u;
#pragma unroll
                for (int j = 0; j < 7; ++j) key[j] = win ? key[j + 1] : key[j];
                key[7] = win ? 0u : key[7];
            }
        }
        { auto r16 = __builtin_amdgcn_permlane16_swap(lm, lm, false, false); lm = r16[0] | r16[1]; auto r32 = __builtin_amdgcn_permlane32_swap(lm, lm, false, false); lm = r32[0] | r32[1]; }
        if (fq == 0) wmask[(4 * gi + tok_i) * 4 + g] = lm;
        { unsigned og = lm; og |= dpp_x4(og); og |= dpp_x8(og);
          if (fq == 0 && tok_i == 0) wmask[64 + gi * 4 + g] = og; }
    }
    LDS_WAIT();
    __syncthreads();
    attn_pass<0>(a, lds, b, kvh, tb, wave, lane, tid);
    attn_pass<1>(a, lds, b, kvh, tb, wave, lane, tid);
    __syncthreads();
}
__device__ __forceinline__ void phase_attn(const Args& a, LAS unsigned char* lds, int vcu, int G, int wave, int lane, int tid) {
    for (int it = vcu; it < 2 * MS; it += G) attn_sample(a, MP + (it >> 1), it & 1, lds, wave, lane);
#pragma nounroll
    for (int u2 = 2 * vcu; u2 < 512; u2 += 2 * G) {
#pragma nounroll
        for (int h = 0; h < 2; ++h) { const int u = u2 >> 1, bh = u >> 5, s = u & 31; attn_unit(a, lds, bh >> 1, bh & 1, h ? 63 - s : s, wave, lane, tid); } }
}
#if PROBE_ATTN
__device__ __forceinline__ void phase_attn_check(const Args& a, LAS unsigned char* lds, int gw, int NGW, int wave, int lane) {
    for (int it = gw; it < 2 * 2048; it += NGW) { const int idx = it >> 1; int r;
        if (idx < 300) r = idx; else if (idx < 600) r = 3 * 8192 + 900 + (idx - 300); else r = (int)(((long)(idx - 600) * 22639L) % MP);
        attn_item<2>(a, r, it & 1, lds, wave, lane); }
}
#endif


template <class F> __device__ __forceinline__ void small_gemm(const bf16* A, const bf16* Bt, int N, int K, int vcu, int G, int wave, int lane_, LAS unsigned char* lds, const F& f) {
    int lane = lane_;
    const int ntiles = 16 * (N >> 6), nk = K >> 7;
#pragma nounroll
    for (int tile = vcu; tile < ntiles; tile += G) {
        asm volatile("" : "+v"(lane));
        const int fr = lane & 15, fq = lane >> 4, rt = tile & 15, ct = tile >> 4;
        const bf16* ap = A + (size_t)(16 * rt + fr) * K + 8 * fq; const bf16* bp = Bt + (size_t)(64 * ct + fr) * K + 8 * fq;
        f32x4 acc[4];
#pragma unroll
        for (int j = 0; j < 4; ++j) acc[j] = (f32x4){0.f, 0.f, 0.f, 0.f};
#pragma nounroll
        for (int it = wave; it < nk; it += NWAVES) { const int k0 = it << 7;
            s16x8 af[4], bfr[4][4];
#pragma unroll
            for (int q = 0; q < 4; ++q) { af[q] = *(const s16x8*)(ap + k0 + 32 * q);
#pragma unroll
                for (int j = 0; j < 4; ++j) bfr[q][j] = *(const s16x8*)(bp + (size_t)(16 * j) * K + k0 + 32 * q); }
#pragma unroll
            for (int q = 0; q < 4; ++q)
#pragma unroll
                for (int j = 0; j < 4; ++j) acc[j] = mfma16(bfr[q][j], af[q], acc[j]);
        }
        LAS f32x4* red = (LAS f32x4*)lds;
#pragma unroll
        for (int j = 0; j < 4; ++j) red[(wave * 4 + j) * 64 + lane] = acc[j];
        __syncthreads();
        if (wave < 4) { f32x4 sum = red[wave * 64 + lane];
#pragma unroll
            for (int w = 1; w < NWAVES; ++w) sum += red[(w * 4 + wave) * 64 + lane];
            f(16 * rt + fr, 64 * ct + 16 * wave + 4 * fq, sum); }
        __syncthreads();
    }
}
__device__ __forceinline__ void sample_post(const Args& a, int gw, int NGW, int lane) {
    unsigned char* ws = a.ws; float* out = a.out;
    const float* Z = (const float*)(ws + WS_ZS);
    const float* rc = (const float*)(ws + WS_ROPE); const float* rs = rc + ROPE_N * 32;
    bf16* U = (bf16*)(ws + WS_U); bf16* QP = (bf16*)(ws + WS_QP); bf16* QR = (bf16*)(ws + WS_QR); bf16* GC = (bf16*)(ws + WS_GC); bf16* GN = (bf16*)(ws + WS_GN);
    float* BG = (float*)(ws + WS_BG);
    const float qg = a.in[16][lane]; const float kg0 = a.in[17][lane], kg1 = a.in[17][64 + lane], kg2 = a.in[17][128 + lane];
    for (int r = MP + gw; r < MT; r += NGW) {
        const float* z = Z + (size_t)(r - MP) * DINP;
        float zg[16], zq[8], zk[12], zm[32], zn;
#pragma unroll
        for (int i = 0; i < 8; ++i) { zg[i] = z[front_rowmap(lane + 64 * i)]; zg[8 + i] = z[front_rowmap(512 + lane + 64 * i)]; zq[i] = z[front_rowmap(OFF_Q + 64 * i + lane)]; }
#pragma unroll
        for (int i = 0; i < 12; ++i) zk[i] = z[front_rowmap(OFF_KV + 64 * i + lane)];
#pragma unroll
        for (int i = 0; i < 32; ++i) zm[i] = z[front_rowmap(OFF_MG + lane + 64 * i)];
        zn = z[front_rowmap(OFF_NG + (lane < 24 ? lane : 0))];
        const bool smp = r >= MP; const int rs_ = r - MP, sb = rs_ >> 3, si = rs_ & 7, b = r >> 13, t = r & 8191;
        const int ri = rope_idx(r); const float cv = rc[ri * 32 + (lane & 31)], sv = rs[ri * 32 + (lane & 31)];
#pragma unroll
        for (int i = 0; i < 8; ++i) { const int c = lane + 64 * i; const float u = zg[i] * sigm(zg[8 + i]);
            U[(size_t)r * 512 + c] = (bf16)f2bf(u);
            if (smp) out[O_SCONV + (size_t)(sb * 30 + 22 + si) * 512 + c] = u;
            else if (t >= 8162) out[O_PCONV + (size_t)(b * 30 + t - 8162) * 512 + c] = u; }
#pragma unroll
        for (int h = 0; h < 8; ++h) { const float x = zq[h]; const float ms = wave_sum(x * x) * (1.0f / 64.0f);
            const float y = x * (1.0f / sqrtf(ms + EPS)) * qg; const float oth = __shfl_xor(y, 32);
            const float yr = lane < 32 ? y * cv - oth * sv : y * cv + oth * sv;
            QP[(size_t)r * 512 + 64 * h + lane] = (bf16)f2bf(y * C2); QR[(size_t)r * 512 + 64 * h + lane] = (bf16)f2bf(yr * C2); }
#pragma unroll
        for (int j = 0; j < 6; ++j)
#pragma unroll
            for (int kvh = 0; kvh < 2; ++kvh) {
                float x = zk[2 * j + kvh];
                if ((j & 1) == 0) { const float ms = wave_sum(x * x) * (1.0f / 64.0f); x = x * (1.0f / sqrtf(ms + EPS)) * (j == 0 ? kg0 : (j == 2 ? kg1 : kg2));
                    if (j >= 2) { const float oth = __shfl_xor(x, 32); x = lane < 32 ? x * cv - oth * sv : x * cv + oth * sv; } }
                const int cc = kvh * 64 + lane;
                if (j < 4) { const size_t po = (j == 0 ? O_PCK : j == 1 ? O_PCV : j == 2 ? O_PSK : O_PSV), so = (j == 0 ? O_SCK : j == 1 ? O_SCV : j == 2 ? O_SSK : O_SSV);
                    if (smp) out[so + (size_t)rs_ * 128 + cc] = x; else out[po + (size_t)r * 128 + cc] = x; }
                if (!smp && j >= 2) { const size_t blk = ((size_t)(b * 128 + (t >> 6)) * 2 + kvh) * 4096; const int key = t & 63;
                    if (j == 2) ((bf16*)(ws + WS_KSB))[blk + key * 64 + lane] = (bf16)f2bf(x); else if (j == 3) ((bf16*)(ws + WS_VST))[blk + lane * 64 + perm64(key)] = (bf16)f2bf(x);
                    else if (j == 4) ((bf16*)(ws + WS_KWB))[blk + key * 64 + lane] = (bf16)f2bf(x); else ((bf16*)(ws + WS_VWT))[blk + lane * 64 + perm64(key)] = (bf16)f2bf(x); }
                if (j >= 4) { if (smp) out[(j == 4 ? O_SWK : O_SWV) + (size_t)(sb * 512 + 504 + si) * 128 + cc] = x;
                        }
            }
        if (lane < 24) BG[(size_t)r * 24 + lane] = sigm(zn);
#pragma unroll
        for (int i = 0; i < 32; ++i) { const int c = lane + 64 * i; const float v = sigm(zm[i]);
            if (i < 16) GC[(size_t)r * 1024 + c] = (bf16)f2bf(v); else GN[(size_t)r * 1024 + c - 1024] = (bf16)f2bf(v); }
    }
}


constexpr int N_PHASES = 12;
#ifndef ONE_LAUNCH
#define ONE_LAUNCH 1
#endif
__global__ void __launch_bounds__(NWAVES * 64, 2) fwd(Args args) {
    extern __shared__ __attribute__((aligned(16))) unsigned char lds_raw[];
    LAS unsigned char* lds = (LAS unsigned char*)lds_raw;
    const int tid = threadIdx.x, lane = tid & 63, wave = __builtin_amdgcn_readfirstlane(tid >> 6);
    const int G = gridDim.x, bx = blockIdx.x;
    const int vcu = (G % 8 == 0) ? (bx % 8) * (G / 8) + bx / 8 : bx;
    const int gw = vcu * NWAVES + wave, NGW = G * NWAVES;
    unsigned char* ws = args.ws;
    for (int u = tid; u < (LDS_BYTES - RING_BYTES) / 4; u += NWAVES * 64) ((LAS unsigned*)(lds + RING_BYTES))[u] = 0u;
    __syncthreads();
    XcdBarrier bar; bar.bar = (unsigned*)(ws + WS_CTL) + CW_BAR; bar.x = 0; bar.st = nullptr;
    if (ONE_LAUNCH) bar = xcd_barrier_post((unsigned*)(ws + WS_CTL) + CW_BAR, (volatile LAS unsigned*)(lds + MISC_OFF) + 8);
    const int lo = args.ph_lo, hi = args.ph_hi;
#define IN(k) (lo <= (k) && (k) < hi)
#define SEAM(k) do { if (ONE_LAUNCH && IN(k) && hi > (k) + 1) xcd_barrier(bar); } while (0)
    const float* modp = (const float*)(ws + WS_MOD);
    if (IN(0)) { phase0(args, lds, gw, NGW, wave, lane); } SEAM(0);
    if (IN(1)) { norm_rows(args.in[0], args.in[1], args.in[14], modp, 0, 1024, (bf16*)(ws + WS_H), gw, NGW, lane); } SEAM(1);
    if (IN(2)) { pg8::Gemm g{(const bf16*)(ws + WS_H), (const bf16*)(ws + WS_WIN), MP, DINP, 1024}; pg8::StaticOrder S; S.init(MP, DINP, G, bx);
        const float* rcp_ = (const float*)(ws + WS_ROPE);
        pg8::EpiFront E{args.out, ws, args.in[16], args.in[17], rcp_, rcp_ + ROPE_N * 32, O_PCK, O_SCK, O_PWK, O_SWK, O_PCONV, O_SCONV,
                        WS_U, WS_QP, WS_QR, WS_GC, WS_GN, WS_BG, WS_KSB, WS_VST, WS_KWB, WS_VWT, WS_KWIN, WS_VWIN, C2};
        pg8::gemm_phase<pg8::EpiFront, pg8::StaticOrder, true, true>(lds, g, S, E);
        { float* zs = (float*)(ws + WS_ZS);
          small_gemm((const bf16*)(ws + WS_H) + (size_t)MP * 1024, (const bf16*)(ws + WS_WIN), DINP, 1024, vcu, G, wave, lane, lds, [&](int r, int c, f32x4 v) { *(f32x4*)(zs + (size_t)r * DINP + c) = v; }); } } SEAM(2);
    if (IN(3)) { sample_post(args, gw, NGW, lane); } SEAM(3);
    if (IN(4)) { phase_conv(args, lds, vcu, G, gw, NGW, wave, lane, tid); } SEAM(4);
    if (IN(5)) { pg8::Gemm g{(const bf16*)(ws + WS_CACT), (const bf16*)(ws + WS_WPW2), MP, 1024, 512}; pg8::StaticOrder S; S.init(MP, 1024, G, bx);
        pg8::EpiGate<false> E{(bf16*)(ws + WS_T1), (const bf16*)(ws + WS_GC), 1024};
        pg8::gemm_phase<pg8::EpiGate<false>, pg8::StaticOrder, true, true>(lds, g, S, E);
        { bf16* t1 = (bf16*)(ws + WS_T1) + (size_t)MP * 1024; const bf16* gc = (const bf16*)(ws + WS_GC) + (size_t)MP * 1024;
          small_gemm((const bf16*)(ws + WS_CACT) + (size_t)MP * 512, (const bf16*)(ws + WS_WPW2), 1024, 512, vcu, G, wave, lane, lds, [&](int r, int c, f32x4 v) {
              const v2u gg = *(const v2u*)(gc + (size_t)r * 1024 + c); v2u w; w.x = pk2(v[0] * pg8::bf_lo(gg.x), v[1] * pg8::bf_hi(gg.x)); w.y = pk2(v[2] * pg8::bf_lo(gg.y), v[3] * pg8::bf_hi(gg.y));
              *(v2u*)(t1 + (size_t)r * 1024 + c) = w; }); } }
    if (IN(5) && !IN(6)) SEAM(5);
    if (IN(6)) { phase_attn(args, lds, vcu, G, wave, lane, tid); } SEAM(6);
#if PROBE_ATTN
    if (IN(7)) { phase_attn_check(args, lds, gw, NGW, wave, lane); __syncthreads(); }
#endif
    if (IN(7)) { pg8::Gemm g{(const bf16*)(ws + WS_O), (const bf16*)(ws + WS_WNSA), MP, 1024, 512}; pg8::StaticOrder S; S.init(MP, 1024, G, bx);
        pg8::EpiGate<true> E{(bf16*)(ws + WS_T1), (const bf16*)(ws + WS_GN), 1024};
        pg8::gemm_phase<pg8::EpiGate<true>, pg8::StaticOrder, true, true>(lds, g, S, E);
        { bf16* t1 = (bf16*)(ws + WS_T1) + (size_t)MP * 1024; const bf16* gn = (const bf16*)(ws + WS_GN) + (size_t)MP * 1024;
          small_gemm((const bf16*)(ws + WS_O) + (size_t)MP * 512, (const bf16*)(ws + WS_WNSA), 1024, 512, vcu, G, wave, lane, lds, [&](int r, int c, f32x4 v) {
              const v2u gg = *(const v2u*)(gn + (size_t)r * 1024 + c); const v2u tt = *(const v2u*)(t1 + (size_t)r * 1024 + c); v2u w;
              w.x = pk2(pg8::bf_lo(tt.x) + v[0] * pg8::bf_lo(gg.x), pg8::bf_hi(tt.x) + v[1] * pg8::bf_hi(gg.x)); w.y = pk2(pg8::bf_lo(tt.y) + v[2] * pg8::bf_lo(gg.y), pg8::bf_hi(tt.y) + v[3] * pg8::bf_hi(gg.y));
              *(v2u*)(t1 + (size_t)r * 1024 + c) = w; }); } } SEAM(7);
    if (IN(8)) { pg8::Gemm g{(const bf16*)(ws + WS_T1), (const bf16*)(ws + WS_WOUT), MP, 1024, 1024}; pg8::StaticOrder S; S.init(MP, 1024, G, bx);
        pg8::EpiResGate<false, true> E{args.in[0], args.in[1], (bf16*)(ws + WS_Y1), modp + 2048};
        pg8::gemm_phase<pg8::EpiResGate<false, true>, pg8::StaticOrder, true, true>(lds, g, S, E);
        { const float* xs = args.in[1]; bf16* ys = (bf16*)(ws + WS_Y1) + (size_t)MP * 1024; const float* mg = modp + 2048;
          small_gemm((const bf16*)(ws + WS_T1) + (size_t)MP * 1024, (const bf16*)(ws + WS_WOUT), 1024, 1024, vcu, G, wave, lane, lds, [&](int r, int c, f32x4 v) {
              const f32x4 y = *(const f32x4*)(xs + (size_t)r * 1024 + c) + *(const f32x4*)(mg + (size_t)(4 + (r >> 3)) * 6144 + c) * v;
              v2u w; w.x = pk2(y[0], y[1]); w.y = pk2(y[2], y[3]); *(v2u*)(ys + (size_t)r * 1024 + c) = w; }); } } SEAM(8);
    if (IN(9)) { norm_rows_bf16((const bf16*)(ws + WS_Y1), args.in[29], modp, 3072, 4096, (bf16*)(ws + WS_H), gw, NGW, lane); } SEAM(9);
    if (IN(10)) { pg8::Gemm g{(const bf16*)(ws + WS_H), (const bf16*)(ws + WS_WGU), MP, 2 * DFF, 1024}; pg8::StaticOrder S; S.init(MP, 2 * DFF, G, bx);
        pg8::EpiSwiGlu E{(bf16*)(ws + WS_ACT), DFF};
        pg8::gemm_phase<pg8::EpiSwiGlu, pg8::StaticOrder, true, true>(lds, g, S, E);
        { bf16* act = (bf16*)(ws + WS_ACT) + (size_t)MP * DFF;
          small_gemm((const bf16*)(ws + WS_H) + (size_t)MP * 1024, (const bf16*)(ws + WS_WGU), 2 * DFF, 1024, vcu, G, wave, lane, lds, [&](int r, int c, f32x4 v) {
              f32x4 up; up[0] = __shfl_xor(v[0], 16); up[1] = __shfl_xor(v[1], 16); up[2] = __shfl_xor(v[2], 16); up[3] = __shfl_xor(v[3], 16);
              if ((c & 4) == 0) { v2u w; w.x = pk2(v[0] * sigm(v[0]) * up[0], v[1] * sigm(v[1]) * up[1]); w.y = pk2(v[2] * sigm(v[2]) * up[2], v[3] * sigm(v[3]) * up[3]);
                  *(v2u*)(act + (size_t)r * DFF + (128 * (c >> 8) + 32 * ((c >> 5) & 3) + 8 * ((c >> 3) & 3) + 4 * ((c >> 7) & 1))) = w; } }); } } SEAM(10);
    if (IN(11)) { pg8::Gemm g{(const bf16*)(ws + WS_ACT), (const bf16*)(ws + WS_WDOWN), MP, 1024, DFF}; pg8::StaticOrder S; S.init(MP, 1024, G, bx);
        pg8::EpiResGate<true, false> E{(const bf16*)(ws + WS_Y1), (const bf16*)(ws + WS_Y1) + (size_t)MP * 1024, args.out, modp + 5120};
        pg8::gemm_phase<pg8::EpiResGate<true, false>, pg8::StaticOrder, true, true>(lds, g, S, E);
        { float* ys = args.out + (size_t)MP * 1024; const bf16* y1 = (const bf16*)(ws + WS_Y1) + (size_t)MP * 1024; const float* mg = modp + 5120;
          small_gemm((const bf16*)(ws + WS_ACT) + (size_t)MP * DFF, (const bf16*)(ws + WS_WDOWN), 1024, DFF, vcu, G, wave, lane, lds, [&](int r, int c, f32x4 v) {
              const v2u t = *(const v2u*)(y1 + (size_t)r * 1024 + c); const f32x4 b = {pg8::bf_lo(t.x), pg8::bf_hi(t.x), pg8::bf_lo(t.y), pg8::bf_hi(t.y)};
              *(f32x4*)(ys + (size_t)r * 1024 + c) = b + *(const f32x4*)(mg + (size_t)(4 + (r >> 3)) * 6144 + c) * v; }); } }
#if PROBE_ATTN
    if (ONE_LAUNCH) { xcd_barrier(bar); const unsigned cnt = __hip_atomic_load((unsigned*)(ws + WS_CTL) + 8, __ATOMIC_RELAXED, __HIP_MEMORY_SCOPE_AGENT);
        if (bx == 0 && tid < 64 && cnt != 0u) args.out[tid] = 10.0f * (float)(1 + (31 - __builtin_clz(cnt))); }
#endif
#undef IN
#undef SEAM
}

extern "C" void kernel_launch(void* const* d_in, const int* in_sizes, int n_in, void* d_out, int out_size, void* d_ws, size_t ws_size, hipStream_t stream) {
    static int grid = 0;
    if (grid == 0) {
        if (n_in != 33 || (size_t)out_size != O_END || ws_size < WS_END) { fprintf(stderr, "kernel_launch: unexpected shapes (n_in %d out %d ws %zu)\n", n_in, out_size, ws_size); grid = -1; return; }
        int dev = 0, cus = 0, per_cu = 0;
        if (hipGetDevice(&dev) != hipSuccess || hipDeviceGetAttribute(&cus, hipDeviceAttributeMultiprocessorCount, dev) != hipSuccess) { grid = -1; return; }
        if (hipFuncSetAttribute((const void*)fwd, hipFuncAttributeMaxDynamicSharedMemorySize, LDS_BYTES) != hipSuccess) { fprintf(stderr, "kernel_launch: hipFuncSetAttribute failed\n"); grid = -1; return; }
        if (hipOccupancyMaxActiveBlocksPerMultiprocessor(&per_cu, (const void*)fwd, NWAVES * 64, LDS_BYTES) != hipSuccess || per_cu < 1) fprintf(stderr, "kernel_launch: occupancy query says %d\n", per_cu);
        (void)hipGetLastError();
        grid = cus;
    }
    if (grid < 0) return;
    (void)hipMemsetAsync((char*)d_ws, 0, ZERO_BYTES, stream);
    Args a{};
    for (int i = 0; i < 33; ++i) a.in[i] = (const float*)d_in[i];
    a.out = (float*)d_out; a.ws = (unsigned char*)d_ws;
#if ONE_LAUNCH
    a.ph_lo = 0; a.ph_hi = N_PHASES;
    hipLaunchKernelGGL(fwd, dim3(grid), dim3(NWAVES * 64), LDS_BYTES, stream, a);
#else
    for (int p = 0; p < N_PHASES; ++p) { a.ph_lo = p; a.ph_hi = p + 1; hipLaunchKernelGGL(fwd, dim3(grid), dim3(NWAVES * 64), LDS_BYTES, stream, a); }
#endif
}
```

```cpp
#include <hip/hip_runtime.h>
#include <cstdio>
#include <cstdint>
#include <cmath>
#define PROBE_PHASE -1
#ifndef PROBE_ATTN
#define PROBE_ATTN 0
#endif
namespace pg8 {
#define PG8_LAS __attribute__((address_space(3)))
typedef unsigned short bf16_t;
typedef short bf16x8 __attribute__((ext_vector_type(8)));
typedef float f32x4 __attribute__((ext_vector_type(4)));
typedef unsigned u32x4 __attribute__((ext_vector_type(4)));
constexpr int BM = 256, BK = 64, HALF = 128, HTB = HALF * BK * 2  , STAGE_BYTES = 8 * HTB, NXCD = 8, WGM = 8;

__host__ __device__ __forceinline__ int lds_byte(int r, int c) { const int st = (r >> 4) * 2 + (c >> 5), rr = r & 15, cc = c & 31, ob = rr * 64 + cc * 2; return st * 1024 + (ob ^ (((ob >> 9) & 1) << 5)); }
__host__ __device__ __forceinline__ void stage_rc(int b, int& R, int& C) { const int st = b / 1024, sb = b % 1024, swz = sb ^ (((sb >> 9) & 1) << 5); R = (st >> 1) * 16 + swz / 64; C = (st & 1) * 32 + (swz % 64) / 2; }
__host__ __device__ __forceinline__ int perm32(int rho) { const int n = rho >> 4, i = rho & 15; return 8 * (i >> 2) + 4 * n + (i & 3); }

struct Unit { int pm, pn; };
struct Gemm { const bf16_t* A; const bf16_t* Bt; int M, N, K; };

struct StaticOrder {
    int nM, nN, nwg, G, c;
    __host__ __device__ void init(int M, int N, int G_, int c_) { nM = M / BM; nN = N / BM; nwg = nM * nN; G = G_; c = c_; }
    __host__ __device__ bool next(int i, Unit& u) const {
        const long L = (long)i * G + c; if (L >= nwg) return false;
        int wgid = (int)L; { const int q = nwg / NXCD, r = nwg % NXCD, xcd = wgid % NXCD, off = wgid / NXCD; wgid = (xcd < r ? xcd * (q + 1) : r * (q + 1) + (xcd - r) * q) + off; }
        const int nig = WGM * nN, gid = wgid / nig, fm = gid * WGM, gsz = (nM - fm) < WGM ? (nM - fm) : WGM;
        u.pm = fm + ((wgid % nig) % gsz); u.pn = (wgid % nig) / gsz; return true;
    }
    __device__ __forceinline__ void a_ready(const Unit&) const {}
    __device__ __forceinline__ void done(const Unit&) const {}
};

typedef float f32x2_cv __attribute__((ext_vector_type(2))); typedef __bf16 bf16x2_cv __attribute__((ext_vector_type(2)));
__device__ __forceinline__ unsigned cvt_pk_bf16(float lo, float hi) { f32x2_cv v = {lo, hi}; bf16x2_cv b = __builtin_convertvector(v, bf16x2_cv); return __builtin_bit_cast(unsigned, b); }
typedef float f32x2 __attribute__((ext_vector_type(2)));

constexpr int ROWS_P = 32768;
__device__ __forceinline__ int mod_row(int r) { return r < ROWS_P ? (r >> 13) : 4 + ((r - ROWS_P) >> 3); }
__device__ __forceinline__ float bf_lo(unsigned w) { return __uint_as_float(w << 16); }
__device__ __forceinline__ float bf_hi(unsigned w) { return __uint_as_float(w & 0xffff0000u); }
__device__ __forceinline__ float sigmoid_f(float x) { return __builtin_amdgcn_rcpf(1.0f + __builtin_amdgcn_exp2f(-1.4426950408889634f * x)); }

struct EpiF32 {
    static constexpr bool PERM = false, AFTER_DRAIN = false;
    float* C; int ldc;
    __device__ __forceinline__ void operator()(const f32x4 (&acc)[2][2][4][2], const Unit& u, int wr, int wc, int fr, int fq) const {
        const int row0 = u.pm * BM + wr * 64 + fr, col0 = u.pn * BM + wc * 32 + 4 * fq;
#pragma unroll
        for (int ai = 0; ai < 2; ++ai)
#pragma unroll
            for (int m = 0; m < 4; ++m) { float* rowp = C + (size_t)(row0 + ai * HALF + m * 16) * ldc + col0;
#pragma unroll
                for (int bj = 0; bj < 2; ++bj)
#pragma unroll
                    for (int n = 0; n < 2; ++n) *(f32x4*)(rowp + bj * HALF + n * 16) = acc[ai][bj][m][n]; }
    }
};
template <bool ADD> struct EpiGate {
    static constexpr bool PERM = true, AFTER_DRAIN = false;
    bf16_t* O; const bf16_t* G; int ldc;
    __device__ __forceinline__ void operator()(const f32x4 (&acc)[2][2][4][2], const Unit& u, int wr, int wc, int fr, int fq) const {
        const int row0 = u.pm * BM + wr * 64 + fr, col0 = u.pn * BM + wc * 32 + 8 * fq;
#pragma unroll
        for (int ai = 0; ai < 2; ++ai)
#pragma unroll
            for (int m = 0; m < 4; ++m) { const size_t ro = (size_t)(row0 + ai * HALF + m * 16) * ldc + col0;
#pragma unroll
                for (int bj = 0; bj < 2; ++bj) {
                    const u32x4 g = *(const u32x4*)(G + ro + bj * HALF);
                    f32x4 v0 = acc[ai][bj][m][0], v1 = acc[ai][bj][m][1];
                    v0[0] *= bf_lo(g.x); v0[1] *= bf_hi(g.x); v0[2] *= bf_lo(g.y); v0[3] *= bf_hi(g.y);
                    v1[0] *= bf_lo(g.z); v1[1] *= bf_hi(g.z); v1[2] *= bf_lo(g.w); v1[3] *= bf_hi(g.w);
                    if (ADD) { const u32x4 t = *(const u32x4*)(O + ro + bj * HALF);
                        v0[0] += bf_lo(t.x); v0[1] += bf_hi(t.x); v0[2] += bf_lo(t.y); v0[3] += bf_hi(t.y);
                        v1[0] += bf_lo(t.z); v1[1] += bf_hi(t.z); v1[2] += bf_lo(t.w); v1[3] += bf_hi(t.w); }
                    u32x4 w; w.x = cvt_pk_bf16(v0[0], v0[1]); w.y = cvt_pk_bf16(v0[2], v0[3]); w.z = cvt_pk_bf16(v1[0], v1[1]); w.w = cvt_pk_bf16(v1[2], v1[3]);
                    *(u32x4*)(O + ro + bj * HALF) = w; } }
    }
};
template <bool BASE_BF16, bool OUT_BF16> struct EpiResGate {
    static constexpr bool PERM = true, AFTER_DRAIN = false;
    const void* bp; const void* bs; void* out; const float* modg;
    __device__ __forceinline__ void operator()(const f32x4 (&acc)[2][2][4][2], const Unit& u, int wr, int wc, int fr, int fq) const {
        const int row0 = u.pm * BM + wr * 64 + fr, col0 = u.pn * BM + wc * 32 + 8 * fq;
        const float* g = modg + (size_t)mod_row(u.pm * BM) * 6144 + col0;
        f32x4 gv[2][2];
#pragma unroll
        for (int bj = 0; bj < 2; ++bj)
#pragma unroll
            for (int n = 0; n < 2; ++n) gv[bj][n] = *(const f32x4*)(g + bj * HALF + n * 4);
#pragma unroll
        for (int ai = 0; ai < 2; ++ai)
#pragma unroll
            for (int m = 0; m < 4; ++m) { const int r = row0 + ai * HALF + m * 16;
                const size_t bo = (r < ROWS_P ? (size_t)r : (size_t)(r - ROWS_P)) * 1024 + col0, oo = (size_t)r * 1024 + col0;
                const void* bb = r < ROWS_P ? bp : bs;
#pragma unroll
                for (int bj = 0; bj < 2; ++bj) { f32x4 b0, b1;
                    if (BASE_BF16) { const u32x4 t = *(const u32x4*)((const bf16_t*)bb + bo + bj * HALF);
                        b0 = (f32x4){bf_lo(t.x), bf_hi(t.x), bf_lo(t.y), bf_hi(t.y)}; b1 = (f32x4){bf_lo(t.z), bf_hi(t.z), bf_lo(t.w), bf_hi(t.w)}; }
                    else { const float* b = (const float*)bb + bo + bj * HALF; b0 = *(const f32x4*)b; b1 = *(const f32x4*)(b + 4); }
                    const f32x4 v0 = b0 + gv[bj][0] * acc[ai][bj][m][0], v1 = b1 + gv[bj][1] * acc[ai][bj][m][1];
                    if (OUT_BF16) { u32x4 w; w.x = cvt_pk_bf16(v0[0], v0[1]); w.y = cvt_pk_bf16(v0[2], v0[3]); w.z = cvt_pk_bf16(v1[0], v1[1]); w.w = cvt_pk_bf16(v1[2], v1[3]);
                        *(u32x4*)((bf16_t*)out + oo + bj * HALF) = w; }
                    else { float* o = (float*)out + oo + bj * HALF; *(f32x4*)o = v0; *(f32x4*)(o + 4) = v1; } } }
    }
};
struct EpiSwiGlu {
    static constexpr bool PERM = true, AFTER_DRAIN = false;
    bf16_t* O; int ldo;
    __device__ __forceinline__ void operator()(const f32x4 (&acc)[2][2][4][2], const Unit& u, int wr, int wc, int fr, int fq) const {
        const int row0 = u.pm * BM + wr * 64 + fr, oc0 = u.pn * 128 + wc * 32 + 8 * fq;
#pragma unroll
        for (int ai = 0; ai < 2; ++ai)
#pragma unroll
            for (int m = 0; m < 4; ++m) { bf16_t* rowp = O + (size_t)(row0 + ai * HALF + m * 16) * ldo + oc0; f32x4 a[2];
#pragma unroll
                for (int bj = 0; bj < 2; ++bj) { const f32x4 gt = acc[ai][bj][m][0], up = acc[ai][bj][m][1];
#pragma unroll
                    for (int i = 0; i < 4; ++i) a[bj][i] = gt[i] * sigmoid_f(gt[i]) * up[i]; }
                u32x4 w; w.x = cvt_pk_bf16(a[0][0], a[0][1]); w.y = cvt_pk_bf16(a[0][2], a[0][3]); w.z = cvt_pk_bf16(a[1][0], a[1][1]); w.w = cvt_pk_bf16(a[1][2], a[1][3]);
                *(u32x4*)rowp = w; }
    }
};

struct EpiFront {
    static constexpr bool PERM = true, AFTER_DRAIN = false;
    float* out; unsigned char* ws; const float* qg; const float* kng; const float* rc; const float* rsn;
    size_t o_pck, o_sck, o_pwk, o_swk, o_pconv, o_sconv;
    size_t w_u, w_qp, w_qr, w_gc, w_gn, w_bg, w_ksb, w_vst, w_kwb, w_vwt, w_kwin, w_vwin;
    float c2;
    __device__ __forceinline__ void operator()(const f32x4 (&acc)[2][2][4][2], const Unit& u, int wr, int wc, int fr, int fq) const {
        typedef unsigned u32x2 __attribute__((ext_vector_type(2)));
        const int pn = u.pn;
        const int row0 = u.pm * BM + wr * 64 + fr;
        if (pn < 4) {
            bf16_t* U = (bf16_t*)(ws + w_u);
#pragma unroll
            for (int ai = 0; ai < 2; ++ai)
#pragma unroll
                for (int m = 0; m < 4; ++m) { const int r = row0 + ai * HALF + m * 16; const int t = r & 8191;
#pragma unroll
                    for (int bj = 0; bj < 2; ++bj) { const int ch = 128 * pn + 64 * bj + 16 * wc + 4 * fq; const f32x4 a4 = acc[ai][bj][m][0], b4 = acc[ai][bj][m][1]; f32x4 u4;
#pragma unroll
                        for (int i = 0; i < 4; ++i) u4[i] = a4[i] * sigmoid_f(b4[i]);
                        u32x2 w; w.x = cvt_pk_bf16(u4[0], u4[1]); w.y = cvt_pk_bf16(u4[2], u4[3]); *(u32x2*)(U + (size_t)r * 512 + ch) = w;
                        if (t >= 8162) *(f32x4*)(out + o_pconv + (size_t)((r >> 13) * 30 + t - 8162) * 512 + ch) = u4; } }
        } else if (pn < 9) {
            const bool isq = pn < 6; const int kvt = pn - 6;
            const bool isv = !isq && (wc >= 2); const bool dorope = isq || (!isv && kvt >= 1);
            const float* gp = isq ? qg : kng + kvt * 64;
            f32x4 gn[2][2];
#pragma unroll
            for (int bj = 0; bj < 2; ++bj)
#pragma unroll
                for (int n = 0; n < 2; ++n) gn[bj][n] = isv ? (f32x4){1.f, 1.f, 1.f, 1.f} : *(const f32x4*)(gp + 32 * bj + 8 * fq + 4 * n);
#pragma unroll
            for (int ai = 0; ai < 2; ++ai)
#pragma unroll
                for (int m = 0; m < 4; ++m) { const int r = row0 + ai * HALF + m * 16;
                    f32x4 y[2][2];
#pragma unroll
                    for (int bj = 0; bj < 2; ++bj)
#pragma unroll
                        for (int n = 0; n < 2; ++n) y[bj][n] = acc[ai][bj][m][n];
                    if (!isv) { float ss = 0.f;
#pragma unroll
                        for (int bj = 0; bj < 2; ++bj)
#pragma unroll
                            for (int n = 0; n < 2; ++n) ss += (y[bj][n][0] * y[bj][n][0] + y[bj][n][1] * y[bj][n][1]) + (y[bj][n][2] * y[bj][n][2] + y[bj][n][3] * y[bj][n][3]);
                        ss += __shfl_xor(ss, 16); ss += __shfl_xor(ss, 32);
                        const float rstd = 1.0f / sqrtf(ss * (1.0f / 64.0f) + 1e-6f);
#pragma unroll
                        for (int bj = 0; bj < 2; ++bj)
#pragma unroll
                            for (int n = 0; n < 2; ++n) y[bj][n] = y[bj][n] * rstd * gn[bj][n]; }
                    const int ri = r & 8191;
                    f32x4 yr[2][2];
                    if (dorope) {
#pragma unroll
                        for (int n = 0; n < 2; ++n) { const f32x4 c4 = *(const f32x4*)(rc + (size_t)ri * 32 + 8 * fq + 4 * n), s4 = *(const f32x4*)(rsn + (size_t)ri * 32 + 8 * fq + 4 * n);
                            yr[0][n] = y[0][n] * c4 - y[1][n] * s4; yr[1][n] = y[1][n] * c4 + y[0][n] * s4; } }
                    else {
#pragma unroll
                        for (int n = 0; n < 2; ++n) { yr[0][n] = y[0][n]; yr[1][n] = y[1][n]; } }
                    if (isq) { const int h = 4 * (pn - 4) + wc; bf16_t* qp = (bf16_t*)(ws + w_qp) + (size_t)r * 512 + h * 64 + 8 * fq; bf16_t* qr = (bf16_t*)(ws + w_qr) + (size_t)r * 512 + h * 64 + 8 * fq;
#pragma unroll
                        for (int bj = 0; bj < 2; ++bj) { const f32x4 a0 = y[bj][0] * c2, a1 = y[bj][1] * c2, b0 = yr[bj][0] * c2, b1 = yr[bj][1] * c2; u32x4 w;
                            w.x = cvt_pk_bf16(a0[0], a0[1]); w.y = cvt_pk_bf16(a0[2], a0[3]); w.z = cvt_pk_bf16(a1[0], a1[1]); w.w = cvt_pk_bf16(a1[2], a1[3]); *(u32x4*)(qp + 32 * bj) = w;
                            w.x = cvt_pk_bf16(b0[0], b0[1]); w.y = cvt_pk_bf16(b0[2], b0[3]); w.z = cvt_pk_bf16(b1[0], b1[1]); w.w = cvt_pk_bf16(b1[2], b1[3]); *(u32x4*)(qr + 32 * bj) = w; } }
                    else { const int kvh = wc & 1; const int j = 2 * kvt + (isv ? 1 : 0);
                        const int t = r & 8191;
                        float* fo = nullptr;
                        if (j < 4) fo = out + o_pck + (size_t)j * 4194304 + (size_t)r * 128; else if (t >= 7680) fo = out + o_pwk + (size_t)(j - 4) * 262144 + (size_t)((r >> 13) * 512 + t - 7680) * 128;
                        if (fo) {
#pragma unroll
                            for (int bj = 0; bj < 2; ++bj)
#pragma unroll
                                for (int n = 0; n < 2; ++n) *(f32x4*)(fo + kvh * 64 + 32 * bj + 8 * fq + 4 * n) = yr[bj][n]; }
#if defined(PROBE_ATTN) && PROBE_ATTN
                        if (kvt == 2) { float* kw = (float*)(ws + (isv ? w_vwin : w_kwin)) + (size_t)r * 128 + kvh * 64;
#pragma unroll
                            for (int bj = 0; bj < 2; ++bj)
#pragma unroll
                                for (int n = 0; n < 2; ++n) *(f32x4*)(kw + 32 * bj + 8 * fq + 4 * n) = yr[bj][n]; }
#endif
                        if (kvt >= 1) { const int key = t & 63; const size_t blk = ((size_t)((r >> 13) * 128 + (t >> 6)) * 2 + kvh) * 4096;
                            if (!isv) { bf16_t* kd = (bf16_t*)(ws + (kvt == 1 ? w_ksb : w_kwb)) + blk + key * 64 + 8 * fq;
#pragma unroll
                                for (int bj = 0; bj < 2; ++bj) { u32x4 w; w.x = cvt_pk_bf16(yr[bj][0][0], yr[bj][0][1]); w.y = cvt_pk_bf16(yr[bj][0][2], yr[bj][0][3]); w.z = cvt_pk_bf16(yr[bj][1][0], yr[bj][1][1]); w.w = cvt_pk_bf16(yr[bj][1][2], yr[bj][1][3]);
                                    *(u32x4*)(kd + 32 * bj) = w; } }
                            else { const int kp = (key & 32) | (((key >> 2) & 3) << 3) | (((key >> 4) & 1) << 2) | (key & 3);
                                bf16_t* vd = (bf16_t*)(ws + (kvt == 1 ? w_vst : w_vwt)) + blk + kp;
#pragma unroll
                                for (int bj = 0; bj < 2; ++bj)
#pragma unroll
                                    for (int n = 0; n < 2; ++n)
#pragma unroll
                                        for (int i = 0; i < 4; ++i) { const unsigned b2 = cvt_pk_bf16(y[bj][n][i], 0.f); vd[(size_t)(32 * bj + 8 * fq + 4 * n + i) * 64] = (bf16_t)(b2 & 0xffffu); } } }
                    } }
        } else if (pn < 17) {
            bf16_t* G = (bf16_t*)(ws + (pn < 13 ? w_gc : w_gn)); const int cb = 256 * ((pn - 9) & 3) + 32 * wc + 8 * fq;
#pragma unroll
            for (int ai = 0; ai < 2; ++ai)
#pragma unroll
                for (int m = 0; m < 4; ++m) { const int r = row0 + ai * HALF + m * 16;
#pragma unroll
                    for (int bj = 0; bj < 2; ++bj) { const f32x4 v0 = acc[ai][bj][m][0], v1 = acc[ai][bj][m][1]; u32x4 w;
                        w.x = cvt_pk_bf16(sigmoid_f(v0[0]), sigmoid_f(v0[1])); w.y = cvt_pk_bf16(sigmoid_f(v0[2]), sigmoid_f(v0[3])); w.z = cvt_pk_bf16(sigmoid_f(v1[0]), sigmoid_f(v1[1])); w.w = cvt_pk_bf16(sigmoid_f(v1[2]), sigmoid_f(v1[3]));
                        *(u32x4*)(G + (size_t)r * 1024 + cb + 128 * bj) = w; } }
        } else {
            if (wc == 0 && fq < 3) { float* BG = (float*)(ws + w_bg);
#pragma unroll
                for (int ai = 0; ai < 2; ++ai)
#pragma unroll
                    for (int m = 0; m < 4; ++m) { const int r = row0 + ai * HALF + m * 16;
#pragma unroll
                        for (int n = 0; n < 2; ++n) { const int c = 8 * fq + 4 * n; const f32x4 v = acc[ai][0][m][n]; f32x4 o;
#pragma unroll
                            for (int i = 0; i < 4; ++i) o[i] = sigmoid_f(v[i]);
                            *(f32x4*)(BG + (size_t)r * 24 + c) = o; } } }
        }
    }
};
template <class Epi, class Sched, bool ALIGN_EPI = false, bool SP2 = false>
__device__ __forceinline__ void gemm_phase(PG8_LAS unsigned char* lds, const Gemm g, const Sched& S, const Epi& E) {
    const int tid = threadIdx.x, wid = __builtin_amdgcn_readfirstlane(tid >> 6), lane = tid & 63, wr = wid >> 2, wc = wid & 3, fr = lane & 15, fq = lane >> 4;
    const int K = g.K, nt = K / BK;
    unsigned voffA[2], voffB[2];
#pragma unroll
    for (int i = 0; i < 2; ++i) { int R, C; stage_rc(tid * 16 + i * 8192, R, C); const int Rb = Epi::PERM ? ((R & ~31) + perm32(R & 31)) : R;
        voffA[i] = (unsigned)(R * K + C) * 2u; voffB[i] = (unsigned)(Rb * K + C) * 2u; }
    const size_t kstep = (size_t)(BK * 2);
    const size_t hstep = (size_t)HALF * K * 2;
    const size_t tstep = 2 * hstep;
    const unsigned ldsw = (unsigned)wid * 1024u;
    const int aoff = lds_byte(wr * 64 + fr, fq * 8), boff = lds_byte(wc * 32 + fr, fq * 8);
#define PG8_SA(b, h) (((b) * 2 + (h)) * HTB)
#define PG8_SB(b, h) ((4 + (b) * 2 + (h)) * HTB)
#define PG8_STAGE(bufoff, gbase, voff) do { _Pragma("unroll") for (int _i = 0; _i < 2; ++_i) \
        __builtin_amdgcn_global_load_lds((const unsigned*)((const char*)(gbase) + (voff)[_i]), (PG8_LAS unsigned*)(lds + (bufoff) + ldsw + _i * 8192), 16, 0, 0); } while (0)
#define PG8_LDA(dst, b, h) do { _Pragma("unroll") for (int m = 0; m < 4; ++m) _Pragma("unroll") for (int k = 0; k < 2; ++k) dst[m][k] = *(const PG8_LAS bf16x8*)(lds + PG8_SA(b, h) + aoff + m * 2048 + k * 1024); } while (0)
#define PG8_LDB(dst, b, h) do { _Pragma("unroll") for (int n = 0; n < 2; ++n) _Pragma("unroll") for (int k = 0; k < 2; ++k) dst[n][k] = *(const PG8_LAS bf16x8*)(lds + PG8_SB(b, h) + boff + n * 2048 + k * 1024); } while (0)
#define PG8_MMA(ai, bj, At, Bt) do { __builtin_amdgcn_s_setprio(1); _Pragma("unroll") for (int m = 0; m < 4; ++m) _Pragma("unroll") for (int n = 0; n < 2; ++n) _Pragma("unroll") for (int k = 0; k < 2; ++k) \
        acc[ai][bj][m][n] = __builtin_amdgcn_mfma_f32_16x16x32_bf16(Bt[n][k], At[m][k], acc[ai][bj][m][n], 0, 0, 0); __builtin_amdgcn_s_setprio(0); } while (0)
#define PG8_WAIT_V(n) asm volatile("s_waitcnt vmcnt(" #n ")" ::: "memory")
#define PG8_WAIT_L(n) asm volatile("s_waitcnt lgkmcnt(" #n ")" ::: "memory")
#define PG8_BAR __builtin_amdgcn_s_barrier()
#define PG8_SCHED __builtin_amdgcn_sched_barrier(0)
    Unit cur, nxt; int ui = 0;
    if (!S.next(0, cur)) return;
    f32x4 acc[2][2][4][2];
#pragma unroll
    for (int a = 0; a < 2; ++a)
#pragma unroll
        for (int b = 0; b < 2; ++b)
#pragma unroll
            for (int m = 0; m < 4; ++m)
#pragma unroll
                for (int n = 0; n < 2; ++n) acc[a][b][m][n] = (f32x4){0.f, 0.f, 0.f, 0.f};
    bf16x8 At[4][2], B0[2][2], B1[2][2];
    const char* cA = (const char*)g.A + (size_t)cur.pm * tstep; const char* cB = (const char*)g.Bt + (size_t)cur.pn * tstep;
    S.a_ready(cur);
    if constexpr (SP2) {
        PG8_STAGE(PG8_SB(0, 0), cB, voffB); PG8_STAGE(PG8_SB(0, 1), cB + hstep, voffB); PG8_STAGE(PG8_SA(0, 0), cA, voffA); PG8_STAGE(PG8_SA(0, 1), cA + hstep, voffA);
        if (wr == 1) PG8_BAR;
        PG8_WAIT_V(2); PG8_BAR;
        PG8_STAGE(PG8_SB(1, 0), cB + kstep, voffB); PG8_STAGE(PG8_SA(1, 0), cA + kstep, voffA); PG8_STAGE(PG8_SB(1, 1), cB + hstep + kstep, voffB);
        PG8_WAIT_V(6); PG8_BAR;
    } else {
        PG8_STAGE(PG8_SB(0, 0), cB, voffB); PG8_STAGE(PG8_SA(0, 0), cA, voffA); PG8_STAGE(PG8_SB(0, 1), cB + hstep, voffB); PG8_STAGE(PG8_SA(0, 1), cA + hstep, voffA);
        if (wr == 1) PG8_BAR;
        PG8_WAIT_V(4); PG8_BAR;
        PG8_STAGE(PG8_SB(1, 0), cB + kstep, voffB); PG8_STAGE(PG8_SA(1, 0), cA + kstep, voffA); PG8_STAGE(PG8_SB(1, 1), cB + hstep + kstep, voffB);
        PG8_WAIT_V(6); PG8_BAR;
    }
    for (;;) {
        const bool has_next = S.next(ui + 1, nxt);
        const char* nA = has_next ? (const char*)g.A + (size_t)nxt.pm * tstep : cA; const char* nB = has_next ? (const char*)g.Bt + (size_t)nxt.pn * tstep : cB;
        for (int t = 0; t < nt; t += 2) {
            const bool last = (t == nt - 2);
            const char* a1 = cA + (size_t)(t + 1) * kstep;
            const char* a2 = last ? nA : cA + (size_t)(t + 2) * kstep; const char* b2 = last ? nB : cB + (size_t)(t + 2) * kstep;
            const char* a3 = a2 + kstep; const char* b3 = b2 + kstep;
            if (last && has_next) S.a_ready(nxt);
            if constexpr (SP2) {
            PG8_LDB(B0, 0, 0); PG8_LDB(B1, 0, 1); PG8_SCHED; PG8_LDA(At, 0, 0); PG8_STAGE(PG8_SA(1, 1), a1 + hstep, voffA);
            PG8_WAIT_V(8); PG8_WAIT_L(0); PG8_BAR; PG8_MMA(0, 0, At, B0); PG8_MMA(0, 1, At, B1); PG8_BAR; PG8_SCHED;
            PG8_LDA(At, 0, 1); PG8_STAGE(PG8_SB(0, 0), b2, voffB); PG8_STAGE(PG8_SB(0, 1), b2 + hstep, voffB); PG8_STAGE(PG8_SA(0, 0), a2, voffA);
            PG8_WAIT_V(8); PG8_WAIT_L(0); PG8_BAR; PG8_MMA(1, 0, At, B0); PG8_MMA(1, 1, At, B1); PG8_BAR; PG8_SCHED;
            PG8_LDB(B0, 1, 0); PG8_LDB(B1, 1, 1); PG8_SCHED; PG8_LDA(At, 1, 0); PG8_STAGE(PG8_SA(0, 1), a2 + hstep, voffA);
            PG8_WAIT_V(8); PG8_WAIT_L(0); PG8_BAR; PG8_MMA(0, 0, At, B0); PG8_MMA(0, 1, At, B1); PG8_BAR; PG8_SCHED;
            PG8_LDA(At, 1, 1); PG8_STAGE(PG8_SB(1, 0), b3, voffB); PG8_STAGE(PG8_SB(1, 1), b3 + hstep, voffB); PG8_STAGE(PG8_SA(1, 0), a3, voffA);
            PG8_WAIT_V(8); PG8_WAIT_L(0); PG8_BAR; PG8_MMA(1, 0, At, B0); PG8_MMA(1, 1, At, B1); PG8_BAR; PG8_SCHED;
            } else {
            PG8_LDB(B0, 0, 0); PG8_SCHED; PG8_LDA(At, 0, 0); PG8_STAGE(PG8_SA(1, 1), a1 + hstep, voffA);
            PG8_WAIT_L(8); PG8_BAR; PG8_WAIT_L(0); PG8_MMA(0, 0, At, B0); PG8_BAR; PG8_SCHED;
            PG8_LDB(B1, 0, 1); PG8_STAGE(PG8_SB(0, 0), b2, voffB);
            PG8_BAR; PG8_WAIT_L(0); PG8_MMA(0, 1, At, B1); PG8_BAR;
            PG8_LDA(At, 0, 1); PG8_STAGE(PG8_SA(0, 0), a2, voffA);
            PG8_BAR; PG8_WAIT_L(0); PG8_MMA(1, 0, At, B0); PG8_BAR; PG8_SCHED;
            PG8_STAGE(PG8_SB(0, 1), b2 + hstep, voffB);
            PG8_WAIT_V(6); PG8_BAR; PG8_MMA(1, 1, At, B1); PG8_BAR;
            PG8_LDB(B0, 1, 0); PG8_SCHED; PG8_LDA(At, 1, 0); PG8_STAGE(PG8_SA(0, 1), a2 + hstep, voffA);
            PG8_WAIT_L(8); PG8_BAR; PG8_WAIT_L(0); PG8_MMA(0, 0, At, B0); PG8_BAR; PG8_SCHED;
            PG8_LDB(B1, 1, 1); PG8_STAGE(PG8_SB(1, 0), b3, voffB);
            PG8_BAR; PG8_WAIT_L(0); PG8_MMA(0, 1, At, B1); PG8_BAR;
            PG8_LDA(At, 1, 1); PG8_STAGE(PG8_SA(1, 0), a3, voffA);
            PG8_BAR; PG8_WAIT_L(0); PG8_MMA(1, 0, At, B0); PG8_BAR; PG8_SCHED;
            PG8_STAGE(PG8_SB(1, 1), b3 + hstep, voffB);
            PG8_WAIT_V(6); PG8_BAR; PG8_MMA(1, 1, At, B1); PG8_BAR;
            }
        }
        if constexpr (ALIGN_EPI) { if (wr == 0) PG8_BAR; }
        if constexpr (!Epi::AFTER_DRAIN) { E(acc, cur, wr, wc, fr, fq); S.done(cur); }
        if (!has_next) break;
#pragma unroll
        for (int a = 0; a < 2; ++a)
#pragma unroll
            for (int b = 0; b < 2; ++b)
#pragma unroll
                for (int m = 0; m < 4; ++m)
#pragma unroll
                    for (int n = 0; n < 2; ++n) acc[a][b][m][n] = (f32x4){0.f, 0.f, 0.f, 0.f};
        cur = nxt; cA = nA; cB = nB; ++ui;
        if constexpr (ALIGN_EPI) { if (wr == 1) PG8_BAR; }
    }
    PG8_WAIT_V(0);
    if constexpr (!ALIGN_EPI) { if (wr == 0) PG8_BAR; }
    PG8_BAR;
    if constexpr (Epi::AFTER_DRAIN) { E.fused(acc, cur, wr, wc, fr, fq, lds, wid, lane); S.done(cur); }
#undef PG8_SA
#undef PG8_SB
#undef PG8_STAGE
#undef PG8_LDA
#undef PG8_LDB
#undef PG8_MMA
#undef PG8_WAIT_V
#undef PG8_WAIT_L
#undef PG8_BAR
#undef PG8_SCHED
}
}
#define GAS __attribute__((address_space(1)))
#define LAS __attribute__((address_space(3)))
typedef unsigned short bf16;
typedef unsigned v4u __attribute__((ext_vector_type(4)));
typedef float f32x4 __attribute__((ext_vector_type(4)));
typedef short bf16x8 __attribute__((ext_vector_type(8)));
typedef GAS unsigned gu32;
typedef GAS unsigned long long gu64;
#define RLX_AGENT __ATOMIC_RELAXED, __HIP_MEMORY_SCOPE_AGENT
#define LDS_WAIT() asm volatile("s_waitcnt lgkmcnt(0)" ::: "memory")
#define VM_WAIT() asm volatile("s_waitcnt vmcnt(0)" ::: "memory")
__device__ __forceinline__ unsigned long long rt() { return __builtin_amdgcn_s_memrealtime(); }
__device__ __forceinline__ unsigned f2bf(float f) { unsigned u = __builtin_bit_cast(unsigned, f); return (u + 0x7fffu + ((u >> 16) & 1u)) >> 16; }
__device__ __forceinline__ unsigned pk2(float lo, float hi) { return f2bf(lo) | (f2bf(hi) << 16); }

#define XB_TMO      128
#define XB_XCNT(j)  (256  + 64 * (j))
#define XB_XSUB(j)  (1280 + 64 * (j))
#define XB_XGEN(j)  (2304 + 64 * (j))
#define XB_TOP      3328
#define XB_TOPGEN   3392
#define XCD_BAR_WORDS 3456
#define XB_SPIN_CAP (1u << 18)

__device__ __forceinline__ unsigned xb_ld(unsigned* p)              { return __hip_atomic_load(p, __ATOMIC_RELAXED, __HIP_MEMORY_SCOPE_AGENT); }
__device__ __forceinline__ unsigned xb_add(unsigned* p, unsigned v) { return __hip_atomic_fetch_add(p, v, __ATOMIC_RELAXED, __HIP_MEMORY_SCOPE_AGENT); }
__device__ __forceinline__ unsigned xb_xcc_id() { return (unsigned)__builtin_amdgcn_s_getreg((3 << 11) | 20) & 0xFu; }
#define XB_SPIN(cond, bar) do { unsigned _sp = 0; while (cond) { __builtin_amdgcn_s_sleep(1); \
    if ((++_sp & 255u) == 0u) { if (xb_ld(&(bar)[XB_TMO])) break; if (_sp > XB_SPIN_CAP) { atomicAdd(&(bar)[XB_TMO], 1u); break; } } } } while (0)

struct XcdBarrier {
    unsigned* bar; unsigned x;
    volatile LAS unsigned* st;
};

__device__ __forceinline__ XcdBarrier xcd_barrier_post(unsigned* bar, volatile LAS unsigned* st) {
    XcdBarrier b; b.bar = bar; b.x = xb_xcc_id(); b.st = st;
    if (threadIdx.x == 0) (void)xb_add(&bar[XB_XCNT(b.x)], 1u);
    return b;
}
__device__ __forceinline__ void xcd_barrier_complete(unsigned* bar, unsigned x, unsigned& nloc, unsigned& nx) {
    const unsigned G = gridDim.x * gridDim.y * gridDim.z;
    unsigned sum, cnt, mine, sp = 0u;
    for (;;) {
        sum = 0u; cnt = 0u; mine = 0u;
#pragma unroll
        for (unsigned j = 0; j < 16; ++j) { const unsigned c = xb_ld(&bar[XB_XCNT(j)]); sum += c; cnt += (c > 0u) ? 1u : 0u; mine = (j == x) ? c : mine; }
        if (sum == G) break;
        __builtin_amdgcn_s_sleep(1);
        if ((++sp & 255u) == 0u) { if (xb_ld(&bar[XB_TMO])) break; if (sp > XB_SPIN_CAP) { atomicAdd(&bar[XB_TMO], 1u); break; } }
    }
    nloc = mine > 0u ? mine : 1u; nx = cnt > 0u ? cnt : 1u;
}

__device__ __forceinline__ void xcd_barrier(const XcdBarrier& b) {
    asm volatile("s_waitcnt vmcnt(0)" ::: "memory");
    __syncthreads();
    if (threadIdx.x == 0) {
        unsigned* bar = b.bar;
        __builtin_amdgcn_s_waitcnt(0);
        unsigned nloc = b.st[0], nx = b.st[1];
        if (nloc == 0u) { xcd_barrier_complete(bar, b.x, nloc, nx); b.st[0] = nloc; b.st[1] = nx; }
        const unsigned old = xb_add(&bar[XB_XSUB(b.x)], 1u);
        const unsigned gen = old / nloc;
        if (old + 1u == (gen + 1u) * nloc) {
            __builtin_amdgcn_fence(__ATOMIC_RELEASE, "agent");
            asm volatile("s_waitcnt vmcnt(0)" ::: "memory");
            const unsigned og = xb_add(&bar[XB_TOP], 1u);
            const unsigned tg = og / nx;
            if (og + 1u == (tg + 1u) * nx) xb_add(&bar[XB_TOPGEN], 1u);
            else XB_SPIN(xb_ld(&bar[XB_TOPGEN]) == tg, bar);
            __builtin_amdgcn_fence(__ATOMIC_ACQUIRE, "agent");
            xb_add(&bar[XB_XGEN(b.x)], 1u);
            asm volatile("s_waitcnt vmcnt(0)" ::: "memory");
        } else {
            XB_SPIN(xb_ld(&bar[XB_XGEN(b.x)]) == gen, bar);
            __builtin_amdgcn_fence(__ATOMIC_ACQUIRE, "agent");
            asm volatile("s_waitcnt vmcnt(0)" ::: "memory");
        }
    }
    __syncthreads();
}

constexpr int NWAVES = 8;
constexpr int MP = 32768, MS = 256, MT = MP + MS;
constexpr int DM = 1024, DIN = 4376, DINP = 4608, DFF = 2816, DCONV = 512, QW = 512;
constexpr int OFF_Q = 1024, OFF_KV = 1536, OFF_NG = 2304, OFF_MG = 2328;
constexpr int NSEQ = 36;
constexpr float EPS = 1e-6f;
constexpr size_t O_YP = 0, O_YS = 33554432, O_PCK = 33816576, O_PCV = O_PCK + 4194304, O_PSK = O_PCV + 4194304, O_PSV = O_PSK + 4194304,
                 O_PWK = O_PSV + 4194304, O_PWV = O_PWK + 262144, O_PCONV = O_PWV + 262144, O_SCK = O_PCONV + 61440, O_SCV = O_SCK + 32768,
                 O_SSK = O_SCV + 32768, O_SSV = O_SSK + 32768, O_SWK = O_SSV + 32768, O_SWV = O_SWK + 2097152, O_SCONV = O_SWV + 2097152, O_END = O_SCONV + 491520;
constexpr size_t MiB = 1u << 20;
constexpr size_t WS_CTL = 0, WS_MOD = 1 * MiB, ZERO_BYTES = 2 * MiB;
constexpr size_t WS_ROPE = 2 * MiB;
constexpr size_t WS_WIN = 5 * MiB, WS_WPW2 = 14 * MiB, WS_WNSA = 15 * MiB, WS_WOUT = 16 * MiB, WS_WGU = 18 * MiB, WS_WDOWN = 29 * MiB;
constexpr size_t WS_KC = 36 * MiB, WS_VC = 41 * MiB, WS_BG = 46 * MiB, WS_H = 50 * MiB, WS_U = 115 * MiB, WS_QP = 148 * MiB, WS_QR = 181 * MiB,
                 WS_CACT = 214 * MiB, WS_O = 247 * MiB, WS_GC = 280 * MiB, WS_GN = 345 * MiB, WS_T1 = 410 * MiB, WS_KWIN = 475 * MiB, WS_VWIN = 491 * MiB,
                 WS_ACT = 507 * MiB, WS_Z = 685 * MiB, WS_OC = WS_Z  , WS_Y1 = WS_GC  , WS_ZS = 760 * MiB  ,
                 WS_KSB = 1268 * MiB, WS_VST = 1276 * MiB, WS_KWB = 1284 * MiB, WS_VWT = 1292 * MiB, WS_KCB = 1300 * MiB, WS_VCT = 1301 * MiB, WS_END = 1302 * MiB;
constexpr float C2 = 0.125f * 1.4426950408889634f;
constexpr int ROPE_N = 8200;
constexpr int CW_BAR = 4096;
constexpr int RING_BYTES = 131072, LDS_BYTES = 163840, MISC_OFF = LDS_BYTES - 256;

typedef unsigned v2u __attribute__((ext_vector_type(2)));
typedef float f32x2 __attribute__((ext_vector_type(2)));
__device__ __forceinline__ float bf2f(unsigned short b) { return __uint_as_float(((unsigned)b) << 16); }
__device__ __forceinline__ float wave_sum(float v) {
#pragma unroll
    for (int o = 1; o < 64; o <<= 1) v += __shfl_xor(v, o);
    return v;
}
__device__ __forceinline__ float wave_max(float v) {
#pragma unroll
    for (int o = 1; o < 64; o <<= 1) v = fmaxf(v, __shfl_xor(v, o));
    return v;
}
__device__ __forceinline__ unsigned dpp_x1(unsigned v) { return (unsigned)__builtin_amdgcn_update_dpp(0, (int)v, 0xB1, 0xF, 0xF, false); }
__device__ __forceinline__ unsigned dpp_x2(unsigned v) { return (unsigned)__builtin_amdgcn_update_dpp(0, (int)v, 0x4E, 0xF, 0xF, false); }
__device__ __forceinline__ unsigned umax_x16(unsigned v) { auto r = __builtin_amdgcn_permlane16_swap(v, v, false, false); return r[0] > r[1] ? r[0] : r[1]; }
__device__ __forceinline__ unsigned umax_x32(unsigned v) { auto r = __builtin_amdgcn_permlane32_swap(v, v, false, false); return r[0] > r[1] ? r[0] : r[1]; }
__device__ __forceinline__ float fsum_x16(float v) { auto r = __builtin_amdgcn_permlane16_swap(__float_as_uint(v), __float_as_uint(v), false, false); return __uint_as_float(r[0]) + __uint_as_float(r[1]); }
__device__ __forceinline__ float fsum_x32(float v) { auto r = __builtin_amdgcn_permlane32_swap(__float_as_uint(v), __float_as_uint(v), false, false); return __uint_as_float(r[0]) + __uint_as_float(r[1]); }
__device__ __forceinline__ float fmax_x16(float v) { auto r = __builtin_amdgcn_permlane16_swap(__float_as_uint(v), __float_as_uint(v), false, false); return fmaxf(__uint_as_float(r[0]), __uint_as_float(r[1])); }
__device__ __forceinline__ float fmax_x32(float v) { auto r = __builtin_amdgcn_permlane32_swap(__float_as_uint(v), __float_as_uint(v), false, false); return fmaxf(__uint_as_float(r[0]), __uint_as_float(r[1])); }
__device__ __forceinline__ float dpp_x1f(float v) { return __uint_as_float(dpp_x1(__float_as_uint(v))); }
__device__ __forceinline__ float dpp_x2f(float v) { return __uint_as_float(dpp_x2(__float_as_uint(v))); }
__device__ __forceinline__ unsigned dpp_x4(unsigned v) { const int t = __builtin_amdgcn_update_dpp(0, (int)v, 0x141, 0xF, 0xF, false); return (unsigned)__builtin_amdgcn_update_dpp(0, t, 0x1B, 0xF, 0xF, false); }
__device__ __forceinline__ unsigned dpp_x8(unsigned v) { const int t = __builtin_amdgcn_update_dpp(0, (int)v, 0x140, 0xF, 0xF, false); return (unsigned)__builtin_amdgcn_update_dpp(0, t, 0x141, 0xF, 0xF, false); }
__device__ __forceinline__ float sigm(float x) { return 1.0f / (1.0f + __expf(-x)); }
__device__ __forceinline__ float wsum(float v) { v += dpp_x1f(v); v += dpp_x2f(v); v += __uint_as_float(dpp_x4(__float_as_uint(v))); v += __uint_as_float(dpp_x8(__float_as_uint(v))); v = fsum_x16(v); return fsum_x32(v); }
__device__ __forceinline__ float wmax(float v) { v = fmaxf(v, dpp_x1f(v)); v = fmaxf(v, dpp_x2f(v)); v = fmaxf(v, __uint_as_float(dpp_x4(__float_as_uint(v)))); v = fmaxf(v, __uint_as_float(dpp_x8(__float_as_uint(v)))); v = fmax_x16(v); return fmax_x32(v); }
__device__ __forceinline__ int mrow(int r) { return r < MP ? (r >> 13) : 4 + ((r - MP) >> 3); }
__device__ __forceinline__ int rope_idx(int r) { return r < MP ? (r & 8191) : 8192 + ((r - MP) & 7); }
__device__ __forceinline__ int perm64(int u) { return (u & 32) | (((u >> 2) & 3) << 3) | (((u >> 4) & 1) << 2) | (u & 3); }
__device__ __forceinline__ int perm128(int u) { return (u & ~31) | (((u >> 2) & 3) << 3) | (((u >> 4) & 1) << 2) | (u & 3); }
__device__ __forceinline__ size_t kc_off(int s) { return s < 4 ? (size_t)s * 128 * 128 : (size_t)4 * 128 * 128 + (size_t)(s - 4) * 257 * 128; }

struct Args { const float* in[33]; float* out; unsigned char* ws; int ph_lo, ph_hi; };

__device__ __forceinline__ int front_rowmap(int n) {
    if (n < 1024) { const int nn = n >= 512 ? 1 : 0, ch = n & 511; return 256 * (ch >> 7) + 128 * ((ch >> 6) & 1) + 32 * ((ch >> 4) & 3) + 8 * ((ch >> 2) & 3) + 4 * nn + (ch & 3); }
    if (n < OFF_KV) { const int hd = n - OFF_Q, h = hd >> 6, d = hd & 63; return 256 * (4 + (h >> 2)) + 128 * (d >> 5) + 32 * (h & 3) + (d & 31); }
    if (n < OFF_NG) { const int x = n - OFF_KV, j = x >> 7, kvh = (x >> 6) & 1, d = x & 63; return 256 * (6 + (j >> 1)) + 128 * (d >> 5) + 32 * ((j & 1) * 2 + kvh) + (d & 31); }
    if (n < OFF_MG) return 256 * 17 + (n - OFF_NG);
    return 256 * 9 + (n - OFF_MG);
}
__device__ __forceinline__ int gu_rowmap(int j) { const int rem = j & 127; return 256 * (j >> 7) + 128 * ((rem >> 2) & 1) + 32 * (rem >> 5) + 8 * ((rem >> 3) & 3) + (rem & 3); }
template <int MODE> __device__ __forceinline__ int rowmap(int n) { return MODE == 0 ? n : (MODE == 1 ? gu_rowmap(n) : (MODE == 2 ? gu_rowmap(n) + 4 : front_rowmap(n))); }
template <int MODE> __device__ __forceinline__ void transpose_item(const float* W, int K, int N, bf16* WT, LAS float* scr, int item, int lane) {
    const int nblk = (N + 31) / 32, kb = item / nblk, nb = item % nblk, k0 = 64 * kb, n0 = 32 * nb;
    const int nn = n0 + (lane & 31);
    float tv[32];
#pragma unroll
    for (int i = 0; i < 32; ++i) { const int kk = 2 * i + (lane >> 5); tv[i] = W[(size_t)(k0 + kk) * N + (nn < N ? nn : N - 1)]; }
#pragma unroll
    for (int i = 0; i < 32; ++i) { const int kk = 2 * i + (lane >> 5); scr[kk * 33 + (lane & 31)] = (nn < N) ? tv[i] : 0.f; }
    LDS_WAIT(); asm volatile("" ::: "memory");
    const int c = lane & 7;
#pragma unroll
    for (int j = 0; j < 4; ++j) { const int nl = (lane >> 3) + 8 * j, n = n0 + nl; const LAS float* s = scr + (8 * c) * 33 + nl;
        v4u o; o.x = pk2(s[0 * 33], s[1 * 33]); o.y = pk2(s[2 * 33], s[3 * 33]); o.z = pk2(s[4 * 33], s[5 * 33]); o.w = pk2(s[6 * 33], s[7 * 33]);
        if (n < N) *(v4u*)(WT + (size_t)rowmap<MODE>(n) * K + k0 + 8 * c) = o; }
    LDS_WAIT(); asm volatile("" ::: "memory");
}
__device__ __forceinline__ f32x2 compress_block(const float* rows, int nvalid, const float* pm, const float* w, float* outp, LAS float* scr, int lane) {
    const int c4 = 4 * (lane & 31), half = lane >> 5, d = c4 & 63, nh = nvalid >> 1;
    f32x4 acc = {0.f, 0.f, 0.f, 0.f};
    for (int i0 = 0; i0 < nh; i0 += 8) {
        f32x4 x[8], m[8];
#pragma unroll
        for (int q = 0; q < 8; ++q) { const bool ok = i0 + q < nh; const int j = 2 * (ok ? i0 + q : 0) + half;
            x[q] = *(const f32x4*)(rows + (size_t)j * 128 + c4); m[q] = *(const f32x4*)(pm + j * 64 + d); if (!ok) x[q] = (f32x4){0.f, 0.f, 0.f, 0.f}; }
#pragma unroll
        for (int q = 0; q < 8; ++q) acc += x[q] * (m[q] + 1.0f);
    }
#pragma unroll
    for (int i = 0; i < 4; ++i) acc[i] += __shfl_xor(acc[i], 32);
    if (lane < 32) *(LAS f32x4*)(scr + c4) = acc * (1.0f / 64.0f);
    LDS_WAIT(); asm volatile("" ::: "memory");
    const int kvh = lane >> 5, e = 2 * (lane & 31);
    f32x2 o = {0.f, 0.f};
#pragma unroll 8
    for (int dd = 0; dd < 64; ++dd) { const float sv = scr[kvh * 64 + dd]; const f32x2 ww = *(const f32x2*)(w + dd * 64 + e); o.x += sv * ww.x; o.y += sv * ww.y; }
    *(f32x2*)(outp + kvh * 64 + e) = o;
    LDS_WAIT(); asm volatile("" ::: "memory");
    return o;
}
__device__ __forceinline__ f32x2 summary_finish(f32x4 acc, const LAS float* wl, float* outp, LAS float* scr, int lane) {
    const int c4 = 4 * (lane & 31);
#pragma unroll
    for (int i = 0; i < 4; ++i) acc[i] = fsum_x32(acc[i]);
    if (lane < 32) *(LAS f32x4*)(scr + c4) = acc * (1.0f / 64.0f);
    LDS_WAIT(); asm volatile("" ::: "memory");
    const int kvh = lane >> 5, e = 2 * (lane & 31);
    f32x2 o = {0.f, 0.f};
#pragma unroll 16
    for (int dd = 0; dd < 64; ++dd) { const float sv = scr[kvh * 64 + dd]; const f32x2 ww = *(const LAS f32x2*)(wl + dd * 64 + e); o.x += sv * ww.x; o.y += sv * ww.y; }
    *(f32x2*)(outp + kvh * 64 + e) = o;
    LDS_WAIT(); asm volatile("" ::: "memory");
    return o;
}
template <int NV> __device__ __forceinline__ f32x2 compress_one(const float* rows, const LAS float* pml, const LAS float* wl, float* outp, LAS float* scr, int lane) {
    const int c4 = 4 * (lane & 31), half = lane >> 5, d = c4 & 63;
    const f32x4* s4 = (const f32x4*)(rows + (size_t)half * 128 + c4);
    f32x4 x[NV / 2];
#pragma unroll
    for (int q = 0; q < NV / 2; ++q) x[q] = s4[(size_t)q * 64];
    f32x4 acc = {0.f, 0.f, 0.f, 0.f};
#pragma unroll
    for (int q = 0; q < NV / 2; ++q) { const f32x4 m = *(const LAS f32x4*)(pml + (2 * q + half) * 64 + d); acc += x[q] * (m + 1.0f); }
    return summary_finish(acc, wl, outp, scr, lane);
}
__device__ __forceinline__ void compress_page(const float* src, const LAS float* pml, const LAS float* wl, float* dst, LAS float* scr, int lane) {
    const int c4 = 4 * (lane & 31), half = lane >> 5, d = c4 & 63;
    const f32x4* s4 = (const f32x4*)(src + (size_t)half * 128 + c4);
    f32x4 xb[3][8];
    auto request = [&](const int bt) __attribute__((always_inline)) {
#pragma unroll
        for (int q = 0; q < 8; ++q) xb[bt % 3][q] = s4[(size_t)(8 * bt + q) * 64]; };
    auto consume = [&](const int bt, f32x4 acc) __attribute__((always_inline)) {
#pragma unroll
        for (int q = 0; q < 8; ++q) { const int j = 2 * (8 * (bt & 3) + q) + half; const f32x4 m = *(const LAS f32x4*)(pml + j * 64 + d); acc += xb[bt % 3][q] * (m + 1.0f); }
        return acc; };
    request(0); request(1); request(2);
    f32x4 acc = {0.f, 0.f, 0.f, 0.f};
#pragma unroll
    for (int bt = 0; bt < 8; ++bt) {
        asm volatile("" ::: "memory");
        acc = consume(bt, acc);
        asm volatile("" ::: "memory");
        if (bt + 3 < 8) request(bt + 3);
        if ((bt & 3) == 3) { (void)summary_finish(acc, wl, dst + (bt >> 2) * 128, scr, lane); acc = (f32x4){0.f, 0.f, 0.f, 0.f}; }
    }
}
__device__ __forceinline__ void phase0(const Args& a, LAS unsigned char* lds, int gw, int NGW, int wave, int lane_) {
    int lane = lane_;
    unsigned char* ws = a.ws;
    LAS float* scr = (LAS float*)(lds + wave * 10240);
    constexpr int I_IN = 16 * 137, I_PW2 = 8 * 32, I_NSA = 8 * 32, I_OUT = 16 * 32, I_G = 16 * 88, I_U = 16 * 88, I_D = 44 * 32;
    constexpr int N_TR = I_IN + I_PW2 + I_NSA + I_OUT + I_G + I_U + I_D;
    constexpr int N_MOD = 96 * 16;
    constexpr int N_LIGHT = N_TR + N_MOD;
#pragma nounroll
    for (int it = gw; it < N_LIGHT; it += NGW) {
        int r = it; asm volatile("" : "+v"(lane));
        if (r < N_TR) {
            if (r < I_IN) { transpose_item<3>(a.in[15], 1024, DIN, (bf16*)(ws + WS_WIN), scr, r, lane); continue; } r -= I_IN;
            if (r < I_PW2) { transpose_item<0>(a.in[22], 512, 1024, (bf16*)(ws + WS_WPW2), scr, r, lane); continue; } r -= I_PW2;
            if (r < I_NSA) { transpose_item<0>(a.in[27], 512, 1024, (bf16*)(ws + WS_WNSA), scr, r, lane); continue; } r -= I_NSA;
            if (r < I_OUT) { transpose_item<0>(a.in[28], 1024, 1024, (bf16*)(ws + WS_WOUT), scr, r, lane); continue; } r -= I_OUT;
            if (r < I_G) { transpose_item<1>(a.in[30], 1024, DFF, (bf16*)(ws + WS_WGU), scr, r, lane); continue; } r -= I_G;
            if (r < I_U) { transpose_item<2>(a.in[31], 1024, DFF, (bf16*)(ws + WS_WGU), scr, r, lane); continue; } r -= I_U;
            transpose_item<0>(a.in[32], DFF, 1024, (bf16*)(ws + WS_WDOWN), scr, r, lane); continue;
        }
        r -= N_TR;
        if (r < N_MOD) {
            const int cb = r % 96, kb = r / 96, j = cb * 64 + lane, k0 = kb * 64;
            for (int mb = 0; mb < NSEQ; ++mb) { const float* cp = mb < 4 ? a.in[10] + mb * 1024 : a.in[11] + (mb - 4) * 1024; const float cv = cp[k0 + lane]; scr[mb * 64 + lane] = cv * sigm(cv); }
            LDS_WAIT(); asm volatile("" ::: "memory");
            float acc[NSEQ];
#pragma unroll
            for (int mb = 0; mb < NSEQ; ++mb) acc[mb] = 0.f;
            const float* wp = a.in[12] + (size_t)k0 * 6144 + j;
#pragma unroll 4
            for (int k4 = 0; k4 < 16; ++k4) {
                const float w0 = wp[(size_t)(4 * k4 + 0) * 6144], w1 = wp[(size_t)(4 * k4 + 1) * 6144], w2 = wp[(size_t)(4 * k4 + 2) * 6144], w3 = wp[(size_t)(4 * k4 + 3) * 6144];
#pragma unroll
                for (int mb = 0; mb < NSEQ; ++mb) { const f32x4 q = *(const LAS f32x4*)(scr + mb * 64 + 4 * k4); acc[mb] += q.x * w0 + q.y * w1 + q.z * w2 + q.w * w3; }
            }
            float* modp = (float*)(ws + WS_MOD);
            const float bias = (kb == 0) ? a.in[13][j] : 0.f;
#pragma unroll
            for (int mb = 0; mb < NSEQ; ++mb) atomicAdd(modp + mb * 6144 + j, acc[mb] + bias);
            LDS_WAIT(); asm volatile("" ::: "memory");
            continue;
        }
    }
    const int gt = gw * 64 + lane, NT = NGW * 64;
    { v4u* p = (v4u*)((bf16*)(ws + WS_WIN) + (size_t)DIN * 1024); const int n16 = (DINP - DIN) * 1024 * 2 / 16; const v4u z = {0u, 0u, 0u, 0u}; for (int i = gt; i < n16; i += NT) p[i] = z; }
    { float* rc = (float*)(ws + WS_ROPE); float* rs = rc + ROPE_N * 32;
#pragma nounroll
      for (int i = gt; i < ROPE_N * 32; i += NT) {
          const int j = i & 31, p = i >> 5; const int pos = p < 8192 ? p : 16384 + (p - 8192);
          double inv = 1.0;
#pragma nounroll
          for (int q = 0; q < j; ++q) inv *= 0.7498942093324558;
          const double ang = (double)pos * inv;
          const double kq = __builtin_rint(ang * 0.6366197723675814);
          double rr = __builtin_fma(-kq, 1.5707963267948966, ang); rr = __builtin_fma(-kq, 6.123233995736766e-17, rr);
          const double r2 = rr * rr;
          const double sn = rr * (1.0 + r2 * (-1.0 / 6 + r2 * (1.0 / 120 + r2 * (-1.0 / 5040 + r2 * (1.0 / 362880 + r2 * (-1.0 / 39916800 + r2 * (1.0 / 6227020800.0)))))));
          const double cs = 1.0 + r2 * (-0.5 + r2 * (1.0 / 24 + r2 * (-1.0 / 720 + r2 * (1.0 / 40320 + r2 * (-1.0 / 3628800 + r2 * (1.0 / 479001600.0))))));
          const int qd = ((int)(long long)kq) & 3;
          const double c = (qd == 0) ? cs : (qd == 1) ? -sn : (qd == 2) ? -cs : sn;
          const double s = (qd == 0) ? sn : (qd == 1) ? cs : (qd == 2) ? -sn : -cs;
          rc[i] = (float)c; rs[i] = (float)s; } }
    { const int per = 504 * 128 / 4, n4 = 32 * per;
      for (int i = gt; i < 2 * n4; i += NT) { const int kv = i >= n4, ii = kv ? i - n4 : i, sb = ii / per, o = ii % per;
          const f32x4 v = ((const f32x4*)((kv ? a.in[7] : a.in[6]) + (size_t)sb * 512 * 128 + 8 * 128))[o];
          ((f32x4*)(a.out + (kv ? O_SWV : O_SWK) + (size_t)sb * 512 * 128))[o] = v; } }
    { const int per = 22 * 512 / 4, n4 = 32 * per;
      for (int i = gt; i < n4; i += NT) { const int sb = i / per, o = i % per;
          ((f32x4*)(a.out + O_SCONV + (size_t)sb * 30 * 512))[o] = ((const f32x4*)(a.in[8] + (size_t)sb * 30 * 512 + 8 * 512))[o]; } }
}

__device__ __forceinline__ void norm_rows(const float* xp, const float* xs, const float* g, const float* modp, int sh_off, int sc_off, bf16* H, int gw, int NGW, int lane_) {
    int lane = lane_; asm volatile("" : "+v"(lane));
    for (int r = gw; r < MT; r += NGW) {
        const f32x4* xr = (const f32x4*)(r < MP ? xp + (size_t)r * 1024 : xs + (size_t)(r - MP) * 1024) + lane;
        const float* mp = modp + (size_t)mrow(r) * 6144;
        f32x4 v[4]; float ss = 0.f;
#pragma unroll
        for (int j = 0; j < 4; ++j) { v[j] = xr[64 * j]; ss += (v[j].x * v[j].x + v[j].y * v[j].y) + (v[j].z * v[j].z + v[j].w * v[j].w); }
        const float rstd = 1.0f / sqrtf(wave_sum(ss) * (1.0f / 1024.0f) + EPS);
        v2u* o8 = (v2u*)(H + (size_t)r * 1024) + lane;
#pragma unroll
        for (int j = 0; j < 4; ++j) { const int c = 4 * (lane + 64 * j);
            const f32x4 gg = *(const f32x4*)(g + c), sc = *(const f32x4*)(mp + sc_off + c), sh = *(const f32x4*)(mp + sh_off + c);
            const f32x4 h = (v[j] * rstd * gg) * (1.0f + sc) + sh;
            v2u w; w.x = pk2(h.x, h.y); w.y = pk2(h.z, h.w); o8[64 * j] = w; }
    }
}

__device__ __forceinline__ void norm_rows_bf16(const bf16* X, const float* g, const float* modp, int sh_off, int sc_off, bf16* H, int gw, int NGW, int lane_) {
    int lane = lane_; asm volatile("" : "+v"(lane));
    for (int r = gw; r < MT; r += NGW) {
        const v2u* xr = (const v2u*)(X + (size_t)r * 1024) + lane;
        const float* mp = modp + (size_t)mrow(r) * 6144;
        f32x4 v[4]; float ss = 0.f;
#pragma unroll
        for (int j = 0; j < 4; ++j) { const v2u t = xr[64 * j]; v[j] = (f32x4){pg8::bf_lo(t.x), pg8::bf_hi(t.x), pg8::bf_lo(t.y), pg8::bf_hi(t.y)}; ss += (v[j].x * v[j].x + v[j].y * v[j].y) + (v[j].z * v[j].z + v[j].w * v[j].w); }
        const float rstd = 1.0f / sqrtf(wsum(ss) * (1.0f / 1024.0f) + EPS);
        v2u* o8 = (v2u*)(H + (size_t)r * 1024) + lane;
#pragma unroll
        for (int j = 0; j < 4; ++j) { const int c = 4 * (lane + 64 * j);
            const f32x4 gg = *(const f32x4*)(g + c), sc = *(const f32x4*)(mp + sc_off + c), sh = *(const f32x4*)(mp + sh_off + c);
            const f32x4 h = (v[j] * rstd * gg) * (1.0f + sc) + sh;
            v2u w; w.x = pk2(h.x, h.y); w.y = pk2(h.z, h.w); o8[64 * j] = w; }
    }
}

__device__ __forceinline__ void phase_pages(const Args& a, LAS unsigned char* lds, int gw, int NGW, int wave, int lane_, int tid_) {
    unsigned char* ws = a.ws; int lane = lane_, tid = tid_; asm volatile("" : "+v"(lane)); asm volatile("" : "+v"(tid));
    LAS float* scr = (LAS float*)(lds + wave * 1024);
    LAS float* tabs = (LAS float*)(lds + 8192);
    __syncthreads();
    { const f32x4* g0 = (const f32x4*)a.in[23]; const f32x4* g1 = (const f32x4*)a.in[25]; const f32x4* g2 = (const f32x4*)a.in[24]; const f32x4* g3 = (const f32x4*)a.in[26];
#pragma nounroll
      for (int i = tid; i < 1024; i += NWAVES * 64) { ((LAS f32x4*)tabs)[i] = g0[i]; ((LAS f32x4*)tabs)[1024 + i] = g1[i]; ((LAS f32x4*)tabs)[2048 + i] = g2[i]; ((LAS f32x4*)tabs)[3072 + i] = g3[i]; } }
    LDS_WAIT(); __syncthreads();
#pragma nounroll
    for (int r = gw; r < 32 * 128 * 2; r += NGW) { const int kv = r & 1, pg = (r >> 1) & 127, sb = r >> 8;
        const int page = __builtin_amdgcn_readfirstlane(((const int*)a.in[9])[sb * 128 + pg]);
        const float* src = (kv ? a.in[3] : a.in[2]) + (size_t)page * (128 * 128);
        float* dst = (float*)(ws + (kv ? WS_VC : WS_KC)) + kc_off(4 + sb) + (size_t)(2 * pg) * 128;
        compress_page(src, tabs + (kv ? 4096 : 0), tabs + (kv ? 12288 : 8192), dst, scr, lane); }
    __syncthreads();
}

__device__ __forceinline__ void unpack8(const v4u p, float (&x)[8]) { x[0] = pg8::bf_lo(p.x); x[1] = pg8::bf_hi(p.x); x[2] = pg8::bf_lo(p.y); x[3] = pg8::bf_hi(p.y); x[4] = pg8::bf_lo(p.z); x[5] = pg8::bf_hi(p.z); x[6] = pg8::bf_lo(p.w); x[7] = pg8::bf_hi(p.w); }
__device__ __forceinline__ void phase_conv(const Args& a, LAS unsigned char* lds, int vcu, int G, int gw, int NGW, int wave, int lane, int tid_) {
    unsigned char* ws = a.ws; const int tid = tid_;
    constexpr int TAPB = 31 * 512 * 4;
    { LAS f32x4* wl4 = (LAS f32x4*)lds; const f32x4* wg4 = (const f32x4*)a.in[18]; for (int i = tid; i < 31 * 512 / 4; i += NWAVES * 64) wl4[i] = wg4[i]; }
    const LAS float* wl = (const LAS float*)lds; LAS unsigned char* rl = lds + TAPB;
    const bf16* U = (const bf16*)(ws + WS_U); bf16* CACT = (bf16*)(ws + WS_CACT);
    const int c0_ = lane * 8;
    auto do_tile = [&](const bool smp, const int idx) __attribute__((always_inline)) {
        int tid = tid_, c0 = c0_; asm volatile("" : "+v"(tid)); asm volatile("" : "+v"(c0));
        const int sb = idx, r0 = smp ? MP + 8 * sb : 64 * idx, t0 = r0 & 8191, ntok = smp ? 8 : 64, nrows = ntok + 30;
        __syncthreads();
        if (smp) {
            for (int q = tid; q < nrows * 64; q += NWAVES * 64) { const int k = q >> 6, cc = (q & 63) * 8; v4u v = {0u, 0u, 0u, 0u};
                if (k < 30) { const float* sp = a.in[8] + (size_t)(sb * 30 + k) * 512 + cc; const f32x4 p0 = *(const f32x4*)sp, p1 = *(const f32x4*)(sp + 4);
                    v.x = pk2(p0.x, p0.y); v.y = pk2(p0.z, p0.w); v.z = pk2(p1.x, p1.y); v.w = pk2(p1.z, p1.w); }
                else v = *(const v4u*)(U + (size_t)(r0 + k - 30) * 512 + cc);
                *(LAS v4u*)(rl + k * 1024 + (q & 63) * 16) = v; }
        } else {
            v4u st[12];
#pragma unroll
            for (int i = 0; i < 12; ++i) { const int q = tid + i * (NWAVES * 64), k = q >> 6, cc = (q & 63) * 8; st[i] = (v4u){0u, 0u, 0u, 0u};
                if (q < 94 * 64 && t0 - 30 + k >= 0) st[i] = *(const v4u*)(U + (size_t)(r0 - 30 + k) * 512 + cc); }
#pragma unroll
            for (int i = 0; i < 12; ++i) { const int q = tid + i * (NWAVES * 64), k = q >> 6; if (q < 94 * 64) *(LAS v4u*)(rl + k * 1024 + (q & 63) * 16) = st[i]; }
        }
        __syncthreads();
        if (8 * wave < ntok) {
            float acc[8][8];
            { const f32x4 b0 = *(const f32x4*)(a.in[19] + c0), b1 = *(const f32x4*)(a.in[19] + c0 + 4);
#pragma unroll
              for (int tt = 0; tt < 8; ++tt) { acc[tt][0] = b0.x; acc[tt][1] = b0.y; acc[tt][2] = b0.z; acc[tt][3] = b0.w; acc[tt][4] = b1.x; acc[tt][5] = b1.y; acc[tt][6] = b1.z; acc[tt][7] = b1.w; } }
            const LAS unsigned char* rw = rl + (8 * wave) * 1024 + lane * 16;
            f32x4 w0[8], w1[8];
#pragma unroll
            for (int i = 0; i < 8; ++i) { w0[i] = (f32x4){0.f, 0.f, 0.f, 0.f}; w1[i] = (f32x4){0.f, 0.f, 0.f, 0.f}; }
#pragma nounroll
            for (int rb = 0; rb < 40; rb += 8) {
#pragma unroll
                for (int i = 0; i < 8; ++i) { const int rr = rb + i;
                    if (rr < 38) {
                        f32x4 a0 = {0.f, 0.f, 0.f, 0.f}, a1 = {0.f, 0.f, 0.f, 0.f};
                        if (rr < 31) { a0 = *(const LAS f32x4*)(wl + rr * 512 + c0); a1 = *(const LAS f32x4*)(wl + rr * 512 + c0 + 4); }
                        w0[i] = a0; w1[i] = a1;
                        float x[8]; unpack8(*(const LAS v4u*)(rw + rr * 1024), x);
#pragma unroll
                        for (int tt = 0; tt < 8; ++tt) { const f32x4 u0 = w0[(i - tt) & 7], u1 = w1[(i - tt) & 7];
                            acc[tt][0] += x[0] * u0.x; acc[tt][1] += x[1] * u0.y; acc[tt][2] += x[2] * u0.z; acc[tt][3] += x[3] * u0.w;
                            acc[tt][4] += x[4] * u1.x; acc[tt][5] += x[5] * u1.y; acc[tt][6] += x[6] * u1.z; acc[tt][7] += x[7] * u1.w; } } }
            }
            const f32x4 g0 = *(const f32x4*)(a.in[20] + c0), g1 = *(const f32x4*)(a.in[20] + c0 + 4), e0 = *(const f32x4*)(a.in[21] + c0), e1 = *(const f32x4*)(a.in[21] + c0 + 4);
            const float lg[8] = {g0.x, g0.y, g0.z, g0.w, g1.x, g1.y, g1.z, g1.w}, lb[8] = {e0.x, e0.y, e0.z, e0.w, e1.x, e1.y, e1.z, e1.w};
#pragma unroll
            for (int tt = 0; tt < 8; ++tt) {
                float sm = 0.f;
#pragma unroll
                for (int i = 0; i < 8; ++i) sm += acc[tt][i];
                const float mean = wsum(sm) * (1.0f / 512.0f); float q = 0.f;
#pragma unroll
                for (int i = 0; i < 8; ++i) { acc[tt][i] -= mean; q += acc[tt][i] * acc[tt][i]; }
                const float rstd = 1.0f / sqrtf(wsum(q) * (1.0f / 512.0f) + EPS);
                float y[8];
#pragma unroll
                for (int i = 0; i < 8; ++i) { const float v = acc[tt][i] * rstd * lg[i] + lb[i]; y[i] = v * sigm(v); }
                v4u o; o.x = pk2(y[0], y[1]); o.y = pk2(y[2], y[3]); o.z = pk2(y[4], y[5]); o.w = pk2(y[6], y[7]);
                *(v4u*)(CACT + (size_t)(r0 + 8 * wave + tt) * 512 + c0) = o;
            }
        }
    };
    { int u = vcu; bool smpu = false;
#pragma nounroll
      for (;;) {
          if (!smpu && u >= 512) { smpu = true; u = G - 1 - vcu; }
          if (smpu && u >= 32) break;
          do_tile(smpu, u);
          u += G; } }
    __syncthreads();
    LAS float* scr = (LAS float*)(lds + wave * 1024);
    LAS float* tabs = (LAS float*)(lds + 8192);
    if (gw < 1024 + 64) {
        const f32x4* g0 = (const f32x4*)a.in[23]; const f32x4* g1 = (const f32x4*)a.in[25]; const f32x4* g2 = (const f32x4*)a.in[24]; const f32x4* g3 = (const f32x4*)a.in[26];
        for (int i = lane; i < 1024; i += 64) { ((LAS f32x4*)tabs)[i] = g0[i]; ((LAS f32x4*)tabs)[1024 + i] = g1[i]; ((LAS f32x4*)tabs)[2048 + i] = g2[i]; ((LAS f32x4*)tabs)[3072 + i] = g3[i]; }
    }
    LDS_WAIT(); __syncthreads();
    for (int it = gw; it < 1024 + 64; it += NGW) {
        if (it < 1024) { const int kv = it & 1, n = (it >> 1) & 127, b = it >> 8;
            const float* rows = a.out + (kv ? O_PCV : O_PCK) + (size_t)(b * 8192 + 64 * n) * 128;
            float* dst = (float*)(ws + (kv ? WS_VC : WS_KC)) + kc_off(b) + (size_t)n * 128;
            const f32x2 o = compress_one<64>(rows, tabs + (kv ? 4096 : 0), tabs + (kv ? 12288 : 8192), dst, scr, lane);
            const int kvh = lane >> 5, e = 2 * (lane & 31);
            if (!kv) { *(unsigned*)((bf16*)(ws + WS_KCB) + ((size_t)(b * 2 + kvh) * 128 + n) * 64 + e) = pk2(o.x, o.y); }
            else { bf16* vt = (bf16*)(ws + WS_VCT) + (size_t)(b * 2 + kvh) * 64 * 128 + perm128(n); vt[(size_t)e * 128] = (bf16)f2bf(o.x); vt[(size_t)(e + 1) * 128] = (bf16)f2bf(o.y); } }
        else { const int i2 = it - 1024, kv = i2 & 1, sb = i2 >> 1;
            const float* rows = a.out + (kv ? O_SCV : O_SCK) + (size_t)(sb * 8) * 128;
            float* dst = (float*)(ws + (kv ? WS_VC : WS_KC)) + kc_off(4 + sb) + (size_t)256 * 128;
            (void)compress_one<8>(rows, tabs + (kv ? 4096 : 0), tabs + (kv ? 12288 : 8192), dst, scr, lane); }
    }
}

template <int MODE> __device__ __forceinline__ void attn_item(const Args& a, int r, int kvh, LAS unsigned char* ldsb, int wave, int lane) {
    unsigned char* ws = a.ws; float* out = a.out;
    LAS float* scr = (LAS float*)(ldsb + wave * 16384);
    const bool smp = r >= MP; const int rs_ = r - MP, sb = rs_ >> 3, si = rs_ & 7, b = r >> 13;
    const int seq = smp ? 4 + sb : b, qpos = smp ? 16384 + si : (r & 8191), cur = qpos >> 6, NB = smp ? 257 : 128;
    LAS float* s_qp = scr;
    LAS float* s_qr = scr + 256;
    LAS float* s_p = scr + 512;
    const bf16* QP = (const bf16*)(ws + WS_QP) + (size_t)r * 512 + kvh * 256; const bf16* QR = (const bf16*)(ws + WS_QR) + (size_t)r * 512 + kvh * 256;
    float qn2[4];
#pragma unroll
    for (int g = 0; g < 4; ++g) { const float x = bf2f(QP[g * 64 + lane]), y = bf2f(QR[g * 64 + lane]); s_qp[lane * 4 + g] = x; s_qr[lane * 4 + g] = y; qn2[g] = wave_sum(y * y); }
    const float gks = wave_max(fabsf(a.in[17][64 + lane])), gkw = wave_max(fabsf(a.in[17][128 + lane]));
    float mref_s[4], mref_w[4];
#pragma unroll
    for (int g = 0; g < 4; ++g) { const float qn = sqrtf(qn2[g]) * 8.0f; mref_s[g] = qn * gks; mref_w[g] = qn * gkw; }
    LDS_WAIT(); asm volatile("" ::: "memory");
    const float* KC = (const float*)(ws + WS_KC) + kc_off(seq) + kvh * 64; const float* VC = (const float*)(ws + WS_VC) + kc_off(seq) + kvh * 64;
    const int n_ok = (qpos + 1) >> 6;
    float sc[5][4];
#pragma unroll
    for (int c = 0; c < 5; ++c) { const int n = lane + 64 * c;
#pragma unroll
        for (int g = 0; g < 4; ++g) sc[c][g] = 0.f;
        if (n < n_ok && n < NB) { const f32x4* kr = (const f32x4*)(KC + (size_t)n * 128);
#pragma unroll 4
            for (int d4 = 0; d4 < 16; ++d4) { const f32x4 k = kr[d4];
                const f32x4 q0 = *(const LAS f32x4*)(s_qp + (4 * d4 + 0) * 4), q1 = *(const LAS f32x4*)(s_qp + (4 * d4 + 1) * 4), q2 = *(const LAS f32x4*)(s_qp + (4 * d4 + 2) * 4), q3 = *(const LAS f32x4*)(s_qp + (4 * d4 + 3) * 4);
#pragma unroll
                for (int g = 0; g < 4; ++g) sc[c][g] += k.x * q0[g] + k.y * q1[g] + k.z * q2[g] + k.w * q3[g]; } } }
    float imp[5];
#pragma unroll
    for (int c = 0; c < 5; ++c) imp[c] = 0.f;
#pragma unroll
    for (int g = 0; g < 4; ++g) {
        float m = -INFINITY;
#pragma unroll
        for (int c = 0; c < 5; ++c) { const int n = lane + 64 * c; if (n < n_ok && n < NB) m = fmaxf(m, sc[c][g]); }
        m = wave_max(m); if (!(m > -INFINITY)) m = 0.f;
        float e[5], zs = 0.f;
#pragma unroll
        for (int c = 0; c < 5; ++c) { const int n = lane + 64 * c; e[c] = (n < n_ok && n < NB) ? __builtin_amdgcn_exp2f(sc[c][g] - m) : 0.f; zs += e[c]; }
        zs = wave_sum(zs); const float iz = 1.0f / fmaxf(zs, 1e-30f);
#pragma unroll
        for (int c = 0; c < 5; ++c) { const int n = lane + 64 * c; const float p = e[c] * iz; imp[c] += p; if (n < NB) s_p[n * 4 + g] = p; }
    }
    LDS_WAIT(); asm volatile("" ::: "memory");
    float o_cmp[4] = {0.f, 0.f, 0.f, 0.f};
    { const int nn = n_ok < NB ? n_ok : NB; const int nstart = MODE == 1 ? wave : 0, nstep = MODE == 1 ? NWAVES : 1;
      for (int n0 = nstart; n0 < nn; n0 += 8 * nstep) { float v[8];
#pragma unroll
          for (int q = 0; q < 8; ++q) { const int n = n0 + q * nstep; v[q] = VC[(size_t)(n < nn ? n : nstart) * 128 + lane]; }
#pragma unroll
          for (int q = 0; q < 8; ++q) { const int n = n0 + q * nstep; if (n < nn) { const f32x4 p = *(const LAS f32x4*)(s_p + n * 4);
#pragma unroll
              for (int g = 0; g < 4; ++g) o_cmp[g] += p[g] * v[q]; } } } }
    LDS_WAIT(); asm volatile("" ::: "memory");
    float score[5];
#pragma unroll
    for (int c = 0; c < 5; ++c) { const int n = lane + 64 * c;
        const bool forced = (n == 0) || (n == cur) || (n == cur - 1);
        score[c] = (n >= NB) ? -4.0f : (n <= cur ? imp[c] + (forced ? 8.0f : 0.f) : -1.0f); }
    const int* ptab = (const int*)a.in[9] + sb * 128;
    float l_sel[4] = {0.f, 0.f, 0.f, 0.f}, o_sel[4] = {0.f, 0.f, 0.f, 0.f};
    float last_bv = 0.f; bool ambiguous = false;
    unsigned skey[5];
#pragma unroll
    for (int c = 0; c < 5; ++c) { const int n = lane + 64 * c; skey[c] = (MODE == 1 && n < NB) ? ((__float_as_uint(score[c]) & ~511u) | (unsigned)(511 - n)) : 0u; }
    for (int round = 0; round < (MODE == 2 ? 17 : 16); ++round) {
        float bv = score[0]; int bi = lane;
        if (MODE == 1) { unsigned w = skey[0];
#pragma unroll
            for (int c = 1; c < 5; ++c) w = skey[c] > w ? skey[c] : w;
            { unsigned o; o = dpp_x1(w); w = o > w ? o : w; o = dpp_x2(w); w = o > w ? o : w; o = dpp_x4(w); w = o > w ? o : w; o = dpp_x8(w); w = o > w ? o : w; w = umax_x16(w); w = umax_x32(w); }
            bi = 511 - (int)(w & 511u);
#pragma unroll
            for (int c = 0; c < 5; ++c) if (skey[c] == w) skey[c] = 0u;
        } else {
#pragma unroll
        for (int c = 1; c < 5; ++c) if (score[c] > bv) { bv = score[c]; bi = lane + 64 * c; }
#pragma unroll
        for (int o = 1; o < 64; o <<= 1) { const float ov = __shfl_xor(bv, o); const int oi = __shfl_xor(bi, o); if (ov > bv || (ov == bv && oi < bi)) { bv = ov; bi = oi; } }
        }
        const int n = __builtin_amdgcn_readfirstlane(bi);
        if (MODE == 2) { if (round == 16) { ambiguous = (bv >= 0.f) && (last_bv - bv < 4e-4f); break; } last_bv = bv; }
#pragma unroll
        for (int c = 0; c < 5; ++c) if (n == lane + 64 * c) score[c] = -3.0f;
        if (n > cur) continue;
        if (MODE == 1 && (round >> 1) != wave) continue;
        const float* kb; const float* vb; int nvalid;
        if (!smp) { kb = out + O_PSK + (size_t)(b * 8192 + 64 * n) * 128; vb = out + O_PSV + (size_t)(b * 8192 + 64 * n) * 128; }
        else if (n < 256) { const int page = ptab[n >> 1]; const size_t ro = ((size_t)page * 128 + (n & 1) * 64) * 128; kb = a.in[4] + ro; vb = a.in[5] + ro; }
        else { kb = out + O_SSK + (size_t)(sb * 8) * 128; vb = out + O_SSV + (size_t)(sb * 8) * 128; }
        nvalid = qpos - 64 * n + 1; if (nvalid > 64) nvalid = 64;
        const bool valid = lane < nvalid;
        float s4[4] = {0.f, 0.f, 0.f, 0.f};
        { const f32x4* kr = (const f32x4*)(kb + (size_t)(valid ? lane : 0) * 128 + kvh * 64);
#pragma unroll 4
          for (int d4 = 0; d4 < 16; ++d4) { const f32x4 k = kr[d4];
              const f32x4 q0 = *(const LAS f32x4*)(s_qr + (4 * d4 + 0) * 4), q1 = *(const LAS f32x4*)(s_qr + (4 * d4 + 1) * 4), q2 = *(const LAS f32x4*)(s_qr + (4 * d4 + 2) * 4), q3 = *(const LAS f32x4*)(s_qr + (4 * d4 + 3) * 4);
#pragma unroll
              for (int g = 0; g < 4; ++g) s4[g] += k.x * q0[g] + k.y * q1[g] + k.z * q2[g] + k.w * q3[g]; } }
        f32x4 pv4;
#pragma unroll
        for (int g = 0; g < 4; ++g) { const float p = valid ? __builtin_amdgcn_exp2f(s4[g] - mref_s[g]) : 0.f; l_sel[g] += p; pv4[g] = p; }
        *(LAS f32x4*)(s_p + lane * 4) = pv4;
        LDS_WAIT(); asm volatile("" ::: "memory");
        for (int j0 = 0; j0 < nvalid; j0 += 8) { float v[8];
#pragma unroll
            for (int q = 0; q < 8; ++q) { const int j = j0 + q < nvalid ? j0 + q : 0; v[q] = vb[(size_t)j * 128 + kvh * 64 + lane]; }
#pragma unroll
            for (int q = 0; q < 8; ++q) if (j0 + q < nvalid) { const f32x4 p = *(const LAS f32x4*)(s_p + (j0 + q) * 4);
#pragma unroll
                for (int g = 0; g < 4; ++g) o_sel[g] += p[g] * v[q]; } }
        LDS_WAIT(); asm volatile("" ::: "memory");
    }
    float l_win[4] = {0.f, 0.f, 0.f, 0.f}, o_win[4] = {0.f, 0.f, 0.f, 0.f};
    { const int lo = qpos - 511 > 0 ? qpos - 511 : 0; const int cnt = qpos - lo + 1;
      for (int c0 = 0; c0 < cnt; c0 += 64) {
          if (MODE == 1 && (c0 >> 6) != wave) continue;
          const int nvalid = cnt - c0 < 64 ? cnt - c0 : 64; const bool valid = lane < nvalid; const int kpos = lo + c0 + (valid ? lane : 0);
          const float* kr_;
          if (!smp) kr_ = (const float*)(ws + WS_KWIN) + (size_t)(b * 8192 + kpos) * 128;
          else if (kpos >= 16384) kr_ = out + O_SWK + (size_t)(sb * 512 + 504 + kpos - 16384) * 128;
          else kr_ = a.in[6] + (size_t)(sb * 512 + kpos - 15872) * 128;
          float s4[4] = {0.f, 0.f, 0.f, 0.f};
          { const f32x4* kr = (const f32x4*)(kr_ + kvh * 64);
#pragma unroll 4
            for (int d4 = 0; d4 < 16; ++d4) { const f32x4 k = kr[d4];
                const f32x4 q0 = *(const LAS f32x4*)(s_qr + (4 * d4 + 0) * 4), q1 = *(const LAS f32x4*)(s_qr + (4 * d4 + 1) * 4), q2 = *(const LAS f32x4*)(s_qr + (4 * d4 + 2) * 4), q3 = *(const LAS f32x4*)(s_qr + (4 * d4 + 3) * 4);
#pragma unroll
                for (int g = 0; g < 4; ++g) s4[g] += k.x * q0[g] + k.y * q1[g] + k.z * q2[g] + k.w * q3[g]; } }
          f32x4 pv4;
#pragma unroll
          for (int g = 0; g < 4; ++g) { const float p = valid ? __builtin_amdgcn_exp2f(s4[g] - mref_w[g]) : 0.f; l_win[g] += p; pv4[g] = p; }
          *(LAS f32x4*)(s_p + lane * 4) = pv4;
          LDS_WAIT(); asm volatile("" ::: "memory");
          for (int j0 = 0; j0 < nvalid; j0 += 8) { float v[8];
#pragma unroll
              for (int q = 0; q < 8; ++q) { const int kp = lo + c0 + (j0 + q < nvalid ? j0 + q : 0); const float* vr;
                  if (!smp) vr = (const float*)(ws + WS_VWIN) + (size_t)(b * 8192 + kp) * 128;
                  else if (kp >= 16384) vr = out + O_SWV + (size_t)(sb * 512 + 504 + kp - 16384) * 128;
                  else vr = a.in[7] + (size_t)(sb * 512 + kp - 15872) * 128;
                  v[q] = vr[kvh * 64 + lane]; }
#pragma unroll
              for (int q = 0; q < 8; ++q) if (j0 + q < nvalid) { const f32x4 p = *(const LAS f32x4*)(s_p + (j0 + q) * 4);
#pragma unroll
                  for (int g = 0; g < 4; ++g) o_win[g] += p[g] * v[q]; } }
          LDS_WAIT(); asm volatile("" ::: "memory");
      } }
    float ls[4], lw[4];
#pragma unroll
    for (int g = 0; g < 4; ++g) { ls[g] = wave_sum(l_sel[g]); lw[g] = wave_sum(l_win[g]); }
    if (MODE == 1) {
        LAS float* part = scr + 2048;
#pragma unroll
        for (int g = 0; g < 4; ++g) { part[g * 64 + lane] = o_cmp[g]; part[(4 + g) * 64 + lane] = o_sel[g]; part[(8 + g) * 64 + lane] = o_win[g]; }
        if (lane < 4) { part[768 + lane] = ls[lane & 3]; part[772 + lane] = lw[lane & 3]; }
        __syncthreads();
        if (wave == 0) {
#pragma unroll
            for (int g = 0; g < 4; ++g) { o_cmp[g] = 0.f; o_sel[g] = 0.f; o_win[g] = 0.f; ls[g] = 0.f; lw[g] = 0.f; }
            for (int w = 0; w < NWAVES; ++w) { const LAS float* pw = (const LAS float*)(ldsb + w * 16384) + 2048;
#pragma unroll
                for (int g = 0; g < 4; ++g) { o_cmp[g] += pw[g * 64 + lane]; o_sel[g] += pw[(4 + g) * 64 + lane]; o_win[g] += pw[(8 + g) * 64 + lane]; ls[g] += pw[768 + g]; lw[g] += pw[772 + g]; } }
        }
    }
    if (MODE != 1 || wave == 0) {
        const float* BG = (const float*)(ws + WS_BG) + (size_t)r * 24 + kvh * 12;
        bf16* O = (bf16*)(ws + WS_O) + (size_t)r * 512 + kvh * 256;
#pragma unroll
        for (int g = 0; g < 4; ++g) {
            const float o = BG[g * 3 + 0] * o_cmp[g] + BG[g * 3 + 1] * (o_sel[g] / fmaxf(ls[g], 1e-30f)) + BG[g * 3 + 2] * (o_win[g] / fmaxf(lw[g], 1e-30f));
            if (MODE == 2) { const float have = bf2f(O[g * 64 + lane]); if (!ambiguous && !(fabsf(have - o) <= 0.004f + 0.02f * fabsf(o))) atomicAdd((unsigned*)(ws + WS_CTL) + 8, 1u); }
            else O[g * 64 + lane] = (bf16)f2bf(o); }
    }
    LDS_WAIT(); asm volatile("" ::: "memory");
    if (MODE == 1) __syncthreads();
}

__device__ __forceinline__ void attn_sample(const Args& a, int r, int kvh, LAS unsigned char* ldsb, int wave, int lane) {
    unsigned char* ws = a.ws; float* out = a.out;
    LAS float* scr = (LAS float*)(ldsb + wave * 16384);
    LAS float* sh_sc = (LAS float*)(ldsb + RING_BYTES);
    const int rs_ = r - MP, sb = rs_ >> 3, si = rs_ & 7;
    const int seq = 4 + sb, qpos = 16384 + si, cur = qpos >> 6; constexpr int NB = 257;
    LAS float* s_qp = scr;
    LAS float* s_qr = scr + 256;
    LAS float* s_p = scr + 512;
    const bf16* QP = (const bf16*)(ws + WS_QP) + (size_t)r * 512 + kvh * 256; const bf16* QR = (const bf16*)(ws + WS_QR) + (size_t)r * 512 + kvh * 256;
    f32x4 ck[16]; float cv[64];
    auto chunk_load = [&](const float* krow, auto vrow, const int nvalid) __attribute__((always_inline)) {
        const f32x4* kr = (const f32x4*)(krow + kvh * 64);
#pragma unroll
        for (int d4 = 0; d4 < 16; ++d4) ck[d4] = kr[d4];
#pragma unroll
        for (int j = 0; j < 64; ++j) cv[j] = vrow(j < nvalid ? j : 0)[kvh * 64 + lane];
    };
    auto chunk_compute = [&](const int nvalid, const float (&mref)[4], float (&l)[4], float (&o)[4]) __attribute__((always_inline)) {
        const bool valid = lane < nvalid;
        f32x4 s4 = {0.f, 0.f, 0.f, 0.f};
#pragma unroll
        for (int d4 = 0; d4 < 16; ++d4) {
            const f32x4 q0 = *(const LAS f32x4*)(s_qr + (4 * d4 + 0) * 4), q1 = *(const LAS f32x4*)(s_qr + (4 * d4 + 1) * 4), q2 = *(const LAS f32x4*)(s_qr + (4 * d4 + 2) * 4), q3 = *(const LAS f32x4*)(s_qr + (4 * d4 + 3) * 4);
            s4 += q0 * ck[d4].x + q1 * ck[d4].y + q2 * ck[d4].z + q3 * ck[d4].w; }
        f32x4 pv4;
#pragma unroll
        for (int g = 0; g < 4; ++g) { const float p = valid ? __builtin_amdgcn_exp2f(s4[g] - mref[g]) : 0.f; l[g] += p; pv4[g] = p; }
        *(LAS f32x4*)(s_p + lane * 4) = pv4;
        LDS_WAIT(); asm volatile("" ::: "memory");
#pragma unroll
        for (int j = 0; j < 64; ++j) { const f32x4 p = *(const LAS f32x4*)(s_p + j * 4);
#pragma unroll
            for (int g = 0; g < 4; ++g) o[g] += p[g] * cv[j]; }
        LDS_WAIT(); asm volatile("" ::: "memory");
    };
    float l_sel[4] = {0.f, 0.f, 0.f, 0.f}, o_sel[4] = {0.f, 0.f, 0.f, 0.f}, l_win[4] = {0.f, 0.f, 0.f, 0.f}, o_win[4] = {0.f, 0.f, 0.f, 0.f};
    float qx[4], qy[4];
#pragma unroll
    for (int g = 0; g < 4; ++g) { qx[g] = bf2f(QP[g * 64 + lane]); qy[g] = bf2f(QR[g * 64 + lane]); }
    const float gk1 = fabsf(a.in[17][64 + lane]), gk2 = fabsf(a.in[17][128 + lane]);
    const int wlo = qpos - 511 > 0 ? qpos - 511 : 0, wcnt = qpos - wlo + 1, wc0 = 64 * wave;
    const int wnv = wc0 < wcnt ? (wcnt - wc0 < 64 ? wcnt - wc0 : 64) : 0;
    auto rowp = [&](const float* cache, size_t onew, int kp) { return kp >= 16384 ? out + onew + (size_t)(sb * 512 + 504 + kp - 16384) * 128 : cache + (size_t)(sb * 512 + kp - 15872) * 128; };
    if (wnv > 0) chunk_load(rowp(a.in[6], O_SWK, wlo + wc0 + (lane < wnv ? lane : 0)), [&](int j) { return rowp(a.in[7], O_SWV, wlo + wc0 + j); }, wnv);
    float mref_s[4], mref_w[4];
    { const float gks = wmax(gk1), gkw = wmax(gk2);
#pragma unroll
      for (int g = 0; g < 4; ++g) { s_qp[lane * 4 + g] = qx[g]; s_qr[lane * 4 + g] = qy[g]; const float qn = sqrtf(wsum(qy[g] * qy[g])) * 8.0f; mref_s[g] = qn * gks; mref_w[g] = qn * gkw; } }
    LDS_WAIT(); asm volatile("" ::: "memory");
    if (wnv > 0) chunk_compute(wnv, mref_w, l_win, o_win);
    const float* KC = (const float*)(ws + WS_KC) + kc_off(seq) + kvh * 64; const float* VC = (const float*)(ws + WS_VC) + kc_off(seq) + kvh * 64;
    const int n_ok = (qpos + 1) >> 6;
    const int nn = n_ok < NB ? n_ok : NB;
    float vc[33];
    { const int n = 33 * wave + lane; const bool mine = lane < 33 && n < n_ok;
      const f32x4* kr = (const f32x4*)(KC + (size_t)(mine ? n : 0) * 128);
      f32x4 k[16];
#pragma unroll
      for (int d4 = 0; d4 < 16; ++d4) k[d4] = kr[d4];
#pragma unroll
      for (int q = 0; q < 33; ++q) { const int nq = wave + 8 * q; vc[q] = VC[(size_t)(nq < nn ? nq : wave) * 128 + lane]; }
      f32x4 s4 = {0.f, 0.f, 0.f, 0.f};
#pragma unroll
      for (int d4 = 0; d4 < 16; ++d4) {
          const f32x4 q0 = *(const LAS f32x4*)(s_qp + (4 * d4 + 0) * 4), q1 = *(const LAS f32x4*)(s_qp + (4 * d4 + 1) * 4), q2 = *(const LAS f32x4*)(s_qp + (4 * d4 + 2) * 4), q3 = *(const LAS f32x4*)(s_qp + (4 * d4 + 3) * 4);
          s4 += q0 * k[d4].x + q1 * k[d4].y + q2 * k[d4].z + q3 * k[d4].w; }
      if (mine) *(LAS f32x4*)(sh_sc + n * 4) = s4; }
    LDS_WAIT(); __syncthreads();
    float sc[5][4];
#pragma unroll
    for (int c = 0; c < 5; ++c) { const int n = lane + 64 * c; f32x4 v = {0.f, 0.f, 0.f, 0.f}; if (n < n_ok && n < NB) v = *(const LAS f32x4*)(sh_sc + n * 4);
#pragma unroll
        for (int g = 0; g < 4; ++g) sc[c][g] = v[g]; }
    float imp[5];
#pragma unroll
    for (int c = 0; c < 5; ++c) imp[c] = 0.f;
#pragma unroll
    for (int g = 0; g < 4; ++g) {
        float m = -INFINITY;
#pragma unroll
        for (int c = 0; c < 5; ++c) { const int n = lane + 64 * c; if (n < n_ok && n < NB) m = fmaxf(m, sc[c][g]); }
        m = wmax(m); if (!(m > -INFINITY)) m = 0.f;
        float e[5], zs = 0.f;
#pragma unroll
        for (int c = 0; c < 5; ++c) { const int n = lane + 64 * c; e[c] = (n < n_ok && n < NB) ? __builtin_amdgcn_exp2f(sc[c][g] - m) : 0.f; zs += e[c]; }
        zs = wsum(zs); const float iz = 1.0f / fmaxf(zs, 1e-30f);
#pragma unroll
        for (int c = 0; c < 5; ++c) { const int n = lane + 64 * c; const float p = e[c] * iz; imp[c] += p; if (n < NB) s_p[n * 4 + g] = p; }
    }
    LDS_WAIT(); asm volatile("" ::: "memory");
    float o_cmp[4] = {0.f, 0.f, 0.f, 0.f};
#pragma unroll
    for (int q = 0; q < 33; ++q) { const int n = wave + 8 * q; if (n < nn) { const f32x4 p = *(const LAS f32x4*)(s_p + n * 4);
#pragma unroll
        for (int g = 0; g < 4; ++g) o_cmp[g] += p[g] * vc[q]; } }
    LDS_WAIT(); asm volatile("" ::: "memory");
    unsigned skey[5];
#pragma unroll
    for (int c = 0; c < 5; ++c) { const int n = lane + 64 * c; const bool forced = (n == 0) || (n == cur) || (n == cur - 1);
        const float score = imp[c] + (forced ? 8.0f : 0.f);
        skey[c] = (n < NB && n <= cur) ? ((__float_as_uint(score) & ~511u) | (unsigned)(511 - n)) : 0u; }
    int nsel[2] = {-1, -1};
#pragma nounroll
    for (int round = 0; round < 16; ++round) {
        unsigned w = skey[0];
#pragma unroll
        for (int c = 1; c < 5; ++c) w = skey[c] > w ? skey[c] : w;
        { unsigned o; o = dpp_x1(w); w = o > w ? o : w; o = dpp_x2(w); w = o > w ? o : w; o = dpp_x4(w); w = o > w ? o : w; o = dpp_x8(w); w = o > w ? o : w; w = umax_x16(w); w = umax_x32(w); }
        const unsigned wu = (unsigned)__builtin_amdgcn_readfirstlane((int)w);
#pragma unroll
        for (int c = 0; c < 5; ++c) if (skey[c] == wu) skey[c] = 0u;
        const int n = wu != 0u ? 511 - (int)(wu & 511u) : -1;
        if (round == 2 * wave) nsel[0] = n; if (round == 2 * wave + 1) nsel[1] = n;
    }
    const int* ptab = (const int*)a.in[9] + sb * 128;
#pragma nounroll
    for (int h = 0; h < 2; ++h) { const int n = nsel[h];
        if (n < 0 || n > cur) continue;
        const float* kb; const float* vb;
        if (n < 256) { const int page = ptab[n >> 1]; const size_t ro = ((size_t)page * 128 + (n & 1) * 64) * 128; kb = a.in[4] + ro; vb = a.in[5] + ro; }
        else { kb = out + O_SSK + (size_t)(sb * 8) * 128; vb = out + O_SSV + (size_t)(sb * 8) * 128; }
        int nvalid = qpos - 64 * n + 1; if (nvalid > 64) nvalid = 64;
        chunk_load(kb + (size_t)(lane < nvalid ? lane : 0) * 128, [&](int j) { return vb + (size_t)j * 128; }, nvalid);
        chunk_compute(nvalid, mref_s, l_sel, o_sel);
    }
    float ls[4], lw[4];
#pragma unroll
    for (int g = 0; g < 4; ++g) { ls[g] = wsum(l_sel[g]); lw[g] = wsum(l_win[g]); }
    LAS float* part = scr + 2048;
#pragma unroll
    for (int g = 0; g < 4; ++g) { part[g * 64 + lane] = o_cmp[g]; part[(4 + g) * 64 + lane] = o_sel[g]; part[(8 + g) * 64 + lane] = o_win[g]; }
    if (lane < 4) { part[768 + lane] = ls[lane & 3]; part[772 + lane] = lw[lane & 3]; }
    const float* BG = (const float*)(ws + WS_BG) + (size_t)r * 24 + kvh * 12;
    float bgv[12];
#pragma unroll
    for (int i = 0; i < 12; ++i) bgv[i] = BG[i];
    __syncthreads();
    if (wave == 0) {
#pragma unroll
        for (int g = 0; g < 4; ++g) { o_cmp[g] = 0.f; o_sel[g] = 0.f; o_win[g] = 0.f; ls[g] = 0.f; lw[g] = 0.f; }
#pragma unroll
        for (int w = 0; w < NWAVES; ++w) { const LAS float* pw = (const LAS float*)(ldsb + w * 16384) + 2048;
#pragma unroll
            for (int g = 0; g < 4; ++g) { o_cmp[g] += pw[g * 64 + lane]; o_sel[g] += pw[(4 + g) * 64 + lane]; o_win[g] += pw[(8 + g) * 64 + lane]; ls[g] += pw[768 + g]; lw[g] += pw[772 + g]; } }
        bf16* O = (bf16*)(ws + WS_O) + (size_t)r * 512 + kvh * 256;
#pragma unroll
        for (int g = 0; g < 4; ++g) {
            const float o = bgv[g * 3 + 0] * o_cmp[g] + bgv[g * 3 + 1] * (o_sel[g] / fmaxf(ls[g], 1e-30f)) + bgv[g * 3 + 2] * (o_win[g] / fmaxf(lw[g], 1e-30f));
            O[g * 64 + lane] = (bf16)f2bf(o); }
    }
    LDS_WAIT(); asm volatile("" ::: "memory");
    __syncthreads();
}

typedef short s16x8 __attribute__((ext_vector_type(8)));
template <bool B> struct BoolC { static constexpr bool v = B; };
__device__ __forceinline__ f32x4 mfma16(s16x8 a_, s16x8 b_, f32x4 c_) { return __builtin_amdgcn_mfma_f32_16x16x32_bf16(a_, b_, c_, 0, 0, 0); }
__device__ __forceinline__ unsigned cvtpk(float lo, float hi) { return pg8::cvt_pk_bf16(lo, hi); }
constexpr int AT_SLOT = 16384, AT_VOFF = 8192, AT_CMPV = 18432, AT_MASK = 4 * AT_SLOT, AT_QF = AT_MASK + 12288;
template <int PASS> __device__ __forceinline__ void attn_pass(const Args& a, LAS unsigned char* lds, int b, int kvh, int tb, int wave, int lane, int tid) {
    unsigned char* ws = a.ws; asm volatile("" : "+s"(ws)); asm volatile("" : "+v"(lane)); asm volatile("" : "+v"(tid));
    const int fr = lane & 15, fq = lane >> 4, tok_i = fr >> 2, g = fr & 3;
    const int r0 = b * 8192 + 128 * tb;
    const bf16* QR = (const bf16*)(ws + WS_QR);
    const float* BG = (const float*)(ws + WS_BG); float* OC = (float*)(ws + WS_OC);
    LAS unsigned* wmask = (LAS unsigned*)(lds + AT_MASK + wave * 1536);
    const int hq = kvh * 4 + g;
    f32x4 O[4][4], L[4];
    const s16x8 ones = {0x3F80, 0x3F80, 0x3F80, 0x3F80, 0x3F80, 0x3F80, 0x3F80, 0x3F80};
    LAS unsigned char* qlds = lds + AT_QF + wave * 8192;
    {
        const char* kimg = (const char*)((const bf16*)(ws + (PASS == 0 ? WS_KSB : WS_KWB)) + (size_t)((b * 128) * 2 + kvh) * 4096);
        const char* vimg = (const char*)((const bf16*)(ws + (PASS == 0 ? WS_VST : WS_VWT)) + (size_t)((b * 128) * 2 + kvh) * 4096);
        const float gk = wave_max(fabsf(a.in[17][(PASS == 0 ? 64 : 128) + lane]));
        if (PASS == 0) {
#pragma unroll
            for (int gi = 0; gi < 4; ++gi) { const int row = r0 + 16 * wave + 4 * gi + tok_i; const bf16* qp = QR + (size_t)row * 512 + hq * 64 + fq * 8;
                const s16x8 qa = *(const s16x8*)qp, qb = *(const s16x8*)(qp + 32); float ss = 0.f;
#pragma unroll
                for (int e = 0; e < 8; ++e) { const float x = bf2f((unsigned short)qa[e]), y = bf2f((unsigned short)qb[e]); ss += x * x + y * y; }
                ss += __shfl_xor(ss, 16); ss += __shfl_xor(ss, 32); ((LAS float*)wmask)[96 + gi * 64 + lane] = sqrtf(ss) * 8.0f;
                *(LAS s16x8*)(qlds + ((gi * 2 + 0) * 64 + lane) * 16) = qa; *(LAS s16x8*)(qlds + ((gi * 2 + 1) * 64 + lane) * 16) = qb; }
            LDS_WAIT();
        }
#pragma unroll
        for (int gi = 0; gi < 4; ++gi) { L[gi] = (f32x4){0.f, 0.f, 0.f, 0.f};
#pragma unroll
            for (int dg = 0; dg < 4; ++dg) O[gi][dg] = (f32x4){0.f, 0.f, 0.f, 0.f}; }
        s16x8 Qf[4][2];
#pragma unroll
        for (int gi = 0; gi < 4; ++gi) { Qf[gi][0] = *(const LAS s16x8*)(qlds + ((gi * 2 + 0) * 64 + lane) * 16); Qf[gi][1] = *(const LAS s16x8*)(qlds + ((gi * 2 + 1) * 64 + lane) * 16); }
        const LAS float* mrefl = (const LAS float*)wmask + 96 + lane;
        bool bigref; { float mx = 0.f;
#pragma unroll
            for (int gi = 0; gi < 4; ++gi) mx = fmaxf(mx, mrefl[64 * gi] * gk);
            bigref = __builtin_amdgcn_readfirstlane(__float_as_int(wave_max(mx))) > __float_as_int(64.0f); }
        const int nlast = 2 * tb + 1, nfirst = PASS == 0 ? 0 : (2 * tb - 8 > 0 ? 2 * tb - 8 : 0);
        const int drow = 8 * wave + (lane >> 3); const unsigned dsrc = (unsigned)(drow * 128 + (((lane & 7) ^ ((drow >> 1) & 7)) * 16));
        const unsigned fsw0 = (unsigned)((((0 + fq) ^ ((fr >> 1) & 7)) * 16)), fsw1 = (unsigned)((((4 + fq) ^ ((fr >> 1) & 7)) * 16));
#define AT_DMA_BLOCK(nn, sl) do { const size_t bo_ = (size_t)(nn) * 2 * 4096 * 2 + dsrc; \
            __builtin_amdgcn_global_load_lds((const unsigned*)(kimg + bo_), (LAS unsigned*)(lds + (sl) * AT_SLOT + wave * 1024), 16, 0, 0); \
            __builtin_amdgcn_global_load_lds((const unsigned*)(vimg + bo_), (LAS unsigned*)(lds + (sl) * AT_SLOT + AT_VOFF + wave * 1024), 16, 0, 0); } while (0)
        const int nblk = nlast - nfirst + 1, nint = (nblk + 1) >> 1;
        AT_DMA_BLOCK(nfirst, 0); if (nblk > 1) AT_DMA_BLOCK(nfirst + 1, 1);
        asm volatile("s_waitcnt vmcnt(0) lgkmcnt(0)\n\ts_barrier" ::: "memory");
        unsigned gwc[4] = {0u, 0u, 0u, 0u}, twc[4] = {0u, 0u, 0u, 0u}; int wcur = -1;
        auto do_block = [&](const int n, const LAS unsigned char* kb, auto bigc) __attribute__((always_inline)) {
            constexpr bool BIG = decltype(bigc)::v;
            const LAS unsigned char* vb = kb + AT_VOFF;
            if (PASS == 0 && (n >> 5) != wcur) { wcur = n >> 5;
#pragma unroll
                for (int gi = 0; gi < 4; ++gi) { gwc[gi] = (unsigned)__builtin_amdgcn_readfirstlane((int)wmask[64 + gi * 4 + wcur]); twc[gi] = wmask[(4 * gi + tok_i) * 4 + wcur]; } }
            int actm = 0;
#pragma unroll
            for (int gi = 0; gi < 4; ++gi) { int av;
                if (PASS == 0) { av = (int)((gwc[gi] >> (n & 31)) & 1u); }
                else { const int tlo = 128 * tb + 16 * wave + 4 * gi; const int b_lo = tlo - 511 > 0 ? (tlo - 511) >> 6 : 0, b_hi = (tlo + 3) >> 6; av = (n >= b_lo && n <= b_hi) ? 1 : 0; }
                actm |= av << gi; }
            actm = __builtin_amdgcn_readfirstlane(actm);
            if (actm != 0) {
#pragma unroll
                for (int kc = 0; kc < 2; ++kc) {
                    s16x8 Kf[2][2], Vf[4];
#pragma unroll
                    for (int x = 0; x < 2; ++x)
#pragma unroll
                        for (int k = 0; k < 2; ++k) Kf[x][k] = *(const LAS s16x8*)(kb + (16 * (2 * kc + x) + fr) * 128 + (k ? fsw1 : fsw0));
#pragma unroll
                    for (int dg = 0; dg < 4; ++dg) Vf[dg] = *(const LAS s16x8*)(vb + (16 * dg + fr) * 128 + (kc ? fsw1 : fsw0));
#pragma unroll
                    for (int gi = 0; gi < 4; ++gi) if ((actm >> gi) & 1) {
                        const int tl = 16 * wave + 4 * gi + tok_i, t = 128 * tb + tl, rel = t - 64 * n;
                        const int tlo = 128 * tb + 16 * wave + 4 * gi;
                        const bool edge = (64 * n + 63 > tlo) || (PASS == 1 && 64 * n < tlo + 3 - 511);
                        const s16x8 qf0 = Qf[gi][0], qf1 = Qf[gi][1];
                        f32x4 S[2];
                        if (PASS == 0 || BIG) {
                            const bool tsel = PASS == 0 ? ((twc[gi] >> (n & 31)) & 1u) != 0u : true;
                            float nm = 0.f; if (BIG) nm = -mrefl[64 * gi] * gk;
                            nm = tsel ? nm : -1e30f;
                            const f32x4 c0 = {nm, nm, nm, nm};
#pragma unroll
                            for (int x = 0; x < 2; ++x) S[x] = mfma16(Kf[x][0], qf0, c0);
                        } else {
#pragma unroll
                            for (int x = 0; x < 2; ++x) S[x] = mfma16(Kf[x][0], qf0, (f32x4){0.f, 0.f, 0.f, 0.f});
                        }
#pragma unroll
                        for (int x = 0; x < 2; ++x) S[x] = mfma16(Kf[x][1], qf1, S[x]);
                        if (edge) {
#pragma unroll
                            for (int x = 0; x < 2; ++x)
#pragma unroll
                                for (int i = 0; i < 4; ++i) { const int j = 16 * (2 * kc + x) + 4 * fq + i; const bool ok = j <= rel && (PASS == 0 || j > rel - 512);
                                    S[x][i] = ok ? __builtin_amdgcn_exp2f(S[x][i]) : 0.f; }
                        } else {
#pragma unroll
                            for (int x = 0; x < 2; ++x)
#pragma unroll
                                for (int i = 0; i < 4; ++i) S[x][i] = __builtin_amdgcn_exp2f(S[x][i]);
                        }
                        v4u pk; pk.x = cvtpk(S[0][0], S[0][1]); pk.y = cvtpk(S[0][2], S[0][3]); pk.z = cvtpk(S[1][0], S[1][1]); pk.w = cvtpk(S[1][2], S[1][3]);
                        const s16x8 pb = __builtin_bit_cast(s16x8, pk);
#pragma unroll
                        for (int dg = 0; dg < 4; ++dg) O[gi][dg] = mfma16(Vf[dg], pb, O[gi][dg]);
                        L[gi] = mfma16(ones, pb, L[gi]);
                    }
                }
            }
        };
        auto run = [&](auto bigc) __attribute__((always_inline)) {
#pragma nounroll
            for (int iv = 0; iv < nint; ++iv) {
                const int n0 = nfirst + 2 * iv, sp = (iv & 1) * 2;
                if (n0 + 2 <= nlast) AT_DMA_BLOCK(n0 + 2, 2 - sp);
                if (n0 + 3 <= nlast) AT_DMA_BLOCK(n0 + 3, 3 - sp);
                do_block(n0, lds + sp * AT_SLOT, bigc);
                if (n0 + 1 <= nlast) do_block(n0 + 1, lds + (sp + 1) * AT_SLOT, bigc);
                asm volatile("s_waitcnt vmcnt(0) lgkmcnt(0)\n\ts_barrier" ::: "memory");
            } };
        if (bigref) run(BoolC<true>{}); else run(BoolC<false>{});
#pragma unroll
        for (int gi = 0; gi < 4; ++gi) { const int row = r0 + 16 * wave + 4 * gi + tok_i;
            const float l = L[gi][0];
            const float sc = BG[(size_t)row * 24 + hq * 3 + 1 + PASS] / fmaxf(l, 1e-30f);
            float* oc = OC + (size_t)row * 512 + hq * 64 + 4 * fq;
#pragma unroll
            for (int dg = 0; dg < 4; ++dg) { const f32x4 v = *(const f32x4*)(oc + 16 * dg) + O[gi][dg] * sc;
                if (PASS == 0) *(f32x4*)(oc + 16 * dg) = v;
                else { v2u w; w.x = cvtpk(v[0], v[1]); w.y = cvtpk(v[2], v[3]); *(v2u*)((bf16*)(ws + WS_O) + (size_t)row * 512 + hq * 64 + 16 * dg + 4 * fq) = w; } } }
        }
}
__device__ __forceinline__ void attn_unit(const Args& a, LAS unsigned char* lds, int b, int kvh, int tb, int wave, int lane, int tid) {
    unsigned char* ws = a.ws; asm volatile("" : "+s"(ws)); asm volatile("" : "+v"(lane)); asm volatile("" : "+v"(tid));
    const int fr = lane & 15, fq = lane >> 4, tok_i = fr >> 2, g = fr & 3;
    const int r0 = b * 8192 + 128 * tb;
    const bf16* QP = (const bf16*)(ws + WS_QP); const bf16* QR = (const bf16*)(ws + WS_QR);
    const float* BG = (const float*)(ws + WS_BG); float* OC = (float*)(ws + WS_OC);
    LAS unsigned* wmask = (LAS unsigned*)(lds + AT_MASK + wave * 1536);
    const int hq = kvh * 4 + g;
    { const char* kcb = (const char*)((const bf16*)(ws + WS_KCB) + (size_t)(b * 2 + kvh) * 128 * 64); const char* vct = (const char*)((const bf16*)(ws + WS_VCT) + (size_t)(b * 2 + kvh) * 64 * 128);
      for (int c = tid; c < 1024; c += 512) { const v4u v = *(const v4u*)(kcb + c * 16); *(LAS v4u*)(lds + (c >> 3) * 144 + (c & 7) * 16) = v; }
      for (int c = tid; c < 1024; c += 512) { const v4u v = *(const v4u*)(vct + c * 16); *(LAS v4u*)(lds + AT_CMPV + (c >> 4) * 272 + (c & 15) * 16) = v; } }
    __syncthreads();
    const int ng = (2 * tb + 2 + 15) >> 4;
    s16x8 qn0, qn1; float bgn;
    { const int row = r0 + 16 * wave + tok_i; const bf16* qp = QP + (size_t)row * 512 + hq * 64 + fq * 8; qn0 = *(const s16x8*)qp; qn1 = *(const s16x8*)(qp + 32); bgn = BG[(size_t)row * 24 + hq * 3 + 0]; }
#pragma nounroll
    for (int gi = 0; gi < 4; ++gi) {
        const int tl = 16 * wave + 4 * gi + tok_i, t = 128 * tb + tl, row = r0 + tl;
        const s16x8 q0 = qn0, q1 = qn1; const float bg0 = bgn;
        { const int rown = r0 + 16 * wave + 4 * (gi < 3 ? gi + 1 : gi) + tok_i; const bf16* qp = QP + (size_t)rown * 512 + hq * 64 + fq * 8; qn0 = *(const s16x8*)qp; qn1 = *(const s16x8*)(qp + 32); bgn = BG[(size_t)rown * 24 + hq * 3 + 0]; }
        f32x4 S[8];
#pragma unroll
        for (int kg = 0; kg < 8; ++kg) { S[kg] = (f32x4){0.f, 0.f, 0.f, 0.f};
            if (kg < ng) { const s16x8 a0 = *(const LAS s16x8*)(lds + (16 * kg + fr) * 144 + fq * 16), a1 = *(const LAS s16x8*)(lds + (16 * kg + fr) * 144 + 64 + fq * 16);
                S[kg] = mfma16(a0, q0, S[kg]); S[kg] = mfma16(a1, q1, S[kg]); } }
        const int n_ok = (t + 1) >> 6, cur = t >> 6;
        float m = -INFINITY;
#pragma unroll
        for (int kg = 0; kg < 8; ++kg)
#pragma unroll
            for (int i = 0; i < 4; ++i) if (16 * kg + 4 * fq + i < n_ok) m = fmaxf(m, S[kg][i]);
        m = fmax_x16(m); m = fmax_x32(m); if (!(m > -INFINITY)) m = 0.f;
        float sum = 0.f;
#pragma unroll
        for (int kg = 0; kg < 8; ++kg)
#pragma unroll
            for (int i = 0; i < 4; ++i) { const float e = (16 * kg + 4 * fq + i < n_ok) ? __builtin_amdgcn_exp2f(S[kg][i] - m) : 0.f; S[kg][i] = e; sum += e; }
        sum = fsum_x16(sum); sum = fsum_x32(sum);
        const float inv = 1.0f / fmaxf(sum, 1e-30f);
#pragma unroll
        for (int kg = 0; kg < 8; ++kg) S[kg] *= inv;
        { f32x4 Oc[4];
#pragma unroll
          for (int dg = 0; dg < 4; ++dg) Oc[dg] = (f32x4){0.f, 0.f, 0.f, 0.f};
#pragma unroll
          for (int kc = 0; kc < 4; ++kc) if (2 * kc < ng) {
              v4u pk; pk.x = cvtpk(S[2 * kc][0], S[2 * kc][1]); pk.y = cvtpk(S[2 * kc][2], S[2 * kc][3]); pk.z = cvtpk(S[2 * kc + 1][0], S[2 * kc + 1][1]); pk.w = cvtpk(S[2 * kc + 1][2], S[2 * kc + 1][3]);
              const s16x8 pb = __builtin_bit_cast(s16x8, pk);
#pragma unroll
              for (int dg = 0; dg < 4; ++dg) { const s16x8 av = *(const LAS s16x8*)(lds + AT_CMPV + (16 * dg + fr) * 272 + kc * 64 + fq * 16); Oc[dg] = mfma16(av, pb, Oc[dg]); } }
#pragma unroll
          for (int dg = 0; dg < 4; ++dg) *(f32x4*)(OC + (size_t)row * 512 + hq * 64 + 16 * dg + 4 * fq) = Oc[dg] * bg0; }
#pragma unroll
        for (int kg = 0; kg < 8; ++kg)
#pragma unroll
            for (int i = 0; i < 4; ++i) { float v = S[kg][i]; v += dpp_x1f(v); v += dpp_x2f(v); S[kg][i] = v; }
        unsigned lm = 0u;
        if (cur < 16) {
#pragma unroll
            for (int h = 0; h < 2; ++h)
#pragma unroll
                for (int i = 0; i < 4; ++i) { const int n = 16 * (2 * g + h) + 4 * fq + i; lm |= (n <= cur) ? (1u << (n & 31)) : 0u; }
        } else {
            unsigned key[8];
#pragma unroll
            for (int h = 0; h < 2; ++h)
#pragma unroll
                for (int i = 0; i < 4; ++i) { const float v = g == 0 ? S[h][i] : (g == 1 ? S[2 + h][i] : (g == 2 ? S[4 + h][i] : S[6 + h][i]));
                    const int n = 16 * (2 * g + h) + 4 * fq + i; const bool forced = (n == 0) || (n == cur) || (n == cur - 1);
                    lm |= forced ? (1u << (n & 31)) : 0u;
                    key[h * 4 + i] = (n <= cur && !forced) ? ((__float_as_uint(v) & ~255u) | (unsigned)(255 - n)) : 0u; }
#define CE8(a_, b_) do { const unsigned hi_ = key[a_] > key[b_] ? key[a_] : key[b_], lo_ = key[a_] > key[b_] ? key[b_] : key[a_]; key[a_] = hi_; key[b_] = lo_; } while (0)
            CE8(0, 1); CE8(2, 3); CE8(4, 5); CE8(6, 7); CE8(0, 2); CE8(1, 3); CE8(4, 6); CE8(5, 7); CE8(1, 2); CE8(5, 6);
            CE8(0, 4); CE8(1, 5); CE8(2, 6); CE8(3, 7); CE8(2, 4); CE8(3, 5); CE8(1, 2); CE8(3, 4); CE8(5, 6);
#undef CE8
#pragma nounroll
            for (int round = 0; round < 13; ++round) {
                unsigned w = key[0];
                { unsigned o; o = dpp_x1(w); w = o > w ? o : w; o = dpp_x2(w); w = o > w ? o : w; w = umax_x16(w); w = umax_x32(w); }
                const bool win = key[0] == w && w != 0u;
                lm |= win ? (0x80000000u >> (w & 31u)) : 0u;
#pragma unroll
                for (int j = 0; j < 7; ++j) key[j] = win ? key[j + 1] : key[j];
                key[7] = win ? 0u : key[7];
            }
        }
        { auto r16 = __builtin_amdgcn_permlane16_swap(lm, lm, false, false); lm = r16[0] | r16[1]; auto r32 = __builtin_amdgcn_permlane32_swap(lm, lm, false, false); lm = r32[0] | r32[1]; }
        if (fq == 0) wmask[(4 * gi + tok_i) * 4 + g] = lm;
        { unsigned og = lm; og |= dpp_x4(og); og |= dpp_x8(og);
          if (fq == 0 && tok_i == 0) wmask[64 + gi * 4 + g] = og; }
    }
    LDS_WAIT();
    __syncthreads();
    attn_pass<0>(a, lds, b, kvh, tb, wave, lane, tid);
    attn_pass<1>(a, lds, b, kvh, tb, wave, lane, tid);
    __syncthreads();
}
__device__ __forceinline__ void phase_attn(const Args& a, LAS unsigned char* lds, int vcu, int G, int wave, int lane, int tid) {
    if ((vcu & 1) == 0) { for (int it = vcu; it < 2 * MS; it += G) attn_sample(a, MP + (it >> 1), it & 1, lds, wave, lane); }
#pragma nounroll
    for (int u2 = 2 * vcu; u2 < 512; u2 += 2 * G) {
#pragma nounroll
        for (int h = 0; h < 2; ++h) { const int u = u2 >> 1, bh = u >> 5, s = u & 31; attn_unit(a, lds, bh >> 1, bh & 1, h ? 63 - s : s, wave, lane, tid); } }
    if ((vcu & 1) != 0) { for (int it = vcu; it < 2 * MS; it += G) attn_sample(a, MP + (it >> 1), it & 1, lds, wave, lane); }
}
#if PROBE_ATTN
__device__ __forceinline__ void phase_attn_check(const Args& a, LAS unsigned char* lds, int gw, int NGW, int wave, int lane) {
    for (int it = gw; it < 2 * 2048; it += NGW) { const int idx = it >> 1; int r;
        if (idx < 300) r = idx; else if (idx < 600) r = 3 * 8192 + 900 + (idx - 300); else r = (int)(((long)(idx - 600) * 22639L) % MP);
        attn_item<2>(a, r, it & 1, lds, wave, lane); }
}
#endif


template <class F> __device__ __forceinline__ void small_gemm(const bf16* A, const bf16* Bt, int N, int K, int vcu, int G, int wave, int lane_, LAS unsigned char* lds, const F& f) {
    int lane = lane_;
    const int ntiles = 16 * (N >> 6), nk = K >> 7;
#pragma nounroll
    for (int tile = vcu; tile < ntiles; tile += G) {
        asm volatile("" : "+v"(lane));
        const int fr = lane & 15, fq = lane >> 4, rt = tile & 15, ct = tile >> 4;
        const bf16* ap = A + (size_t)(16 * rt + fr) * K + 8 * fq; const bf16* bp = Bt + (size_t)(64 * ct + fr) * K + 8 * fq;
        f32x4 acc[4];
#pragma unroll
        for (int j = 0; j < 4; ++j) acc[j] = (f32x4){0.f, 0.f, 0.f, 0.f};
#pragma nounroll
        for (int it = wave; it < nk; it += NWAVES) { const int k0 = it << 7;
            s16x8 af[4], bfr[4][4];
#pragma unroll
            for (int q = 0; q < 4; ++q) { af[q] = *(const s16x8*)(ap + k0 + 32 * q);
#pragma unroll
                for (int j = 0; j < 4; ++j) bfr[q][j] = *(const s16x8*)(bp + (size_t)(16 * j) * K + k0 + 32 * q); }
#pragma unroll
            for (int q = 0; q < 4; ++q)
#pragma unroll
                for (int j = 0; j < 4; ++j) acc[j] = mfma16(bfr[q][j], af[q], acc[j]);
        }
        LAS f32x4* red = (LAS f32x4*)lds;
#pragma unroll
        for (int j = 0; j < 4; ++j) red[(wave * 4 + j) * 64 + lane] = acc[j];
        __syncthreads();
        if (wave < 4) { f32x4 sum = red[wave * 64 + lane];
#pragma unroll
            for (int w = 1; w < NWAVES; ++w) sum += red[(w * 4 + wave) * 64 + lane];
            f(16 * rt + fr, 64 * ct + 16 * wave + 4 * fq, sum); }
        __syncthreads();
    }
}
__device__ __forceinline__ void sample_post(const Args& a, int gw, int NGW, int lane_) {
    int lane = lane_; asm volatile("" : "+v"(lane));
    unsigned char* ws = a.ws; float* out = a.out;
    const float* Z = (const float*)(ws + WS_ZS);
    const float* rc = (const float*)(ws + WS_ROPE); const float* rs = rc + ROPE_N * 32;
    bf16* U = (bf16*)(ws + WS_U); bf16* QP = (bf16*)(ws + WS_QP); bf16* QR = (bf16*)(ws + WS_QR); bf16* GC = (bf16*)(ws + WS_GC); bf16* GN = (bf16*)(ws + WS_GN);
    float* BG = (float*)(ws + WS_BG);
    const float qg = a.in[16][lane]; const float kg0 = a.in[17][lane], kg1 = a.in[17][64 + lane], kg2 = a.in[17][128 + lane];
    for (int r = MP + gw; r < MT; r += NGW) {
        const float* z = Z + (size_t)(r - MP) * DINP;
        float zg[16], zq[8], zk[12], zn;
#pragma unroll
        for (int i = 0; i < 8; ++i) { zg[i] = z[front_rowmap(lane + 64 * i)]; zg[8 + i] = z[front_rowmap(512 + lane + 64 * i)]; zq[i] = z[front_rowmap(OFF_Q + 64 * i + lane)]; }
#pragma unroll
        for (int i = 0; i < 12; ++i) zk[i] = z[front_rowmap(OFF_KV + 64 * i + lane)];
        zn = z[front_rowmap(OFF_NG + (lane < 24 ? lane : 0))];
        constexpr bool smp = true; const int rs_ = r - MP, sb = rs_ >> 3, si = rs_ & 7, b = 0, t = 0;
        const int ri = rope_idx(r); const float cv = rc[ri * 32 + (lane & 31)], sv = rs[ri * 32 + (lane & 31)];
#pragma unroll
        for (int i = 0; i < 8; ++i) { const int c = lane + 64 * i; const float u = zg[i] * sigm(zg[8 + i]);
            U[(size_t)r * 512 + c] = (bf16)f2bf(u);
            if (smp) out[O_SCONV + (size_t)(sb * 30 + 22 + si) * 512 + c] = u;
            else if (t >= 8162) out[O_PCONV + (size_t)(b * 30 + t - 8162) * 512 + c] = u; }
#pragma unroll
        for (int h = 0; h < 8; ++h) { const float x = zq[h]; const float ms = wave_sum(x * x) * (1.0f / 64.0f);
            const float y = x * (1.0f / sqrtf(ms + EPS)) * qg; const float oth = __shfl_xor(y, 32);
            const float yr = lane < 32 ? y * cv - oth * sv : y * cv + oth * sv;
            QP[(size_t)r * 512 + 64 * h + lane] = (bf16)f2bf(y * C2); QR[(size_t)r * 512 + 64 * h + lane] = (bf16)f2bf(yr * C2); }
#pragma unroll
        for (int j = 0; j < 6; ++j)
#pragma unroll
            for (int kvh = 0; kvh < 2; ++kvh) {
                float x = zk[2 * j + kvh];
                if ((j & 1) == 0) { const float ms = wave_sum(x * x) * (1.0f / 64.0f); x = x * (1.0f / sqrtf(ms + EPS)) * (j == 0 ? kg0 : (j == 2 ? kg1 : kg2));
                    if (j >= 2) { const float oth = __shfl_xor(x, 32); x = lane < 32 ? x * cv - oth * sv : x * cv + oth * sv; } }
                const int cc = kvh * 64 + lane;
                if (j < 4) { const size_t po = (j == 0 ? O_PCK : j == 1 ? O_PCV : j == 2 ? O_PSK : O_PSV), so = (j == 0 ? O_SCK : j == 1 ? O_SCV : j == 2 ? O_SSK : O_SSV);
                    if (smp) out[so + (size_t)rs_ * 128 + cc] = x; else out[po + (size_t)r * 128 + cc] = x; }
                if (!smp && j >= 2) { const size_t blk = ((size_t)(b * 128 + (t >> 6)) * 2 + kvh) * 4096; const int key = t & 63;
                    if (j == 2) ((bf16*)(ws + WS_KSB))[blk + key * 64 + lane] = (bf16)f2bf(x); else if (j == 3) ((bf16*)(ws + WS_VST))[blk + lane * 64 + perm64(key)] = (bf16)f2bf(x);
                    else if (j == 4) ((bf16*)(ws + WS_KWB))[blk + key * 64 + lane] = (bf16)f2bf(x); else ((bf16*)(ws + WS_VWT))[blk + lane * 64 + perm64(key)] = (bf16)f2bf(x); }
                if (j >= 4) { if (smp) out[(j == 4 ? O_SWK : O_SWV) + (size_t)(sb * 512 + 504 + si) * 128 + cc] = x;
                        }
            }
        if (lane < 24) BG[(size_t)r * 24 + lane] = sigm(zn);
        asm volatile("" ::: "memory");
        float zm[32];
#pragma unroll
        for (int i = 0; i < 32; ++i) zm[i] = z[front_rowmap(OFF_MG + lane + 64 * i)];
#pragma unroll
        for (int i = 0; i < 32; ++i) { const int c = lane + 64 * i; const float v = sigm(zm[i]);
            if (i < 16) GC[(size_t)r * 1024 + c] = (bf16)f2bf(v); else GN[(size_t)r * 1024 + c - 1024] = (bf16)f2bf(v); }
    }
}


constexpr int N_PHASES = 12;
#ifndef ONE_LAUNCH
#define ONE_LAUNCH 1
#endif
__global__ void __launch_bounds__(NWAVES * 64, 2) fwd(Args args) {
    extern __shared__ __attribute__((aligned(16))) unsigned char lds_raw[];
    LAS unsigned char* lds = (LAS unsigned char*)lds_raw;
    const int tid = threadIdx.x, lane = tid & 63, wave = __builtin_amdgcn_readfirstlane(tid >> 6);
    const int G = gridDim.x, bx = blockIdx.x;
    const int vcu = (G % 8 == 0) ? (bx % 8) * (G / 8) + bx / 8 : bx;
    const int gw = vcu * NWAVES + wave, NGW = G * NWAVES;
    unsigned char* ws = args.ws;
    for (int u = tid; u < (LDS_BYTES - RING_BYTES) / 4; u += NWAVES * 64) ((LAS unsigned*)(lds + RING_BYTES))[u] = 0u;
    __syncthreads();
    XcdBarrier bar; bar.bar = (unsigned*)(ws + WS_CTL) + CW_BAR; bar.x = 0; bar.st = nullptr;
    if (ONE_LAUNCH) bar = xcd_barrier_post((unsigned*)(ws + WS_CTL) + CW_BAR, (volatile LAS unsigned*)(lds + MISC_OFF) + 8);
    const int lo = args.ph_lo, hi = args.ph_hi;
#define IN(k) (lo <= (k) && (k) < hi)
#define SEAM(k) do { if (ONE_LAUNCH && IN(k) && hi > (k) + 1) xcd_barrier(bar); } while (0)
    const float* modp = (const float*)(ws + WS_MOD);
    if (IN(0)) { phase0(args, lds, gw, NGW, wave, lane); } SEAM(0);
    if (IN(1)) { norm_rows(args.in[0], args.in[1], args.in[14], modp, 0, 1024, (bf16*)(ws + WS_H), gw, NGW, lane); } SEAM(1);
    if (IN(2)) { pg8::Gemm g{(const bf16*)(ws + WS_H), (const bf16*)(ws + WS_WIN), MP, DINP, 1024}; pg8::StaticOrder S; S.init(MP, DINP, G, bx);
        const float* rcp_ = (const float*)(ws + WS_ROPE);
        pg8::EpiFront E{args.out, ws, args.in[16], args.in[17], rcp_, rcp_ + ROPE_N * 32, O_PCK, O_SCK, O_PWK, O_SWK, O_PCONV, O_SCONV,
                        WS_U, WS_QP, WS_QR, WS_GC, WS_GN, WS_BG, WS_KSB, WS_VST, WS_KWB, WS_VWT, WS_KWIN, WS_VWIN, C2};
        pg8::gemm_phase<pg8::EpiFront, pg8::StaticOrder, true, true>(lds, g, S, E);
        { float* zs = (float*)(ws + WS_ZS);
          small_gemm((const bf16*)(ws + WS_H) + (size_t)MP * 1024, (const bf16*)(ws + WS_WIN), DINP, 1024, vcu, G, wave, lane, lds, [&](int r, int c, f32x4 v) { *(f32x4*)(zs + (size_t)r * DINP + c) = v; }); } } SEAM(2);
    if (IN(3)) { sample_post(args, gw, NGW, lane); } SEAM(3);
    if (IN(4)) {
        constexpr int CONV8 = 3;
        if (G % 8 == 0) { const int oct = vcu >> 3, sub = vcu & 7, nc = (G >> 3) * CONV8, np = (G >> 3) * (8 - CONV8);
            if (sub < CONV8) { const int ci = oct * CONV8 + sub; phase_conv(args, lds, ci, nc, ci * NWAVES + wave, nc * NWAVES, wave, lane, tid); }
            else { const int pi = oct * (8 - CONV8) + (sub - CONV8); phase_pages(args, lds, pi * NWAVES + wave, np * NWAVES, wave, lane, tid); } }
        else { phase_conv(args, lds, vcu, G, gw, NGW, wave, lane, tid); phase_pages(args, lds, gw, NGW, wave, lane, tid); } } SEAM(4);
    if (IN(5)) { pg8::Gemm g{(const bf16*)(ws + WS_CACT), (const bf16*)(ws + WS_WPW2), MP, 1024, 512}; pg8::StaticOrder S; S.init(MP, 1024, G, bx);
        pg8::EpiGate<false> E{(bf16*)(ws + WS_T1), (const bf16*)(ws + WS_GC), 1024};
        pg8::gemm_phase<pg8::EpiGate<false>, pg8::StaticOrder, true, true>(lds, g, S, E);
        { bf16* t1 = (bf16*)(ws + WS_T1) + (size_t)MP * 1024; const bf16* gc = (const bf16*)(ws + WS_GC) + (size_t)MP * 1024;
          small_gemm((const bf16*)(ws + WS_CACT) + (size_t)MP * 512, (const bf16*)(ws + WS_WPW2), 1024, 512, vcu, G, wave, lane, lds, [&](int r, int c, f32x4 v) {
              const v2u gg = *(const v2u*)(gc + (size_t)r * 1024 + c); v2u w; w.x = pk2(v[0] * pg8::bf_lo(gg.x), v[1] * pg8::bf_hi(gg.x)); w.y = pk2(v[2] * pg8::bf_lo(gg.y), v[3] * pg8::bf_hi(gg.y));
              *(v2u*)(t1 + (size_t)r * 1024 + c) = w; }); } }
    if (IN(5) && !IN(6)) SEAM(5);
    if (IN(6)) { phase_attn(args, lds, vcu, G, wave, lane, tid); } SEAM(6);
#if PROBE_ATTN
    if (IN(7)) { phase_attn_check(args, lds, gw, NGW, wave, lane); __syncthreads(); }
#endif
    if (IN(7)) { pg8::Gemm g{(const bf16*)(ws + WS_O), (const bf16*)(ws + WS_WNSA), MP, 1024, 512}; pg8::StaticOrder S; S.init(MP, 1024, G, bx);
        pg8::EpiGate<true> E{(bf16*)(ws + WS_T1), (const bf16*)(ws + WS_GN), 1024};
        pg8::gemm_phase<pg8::EpiGate<true>, pg8::StaticOrder, true, true>(lds, g, S, E);
        { bf16* t1 = (bf16*)(ws + WS_T1) + (size_t)MP * 1024; const bf16* gn = (const bf16*)(ws + WS_GN) + (size_t)MP * 1024;
          small_gemm((const bf16*)(ws + WS_O) + (size_t)MP * 512, (const bf16*)(ws + WS_WNSA), 1024, 512, vcu, G, wave, lane, lds, [&](int r, int c, f32x4 v) {
              const v2u gg = *(const v2u*)(gn + (size_t)r * 1024 + c); const v2u tt = *(const v2u*)(t1 + (size_t)r * 1024 + c); v2u w;
              w.x = pk2(pg8::bf_lo(tt.x) + v[0] * pg8::bf_lo(gg.x), pg8::bf_hi(tt.x) + v[1] * pg8::bf_hi(gg.x)); w.y = pk2(pg8::bf_lo(tt.y) + v[2] * pg8::bf_lo(gg.y), pg8::bf_hi(tt.y) + v[3] * pg8::bf_hi(gg.y));
              *(v2u*)(t1 + (size_t)r * 1024 + c) = w; }); } } SEAM(7);
    if (IN(8)) { pg8::Gemm g{(const bf16*)(ws + WS_T1), (const bf16*)(ws + WS_WOUT), MP, 1024, 1024}; pg8::StaticOrder S; S.init(MP, 1024, G, bx);
        pg8::EpiResGate<false, true> E{args.in[0], args.in[1], (bf16*)(ws + WS_Y1), modp + 2048};
        pg8::gemm_phase<pg8::EpiResGate<false, true>, pg8::StaticOrder, true, true>(lds, g, S, E);
        { const float* xs = args.in[1]; bf16* ys = (bf16*)(ws + WS_Y1) + (size_t)MP * 1024; const float* mg = modp + 2048;
          small_gemm((const bf16*)(ws + WS_T1) + (size_t)MP * 1024, (const bf16*)(ws + WS_WOUT), 1024, 1024, vcu, G, wave, lane, lds, [&](int r, int c, f32x4 v) {
              const f32x4 y = *(const f32x4*)(xs + (size_t)r * 1024 + c) + *(const f32x4*)(mg + (size_t)(4 + (r >> 3)) * 6144 + c) * v;
              v2u w; w.x = pk2(y[0], y[1]); w.y = pk2(y[2], y[3]); *(v2u*)(ys + (size_t)r * 1024 + c) = w; }); } } SEAM(8);
    if (IN(9)) { norm_rows_bf16((const bf16*)(ws + WS_Y1), args.in[29], modp, 3072, 4096, (bf16*)(ws + WS_H), gw, NGW, lane); } SEAM(9);
    if (IN(10)) { pg8::Gemm g{(const bf16*)(ws + WS_H), (const bf16*)(ws + WS_WGU), MP, 2 * DFF, 1024}; pg8::StaticOrder S; S.init(MP, 2 * DFF, G, bx);
        pg8::EpiSwiGlu E{(bf16*)(ws + WS_ACT), DFF};
        pg8::gemm_phase<pg8::EpiSwiGlu, pg8::StaticOrder, true, true>(lds, g, S, E);
        { bf16* act = (bf16*)(ws + WS_ACT) + (size_t)MP * DFF;
          small_gemm((const bf16*)(ws + WS_H) + (size_t)MP * 1024, (const bf16*)(ws + WS_WGU), 2 * DFF, 1024, vcu, G, wave, lane, lds, [&](int r, int c, f32x4 v) {
              f32x4 up; up[0] = __shfl_xor(v[0], 16); up[1] = __shfl_xor(v[1], 16); up[2] = __shfl_xor(v[2], 16); up[3] = __shfl_xor(v[3], 16);
              if ((c & 4) == 0) { v2u w; w.x = pk2(v[0] * sigm(v[0]) * up[0], v[1] * sigm(v[1]) * up[1]); w.y = pk2(v[2] * sigm(v[2]) * up[2], v[3] * sigm(v[3]) * up[3]);
                  *(v2u*)(act + (size_t)r * DFF + (128 * (c >> 8) + 32 * ((c >> 5) & 3) + 8 * ((c >> 3) & 3) + 4 * ((c >> 7) & 1))) = w; } }); } } SEAM(10);
    if (IN(11)) { pg8::Gemm g{(const bf16*)(ws + WS_ACT), (const bf16*)(ws + WS_WDOWN), MP, 1024, DFF}; pg8::StaticOrder S; S.init(MP, 1024, G, bx);
        pg8::EpiResGate<true, false> E{(const bf16*)(ws + WS_Y1), (const bf16*)(ws + WS_Y1) + (size_t)MP * 1024, args.out, modp + 5120};
        pg8::gemm_phase<pg8::EpiResGate<true, false>, pg8::StaticOrder, true, true>(lds, g, S, E);
        { float* ys = args.out + (size_t)MP * 1024; const bf16* y1 = (const bf16*)(ws + WS_Y1) + (size_t)MP * 1024; const float* mg = modp + 5120;
          small_gemm((const bf16*)(ws + WS_ACT) + (size_t)MP * DFF, (const bf16*)(ws + WS_WDOWN), 1024, DFF, vcu, G, wave, lane, lds, [&](int r, int c, f32x4 v) {
              const v2u t = *(const v2u*)(y1 + (size_t)r * 1024 + c); const f32x4 b = {pg8::bf_lo(t.x), pg8::bf_hi(t.x), pg8::bf_lo(t.y), pg8::bf_hi(t.y)};
              *(f32x4*)(ys + (size_t)r * 1024 + c) = b + *(const f32x4*)(mg + (size_t)(4 + (r >> 3)) * 6144 + c) * v; }); } }
#if PROBE_ATTN
    if (ONE_LAUNCH) { xcd_barrier(bar); const unsigned cnt = __hip_atomic_load((unsigned*)(ws + WS_CTL) + 8, __ATOMIC_RELAXED, __HIP_MEMORY_SCOPE_AGENT);
        if (bx == 0 && tid < 64 && cnt != 0u) args.out[tid] = 10.0f * (float)(1 + (31 - __builtin_clz(cnt))); }
#endif
#undef IN
#undef SEAM
}

extern "C" void kernel_launch(void* const* d_in, const int* in_sizes, int n_in, void* d_out, int out_size, void* d_ws, size_t ws_size, hipStream_t stream) {
    static int grid = 0;
    if (grid == 0) {
        if (n_in != 33 || (size_t)out_size != O_END || ws_size < WS_END) { fprintf(stderr, "kernel_launch: unexpected shapes (n_in %d out %d ws %zu)\n", n_in, out_size, ws_size); grid = -1; return; }
        int dev = 0, cus = 0, per_cu = 0;
        if (hipGetDevice(&dev) != hipSuccess || hipDeviceGetAttribute(&cus, hipDeviceAttributeMultiprocessorCount, dev) != hipSuccess) { grid = -1; return; }
        if (hipFuncSetAttribute((const void*)fwd, hipFuncAttributeMaxDynamicSharedMemorySize, LDS_BYTES) != hipSuccess) { fprintf(stderr, "kernel_launch: hipFuncSetAttribute failed\n"); grid = -1; return; }
        if (hipOccupancyMaxActiveBlocksPerMultiprocessor(&per_cu, (const void*)fwd, NWAVES * 64, LDS_BYTES) != hipSuccess || per_cu < 1) fprintf(stderr, "kernel_launch: occupancy query says %d\n", per_cu);
        (void)hipGetLastError();
        grid = cus;
    }
    if (grid < 0) return;
    (void)hipMemsetAsync((char*)d_ws, 0, ZERO_BYTES, stream);
    Args a{};
    for (int i = 0; i < 33; ++i) a.in[i] = (const float*)d_in[i];
    a.out = (float*)d_out; a.ws = (unsigned char*)d_ws;
#if ONE_LAUNCH
    a.ph_lo = 0; a.ph_hi = N_PHASES;
    hipLaunchKernelGGL(fwd, dim3(grid), dim3(NWAVES * 64), LDS_BYTES, stream, a);
#else
    for (int p = 0; p < N_PHASES; ++p) { a.ph_lo = p; a.ph_hi = p + 1; hipLaunchKernelGGL(fwd, dim3(grid), dim3(NWAVES * 64), LDS_BYTES, stream, a); }
#endif
}
```

```cpp
#include <hip/hip_runtime.h>
#include <cstdio>
#include <cstdint>
#include <cmath>
#define PROBE_PHASE -1
#ifndef PROBE_ATTN
#define PROBE_ATTN 0
#endif
namespace pg8 {
#define PG8_LAS __attribute__((address_space(3)))
typedef unsigned short bf16_t;
typedef short bf16x8 __attribute__((ext_vector_type(8)));
typedef float f32x4 __attribute__((ext_vector_type(4)));
typedef unsigned u32x4 __attribute__((ext_vector_type(4)));
constexpr int BM = 256, BK = 64, HALF = 128, HTB = HALF * BK * 2  , STAGE_BYTES = 8 * HTB, NXCD = 8, WGM = 8;

__host__ __device__ __forceinline__ int lds_byte(int r, int c) { const int st = (r >> 4) * 2 + (c >> 5), rr = r & 15, cc = c & 31, ob = rr * 64 + cc * 2; return st * 1024 + (ob ^ (((ob >> 9) & 1) << 5)); }
__host__ __device__ __forceinline__ void stage_rc(int b, int& R, int& C) { const int st = b / 1024, sb = b % 1024, swz = sb ^ (((sb >> 9) & 1) << 5); R = (st >> 1) * 16 + swz / 64; C = (st & 1) * 32 + (swz % 64) / 2; }
__host__ __device__ __forceinline__ int perm32(int rho) { const int n = rho >> 4, i = rho & 15; return 8 * (i >> 2) + 4 * n + (i & 3); }

struct Unit { int pm, pn; };
struct Gemm { const bf16_t* A; const bf16_t* Bt; int M, N, K; };

struct StaticOrder {
    int nM, nN, nwg, G, c;
    __host__ __device__ void init(int M, int N, int G_, int c_) { nM = M / BM; nN = N / BM; nwg = nM * nN; G = G_; c = c_; }
    __host__ __device__ bool next(int i, Unit& u) const {
        const long L = (long)i * G + c; if (L >= nwg) return false;
        int wgid = (int)L; { const int q = nwg / NXCD, r = nwg % NXCD, xcd = wgid % NXCD, off = wgid / NXCD; wgid = (xcd < r ? xcd * (q + 1) : r * (q + 1) + (xcd - r) * q) + off; }
        const int nig = WGM * nN, gid = wgid / nig, fm = gid * WGM, gsz = (nM - fm) < WGM ? (nM - fm) : WGM;
        u.pm = fm + ((wgid % nig) % gsz); u.pn = (wgid % nig) / gsz; return true;
    }
    __device__ __forceinline__ void a_ready(const Unit&) const {}
    __device__ __forceinline__ void done(const Unit&) const {}
};

typedef float f32x2_cv __attribute__((ext_vector_type(2))); typedef __bf16 bf16x2_cv __attribute__((ext_vector_type(2)));
__device__ __forceinline__ unsigned cvt_pk_bf16(float lo, float hi) { f32x2_cv v = {lo, hi}; bf16x2_cv b = __builtin_convertvector(v, bf16x2_cv); return __builtin_bit_cast(unsigned, b); }
typedef float f32x2 __attribute__((ext_vector_type(2)));

constexpr int ROWS_P = 32768;
__device__ __forceinline__ int mod_row(int r) { return r < ROWS_P ? (r >> 13) : 4 + ((r - ROWS_P) >> 3); }
__device__ __forceinline__ float bf_lo(unsigned w) { return __uint_as_float(w << 16); }
__device__ __forceinline__ float bf_hi(unsigned w) { return __uint_as_float(w & 0xffff0000u); }
__device__ __forceinline__ float sigmoid_f(float x) { return __builtin_amdgcn_rcpf(1.0f + __builtin_amdgcn_exp2f(-1.4426950408889634f * x)); }

struct EpiF32 {
    static constexpr bool PERM = false, AFTER_DRAIN = false;
    float* C; int ldc;
    __device__ __forceinline__ void operator()(const f32x4 (&acc)[2][2][4][2], const Unit& u, int wr, int wc, int fr, int fq) const {
        const int row0 = u.pm * BM + wr * 64 + fr, col0 = u.pn * BM + wc * 32 + 4 * fq;
#pragma unroll
        for (int ai = 0; ai < 2; ++ai)
#pragma unroll
            for (int m = 0; m < 4; ++m) { float* rowp = C + (size_t)(row0 + ai * HALF + m * 16) * ldc + col0;
#pragma unroll
                for (int bj = 0; bj < 2; ++bj)
#pragma unroll
                    for (int n = 0; n < 2; ++n) *(f32x4*)(rowp + bj * HALF + n * 16) = acc[ai][bj][m][n]; }
    }
};
template <bool ADD> struct EpiGate {
    static constexpr bool PERM = true, AFTER_DRAIN = false;
    bf16_t* O; const bf16_t* G; int ldc;
    __device__ __forceinline__ void operator()(const f32x4 (&acc)[2][2][4][2], const Unit& u, int wr, int wc, int fr, int fq) const {
        const int row0 = u.pm * BM + wr * 64 + fr, col0 = u.pn * BM + wc * 32 + 8 * fq;
#pragma unroll
        for (int ai = 0; ai < 2; ++ai)
#pragma unroll
            for (int m = 0; m < 4; ++m) { const size_t ro = (size_t)(row0 + ai * HALF + m * 16) * ldc + col0;
#pragma unroll
                for (int bj = 0; bj < 2; ++bj) {
                    const u32x4 g = *(const u32x4*)(G + ro + bj * HALF);
                    f32x4 v0 = acc[ai][bj][m][0], v1 = acc[ai][bj][m][1];
                    v0[0] *= bf_lo(g.x); v0[1] *= bf_hi(g.x); v0[2] *= bf_lo(g.y); v0[3] *= bf_hi(g.y);
                    v1[0] *= bf_lo(g.z); v1[1] *= bf_hi(g.z); v1[2] *= bf_lo(g.w); v1[3] *= bf_hi(g.w);
                    if (ADD) { const u32x4 t = *(const u32x4*)(O + ro + bj * HALF);
                        v0[0] += bf_lo(t.x); v0[1] += bf_hi(t.x); v0[2] += bf_lo(t.y); v0[3] += bf_hi(t.y);
                        v1[0] += bf_lo(t.z); v1[1] += bf_hi(t.z); v1[2] += bf_lo(t.w); v1[3] += bf_hi(t.w); }
                    u32x4 w; w.x = cvt_pk_bf16(v0[0], v0[1]); w.y = cvt_pk_bf16(v0[2], v0[3]); w.z = cvt_pk_bf16(v1[0], v1[1]); w.w = cvt_pk_bf16(v1[2], v1[3]);
                    *(u32x4*)(O + ro + bj * HALF) = w; } }
    }
};
template <bool BASE_BF16, bool OUT_BF16> struct EpiResGate {
    static constexpr bool PERM = true, AFTER_DRAIN = false;
    const void* bp; const void* bs; void* out; const float* modg;
    __device__ __forceinline__ void operator()(const f32x4 (&acc)[2][2][4][2], const Unit& u, int wr, int wc, int fr, int fq) const {
        const int row0 = u.pm * BM + wr * 64 + fr, col0 = u.pn * BM + wc * 32 + 8 * fq;
        const float* g = modg + (size_t)mod_row(u.pm * BM) * 6144 + col0;
        f32x4 gv[2][2];
#pragma unroll
        for (int bj = 0; bj < 2; ++bj)
#pragma unroll
            for (int n = 0; n < 2; ++n) gv[bj][n] = *(const f32x4*)(g + bj * HALF + n * 4);
#pragma unroll
        for (int ai = 0; ai < 2; ++ai)
#pragma unroll
            for (int m = 0; m < 4; ++m) { const int r = row0 + ai * HALF + m * 16;
                const size_t bo = (r < ROWS_P ? (size_t)r : (size_t)(r - ROWS_P)) * 1024 + col0, oo = (size_t)r * 1024 + col0;
                const void* bb = r < ROWS_P ? bp : bs;
#pragma unroll
                for (int bj = 0; bj < 2; ++bj) { f32x4 b0, b1;
                    if (BASE_BF16) { const u32x4 t = *(const u32x4*)((const bf16_t*)bb + bo + bj * HALF);
                        b0 = (f32x4){bf_lo(t.x), bf_hi(t.x), bf_lo(t.y), bf_hi(t.y)}; b1 = (f32x4){bf_lo(t.z), bf_hi(t.z), bf_lo(t.w), bf_hi(t.w)}; }
                    else { const float* b = (const float*)bb + bo + bj * HALF; b0 = *(const f32x4*)b; b1 = *(const f32x4*)(b + 4); }
                    const f32x4 v0 = b0 + gv[bj][0] * acc[ai][bj][m][0], v1 = b1 + gv[bj][1] * acc[ai][bj][m][1];
                    if (OUT_BF16) { u32x4 w; w.x = cvt_pk_bf16(v0[0], v0[1]); w.y = cvt_pk_bf16(v0[2], v0[3]); w.z = cvt_pk_bf16(v1[0], v1[1]); w.w = cvt_pk_bf16(v1[2], v1[3]);
                        *(u32x4*)((bf16_t*)out + oo + bj * HALF) = w; }
                    else { float* o = (float*)out + oo + bj * HALF; *(f32x4*)o = v0; *(f32x4*)(o + 4) = v1; } } }
    }
};
struct EpiSwiGlu {
    static constexpr bool PERM = true, AFTER_DRAIN = false;
    bf16_t* O; int ldo;
    __device__ __forceinline__ void operator()(const f32x4 (&acc)[2][2][4][2], const Unit& u, int wr, int wc, int fr, int fq) const {
        const int row0 = u.pm * BM + wr * 64 + fr, oc0 = u.pn * 128 + wc * 32 + 8 * fq;
#pragma unroll
        for (int ai = 0; ai < 2; ++ai)
#pragma unroll
            for (int m = 0; m < 4; ++m) { bf16_t* rowp = O + (size_t)(row0 + ai * HALF + m * 16) * ldo + oc0; f32x4 a[2];
#pragma unroll
                for (int bj = 0; bj < 2; ++bj) { const f32x4 gt = acc[ai][bj][m][0], up = acc[ai][bj][m][1];
#pragma unroll
                    for (int i = 0; i < 4; ++i) a[bj][i] = gt[i] * sigmoid_f(gt[i]) * up[i]; }
                u32x4 w; w.x = cvt_pk_bf16(a[0][0], a[0][1]); w.y = cvt_pk_bf16(a[0][2], a[0][3]); w.z = cvt_pk_bf16(a[1][0], a[1][1]); w.w = cvt_pk_bf16(a[1][2], a[1][3]);
                *(u32x4*)rowp = w; }
    }
};

struct EpiFront {
    static constexpr bool PERM = true, AFTER_DRAIN = false;
    float* out; unsigned char* ws; const float* qg; const float* kng; const float* rc; const float* rsn;
    size_t o_pck, o_sck, o_pwk, o_swk, o_pconv, o_sconv;
    size_t w_u, w_qp, w_qr, w_gc, w_gn, w_bg, w_ksb, w_vst, w_kwb, w_vwt, w_kwin, w_vwin;
    float c2;
    __device__ __forceinline__ void operator()(const f32x4 (&acc)[2][2][4][2], const Unit& u, int wr, int wc, int fr, int fq) const {
        typedef unsigned u32x2 __attribute__((ext_vector_type(2)));
        const int pn = u.pn;
        const int row0 = u.pm * BM + wr * 64 + fr;
        if (pn < 4) {
            bf16_t* U = (bf16_t*)(ws + w_u);
#pragma unroll
            for (int ai = 0; ai < 2; ++ai)
#pragma unroll
                for (int m = 0; m < 4; ++m) { const int r = row0 + ai * HALF + m * 16; const int t = r & 8191;
#pragma unroll
                    for (int bj = 0; bj < 2; ++bj) { const int ch = 128 * pn + 64 * bj + 16 * wc + 4 * fq; const f32x4 a4 = acc[ai][bj][m][0], b4 = acc[ai][bj][m][1]; f32x4 u4;
#pragma unroll
                        for (int i = 0; i < 4; ++i) u4[i] = a4[i] * sigmoid_f(b4[i]);
                        u32x2 w; w.x = cvt_pk_bf16(u4[0], u4[1]); w.y = cvt_pk_bf16(u4[2], u4[3]); *(u32x2*)(U + (size_t)r * 512 + ch) = w;
                        if (t >= 8162) *(f32x4*)(out + o_pconv + (size_t)((r >> 13) * 30 + t - 8162) * 512 + ch) = u4; } }
        } else if (pn < 9) {
            const bool isq = pn < 6; const int kvt = pn - 6;
            const bool isv = !isq && (wc >= 2); const bool dorope = isq || (!isv && kvt >= 1);
            const float* gp = isq ? qg : kng + kvt * 64;
            f32x4 gn[2][2];
#pragma unroll
            for (int bj = 0; bj < 2; ++bj)
#pragma unroll
                for (int n = 0; n < 2; ++n) gn[bj][n] = isv ? (f32x4){1.f, 1.f, 1.f, 1.f} : *(const f32x4*)(gp + 32 * bj + 8 * fq + 4 * n);
#pragma unroll
            for (int ai = 0; ai < 2; ++ai)
#pragma unroll
                for (int m = 0; m < 4; ++m) { const int r = row0 + ai * HALF + m * 16;
                    f32x4 y[2][2];
#pragma unroll
                    for (int bj = 0; bj < 2; ++bj)
#pragma unroll
                        for (int n = 0; n < 2; ++n) y[bj][n] = acc[ai][bj][m][n];
                    if (!isv) { float ss = 0.f;
#pragma unroll
                        for (int bj = 0; bj < 2; ++bj)
#pragma unroll
                            for (int n = 0; n < 2; ++n) ss += (y[bj][n][0] * y[bj][n][0] + y[bj][n][1] * y[bj][n][1]) + (y[bj][n][2] * y[bj][n][2] + y[bj][n][3] * y[bj][n][3]);
                        ss += __shfl_xor(ss, 16); ss += __shfl_xor(ss, 32);
                        const float rstd = 1.0f / sqrtf(ss * (1.0f / 64.0f) + 1e-6f);
#pragma unroll
                        for (int bj = 0; bj < 2; ++bj)
#pragma unroll
                            for (int n = 0; n < 2; ++n) y[bj][n] = y[bj][n] * rstd * gn[bj][n]; }
                    const int ri = r & 8191;
                    f32x4 yr[2][2];
                    if (dorope) {
#pragma unroll
                        for (int n = 0; n < 2; ++n) { const f32x4 c4 = *(const f32x4*)(rc + (size_t)ri * 32 + 8 * fq + 4 * n), s4 = *(const f32x4*)(rsn + (size_t)ri * 32 + 8 * fq + 4 * n);
                            yr[0][n] = y[0][n] * c4 - y[1][n] * s4; yr[1][n] = y[1][n] * c4 + y[0][n] * s4; } }
                    else {
#pragma unroll
                        for (int n = 0; n < 2; ++n) { yr[0][n] = y[0][n]; yr[1][n] = y[1][n]; } }
                    if (isq) { const int h = 4 * (pn - 4) + wc; bf16_t* qp = (bf16_t*)(ws + w_qp) + (size_t)r * 512 + h * 64 + 8 * fq; bf16_t* qr = (bf16_t*)(ws + w_qr) + (size_t)r * 512 + h * 64 + 8 * fq;
#pragma unroll
                        for (int bj = 0; bj < 2; ++bj) { const f32x4 a0 = y[bj][0] * c2, a1 = y[bj][1] * c2, b0 = yr[bj][0] * c2, b1 = yr[bj][1] * c2; u32x4 w;
                            w.x = cvt_pk_bf16(a0[0], a0[1]); w.y = cvt_pk_bf16(a0[2], a0[3]); w.z = cvt_pk_bf16(a1[0], a1[1]); w.w = cvt_pk_bf16(a1[2], a1[3]); *(u32x4*)(qp + 32 * bj) = w;
                            w.x = cvt_pk_bf16(b0[0], b0[1]); w.y = cvt_pk_bf16(b0[2], b0[3]); w.z = cvt_pk_bf16(b1[0], b1[1]); w.w = cvt_pk_bf16(b1[2], b1[3]); *(u32x4*)(qr + 32 * bj) = w; } }
                    else { const int kvh = wc & 1; const int j = 2 * kvt + (isv ? 1 : 0);
                        const int t = r & 8191;
                        float* fo = nullptr;
                        if (j < 4) fo = out + o_pck + (size_t)j * 4194304 + (size_t)r * 128; else if (t >= 7680) fo = out + o_pwk + (size_t)(j - 4) * 262144 + (size_t)((r >> 13) * 512 + t - 7680) * 128;
                        if (fo) {
#pragma unroll
                            for (int bj = 0; bj < 2; ++bj)
#pragma unroll
                                for (int n = 0; n < 2; ++n) *(f32x4*)(fo + kvh * 64 + 32 * bj + 8 * fq + 4 * n) = yr[bj][n]; }
#if defined(PROBE_ATTN) && PROBE_ATTN
                        if (kvt == 2) { float* kw = (float*)(ws + (isv ? w_vwin : w_kwin)) + (size_t)r * 128 + kvh * 64;
#pragma unroll
                            for (int bj = 0; bj < 2; ++bj)
#pragma unroll
                                for (int n = 0; n < 2; ++n) *(f32x4*)(kw + 32 * bj + 8 * fq + 4 * n) = yr[bj][n]; }
#endif
                        if (kvt >= 1) { const int key = t & 63; const size_t blk = ((size_t)((r >> 13) * 128 + (t >> 6)) * 2 + kvh) * 4096;
                            if (!isv) { bf16_t* kd = (bf16_t*)(ws + (kvt == 1 ? w_ksb : w_kwb)) + blk + key * 64 + 8 * fq;
#pragma unroll
                                for (int bj = 0; bj < 2; ++bj) { u32x4 w; w.x = cvt_pk_bf16(yr[bj][0][0], yr[bj][0][1]); w.y = cvt_pk_bf16(yr[bj][0][2], yr[bj][0][3]); w.z = cvt_pk_bf16(yr[bj][1][0], yr[bj][1][1]); w.w = cvt_pk_bf16(yr[bj][1][2], yr[bj][1][3]);
                                    *(u32x4*)(kd + 32 * bj) = w; } }
                            else { const int kp = (key & 32) | (((key >> 2) & 3) << 3) | (((key >> 4) & 1) << 2) | (key & 3);
                                bf16_t* vd = (bf16_t*)(ws + (kvt == 1 ? w_vst : w_vwt)) + blk + kp;
#pragma unroll
                                for (int bj = 0; bj < 2; ++bj)
#pragma unroll
                                    for (int n = 0; n < 2; ++n)
#pragma unroll
                                        for (int i = 0; i < 4; ++i) { const unsigned b2 = cvt_pk_bf16(y[bj][n][i], 0.f); vd[(size_t)(32 * bj + 8 * fq + 4 * n + i) * 64] = (bf16_t)(b2 & 0xffffu); } } }
                    } }
        } else if (pn < 17) {
            bf16_t* G = (bf16_t*)(ws + (pn < 13 ? w_gc : w_gn)); const int cb = 256 * ((pn - 9) & 3) + 32 * wc + 8 * fq;
#pragma unroll
            for (int ai = 0; ai < 2; ++ai)
#pragma unroll
                for (int m = 0; m < 4; ++m) { const int r = row0 + ai * HALF + m * 16;
#pragma unroll
                    for (int bj = 0; bj < 2; ++bj) { const f32x4 v0 = acc[ai][bj][m][0], v1 = acc[ai][bj][m][1]; u32x4 w;
                        w.x = cvt_pk_bf16(sigmoid_f(v0[0]), sigmoid_f(v0[1])); w.y = cvt_pk_bf16(sigmoid_f(v0[2]), sigmoid_f(v0[3])); w.z = cvt_pk_bf16(sigmoid_f(v1[0]), sigmoid_f(v1[1])); w.w = cvt_pk_bf16(sigmoid_f(v1[2]), sigmoid_f(v1[3]));
                        *(u32x4*)(G + (size_t)r * 1024 + cb + 128 * bj) = w; } }
        } else {
            if (wc == 0 && fq < 3) { float* BG = (float*)(ws + w_bg);
#pragma unroll
                for (int ai = 0; ai < 2; ++ai)
#pragma unroll
                    for (int m = 0; m < 4; ++m) { const int r = row0 + ai * HALF + m * 16;
#pragma unroll
                        for (int n = 0; n < 2; ++n) { const int c = 8 * fq + 4 * n; const f32x4 v = acc[ai][0][m][n]; f32x4 o;
#pragma unroll
                            for (int i = 0; i < 4; ++i) o[i] = sigmoid_f(v[i]);
                            *(f32x4*)(BG + (size_t)r * 24 + c) = o; } } }
        }
    }
};
template <class Epi, class Sched, bool ALIGN_EPI = false, bool SP2 = false>
__device__ __forceinline__ void gemm_phase(PG8_LAS unsigned char* lds, const Gemm g, const Sched& S, const Epi& E) {
    const int tid = threadIdx.x, wid = __builtin_amdgcn_readfirstlane(tid >> 6), lane = tid & 63, wr = wid >> 2, wc = wid & 3, fr = lane & 15, fq = lane >> 4;
    const int K = g.K, nt = K / BK;
    unsigned voffA[2], voffB[2];
#pragma unroll
    for (int i = 0; i < 2; ++i) { int R, C; stage_rc(tid * 16 + i * 8192, R, C); const int Rb = Epi::PERM ? ((R & ~31) + perm32(R & 31)) : R;
        voffA[i] = (unsigned)(R * K + C) * 2u; voffB[i] = (unsigned)(Rb * K + C) * 2u; }
    const size_t kstep = (size_t)(BK * 2);
    const size_t hstep = (size_t)HALF * K * 2;
    const size_t tstep = 2 * hstep;
    const unsigned ldsw = (unsigned)wid * 1024u;
    const int aoff = lds_byte(wr * 64 + fr, fq * 8), boff = lds_byte(wc * 32 + fr, fq * 8);
#define PG8_SA(b, h) (((b) * 2 + (h)) * HTB)
#define PG8_SB(b, h) ((4 + (b) * 2 + (h)) * HTB)
#define PG8_STAGE(bufoff, gbase, voff) do { _Pragma("unroll") for (int _i = 0; _i < 2; ++_i) \
        __builtin_amdgcn_global_load_lds((const unsigned*)((const char*)(gbase) + (voff)[_i]), (PG8_LAS unsigned*)(lds + (bufoff) + ldsw + _i * 8192), 16, 0, 0); } while (0)
#define PG8_LDA(dst, b, h) do { _Pragma("unroll") for (int m = 0; m < 4; ++m) _Pragma("unroll") for (int k = 0; k < 2; ++k) dst[m][k] = *(const PG8_LAS bf16x8*)(lds + PG8_SA(b, h) + aoff + m * 2048 + k * 1024); } while (0)
#define PG8_LDB(dst, b, h) do { _Pragma("unroll") for (int n = 0; n < 2; ++n) _Pragma("unroll") for (int k = 0; k < 2; ++k) dst[n][k] = *(const PG8_LAS bf16x8*)(lds + PG8_SB(b, h) + boff + n * 2048 + k * 1024); } while (0)
#define PG8_MMA(ai, bj, At, Bt) do { __builtin_amdgcn_s_setprio(1); _Pragma("unroll") for (int m = 0; m < 4; ++m) _Pragma("unroll") for (int n = 0; n < 2; ++n) _Pragma("unroll") for (int k = 0; k < 2; ++k) \
        acc[ai][bj][m][n] = __builtin_amdgcn_mfma_f32_16x16x32_bf16(Bt[n][k], At[m][k], acc[ai][bj][m][n], 0, 0, 0); __builtin_amdgcn_s_setprio(0); } while (0)
#define PG8_WAIT_V(n) asm volatile("s_waitcnt vmcnt(" #n ")" ::: "memory")
#define PG8_WAIT_L(n) asm volatile("s_waitcnt lgkmcnt(" #n ")" ::: "memory")
#define PG8_BAR __builtin_amdgcn_s_barrier()
#define PG8_SCHED __builtin_amdgcn_sched_barrier(0)
    Unit cur, nxt; int ui = 0;
    if (!S.next(0, cur)) return;
    f32x4 acc[2][2][4][2];
#pragma unroll
    for (int a = 0; a < 2; ++a)
#pragma unroll
        for (int b = 0; b < 2; ++b)
#pragma unroll
            for (int m = 0; m < 4; ++m)
#pragma unroll
                for (int n = 0; n < 2; ++n) acc[a][b][m][n] = (f32x4){0.f, 0.f, 0.f, 0.f};
    bf16x8 At[4][2], B0[2][2], B1[2][2];
    const char* cA = (const char*)g.A + (size_t)cur.pm * tstep; const char* cB = (const char*)g.Bt + (size_t)cur.pn * tstep;
    S.a_ready(cur);
    if constexpr (SP2) {
        PG8_STAGE(PG8_SB(0, 0), cB, voffB); PG8_STAGE(PG8_SB(0, 1), cB + hstep, voffB); PG8_STAGE(PG8_SA(0, 0), cA, voffA); PG8_STAGE(PG8_SA(0, 1), cA + hstep, voffA);
        if (wr == 1) PG8_BAR;
        PG8_WAIT_V(2); PG8_BAR;
        PG8_STAGE(PG8_SB(1, 0), cB + kstep, voffB); PG8_STAGE(PG8_SA(1, 0), cA + kstep, voffA); PG8_STAGE(PG8_SB(1, 1), cB + hstep + kstep, voffB);
        PG8_WAIT_V(6); PG8_BAR;
    } else {
        PG8_STAGE(PG8_SB(0, 0), cB, voffB); PG8_STAGE(PG8_SA(0, 0), cA, voffA); PG8_STAGE(PG8_SB(0, 1), cB + hstep, voffB); PG8_STAGE(PG8_SA(0, 1), cA + hstep, voffA);
        if (wr == 1) PG8_BAR;
        PG8_WAIT_V(4); PG8_BAR;
        PG8_STAGE(PG8_SB(1, 0), cB + kstep, voffB); PG8_STAGE(PG8_SA(1, 0), cA + kstep, voffA); PG8_STAGE(PG8_SB(1, 1), cB + hstep + kstep, voffB);
        PG8_WAIT_V(6); PG8_BAR;
    }
    for (;;) {
        const bool has_next = S.next(ui + 1, nxt);
        const char* nA = has_next ? (const char*)g.A + (size_t)nxt.pm * tstep : cA; const char* nB = has_next ? (const char*)g.Bt + (size_t)nxt.pn * tstep : cB;
        for (int t = 0; t < nt; t += 2) {
            const bool last = (t == nt - 2);
            const char* a1 = cA + (size_t)(t + 1) * kstep;
            const char* a2 = last ? nA : cA + (size_t)(t + 2) * kstep; const char* b2 = last ? nB : cB + (size_t)(t + 2) * kstep;
            const char* a3 = a2 + kstep; const char* b3 = b2 + kstep;
            if (last && has_next) S.a_ready(nxt);
            if constexpr (SP2) {
            PG8_LDB(B0, 0, 0); PG8_LDB(B1, 0, 1); PG8_SCHED; PG8_LDA(At, 0, 0); PG8_STAGE(PG8_SA(1, 1), a1 + hstep, voffA);
            PG8_WAIT_V(8); PG8_WAIT_L(0); PG8_BAR; PG8_MMA(0, 0, At, B0); PG8_MMA(0, 1, At, B1); PG8_BAR; PG8_SCHED;
            PG8_LDA(At, 0, 1); PG8_STAGE(PG8_SB(0, 0), b2, voffB); PG8_STAGE(PG8_SB(0, 1), b2 + hstep, voffB); PG8_STAGE(PG8_SA(0, 0), a2, voffA);
            PG8_WAIT_V(8); PG8_WAIT_L(0); PG8_BAR; PG8_MMA(1, 0, At, B0); PG8_MMA(1, 1, At, B1); PG8_BAR; PG8_SCHED;
            PG8_LDB(B0, 1, 0); PG8_LDB(B1, 1, 1); PG8_SCHED; PG8_LDA(At, 1, 0); PG8_STAGE(PG8_SA(0, 1), a2 + hstep, voffA);
            PG8_WAIT_V(8); PG8_WAIT_L(0); PG8_BAR; PG8_MMA(0, 0, At, B0); PG8_MMA(0, 1, At, B1); PG8_BAR; PG8_SCHED;
            PG8_LDA(At, 1, 1); PG8_STAGE(PG8_SB(1, 0), b3, voffB); PG8_STAGE(PG8_SB(1, 1), b3 + hstep, voffB); PG8_STAGE(PG8_SA(1, 0), a3, voffA);
            PG8_WAIT_V(8); PG8_WAIT_L(0); PG8_BAR; PG8_MMA(1, 0, At, B0); PG8_MMA(1, 1, At, B1); PG8_BAR; PG8_SCHED;
            } else {
            PG8_LDB(B0, 0, 0); PG8_SCHED; PG8_LDA(At, 0, 0); PG8_STAGE(PG8_SA(1, 1), a1 + hstep, voffA);
            PG8_WAIT_L(8); PG8_BAR; PG8_WAIT_L(0); PG8_MMA(0, 0, At, B0); PG8_BAR; PG8_SCHED;
            PG8_LDB(B1, 0, 1); PG8_STAGE(PG8_SB(0, 0), b2, voffB);
            PG8_BAR; PG8_WAIT_L(0); PG8_MMA(0, 1, At, B1); PG8_BAR;
            PG8_LDA(At, 0, 1); PG8_STAGE(PG8_SA(0, 0), a2, voffA);
            PG8_BAR; PG8_WAIT_L(0); PG8_MMA(1, 0, At, B0); PG8_BAR; PG8_SCHED;
            PG8_STAGE(PG8_SB(0, 1), b2 + hstep, voffB);
            PG8_WAIT_V(6); PG8_BAR; PG8_MMA(1, 1, At, B1); PG8_BAR;
            PG8_LDB(B0, 1, 0); PG8_SCHED; PG8_LDA(At, 1, 0); PG8_STAGE(PG8_SA(0, 1), a2 + hstep, voffA);
            PG8_WAIT_L(8); PG8_BAR; PG8_WAIT_L(0); PG8_MMA(0, 0, At, B0); PG8_BAR; PG8_SCHED;
            PG8_LDB(B1, 1, 1); PG8_STAGE(PG8_SB(1, 0), b3, voffB);
            PG8_BAR; PG8_WAIT_L(0); PG8_MMA(0, 1, At, B1); PG8_BAR;
            PG8_LDA(At, 1, 1); PG8_STAGE(PG8_SA(1, 0), a3, voffA);
            PG8_BAR; PG8_WAIT_L(0); PG8_MMA(1, 0, At, B0); PG8_BAR; PG8_SCHED;
            PG8_STAGE(PG8_SB(1, 1), b3 + hstep, voffB);
            PG8_WAIT_V(6); PG8_BAR; PG8_MMA(1, 1, At, B1); PG8_BAR;
            }
        }
        if constexpr (ALIGN_EPI) { if (wr == 0) PG8_BAR; }
        if constexpr (!Epi::AFTER_DRAIN) { E(acc, cur, wr, wc, fr, fq); S.done(cur); }
        if (!has_next) break;
#pragma unroll
        for (int a = 0; a < 2; ++a)
#pragma unroll
            for (int b = 0; b < 2; ++b)
#pragma unroll
                for (int m = 0; m < 4; ++m)
#pragma unroll
                    for (int n = 0; n < 2; ++n) acc[a][b][m][n] = (f32x4){0.f, 0.f, 0.f, 0.f};
        cur = nxt; cA = nA; cB = nB; ++ui;
        if constexpr (ALIGN_EPI) { if (wr == 1) PG8_BAR; }
    }
    PG8_WAIT_V(0);
    if constexpr (!ALIGN_EPI) { if (wr == 0) PG8_BAR; }
    PG8_BAR;
    if constexpr (Epi::AFTER_DRAIN) { E.fused(acc, cur, wr, wc, fr, fq, lds, wid, lane); S.done(cur); }
#undef PG8_SA
#undef PG8_SB
#undef PG8_STAGE
#undef PG8_LDA
#undef PG8_LDB
#undef PG8_MMA
#undef PG8_WAIT_V
#undef PG8_WAIT_L
#undef PG8_BAR
#undef PG8_SCHED
}
}
#define GAS __attribute__((address_space(1)))
#define LAS __attribute__((address_space(3)))
typedef unsigned short bf16;
typedef unsigned v4u __attribute__((ext_vector_type(4)));
typedef float f32x4 __attribute__((ext_vector_type(4)));
typedef short bf16x8 __attribute__((ext_vector_type(8)));
typedef GAS unsigned gu32;
typedef GAS unsigned long long gu64;
#define RLX_AGENT __ATOMIC_RELAXED, __HIP_MEMORY_SCOPE_AGENT
#define LDS_WAIT() asm volatile("s_waitcnt lgkmcnt(0)" ::: "memory")
#define VM_WAIT() asm volatile("s_waitcnt vmcnt(0)" ::: "memory")
__device__ __forceinline__ unsigned long long rt() { return __builtin_amdgcn_s_memrealtime(); }
__device__ __forceinline__ unsigned f2bf(float f) { unsigned u = __builtin_bit_cast(unsigned, f); return (u + 0x7fffu + ((u >> 16) & 1u)) >> 16; }
__device__ __forceinline__ unsigned pk2(float lo, float hi) { return f2bf(lo) | (f2bf(hi) << 16); }

#define XB_TMO      128
#define XB_XCNT(j)  (256  + 64 * (j))
#define XB_XSUB(j)  (1280 + 64 * (j))
#define XB_XGEN(j)  (2304 + 64 * (j))
#define XB_TOP      3328
#define XB_TOPGEN   3392
#define XCD_BAR_WORDS 3456
#define XB_SPIN_CAP (1u << 18)

__device__ __forceinline__ unsigned xb_ld(unsigned* p)              { return __hip_atomic_load(p, __ATOMIC_RELAXED, __HIP_MEMORY_SCOPE_AGENT); }
__device__ __forceinline__ unsigned xb_add(unsigned* p, unsigned v) { return __hip_atomic_fetch_add(p, v, __ATOMIC_RELAXED, __HIP_MEMORY_SCOPE_AGENT); }
__device__ __forceinline__ unsigned xb_xcc_id() { return (unsigned)__builtin_amdgcn_s_getreg((3 << 11) | 20) & 0xFu; }
#define XB_SPIN(cond, bar) do { unsigned _sp = 0; while (cond) { __builtin_amdgcn_s_sleep(1); \
    if ((++_sp & 255u) == 0u) { if (xb_ld(&(bar)[XB_TMO])) break; if (_sp > XB_SPIN_CAP) { atomicAdd(&(bar)[XB_TMO], 1u); break; } } } } while (0)

struct XcdBarrier {
    unsigned* bar; unsigned x;
    volatile LAS unsigned* st;
};

__device__ __forceinline__ XcdBarrier xcd_barrier_post(unsigned* bar, volatile LAS unsigned* st) {
    XcdBarrier b; b.bar = bar; b.x = xb_xcc_id(); b.st = st;
    if (threadIdx.x == 0) (void)xb_add(&bar[XB_XCNT(b.x)], 1u);
    return b;
}
__device__ __forceinline__ void xcd_barrier_complete(unsigned* bar, unsigned x, unsigned& nloc, unsigned& nx) {
    const unsigned G = gridDim.x * gridDim.y * gridDim.z;
    unsigned sum, cnt, mine, sp = 0u;
    for (;;) {
        sum = 0u; cnt = 0u; mine = 0u;
#pragma unroll
        for (unsigned j = 0; j < 16; ++j) { const unsigned c = xb_ld(&bar[XB_XCNT(j)]); sum += c; cnt += (c > 0u) ? 1u : 0u; mine = (j == x) ? c : mine; }
        if (sum == G) break;
        __builtin_amdgcn_s_sleep(1);
        if ((++sp & 255u) == 0u) { if (xb_ld(&bar[XB_TMO])) break; if (sp > XB_SPIN_CAP) { atomicAdd(&bar[XB_TMO], 1u); break; } }
    }
    nloc = mine > 0u ? mine : 1u; nx = cnt > 0u ? cnt : 1u;
}

__device__ __forceinline__ void xcd_barrier(const XcdBarrier& b) {
    asm volatile("s_waitcnt vmcnt(0)" ::: "memory");
    __syncthreads();
    if (threadIdx.x == 0) {
        unsigned* bar = b.bar;
        __builtin_amdgcn_s_waitcnt(0);
        unsigned nloc = b.st[0], nx = b.st[1];
        if (nloc == 0u) { xcd_barrier_complete(bar, b.x, nloc, nx); b.st[0] = nloc; b.st[1] = nx; }
        const unsigned old = xb_add(&bar[XB_XSUB(b.x)], 1u);
        const unsigned gen = old / nloc;
        if (old + 1u == (gen + 1u) * nloc) {
            __builtin_amdgcn_fence(__ATOMIC_RELEASE, "agent");
            asm volatile("s_waitcnt vmcnt(0)" ::: "memory");
            const unsigned og = xb_add(&bar[XB_TOP], 1u);
            const unsigned tg = og / nx;
            if (og + 1u == (tg + 1u) * nx) xb_add(&bar[XB_TOPGEN], 1u);
            else XB_SPIN(xb_ld(&bar[XB_TOPGEN]) == tg, bar);
            __builtin_amdgcn_fence(__ATOMIC_ACQUIRE, "agent");
            xb_add(&bar[XB_XGEN(b.x)], 1u);
            asm volatile("s_waitcnt vmcnt(0)" ::: "memory");
        } else {
            XB_SPIN(xb_ld(&bar[XB_XGEN(b.x)]) == gen, bar);
            __builtin_amdgcn_fence(__ATOMIC_ACQUIRE, "agent");
            asm volatile("s_waitcnt vmcnt(0)" ::: "memory");
        }
    }
    __syncthreads();
}

constexpr int NWAVES = 8;
constexpr int MP = 32768, MS = 256, MT = MP + MS;
constexpr int DM = 1024, DIN = 4376, DINP = 4608, DFF = 2816, DCONV = 512, QW = 512;
constexpr int OFF_Q = 1024, OFF_KV = 1536, OFF_NG = 2304, OFF_MG = 2328;
constexpr int NSEQ = 36;
constexpr float EPS = 1e-6f;
constexpr size_t O_YP = 0, O_YS = 33554432, O_PCK = 33816576, O_PCV = O_PCK + 4194304, O_PSK = O_PCV + 4194304, O_PSV = O_PSK + 4194304,
                 O_PWK = O_PSV + 4194304, O_PWV = O_PWK + 262144, O_PCONV = O_PWV + 262144, O_SCK = O_PCONV + 61440, O_SCV = O_SCK + 32768,
                 O_SSK = O_SCV + 32768, O_SSV = O_SSK + 32768, O_SWK = O_SSV + 32768, O_SWV = O_SWK + 2097152, O_SCONV = O_SWV + 2097152, O_END = O_SCONV + 491520;
constexpr size_t MiB = 1u << 20;
constexpr size_t WS_CTL = 0, WS_MOD = 1 * MiB, ZERO_BYTES = 2 * MiB;
constexpr size_t WS_ROPE = 2 * MiB;
constexpr size_t WS_WIN = 5 * MiB, WS_WPW2 = 14 * MiB, WS_WNSA = 15 * MiB, WS_WOUT = 16 * MiB, WS_WGU = 18 * MiB, WS_WDOWN = 29 * MiB;
constexpr size_t WS_KC = 36 * MiB, WS_VC = 41 * MiB, WS_BG = 46 * MiB, WS_H = 50 * MiB, WS_U = 115 * MiB, WS_QP = 148 * MiB, WS_QR = 181 * MiB,
                 WS_CACT = 214 * MiB, WS_O = 247 * MiB, WS_GC = 280 * MiB, WS_GN = 345 * MiB, WS_T1 = 410 * MiB, WS_KWIN = 475 * MiB, WS_VWIN = 491 * MiB,
                 WS_ACT = 507 * MiB, WS_Z = 685 * MiB, WS_OC = WS_Z  , WS_Y1 = WS_GC  , WS_ZS = 760 * MiB  ,
                 WS_KSB = 1268 * MiB, WS_VST = 1276 * MiB, WS_KWB = 1284 * MiB, WS_VWT = 1292 * MiB, WS_KCB = 1300 * MiB, WS_VCT = 1301 * MiB, WS_END = 1302 * MiB;
constexpr float C2 = 0.125f * 1.4426950408889634f;
constexpr int ROPE_N = 8200;
constexpr int CW_BAR = 4096;
constexpr int RING_BYTES = 131072, LDS_BYTES = 163840, MISC_OFF = LDS_BYTES - 256;

typedef unsigned v2u __attribute__((ext_vector_type(2)));
typedef float f32x2 __attribute__((ext_vector_type(2)));
__device__ __forceinline__ float bf2f(unsigned short b) { return __uint_as_float(((unsigned)b) << 16); }
__device__ __forceinline__ float wave_sum(float v) {
#pragma unroll
    for (int o = 1; o < 64; o <<= 1) v += __shfl_xor(v, o);
    return v;
}
__device__ __forceinline__ float wave_max(float v) {
#pragma unroll
    for (int o = 1; o < 64; o <<= 1) v = fmaxf(v, __shfl_xor(v, o));
    return v;
}
__device__ __forceinline__ unsigned dpp_x1(unsigned v) { return (unsigned)__builtin_amdgcn_update_dpp(0, (int)v, 0xB1, 0xF, 0xF, false); }
__device__ __forceinline__ unsigned dpp_x2(unsigned v) { return (unsigned)__builtin_amdgcn_update_dpp(0, (int)v, 0x4E, 0xF, 0xF, false); }
__device__ __forceinline__ unsigned umax_x16(unsigned v) { auto r = __builtin_amdgcn_permlane16_swap(v, v, false, false); return r[0] > r[1] ? r[0] : r[1]; }
__device__ __forceinline__ unsigned umax_x32(unsigned v) { auto r = __builtin_amdgcn_permlane32_swap(v, v, false, false); return r[0] > r[1] ? r[0] : r[1]; }
__device__ __forceinline__ float fsum_x16(float v) { auto r = __builtin_amdgcn_permlane16_swap(__float_as_uint(v), __float_as_uint(v), false, false); return __uint_as_float(r[0]) + __uint_as_float(r[1]); }
__device__ __forceinline__ float fsum_x32(float v) { auto r = __builtin_amdgcn_permlane32_swap(__float_as_uint(v), __float_as_uint(v), false, false); return __uint_as_float(r[0]) + __uint_as_float(r[1]); }
__device__ __forceinline__ float fmax_x16(float v) { auto r = __builtin_amdgcn_permlane16_swap(__float_as_uint(v), __float_as_uint(v), false, false); return fmaxf(__uint_as_float(r[0]), __uint_as_float(r[1])); }
__device__ __forceinline__ float fmax_x32(float v) { auto r = __builtin_amdgcn_permlane32_swap(__float_as_uint(v), __float_as_uint(v), false, false); return fmaxf(__uint_as_float(r[0]), __uint_as_float(r[1])); }
__device__ __forceinline__ float dpp_x1f(float v) { return __uint_as_float(dpp_x1(__float_as_uint(v))); }
__device__ __forceinline__ float dpp_x2f(float v) { return __uint_as_float(dpp_x2(__float_as_uint(v))); }
__device__ __forceinline__ unsigned dpp_x4(unsigned v) { const int t = __builtin_amdgcn_update_dpp(0, (int)v, 0x141, 0xF, 0xF, false); return (unsigned)__builtin_amdgcn_update_dpp(0, t, 0x1B, 0xF, 0xF, false); }
__device__ __forceinline__ unsigned dpp_x8(unsigned v) { const int t = __builtin_amdgcn_update_dpp(0, (int)v, 0x140, 0xF, 0xF, false); return (unsigned)__builtin_amdgcn_update_dpp(0, t, 0x141, 0xF, 0xF, false); }
__device__ __forceinline__ float sigm(float x) { return 1.0f / (1.0f + __expf(-x)); }
__device__ __forceinline__ float wsum(float v) { v += dpp_x1f(v); v += dpp_x2f(v); v += __uint_as_float(dpp_x4(__float_as_uint(v))); v += __uint_as_float(dpp_x8(__float_as_uint(v))); v = fsum_x16(v); return fsum_x32(v); }
__device__ __forceinline__ float wmax(float v) { v = fmaxf(v, dpp_x1f(v)); v = fmaxf(v, dpp_x2f(v)); v = fmaxf(v, __uint_as_float(dpp_x4(__float_as_uint(v)))); v = fmaxf(v, __uint_as_float(dpp_x8(__float_as_uint(v)))); v = fmax_x16(v); return fmax_x32(v); }
__device__ __forceinline__ int mrow(int r) { return r < MP ? (r >> 13) : 4 + ((r - MP) >> 3); }
__device__ __forceinline__ int rope_idx(int r) { return r < MP ? (r & 8191) : 8192 + ((r - MP) & 7); }
__device__ __forceinline__ int perm64(int u) { return (u & 32) | (((u >> 2) & 3) << 3) | (((u >> 4) & 1) << 2) | (u & 3); }
__device__ __forceinline__ int perm128(int u) { return (u & ~31) | (((u >> 2) & 3) << 3) | (((u >> 4) & 1) << 2) | (u & 3); }
__device__ __forceinline__ size_t kc_off(int s) { return s < 4 ? (size_t)s * 128 * 128 : (size_t)4 * 128 * 128 + (size_t)(s - 4) * 257 * 128; }

struct Args { const float* in[33]; float* out; unsigned char* ws; int ph_lo, ph_hi; };

__device__ __forceinline__ int front_rowmap(int n) {
    if (n < 1024) { const int nn = n >= 512 ? 1 : 0, ch = n & 511; return 256 * (ch >> 7) + 128 * ((ch >> 6) & 1) + 32 * ((ch >> 4) & 3) + 8 * ((ch >> 2) & 3) + 4 * nn + (ch & 3); }
    if (n < OFF_KV) { const int hd = n - OFF_Q, h = hd >> 6, d = hd & 63; return 256 * (4 + (h >> 2)) + 128 * (d >> 5) + 32 * (h & 3) + (d & 31); }
    if (n < OFF_NG) { const int x = n - OFF_KV, j = x >> 7, kvh = (x >> 6) & 1, d = x & 63; return 256 * (6 + (j >> 1)) + 128 * (d >> 5) + 32 * ((j & 1) * 2 + kvh) + (d & 31); }
    if (n < OFF_MG) return 256 * 17 + (n - OFF_NG);
    return 256 * 9 + (n - OFF_MG);
}
__device__ __forceinline__ int gu_rowmap(int j) { const int rem = j & 127; return 256 * (j >> 7) + 128 * ((rem >> 2) & 1) + 32 * (rem >> 5) + 8 * ((rem >> 3) & 3) + (rem & 3); }
template <int MODE> __device__ __forceinline__ int rowmap(int n) { return MODE == 0 ? n : (MODE == 1 ? gu_rowmap(n) : (MODE == 2 ? gu_rowmap(n) + 4 : front_rowmap(n))); }
template <int MODE> __device__ __forceinline__ void transpose_item(const float* W, int K, int N, bf16* WT, LAS float* scr, int item, int lane) {
    const int nblk = (N + 31) / 32, kb = item / nblk, nb = item % nblk, k0 = 64 * kb, n0 = 32 * nb;
    const int nn = n0 + (lane & 31);
    float tv[32];
#pragma unroll
    for (int i = 0; i < 32; ++i) { const int kk = 2 * i + (lane >> 5); tv[i] = W[(size_t)(k0 + kk) * N + (nn < N ? nn : N - 1)]; }
#pragma unroll
    for (int i = 0; i < 32; ++i) { const int kk = 2 * i + (lane >> 5); scr[kk * 33 + (lane & 31)] = (nn < N) ? tv[i] : 0.f; }
    LDS_WAIT(); asm volatile("" ::: "memory");
    const int c = lane & 7;
#pragma unroll
    for (int j = 0; j < 4; ++j) { const int nl = (lane >> 3) + 8 * j, n = n0 + nl; const LAS float* s = scr + (8 * c) * 33 + nl;
        v4u o; o.x = pk2(s[0 * 33], s[1 * 33]); o.y = pk2(s[2 * 33], s[3 * 33]); o.z = pk2(s[4 * 33], s[5 * 33]); o.w = pk2(s[6 * 33], s[7 * 33]);
        if (n < N) *(v4u*)(WT + (size_t)rowmap<MODE>(n) * K + k0 + 8 * c) = o; }
    LDS_WAIT(); asm volatile("" ::: "memory");
}
__device__ __forceinline__ f32x2 compress_block(const float* rows, int nvalid, const float* pm, const float* w, float* outp, LAS float* scr, int lane) {
    const int c4 = 4 * (lane & 31), half = lane >> 5, d = c4 & 63, nh = nvalid >> 1;
    f32x4 acc = {0.f, 0.f, 0.f, 0.f};
    for (int i0 = 0; i0 < nh; i0 += 8) {
        f32x4 x[8], m[8];
#pragma unroll
        for (int q = 0; q < 8; ++q) { const bool ok = i0 + q < nh; const int j = 2 * (ok ? i0 + q : 0) + half;
            x[q] = *(const f32x4*)(rows + (size_t)j * 128 + c4); m[q] = *(const f32x4*)(pm + j * 64 + d); if (!ok) x[q] = (f32x4){0.f, 0.f, 0.f, 0.f}; }
#pragma unroll
        for (int q = 0; q < 8; ++q) acc += x[q] * (m[q] + 1.0f);
    }
#pragma unroll
    for (int i = 0; i < 4; ++i) acc[i] += __shfl_xor(acc[i], 32);
    if (lane < 32) *(LAS f32x4*)(scr + c4) = acc * (1.0f / 64.0f);
    LDS_WAIT(); asm volatile("" ::: "memory");
    const int kvh = lane >> 5, e = 2 * (lane & 31);
    f32x2 o = {0.f, 0.f};
#pragma unroll 8
    for (int dd = 0; dd < 64; ++dd) { const float sv = scr[kvh * 64 + dd]; const f32x2 ww = *(const f32x2*)(w + dd * 64 + e); o.x += sv * ww.x; o.y += sv * ww.y; }
    *(f32x2*)(outp + kvh * 64 + e) = o;
    LDS_WAIT(); asm volatile("" ::: "memory");
    return o;
}
__device__ __forceinline__ f32x2 summary_finish(f32x4 acc, const LAS float* wl, float* outp, LAS float* scr, int lane) {
    const int c4 = 4 * (lane & 31);
#pragma unroll
    for (int i = 0; i < 4; ++i) acc[i] = fsum_x32(acc[i]);
    if (lane < 32) *(LAS f32x4*)(scr + c4) = acc * (1.0f / 64.0f);
    LDS_WAIT(); asm volatile("" ::: "memory");
    const int kvh = lane >> 5, e = 2 * (lane & 31);
    f32x2 o = {0.f, 0.f};
#pragma unroll 16
    for (int dd = 0; dd < 64; ++dd) { const float sv = scr[kvh * 64 + dd]; const f32x2 ww = *(const LAS f32x2*)(wl + dd * 64 + e); o.x += sv * ww.x; o.y += sv * ww.y; }
    *(f32x2*)(outp + kvh * 64 + e) = o;
    LDS_WAIT(); asm volatile("" ::: "memory");
    return o;
}
template <int NV> __device__ __forceinline__ f32x2 compress_one(const float* rows, const LAS float* pml, const LAS float* wl, float* outp, LAS float* scr, int lane) {
    const int c4 = 4 * (lane & 31), half = lane >> 5, d = c4 & 63;
    const f32x4* s4 = (const f32x4*)(rows + (size_t)half * 128 + c4);
    f32x4 x[NV / 2];
#pragma unroll
    for (int q = 0; q < NV / 2; ++q) x[q] = s4[(size_t)q * 64];
    f32x4 acc = {0.f, 0.f, 0.f, 0.f};
#pragma unroll
    for (int q = 0; q < NV / 2; ++q) { const f32x4 m = *(const LAS f32x4*)(pml + (2 * q + half) * 64 + d); acc += x[q] * (m + 1.0f); }
    return summary_finish(acc, wl, outp, scr, lane);
}
__device__ __forceinline__ void compress_page(const float* src, const LAS float* pml, const LAS float* wl, float* dst, LAS float* scr, int lane) {
    const int c4 = 4 * (lane & 31), half = lane >> 5, d = c4 & 63;
    const f32x4* s4 = (const f32x4*)(src + (size_t)half * 128 + c4);
    f32x4 xb[3][8];
    auto request = [&](const int bt) __attribute__((always_inline)) {
#pragma unroll
        for (int q = 0; q < 8; ++q) xb[bt % 3][q] = s4[(size_t)(8 * bt + q) * 64]; };
    auto consume = [&](const int bt, f32x4 acc) __attribute__((always_inline)) {
#pragma unroll
        for (int q = 0; q < 8; ++q) { const int j = 2 * (8 * (bt & 3) + q) + half; const f32x4 m = *(const LAS f32x4*)(pml + j * 64 + d); acc += xb[bt % 3][q] * (m + 1.0f); }
        return acc; };
    request(0); request(1); request(2);
    f32x4 acc = {0.f, 0.f, 0.f, 0.f};
#pragma unroll
    for (int bt = 0; bt < 8; ++bt) {
        asm volatile("" ::: "memory");
        acc = consume(bt, acc);
        asm volatile("" ::: "memory");
        if (bt + 3 < 8) request(bt + 3);
        if ((bt & 3) == 3) { (void)summary_finish(acc, wl, dst + (bt >> 2) * 128, scr, lane); acc = (f32x4){0.f, 0.f, 0.f, 0.f}; }
    }
}
__device__ __forceinline__ void phase0(const Args& a, LAS unsigned char* lds, int gw, int NGW, int wave, int lane_) {
    int lane = lane_;
    unsigned char* ws = a.ws;
    LAS float* scr = (LAS float*)(lds + wave * 10240);
    constexpr int I_IN = 16 * 137, I_PW2 = 8 * 32, I_NSA = 8 * 32, I_OUT = 16 * 32, I_G = 16 * 88, I_U = 16 * 88, I_D = 44 * 32;
    constexpr int N_TR = I_IN + I_PW2 + I_NSA + I_OUT + I_G + I_U + I_D;
    constexpr int N_MOD = 96 * 16;
    constexpr int N_LIGHT = N_TR + N_MOD;
#pragma nounroll
    for (int it = gw; it < N_LIGHT; it += NGW) {
        int r = it; asm volatile("" : "+v"(lane));
        if (r < N_TR) {
            if (r < I_IN) { transpose_item<3>(a.in[15], 1024, DIN, (bf16*)(ws + WS_WIN), scr, r, lane); continue; } r -= I_IN;
            if (r < I_PW2) { transpose_item<0>(a.in[22], 512, 1024, (bf16*)(ws + WS_WPW2), scr, r, lane); continue; } r -= I_PW2;
            if (r < I_NSA) { transpose_item<0>(a.in[27], 512, 1024, (bf16*)(ws + WS_WNSA), scr, r, lane); continue; } r -= I_NSA;
            if (r < I_OUT) { transpose_item<0>(a.in[28], 1024, 1024, (bf16*)(ws + WS_WOUT), scr, r, lane); continue; } r -= I_OUT;
            if (r < I_G) { transpose_item<1>(a.in[30], 1024, DFF, (bf16*)(ws + WS_WGU), scr, r, lane); continue; } r -= I_G;
            if (r < I_U) { transpose_item<2>(a.in[31], 1024, DFF, (bf16*)(ws + WS_WGU), scr, r, lane); continue; } r -= I_U;
            transpose_item<0>(a.in[32], DFF, 1024, (bf16*)(ws + WS_WDOWN), scr, r, lane); continue;
        }
        r -= N_TR;
        if (r < N_MOD) {
            const int cb = r % 96, kb = r / 96, j = cb * 64 + lane, k0 = kb * 64;
            for (int mb = 0; mb < NSEQ; ++mb) { const float* cp = mb < 4 ? a.in[10] + mb * 1024 : a.in[11] + (mb - 4) * 1024; const float cv = cp[k0 + lane]; scr[mb * 64 + lane] = cv * sigm(cv); }
            LDS_WAIT(); asm volatile("" ::: "memory");
            float acc[NSEQ];
#pragma unroll
            for (int mb = 0; mb < NSEQ; ++mb) acc[mb] = 0.f;
            const float* wp = a.in[12] + (size_t)k0 * 6144 + j;
#pragma unroll 4
            for (int k4 = 0; k4 < 16; ++k4) {
                const float w0 = wp[(size_t)(4 * k4 + 0) * 6144], w1 = wp[(size_t)(4 * k4 + 1) * 6144], w2 = wp[(size_t)(4 * k4 + 2) * 6144], w3 = wp[(size_t)(4 * k4 + 3) * 6144];
#pragma unroll
                for (int mb = 0; mb < NSEQ; ++mb) { const f32x4 q = *(const LAS f32x4*)(scr + mb * 64 + 4 * k4); acc[mb] += q.x * w0 + q.y * w1 + q.z * w2 + q.w * w3; }
            }
            float* modp = (float*)(ws + WS_MOD);
            const float bias = (kb == 0) ? a.in[13][j] : 0.f;
#pragma unroll
            for (int mb = 0; mb < NSEQ; ++mb) atomicAdd(modp + mb * 6144 + j, acc[mb] + bias);
            LDS_WAIT(); asm volatile("" ::: "memory");
            continue;
        }
    }
    const int gt = gw * 64 + lane, NT = NGW * 64;
    { v4u* p = (v4u*)((bf16*)(ws + WS_WIN) + (size_t)DIN * 1024); const int n16 = (DINP - DIN) * 1024 * 2 / 16; const v4u z = {0u, 0u, 0u, 0u}; for (int i = gt; i < n16; i += NT) p[i] = z; }
    { float* rc = (float*)(ws + WS_ROPE); float* rs = rc + ROPE_N * 32;
#pragma nounroll
      for (int i = gt; i < ROPE_N * 32; i += NT) {
          const int j = i & 31, p = i >> 5; const int pos = p < 8192 ? p : 16384 + (p - 8192);
          double inv = 1.0;
#pragma nounroll
          for (int q = 0; q < j; ++q) inv *= 0.7498942093324558;
          const double ang = (double)pos * inv;
          const double kq = __builtin_rint(ang * 0.6366197723675814);
          double rr = __builtin_fma(-kq, 1.5707963267948966, ang); rr = __builtin_fma(-kq, 6.123233995736766e-17, rr);
          const double r2 = rr * rr;
          const double sn = rr * (1.0 + r2 * (-1.0 / 6 + r2 * (1.0 / 120 + r2 * (-1.0 / 5040 + r2 * (1.0 / 362880 + r2 * (-1.0 / 39916800 + r2 * (1.0 / 6227020800.0)))))));
          const double cs = 1.0 + r2 * (-0.5 + r2 * (1.0 / 24 + r2 * (-1.0 / 720 + r2 * (1.0 / 40320 + r2 * (-1.0 / 3628800 + r2 * (1.0 / 479001600.0))))));
          const int qd = ((int)(long long)kq) & 3;
          const double c = (qd == 0) ? cs : (qd == 1) ? -sn : (qd == 2) ? -cs : sn;
          const double s = (qd == 0) ? sn : (qd == 1) ? cs : (qd == 2) ? -sn : -cs;
          rc[i] = (float)c; rs[i] = (float)s; } }
    { const int per = 504 * 128 / 4, n4 = 32 * per;
      for (int i = gt; i < 2 * n4; i += NT) { const int kv = i >= n4, ii = kv ? i - n4 : i, sb = ii / per, o = ii % per;
          const f32x4 v = ((const f32x4*)((kv ? a.in[7] : a.in[6]) + (size_t)sb * 512 * 128 + 8 * 128))[o];
          ((f32x4*)(a.out + (kv ? O_SWV : O_SWK) + (size_t)sb * 512 * 128))[o] = v; } }
    { const int per = 22 * 512 / 4, n4 = 32 * per;
      for (int i = gt; i < n4; i += NT) { const int sb = i / per, o = i % per;
          ((f32x4*)(a.out + O_SCONV + (size_t)sb * 30 * 512))[o] = ((const f32x4*)(a.in[8] + (size_t)sb * 30 * 512 + 8 * 512))[o]; } }
}

__device__ __forceinline__ void norm_rows(const float* xp, const float* xs, const float* g, const float* modp, int sh_off, int sc_off, bf16* H, int gw, int NGW, int lane_) {
    int lane = lane_; asm volatile("" : "+v"(lane));
#pragma nounroll
    for (int rb = gw; rb < MT; rb += 4 * NGW) {
        f32x4 v[4][4];
#pragma unroll
        for (int q = 0; q < 4; ++q) { const int r = rb + q * NGW < MT ? rb + q * NGW : rb;
            const f32x4* xr = (const f32x4*)(r < MP ? xp + (size_t)r * 1024 : xs + (size_t)(r - MP) * 1024) + lane;
#pragma unroll
            for (int j = 0; j < 4; ++j) v[q][j] = xr[64 * j]; }
#pragma unroll
        for (int q = 0; q < 4; ++q) { const int r = rb + q * NGW; if (r < MT) {
            const float* mp = modp + (size_t)mrow(r) * 6144; float ss = 0.f;
#pragma unroll
            for (int j = 0; j < 4; ++j) ss += (v[q][j].x * v[q][j].x + v[q][j].y * v[q][j].y) + (v[q][j].z * v[q][j].z + v[q][j].w * v[q][j].w);
            const float rstd = 1.0f / sqrtf(wsum(ss) * (1.0f / 1024.0f) + EPS);
            v2u* o8 = (v2u*)(H + (size_t)r * 1024) + lane;
#pragma unroll
            for (int j = 0; j < 4; ++j) { const int c = 4 * (lane + 64 * j);
                const f32x4 gg = *(const f32x4*)(g + c), sc = *(const f32x4*)(mp + sc_off + c), sh = *(const f32x4*)(mp + sh_off + c);
                const f32x4 h = (v[q][j] * rstd * gg) * (1.0f + sc) + sh;
                v2u w; w.x = pk2(h.x, h.y); w.y = pk2(h.z, h.w); o8[64 * j] = w; } } }
    }
}
__device__ __forceinline__ void norm_rows_bf16(const bf16* X, const float* g, const float* modp, int sh_off, int sc_off, bf16* H, int gw, int NGW, int lane_) {
    int lane = lane_; asm volatile("" : "+v"(lane));
#pragma nounroll
    for (int rb = gw; rb < MT; rb += 4 * NGW) {
        v2u t[4][4];
#pragma unroll
        for (int q = 0; q < 4; ++q) { const int r = rb + q * NGW < MT ? rb + q * NGW : rb; const v2u* xr = (const v2u*)(X + (size_t)r * 1024) + lane;
#pragma unroll
            for (int j = 0; j < 4; ++j) t[q][j] = xr[64 * j]; }
#pragma unroll
        for (int q = 0; q < 4; ++q) { const int r = rb + q * NGW; if (r < MT) {
            const float* mp = modp + (size_t)mrow(r) * 6144; f32x4 v[4]; float ss = 0.f;
#pragma unroll
            for (int j = 0; j < 4; ++j) { v[j] = (f32x4){pg8::bf_lo(t[q][j].x), pg8::bf_hi(t[q][j].x), pg8::bf_lo(t[q][j].y), pg8::bf_hi(t[q][j].y)}; ss += (v[j].x * v[j].x + v[j].y * v[j].y) + (v[j].z * v[j].z + v[j].w * v[j].w); }
            const float rstd = 1.0f / sqrtf(wsum(ss) * (1.0f / 1024.0f) + EPS);
            v2u* o8 = (v2u*)(H + (size_t)r * 1024) + lane;
#pragma unroll
            for (int j = 0; j < 4; ++j) { const int c = 4 * (lane + 64 * j);
                const f32x4 gg = *(const f32x4*)(g + c), sc = *(const f32x4*)(mp + sc_off + c), sh = *(const f32x4*)(mp + sh_off + c);
                const f32x4 h = (v[j] * rstd * gg) * (1.0f + sc) + sh;
                v2u w; w.x = pk2(h.x, h.y); w.y = pk2(h.z, h.w); o8[64 * j] = w; } } }
    }
}

__device__ __forceinline__ void phase_pages(const Args& a, LAS unsigned char* lds, int gw, int NGW, int wave, int lane_, int tid_) {
    unsigned char* ws = a.ws; int lane = lane_, tid = tid_; asm volatile("" : "+v"(lane)); asm volatile("" : "+v"(tid));
    LAS float* scr = (LAS float*)(lds + wave * 1024);
    LAS float* tabs = (LAS float*)(lds + 8192);
    __syncthreads();
    { const f32x4* g0 = (const f32x4*)a.in[23]; const f32x4* g1 = (const f32x4*)a.in[25]; const f32x4* g2 = (const f32x4*)a.in[24]; const f32x4* g3 = (const f32x4*)a.in[26];
#pragma nounroll
      for (int i = tid; i < 1024; i += NWAVES * 64) { ((LAS f32x4*)tabs)[i] = g0[i]; ((LAS f32x4*)tabs)[1024 + i] = g1[i]; ((LAS f32x4*)tabs)[2048 + i] = g2[i]; ((LAS f32x4*)tabs)[3072 + i] = g3[i]; } }
    LDS_WAIT(); __syncthreads();
#pragma nounroll
    for (int r = gw; r < 32 * 128 * 2; r += NGW) { const int kv = r & 1, pg = (r >> 1) & 127, sb = r >> 8;
        const int page = __builtin_amdgcn_readfirstlane(((const int*)a.in[9])[sb * 128 + pg]);
        const float* src = (kv ? a.in[3] : a.in[2]) + (size_t)page * (128 * 128);
        float* dst = (float*)(ws + (kv ? WS_VC : WS_KC)) + kc_off(4 + sb) + (size_t)(2 * pg) * 128;
        compress_page(src, tabs + (kv ? 4096 : 0), tabs + (kv ? 12288 : 8192), dst, scr, lane); }
    __syncthreads();
}

__device__ __forceinline__ void sample_post(const Args& a, int gw, int NGW, int lane_) {
    int lane = lane_; asm volatile("" : "+v"(lane));
    unsigned char* ws = a.ws; float* out = a.out;
    const float* Z = (const float*)(ws + WS_ZS);
    const float* rc = (const float*)(ws + WS_ROPE); const float* rs = rc + ROPE_N * 32;
    bf16* U = (bf16*)(ws + WS_U); bf16* QP = (bf16*)(ws + WS_QP); bf16* QR = (bf16*)(ws + WS_QR); bf16* GC = (bf16*)(ws + WS_GC); bf16* GN = (bf16*)(ws + WS_GN);
    float* BG = (float*)(ws + WS_BG);
    const float qg = a.in[16][lane]; const float kg0 = a.in[17][lane], kg1 = a.in[17][64 + lane], kg2 = a.in[17][128 + lane];
    for (int r = MP + gw; r < MT; r += NGW) {
        const float* z = Z + (size_t)(r - MP) * DINP;
        float zg[16], zq[8], zk[12], zn;
#pragma unroll
        for (int i = 0; i < 8; ++i) { zg[i] = z[front_rowmap(lane + 64 * i)]; zg[8 + i] = z[front_rowmap(512 + lane + 64 * i)]; zq[i] = z[front_rowmap(OFF_Q + 64 * i + lane)]; }
#pragma unroll
        for (int i = 0; i < 12; ++i) zk[i] = z[front_rowmap(OFF_KV + 64 * i + lane)];
        zn = z[front_rowmap(OFF_NG + (lane < 24 ? lane : 0))];
        constexpr bool smp = true; const int rs_ = r - MP, sb = rs_ >> 3, si = rs_ & 7, b = 0, t = 0;
        const int ri = rope_idx(r); const float cv = rc[ri * 32 + (lane & 31)], sv = rs[ri * 32 + (lane & 31)];
#pragma unroll
        for (int i = 0; i < 8; ++i) { const int c = lane + 64 * i; const float u = zg[i] * sigm(zg[8 + i]);
            U[(size_t)r * 512 + c] = (bf16)f2bf(u);
            if (smp) out[O_SCONV + (size_t)(sb * 30 + 22 + si) * 512 + c] = u;
            else if (t >= 8162) out[O_PCONV + (size_t)(b * 30 + t - 8162) * 512 + c] = u; }
#pragma unroll
        for (int h = 0; h < 8; ++h) { const float x = zq[h]; const float ms = wave_sum(x * x) * (1.0f / 64.0f);
            const float y = x * (1.0f / sqrtf(ms + EPS)) * qg; const float oth = __shfl_xor(y, 32);
            const float yr = lane < 32 ? y * cv - oth * sv : y * cv + oth * sv;
            QP[(size_t)r * 512 + 64 * h + lane] = (bf16)f2bf(y * C2); QR[(size_t)r * 512 + 64 * h + lane] = (bf16)f2bf(yr * C2); }
#pragma unroll
        for (int j = 0; j < 6; ++j)
#pragma unroll
            for (int kvh = 0; kvh < 2; ++kvh) {
                float x = zk[2 * j + kvh];
                if ((j & 1) == 0) { const float ms = wave_sum(x * x) * (1.0f / 64.0f); x = x * (1.0f / sqrtf(ms + EPS)) * (j == 0 ? kg0 : (j == 2 ? kg1 : kg2));
                    if (j >= 2) { const float oth = __shfl_xor(x, 32); x = lane < 32 ? x * cv - oth * sv : x * cv + oth * sv; } }
                const int cc = kvh * 64 + lane;
                if (j < 4) { const size_t po = (j == 0 ? O_PCK : j == 1 ? O_PCV : j == 2 ? O_PSK : O_PSV), so = (j == 0 ? O_SCK : j == 1 ? O_SCV : j == 2 ? O_SSK : O_SSV);
                    if (smp) out[so + (size_t)rs_ * 128 + cc] = x; else out[po + (size_t)r * 128 + cc] = x; }
                if (!smp && j >= 2) { const size_t blk = ((size_t)(b * 128 + (t >> 6)) * 2 + kvh) * 4096; const int key = t & 63;
                    if (j == 2) ((bf16*)(ws + WS_KSB))[blk + key * 64 + lane] = (bf16)f2bf(x); else if (j == 3) ((bf16*)(ws + WS_VST))[blk + lane * 64 + perm64(key)] = (bf16)f2bf(x);
                    else if (j == 4) ((bf16*)(ws + WS_KWB))[blk + key * 64 + lane] = (bf16)f2bf(x); else ((bf16*)(ws + WS_VWT))[blk + lane * 64 + perm64(key)] = (bf16)f2bf(x); }
                if (j >= 4) { if (smp) out[(j == 4 ? O_SWK : O_SWV) + (size_t)(sb * 512 + 504 + si) * 128 + cc] = x;
                        }
            }
        if (lane < 24) BG[(size_t)r * 24 + lane] = sigm(zn);
        asm volatile("" ::: "memory");
        float zm[32];
#pragma unroll
        for (int i = 0; i < 32; ++i) zm[i] = z[front_rowmap(OFF_MG + lane + 64 * i)];
#pragma unroll
        for (int i = 0; i < 32; ++i) { const int c = lane + 64 * i; const float v = sigm(zm[i]);
            if (i < 16) GC[(size_t)r * 1024 + c] = (bf16)f2bf(v); else GN[(size_t)r * 1024 + c - 1024] = (bf16)f2bf(v); }
    }
}


__device__ __forceinline__ void unpack8(const v4u p, float (&x)[8]) { x[0] = pg8::bf_lo(p.x); x[1] = pg8::bf_hi(p.x); x[2] = pg8::bf_lo(p.y); x[3] = pg8::bf_hi(p.y); x[4] = pg8::bf_lo(p.z); x[5] = pg8::bf_hi(p.z); x[6] = pg8::bf_lo(p.w); x[7] = pg8::bf_hi(p.w); }
__device__ __forceinline__ void phase_conv(const Args& a, LAS unsigned char* lds, int vcu, int G, int gw, int NGW, int wave, int lane, int tid_) {
    unsigned char* ws = a.ws; const int tid = tid_;
    sample_post(a, gw, NGW, lane);
    VM_WAIT(); __syncthreads();
    constexpr int TAPB = 31 * 512 * 4;
    { LAS f32x4* wl4 = (LAS f32x4*)lds; const f32x4* wg4 = (const f32x4*)a.in[18]; for (int i = tid; i < 31 * 512 / 4; i += NWAVES * 64) wl4[i] = wg4[i]; }
    const LAS float* wl = (const LAS float*)lds; LAS unsigned char* rl = lds + TAPB;
    const bf16* U = (const bf16*)(ws + WS_U); bf16* CACT = (bf16*)(ws + WS_CACT);
    const int c0_ = lane * 8;
    auto do_tile = [&](const bool smp, const int idx) __attribute__((always_inline)) {
        int tid = tid_, c0 = c0_; asm volatile("" : "+v"(tid)); asm volatile("" : "+v"(c0));
        const int sb = idx, r0 = smp ? MP + 8 * sb : 64 * idx, t0 = r0 & 8191, ntok = smp ? 8 : 64, nrows = ntok + 30;
        __syncthreads();
        if (smp) {
            for (int q = tid; q < nrows * 64; q += NWAVES * 64) { const int k = q >> 6, cc = (q & 63) * 8; v4u v = {0u, 0u, 0u, 0u};
                if (k < 30) { const float* sp = a.in[8] + (size_t)(sb * 30 + k) * 512 + cc; const f32x4 p0 = *(const f32x4*)sp, p1 = *(const f32x4*)(sp + 4);
                    v.x = pk2(p0.x, p0.y); v.y = pk2(p0.z, p0.w); v.z = pk2(p1.x, p1.y); v.w = pk2(p1.z, p1.w); }
                else v = *(const v4u*)(U + (size_t)(r0 + k - 30) * 512 + cc);
                *(LAS v4u*)(rl + k * 1024 + (q & 63) * 16) = v; }
        } else {
            v4u st[12];
#pragma unroll
            for (int i = 0; i < 12; ++i) { const int q = tid + i * (NWAVES * 64), k = q >> 6, cc = (q & 63) * 8; st[i] = (v4u){0u, 0u, 0u, 0u};
                if (q < 94 * 64 && t0 - 30 + k >= 0) st[i] = *(const v4u*)(U + (size_t)(r0 - 30 + k) * 512 + cc); }
#pragma unroll
            for (int i = 0; i < 12; ++i) { const int q = tid + i * (NWAVES * 64), k = q >> 6; if (q < 94 * 64) *(LAS v4u*)(rl + k * 1024 + (q & 63) * 16) = st[i]; }
        }
        __syncthreads();
        if (8 * wave < ntok) {
            float acc[8][8];
            { const f32x4 b0 = *(const f32x4*)(a.in[19] + c0), b1 = *(const f32x4*)(a.in[19] + c0 + 4);
#pragma unroll
              for (int tt = 0; tt < 8; ++tt) { acc[tt][0] = b0.x; acc[tt][1] = b0.y; acc[tt][2] = b0.z; acc[tt][3] = b0.w; acc[tt][4] = b1.x; acc[tt][5] = b1.y; acc[tt][6] = b1.z; acc[tt][7] = b1.w; } }
            const LAS unsigned char* rw = rl + (8 * wave) * 1024 + lane * 16;
            f32x4 w0[8], w1[8];
#pragma unroll
            for (int i = 0; i < 8; ++i) { w0[i] = (f32x4){0.f, 0.f, 0.f, 0.f}; w1[i] = (f32x4){0.f, 0.f, 0.f, 0.f}; }
#pragma nounroll
            for (int rb = 0; rb < 40; rb += 8) {
#pragma unroll
                for (int i = 0; i < 8; ++i) { const int rr = rb + i;
                    if (rr < 38) {
                        f32x4 a0 = {0.f, 0.f, 0.f, 0.f}, a1 = {0.f, 0.f, 0.f, 0.f};
                        if (rr < 31) { a0 = *(const LAS f32x4*)(wl + rr * 512 + c0); a1 = *(const LAS f32x4*)(wl + rr * 512 + c0 + 4); }
                        w0[i] = a0; w1[i] = a1;
                        float x[8]; unpack8(*(const LAS v4u*)(rw + rr * 1024), x);
#pragma unroll
                        for (int tt = 0; tt < 8; ++tt) { const f32x4 u0 = w0[(i - tt) & 7], u1 = w1[(i - tt) & 7];
                            acc[tt][0] += x[0] * u0.x; acc[tt][1] += x[1] * u0.y; acc[tt][2] += x[2] * u0.z; acc[tt][3] += x[3] * u0.w;
                            acc[tt][4] += x[4] * u1.x; acc[tt][5] += x[5] * u1.y; acc[tt][6] += x[6] * u1.z; acc[tt][7] += x[7] * u1.w; } } }
            }
            const f32x4 g0 = *(const f32x4*)(a.in[20] + c0), g1 = *(const f32x4*)(a.in[20] + c0 + 4), e0 = *(const f32x4*)(a.in[21] + c0), e1 = *(const f32x4*)(a.in[21] + c0 + 4);
            const float lg[8] = {g0.x, g0.y, g0.z, g0.w, g1.x, g1.y, g1.z, g1.w}, lb[8] = {e0.x, e0.y, e0.z, e0.w, e1.x, e1.y, e1.z, e1.w};
#pragma unroll
            for (int tt = 0; tt < 8; ++tt) {
                float sm = 0.f;
#pragma unroll
                for (int i = 0; i < 8; ++i) sm += acc[tt][i];
                const float mean = wsum(sm) * (1.0f / 512.0f); float q = 0.f;
#pragma unroll
                for (int i = 0; i < 8; ++i) { acc[tt][i] -= mean; q += acc[tt][i] * acc[tt][i]; }
                const float rstd = 1.0f / sqrtf(wsum(q) * (1.0f / 512.0f) + EPS);
                float y[8];
#pragma unroll
                for (int i = 0; i < 8; ++i) { const float v = acc[tt][i] * rstd * lg[i] + lb[i]; y[i] = v * sigm(v); }
                v4u o; o.x = pk2(y[0], y[1]); o.y = pk2(y[2], y[3]); o.z = pk2(y[4], y[5]); o.w = pk2(y[6], y[7]);
                *(v4u*)(CACT + (size_t)(r0 + 8 * wave + tt) * 512 + c0) = o;
            }
        }
    };
    { int u = vcu; bool smpu = false;
#pragma nounroll
      for (;;) {
          if (!smpu && u >= 512) { smpu = true; u = vcu; }
          if (smpu && u >= 32) break;
          do_tile(smpu, u);
          u += G; } }
    __syncthreads();
    LAS float* scr = (LAS float*)(lds + wave * 1024);
    LAS float* tabs = (LAS float*)(lds + 8192);
    if (gw - wave < 1024 || vcu < 32) {
        const f32x4* g0 = (const f32x4*)a.in[23]; const f32x4* g1 = (const f32x4*)a.in[25]; const f32x4* g2 = (const f32x4*)a.in[24]; const f32x4* g3 = (const f32x4*)a.in[26];
        for (int i = lane; i < 1024; i += 64) { ((LAS f32x4*)tabs)[i] = g0[i]; ((LAS f32x4*)tabs)[1024 + i] = g1[i]; ((LAS f32x4*)tabs)[2048 + i] = g2[i]; ((LAS f32x4*)tabs)[3072 + i] = g3[i]; }
    }
    LDS_WAIT(); __syncthreads();
    for (int sb = vcu; sb < 32; sb += G) if (wave < 2) { const int kv = wave;
        const float* rows = a.out + (kv ? O_SCV : O_SCK) + (size_t)(sb * 8) * 128;
        float* dst = (float*)(ws + (kv ? WS_VC : WS_KC)) + kc_off(4 + sb) + (size_t)256 * 128;
        (void)compress_one<8>(rows, tabs + (kv ? 4096 : 0), tabs + (kv ? 12288 : 8192), dst, scr, lane); }
    for (int it = gw; it < 1024; it += NGW) {
        { const int kv = it & 1, n = (it >> 1) & 127, b = it >> 8;
            const float* rows = a.out + (kv ? O_PCV : O_PCK) + (size_t)(b * 8192 + 64 * n) * 128;
            float* dst = (float*)(ws + (kv ? WS_VC : WS_KC)) + kc_off(b) + (size_t)n * 128;
            const f32x2 o = compress_one<64>(rows, tabs + (kv ? 4096 : 0), tabs + (kv ? 12288 : 8192), dst, scr, lane);
            const int kvh = lane >> 5, e = 2 * (lane & 31);
            if (!kv) { *(unsigned*)((bf16*)(ws + WS_KCB) + ((size_t)(b * 2 + kvh) * 128 + n) * 64 + e) = pk2(o.x, o.y); }
            else { bf16* vt = (bf16*)(ws + WS_VCT) + (size_t)(b * 2 + kvh) * 64 * 128 + perm128(n); vt[(size_t)e * 128] = (bf16)f2bf(o.x); vt[(size_t)(e + 1) * 128] = (bf16)f2bf(o.y); } }
    }
}

template <int MODE> __device__ __forceinline__ void attn_item(const Args& a, int r, int kvh, LAS unsigned char* ldsb, int wave, int lane) {
    unsigned char* ws = a.ws; float* out = a.out;
    LAS float* scr = (LAS float*)(ldsb + wave * 16384);
    const bool smp = r >= MP; const int rs_ = r - MP, sb = rs_ >> 3, si = rs_ & 7, b = r >> 13;
    const int seq = smp ? 4 + sb : b, qpos = smp ? 16384 + si : (r & 8191), cur = qpos >> 6, NB = smp ? 257 : 128;
    LAS float* s_qp = scr;
    LAS float* s_qr = scr + 256;
    LAS float* s_p = scr + 512;
    const bf16* QP = (const bf16*)(ws + WS_QP) + (size_t)r * 512 + kvh * 256; const bf16* QR = (const bf16*)(ws + WS_QR) + (size_t)r * 512 + kvh * 256;
    float qn2[4];
#pragma unroll
    for (int g = 0; g < 4; ++g) { const float x = bf2f(QP[g * 64 + lane]), y = bf2f(QR[g * 64 + lane]); s_qp[lane * 4 + g] = x; s_qr[lane * 4 + g] = y; qn2[g] = wave_sum(y * y); }
    const float gks = wave_max(fabsf(a.in[17][64 + lane])), gkw = wave_max(fabsf(a.in[17][128 + lane]));
    float mref_s[4], mref_w[4];
#pragma unroll
    for (int g = 0; g < 4; ++g) { const float qn = sqrtf(qn2[g]) * 8.0f; mref_s[g] = qn * gks; mref_w[g] = qn * gkw; }
    LDS_WAIT(); asm volatile("" ::: "memory");
    const float* KC = (const float*)(ws + WS_KC) + kc_off(seq) + kvh * 64; const float* VC = (const float*)(ws + WS_VC) + kc_off(seq) + kvh * 64;
    const int n_ok = (qpos + 1) >> 6;
    float sc[5][4];
#pragma unroll
    for (int c = 0; c < 5; ++c) { const int n = lane + 64 * c;
#pragma unroll
        for (int g = 0; g < 4; ++g) sc[c][g] = 0.f;
        if (n < n_ok && n < NB) { const f32x4* kr = (const f32x4*)(KC + (size_t)n * 128);
#pragma unroll 4
            for (int d4 = 0; d4 < 16; ++d4) { const f32x4 k = kr[d4];
                const f32x4 q0 = *(const LAS f32x4*)(s_qp + (4 * d4 + 0) * 4), q1 = *(const LAS f32x4*)(s_qp + (4 * d4 + 1) * 4), q2 = *(const LAS f32x4*)(s_qp + (4 * d4 + 2) * 4), q3 = *(const LAS f32x4*)(s_qp + (4 * d4 + 3) * 4);
#pragma unroll
                for (int g = 0; g < 4; ++g) sc[c][g] += k.x * q0[g] + k.y * q1[g] + k.z * q2[g] + k.w * q3[g]; } } }
    float imp[5];
#pragma unroll
    for (int c = 0; c < 5; ++c) imp[c] = 0.f;
#pragma unroll
    for (int g = 0; g < 4; ++g) {
        float m = -INFINITY;
#pragma unroll
        for (int c = 0; c < 5; ++c) { const int n = lane + 64 * c; if (n < n_ok && n < NB) m = fmaxf(m, sc[c][g]); }
        m = wave_max(m); if (!(m > -INFINITY)) m = 0.f;
        float e[5], zs = 0.f;
#pragma unroll
        for (int c = 0; c < 5; ++c) { const int n = lane + 64 * c; e[c] = (n < n_ok && n < NB) ? __builtin_amdgcn_exp2f(sc[c][g] - m) : 0.f; zs += e[c]; }
        zs = wave_sum(zs); const float iz = 1.0f / fmaxf(zs, 1e-30f);
#pragma unroll
        for (int c = 0; c < 5; ++c) { const int n = lane + 64 * c; const float p = e[c] * iz; imp[c] += p; if (n < NB) s_p[n * 4 + g] = p; }
    }
    LDS_WAIT(); asm volatile("" ::: "memory");
    float o_cmp[4] = {0.f, 0.f, 0.f, 0.f};
    { const int nn = n_ok < NB ? n_ok : NB; const int nstart = MODE == 1 ? wave : 0, nstep = MODE == 1 ? NWAVES : 1;
      for (int n0 = nstart; n0 < nn; n0 += 8 * nstep) { float v[8];
#pragma unroll
          for (int q = 0; q < 8; ++q) { const int n = n0 + q * nstep; v[q] = VC[(size_t)(n < nn ? n : nstart) * 128 + lane]; }
#pragma unroll
          for (int q = 0; q < 8; ++q) { const int n = n0 + q * nstep; if (n < nn) { const f32x4 p = *(const LAS f32x4*)(s_p + n * 4);
#pragma unroll
              for (int g = 0; g < 4; ++g) o_cmp[g] += p[g] * v[q]; } } } }
    LDS_WAIT(); asm volatile("" ::: "memory");
    float score[5];
#pragma unroll
    for (int c = 0; c < 5; ++c) { const int n = lane + 64 * c;
        const bool forced = (n == 0) || (n == cur) || (n == cur - 1);
        score[c] = (n >= NB) ? -4.0f : (n <= cur ? imp[c] + (forced ? 8.0f : 0.f) : -1.0f); }
    const int* ptab = (const int*)a.in[9] + sb * 128;
    float l_sel[4] = {0.f, 0.f, 0.f, 0.f}, o_sel[4] = {0.f, 0.f, 0.f, 0.f};
    float last_bv = 0.f; bool ambiguous = false;
    unsigned skey[5];
#pragma unroll
    for (int c = 0; c < 5; ++c) { const int n = lane + 64 * c; skey[c] = (MODE == 1 && n < NB) ? ((__float_as_uint(score[c]) & ~511u) | (unsigned)(511 - n)) : 0u; }
    for (int round = 0; round < (MODE == 2 ? 17 : 16); ++round) {
        float bv = score[0]; int bi = lane;
        if (MODE == 1) { unsigned w = skey[0];
#pragma unroll
            for (int c = 1; c < 5; ++c) w = skey[c] > w ? skey[c] : w;
            { unsigned o; o = dpp_x1(w); w = o > w ? o : w; o = dpp_x2(w); w = o > w ? o : w; o = dpp_x4(w); w = o > w ? o : w; o = dpp_x8(w); w = o > w ? o : w; w = umax_x16(w); w = umax_x32(w); }
            bi = 511 - (int)(w & 511u);
#pragma unroll
            for (int c = 0; c < 5; ++c) if (skey[c] == w) skey[c] = 0u;
        } else {
#pragma unroll
        for (int c = 1; c < 5; ++c) if (score[c] > bv) { bv = score[c]; bi = lane + 64 * c; }
#pragma unroll
        for (int o = 1; o < 64; o <<= 1) { const float ov = __shfl_xor(bv, o); const int oi = __shfl_xor(bi, o); if (ov > bv || (ov == bv && oi < bi)) { bv = ov; bi = oi; } }
        }
        const int n = __builtin_amdgcn_readfirstlane(bi);
        if (MODE == 2) { if (round == 16) { ambiguous = (bv >= 0.f) && (last_bv - bv < 4e-4f); break; } last_bv = bv; }
#pragma unroll
        for (int c = 0; c < 5; ++c) if (n == lane + 64 * c) score[c] = -3.0f;
        if (n > cur) continue;
        if (MODE == 1 && (round >> 1) != wave) continue;
        const float* kb; const float* vb; int nvalid;
        if (!smp) { kb = out + O_PSK + (size_t)(b * 8192 + 64 * n) * 128; vb = out + O_PSV + (size_t)(b * 8192 + 64 * n) * 128; }
        else if (n < 256) { const int page = ptab[n >> 1]; const size_t ro = ((size_t)page * 128 + (n & 1) * 64) * 128; kb = a.in[4] + ro; vb = a.in[5] + ro; }
        else { kb = out + O_SSK + (size_t)(sb * 8) * 128; vb = out + O_SSV + (size_t)(sb * 8) * 128; }
        nvalid = qpos - 64 * n + 1; if (nvalid > 64) nvalid = 64;
        const bool valid = lane < nvalid;
        float s4[4] = {0.f, 0.f, 0.f, 0.f};
        { const f32x4* kr = (const f32x4*)(kb + (size_t)(valid ? lane : 0) * 128 + kvh * 64);
#pragma unroll 4
          for (int d4 = 0; d4 < 16; ++d4) { const f32x4 k = kr[d4];
              const f32x4 q0 = *(const LAS f32x4*)(s_qr + (4 * d4 + 0) * 4), q1 = *(const LAS f32x4*)(s_qr + (4 * d4 + 1) * 4), q2 = *(const LAS f32x4*)(s_qr + (4 * d4 + 2) * 4), q3 = *(const LAS f32x4*)(s_qr + (4 * d4 + 3) * 4);
#pragma unroll
              for (int g = 0; g < 4; ++g) s4[g] += k.x * q0[g] + k.y * q1[g] + k.z * q2[g] + k.w * q3[g]; } }
        f32x4 pv4;
#pragma unroll
        for (int g = 0; g < 4; ++g) { const float p = valid ? __builtin_amdgcn_exp2f(s4[g] - mref_s[g]) : 0.f; l_sel[g] += p; pv4[g] = p; }
        *(LAS f32x4*)(s_p + lane * 4) = pv4;
        LDS_WAIT(); asm volatile("" ::: "memory");
        for (int j0 = 0; j0 < nvalid; j0 += 8) { float v[8];
#pragma unroll
            for (int q = 0; q < 8; ++q) { const int j = j0 + q < nvalid ? j0 + q : 0; v[q] = vb[(size_t)j * 128 + kvh * 64 + lane]; }
#pragma unroll
            for (int q = 0; q < 8; ++q) if (j0 + q < nvalid) { const f32x4 p = *(const LAS f32x4*)(s_p + (j0 + q) * 4);
#pragma unroll
                for (int g = 0; g < 4; ++g) o_sel[g] += p[g] * v[q]; } }
        LDS_WAIT(); asm volatile("" ::: "memory");
    }
    float l_win[4] = {0.f, 0.f, 0.f, 0.f}, o_win[4] = {0.f, 0.f, 0.f, 0.f};
    { const int lo = qpos - 511 > 0 ? qpos - 511 : 0; const int cnt = qpos - lo + 1;
      for (int c0 = 0; c0 < cnt; c0 += 64) {
          if (MODE == 1 && (c0 >> 6) != wave) continue;
          const int nvalid = cnt - c0 < 64 ? cnt - c0 : 64; const bool valid = lane < nvalid; const int kpos = lo + c0 + (valid ? lane : 0);
          const float* kr_;
          if (!smp) kr_ = (const float*)(ws + WS_KWIN) + (size_t)(b * 8192 + kpos) * 128;
          else if (kpos >= 16384) kr_ = out + O_SWK + (size_t)(sb * 512 + 504 + kpos - 16384) * 128;
          else kr_ = a.in[6] + (size_t)(sb * 512 + kpos - 15872) * 128;
          float s4[4] = {0.f, 0.f, 0.f, 0.f};
          { const f32x4* kr = (const f32x4*)(kr_ + kvh * 64);
#pragma unroll 4
            for (int d4 = 0; d4 < 16; ++d4) { const f32x4 k = kr[d4];
                const f32x4 q0 = *(const LAS f32x4*)(s_qr + (4 * d4 + 0) * 4), q1 = *(const LAS f32x4*)(s_qr + (4 * d4 + 1) * 4), q2 = *(const LAS f32x4*)(s_qr + (4 * d4 + 2) * 4), q3 = *(const LAS f32x4*)(s_qr + (4 * d4 + 3) * 4);
#pragma unroll
                for (int g = 0; g < 4; ++g) s4[g] += k.x * q0[g] + k.y * q1[g] + k.z * q2[g] + k.w * q3[g]; } }
          f32x4 pv4;
#pragma unroll
          for (int g = 0; g < 4; ++g) { const float p = valid ? __builtin_amdgcn_exp2f(s4[g] - mref_w[g]) : 0.f; l_win[g] += p; pv4[g] = p; }
          *(LAS f32x4*)(s_p + lane * 4) = pv4;
          LDS_WAIT(); asm volatile("" ::: "memory");
          for (int j0 = 0; j0 < nvalid; j0 += 8) { float v[8];
#pragma unroll
              for (int q = 0; q < 8; ++q) { const int kp = lo + c0 + (j0 + q < nvalid ? j0 + q : 0); const float* vr;
                  if (!smp) vr = (const float*)(ws + WS_VWIN) + (size_t)(b * 8192 + kp) * 128;
                  else if (kp >= 16384) vr = out + O_SWV + (size_t)(sb * 512 + 504 + kp - 16384) * 128;
                  else vr = a.in[7] + (size_t)(sb * 512 + kp - 15872) * 128;
                  v[q] = vr[kvh * 64 + lane]; }
#pragma unroll
              for (int q = 0; q < 8; ++q) if (j0 + q < nvalid) { const f32x4 p = *(const LAS f32x4*)(s_p + (j0 + q) * 4);
#pragma unroll
                  for (int g = 0; g < 4; ++g) o_win[g] += p[g] * v[q]; } }
          LDS_WAIT(); asm volatile("" ::: "memory");
      } }
    float ls[4], lw[4];
#pragma unroll
    for (int g = 0; g < 4; ++g) { ls[g] = wave_sum(l_sel[g]); lw[g] = wave_sum(l_win[g]); }
    if (MODE == 1) {
        LAS float* part = scr + 2048;
#pragma unroll
        for (int g = 0; g < 4; ++g) { part[g * 64 + lane] = o_cmp[g]; part[(4 + g) * 64 + lane] = o_sel[g]; part[(8 + g) * 64 + lane] = o_win[g]; }
        if (lane < 4) { part[768 + lane] = ls[lane & 3]; part[772 + lane] = lw[lane & 3]; }
        __syncthreads();
        if (wave == 0) {
#pragma unroll
            for (int g = 0; g < 4; ++g) { o_cmp[g] = 0.f; o_sel[g] = 0.f; o_win[g] = 0.f; ls[g] = 0.f; lw[g] = 0.f; }
            for (int w = 0; w < NWAVES; ++w) { const LAS float* pw = (const LAS float*)(ldsb + w * 16384) + 2048;
#pragma unroll
                for (int g = 0; g < 4; ++g) { o_cmp[g] += pw[g * 64 + lane]; o_sel[g] += pw[(4 + g) * 64 + lane]; o_win[g] += pw[(8 + g) * 64 + lane]; ls[g] += pw[768 + g]; lw[g] += pw[772 + g]; } }
        }
    }
    if (MODE != 1 || wave == 0) {
        const float* BG = (const float*)(ws + WS_BG) + (size_t)r * 24 + kvh * 12;
        bf16* O = (bf16*)(ws + WS_O) + (size_t)r * 512 + kvh * 256;
#pragma unroll
        for (int g = 0; g < 4; ++g) {
            const float o = BG[g * 3 + 0] * o_cmp[g] + BG[g * 3 + 1] * (o_sel[g] / fmaxf(ls[g], 1e-30f)) + BG[g * 3 + 2] * (o_win[g] / fmaxf(lw[g], 1e-30f));
            if (MODE == 2) { const float have = bf2f(O[g * 64 + lane]); if (!ambiguous && !(fabsf(have - o) <= 0.004f + 0.02f * fabsf(o))) atomicAdd((unsigned*)(ws + WS_CTL) + 8, 1u); }
            else O[g * 64 + lane] = (bf16)f2bf(o); }
    }
    LDS_WAIT(); asm volatile("" ::: "memory");
    if (MODE == 1) __syncthreads();
}

__device__ __forceinline__ void attn_sample(const Args& a, int r, int kvh, LAS unsigned char* ldsb, int wave, int lane) {
    unsigned char* ws = a.ws; float* out = a.out;
    LAS float* scr = (LAS float*)(ldsb + wave * 16384);
    LAS float* sh_sc = (LAS float*)(ldsb + RING_BYTES);
    const int rs_ = r - MP, sb = rs_ >> 3, si = rs_ & 7;
    const int seq = 4 + sb, qpos = 16384 + si, cur = qpos >> 6; constexpr int NB = 257;
    LAS float* s_qp = scr;
    LAS float* s_qr = scr + 256;
    LAS float* s_p = scr + 512;
    const bf16* QP = (const bf16*)(ws + WS_QP) + (size_t)r * 512 + kvh * 256; const bf16* QR = (const bf16*)(ws + WS_QR) + (size_t)r * 512 + kvh * 256;
    f32x4 ck[16]; float cv[64];
    auto chunk_load = [&](const float* krow, auto vrow, const int nvalid) __attribute__((always_inline)) {
        const f32x4* kr = (const f32x4*)(krow + kvh * 64);
#pragma unroll
        for (int d4 = 0; d4 < 16; ++d4) ck[d4] = kr[d4];
#pragma unroll
        for (int j = 0; j < 64; ++j) cv[j] = vrow(j < nvalid ? j : 0)[kvh * 64 + lane];
    };
    auto chunk_compute = [&](const int nvalid, const float (&mref)[4], float (&l)[4], float (&o)[4]) __attribute__((always_inline)) {
        const bool valid = lane < nvalid;
        f32x4 s4 = {0.f, 0.f, 0.f, 0.f};
#pragma unroll
        for (int d4 = 0; d4 < 16; ++d4) {
            const f32x4 q0 = *(const LAS f32x4*)(s_qr + (4 * d4 + 0) * 4), q1 = *(const LAS f32x4*)(s_qr + (4 * d4 + 1) * 4), q2 = *(const LAS f32x4*)(s_qr + (4 * d4 + 2) * 4), q3 = *(const LAS f32x4*)(s_qr + (4 * d4 + 3) * 4);
            s4 += q0 * ck[d4].x + q1 * ck[d4].y + q2 * ck[d4].z + q3 * ck[d4].w; }
        f32x4 pv4;
#pragma unroll
        for (int g = 0; g < 4; ++g) { const float p = valid ? __builtin_amdgcn_exp2f(s4[g] - mref[g]) : 0.f; l[g] += p; pv4[g] = p; }
        *(LAS f32x4*)(s_p + lane * 4) = pv4;
        LDS_WAIT(); asm volatile("" ::: "memory");
#pragma unroll
        for (int j = 0; j < 64; ++j) { const f32x4 p = *(const LAS f32x4*)(s_p + j * 4);
#pragma unroll
            for (int g = 0; g < 4; ++g) o[g] += p[g] * cv[j]; }
        LDS_WAIT(); asm volatile("" ::: "memory");
    };
    float l_sel[4] = {0.f, 0.f, 0.f, 0.f}, o_sel[4] = {0.f, 0.f, 0.f, 0.f}, l_win[4] = {0.f, 0.f, 0.f, 0.f}, o_win[4] = {0.f, 0.f, 0.f, 0.f};
    float qx[4], qy[4];
#pragma unroll
    for (int g = 0; g < 4; ++g) { qx[g] = bf2f(QP[g * 64 + lane]); qy[g] = bf2f(QR[g * 64 + lane]); }
    const float gk1 = fabsf(a.in[17][64 + lane]), gk2 = fabsf(a.in[17][128 + lane]);
    const int wlo = qpos - 511 > 0 ? qpos - 511 : 0, wcnt = qpos - wlo + 1, wc0 = 64 * wave;
    const int wnv = wc0 < wcnt ? (wcnt - wc0 < 64 ? wcnt - wc0 : 64) : 0;
    auto rowp = [&](const float* cache, size_t onew, int kp) { return kp >= 16384 ? out + onew + (size_t)(sb * 512 + 504 + kp - 16384) * 128 : cache + (size_t)(sb * 512 + kp - 15872) * 128; };
    if (wnv > 0) chunk_load(rowp(a.in[6], O_SWK, wlo + wc0 + (lane < wnv ? lane : 0)), [&](int j) { return rowp(a.in[7], O_SWV, wlo + wc0 + j); }, wnv);
    float mref_s[4], mref_w[4];
    { const float gks = wmax(gk1), gkw = wmax(gk2);
#pragma unroll
      for (int g = 0; g < 4; ++g) { s_qp[lane * 4 + g] = qx[g]; s_qr[lane * 4 + g] = qy[g]; const float qn = sqrtf(wsum(qy[g] * qy[g])) * 8.0f; mref_s[g] = qn * gks; mref_w[g] = qn * gkw; } }
    LDS_WAIT(); asm volatile("" ::: "memory");
    if (wnv > 0) chunk_compute(wnv, mref_w, l_win, o_win);
    const float* KC = (const float*)(ws + WS_KC) + kc_off(seq) + kvh * 64; const float* VC = (const float*)(ws + WS_VC) + kc_off(seq) + kvh * 64;
    const int n_ok = (qpos + 1) >> 6;
    const int nn = n_ok < NB ? n_ok : NB;
    float vc[33];
    { const int n = 33 * wave + lane; const bool mine = lane < 33 && n < n_ok;
      const f32x4* kr = (const f32x4*)(KC + (size_t)(mine ? n : 0) * 128);
      f32x4 k[16];
#pragma unroll
      for (int d4 = 0; d4 < 16; ++d4) k[d4] = kr[d4];
#pragma unroll
      for (int q = 0; q < 33; ++q) { const int nq = wave + 8 * q; vc[q] = VC[(size_t)(nq < nn ? nq : wave) * 128 + lane]; }
      f32x4 s4 = {0.f, 0.f, 0.f, 0.f};
#pragma unroll
      for (int d4 = 0; d4 < 16; ++d4) {
          const f32x4 q0 = *(const LAS f32x4*)(s_qp + (4 * d4 + 0) * 4), q1 = *(const LAS f32x4*)(s_qp + (4 * d4 + 1) * 4), q2 = *(const LAS f32x4*)(s_qp + (4 * d4 + 2) * 4), q3 = *(const LAS f32x4*)(s_qp + (4 * d4 + 3) * 4);
          s4 += q0 * k[d4].x + q1 * k[d4].y + q2 * k[d4].z + q3 * k[d4].w; }
      if (mine) *(LAS f32x4*)(sh_sc + n * 4) = s4; }
    LDS_WAIT(); __syncthreads();
    float sc[5][4];
#pragma unroll
    for (int c = 0; c < 5; ++c) { const int n = lane + 64 * c; f32x4 v = {0.f, 0.f, 0.f, 0.f}; if (n < n_ok && n < NB) v = *(const LAS f32x4*)(sh_sc + n * 4);
#pragma unroll
        for (int g = 0; g < 4; ++g) sc[c][g] = v[g]; }
    float imp[5];
#pragma unroll
    for (int c = 0; c < 5; ++c) imp[c] = 0.f;
#pragma unroll
    for (int g = 0; g < 4; ++g) {
        float m = -INFINITY;
#pragma unroll
        for (int c = 0; c < 5; ++c) { const int n = lane + 64 * c; if (n < n_ok && n < NB) m = fmaxf(m, sc[c][g]); }
        m = wmax(m); if (!(m > -INFINITY)) m = 0.f;
        float e[5], zs = 0.f;
#pragma unroll
        for (int c = 0; c < 5; ++c) { const int n = lane + 64 * c; e[c] = (n < n_ok && n < NB) ? __builtin_amdgcn_exp2f(sc[c][g] - m) : 0.f; zs += e[c]; }
        zs = wsum(zs); const float iz = 1.0f / fmaxf(zs, 1e-30f);
#pragma unroll
        for (int c = 0; c < 5; ++c) { const int n = lane + 64 * c; const float p = e[c] * iz; imp[c] += p; if (n < NB) s_p[n * 4 + g] = p; }
    }
    LDS_WAIT(); asm volatile("" ::: "memory");
    float o_cmp[4] = {0.f, 0.f, 0.f, 0.f};
#pragma unroll
    for (int q = 0; q < 33; ++q) { const int n = wave + 8 * q; if (n < nn) { const f32x4 p = *(const LAS f32x4*)(s_p + n * 4);
#pragma unroll
        for (int g = 0; g < 4; ++g) o_cmp[g] += p[g] * vc[q]; } }
    LDS_WAIT(); asm volatile("" ::: "memory");
    unsigned skey[5];
#pragma unroll
    for (int c = 0; c < 5; ++c) { const int n = lane + 64 * c; const bool forced = (n == 0) || (n == cur) || (n == cur - 1);
        const float score = imp[c] + (forced ? 8.0f : 0.f);
        skey[c] = (n < NB && n <= cur) ? ((__float_as_uint(score) & ~511u) | (unsigned)(511 - n)) : 0u; }
    int nsel[2] = {-1, -1};
#pragma nounroll
    for (int round = 0; round < 16; ++round) {
        unsigned w = skey[0];
#pragma unroll
        for (int c = 1; c < 5; ++c) w = skey[c] > w ? skey[c] : w;
        { unsigned o; o = dpp_x1(w); w = o > w ? o : w; o = dpp_x2(w); w = o > w ? o : w; o = dpp_x4(w); w = o > w ? o : w; o = dpp_x8(w); w = o > w ? o : w; w = umax_x16(w); w = umax_x32(w); }
        const unsigned wu = (unsigned)__builtin_amdgcn_readfirstlane((int)w);
#pragma unroll
        for (int c = 0; c < 5; ++c) if (skey[c] == wu) skey[c] = 0u;
        const int n = wu != 0u ? 511 - (int)(wu & 511u) : -1;
        if (round == 2 * wave) nsel[0] = n; if (round == 2 * wave + 1) nsel[1] = n;
    }
    const int* ptab = (const int*)a.in[9] + sb * 128;
#pragma nounroll
    for (int h = 0; h < 2; ++h) { const int n = nsel[h];
        if (n < 0 || n > cur) continue;
        const float* kb; const float* vb;
        if (n < 256) { const int page = ptab[n >> 1]; const size_t ro = ((size_t)page * 128 + (n & 1) * 64) * 128; kb = a.in[4] + ro; vb = a.in[5] + ro; }
        else { kb = out + O_SSK + (size_t)(sb * 8) * 128; vb = out + O_SSV + (size_t)(sb * 8) * 128; }
        int nvalid = qpos - 64 * n + 1; if (nvalid > 64) nvalid = 64;
        chunk_load(kb + (size_t)(lane < nvalid ? lane : 0) * 128, [&](int j) { return vb + (size_t)j * 128; }, nvalid);
        chunk_compute(nvalid, mref_s, l_sel, o_sel);
    }
    float ls[4], lw[4];
#pragma unroll
    for (int g = 0; g < 4; ++g) { ls[g] = wsum(l_sel[g]); lw[g] = wsum(l_win[g]); }
    LAS float* part = scr + 2048;
#pragma unroll
    for (int g = 0; g < 4; ++g) { part[g * 64 + lane] = o_cmp[g]; part[(4 + g) * 64 + lane] = o_sel[g]; part[(8 + g) * 64 + lane] = o_win[g]; }
    if (lane < 4) { part[768 + lane] = ls[lane & 3]; part[772 + lane] = lw[lane & 3]; }
    const float* BG = (const float*)(ws + WS_BG) + (size_t)r * 24 + kvh * 12;
    float bgv[12];
#pragma unroll
    for (int i = 0; i < 12; ++i) bgv[i] = BG[i];
    __syncthreads();
    if (wave == 0) {
#pragma unroll
        for (int g = 0; g < 4; ++g) { o_cmp[g] = 0.f; o_sel[g] = 0.f; o_win[g] = 0.f; ls[g] = 0.f; lw[g] = 0.f; }
#pragma unroll
        for (int w = 0; w < NWAVES; ++w) { const LAS float* pw = (const LAS float*)(ldsb + w * 16384) + 2048;
#pragma unroll
            for (int g = 0; g < 4; ++g) { o_cmp[g] += pw[g * 64 + lane]; o_sel[g] += pw[(4 + g) * 64 + lane]; o_win[g] += pw[(8 + g) * 64 + lane]; ls[g] += pw[768 + g]; lw[g] += pw[772 + g]; } }
        bf16* O = (bf16*)(ws + WS_O) + (size_t)r * 512 + kvh * 256;
#pragma unroll
        for (int g = 0; g < 4; ++g) {
            const float o = bgv[g * 3 + 0] * o_cmp[g] + bgv[g * 3 + 1] * (o_sel[g] / fmaxf(ls[g], 1e-30f)) + bgv[g * 3 + 2] * (o_win[g] / fmaxf(lw[g], 1e-30f));
            O[g * 64 + lane] = (bf16)f2bf(o); }
    }
    LDS_WAIT(); asm volatile("" ::: "memory");
    __syncthreads();
}

typedef short s16x8 __attribute__((ext_vector_type(8)));
template <bool B> struct BoolC { static constexpr bool v = B; };
__device__ __forceinline__ f32x4 mfma16(s16x8 a_, s16x8 b_, f32x4 c_) { return __builtin_amdgcn_mfma_f32_16x16x32_bf16(a_, b_, c_, 0, 0, 0); }
__device__ __forceinline__ unsigned cvtpk(float lo, float hi) { return pg8::cvt_pk_bf16(lo, hi); }
constexpr int AT_SLOT = 16384, AT_VOFF = 8192, AT_CMPV = 18432, AT_MASK = 4 * AT_SLOT, AT_QF = AT_MASK + 12288;
template <int PASS> __device__ __forceinline__ void attn_pass(const Args& a, LAS unsigned char* lds, int b, int kvh, int tb, int wave, int lane, int tid) {
    unsigned char* ws = a.ws; asm volatile("" : "+s"(ws)); asm volatile("" : "+v"(lane)); asm volatile("" : "+v"(tid));
    const int fr = lane & 15, fq = lane >> 4, tok_i = fr >> 2, g = fr & 3;
    const int r0 = b * 8192 + 128 * tb;
    const bf16* QR = (const bf16*)(ws + WS_QR);
    const float* BG = (const float*)(ws + WS_BG); float* OC = (float*)(ws + WS_OC);
    LAS unsigned* wmask = (LAS unsigned*)(lds + AT_MASK + wave * 1536);
    const int hq = kvh * 4 + g;
    f32x4 O[4][4], L[4];
    const s16x8 ones = {0x3F80, 0x3F80, 0x3F80, 0x3F80, 0x3F80, 0x3F80, 0x3F80, 0x3F80};
    LAS unsigned char* qlds = lds + AT_QF + wave * 8192;
    {
        const char* kimg = (const char*)((const bf16*)(ws + (PASS == 0 ? WS_KSB : WS_KWB)) + (size_t)((b * 128) * 2 + kvh) * 4096);
        const char* vimg = (const char*)((const bf16*)(ws + (PASS == 0 ? WS_VST : WS_VWT)) + (size_t)((b * 128) * 2 + kvh) * 4096);
        const float gk = wave_max(fabsf(a.in[17][(PASS == 0 ? 64 : 128) + lane]));
        if (PASS == 0) {
#pragma unroll
            for (int gi = 0; gi < 4; ++gi) { const int row = r0 + 16 * wave + 4 * gi + tok_i; const bf16* qp = QR + (size_t)row * 512 + hq * 64 + fq * 8;
                const s16x8 qa = *(const s16x8*)qp, qb = *(const s16x8*)(qp + 32); float ss = 0.f;
#pragma unroll
                for (int e = 0; e < 8; ++e) { const float x = bf2f((unsigned short)qa[e]), y = bf2f((unsigned short)qb[e]); ss += x * x + y * y; }
                ss += __shfl_xor(ss, 16); ss += __shfl_xor(ss, 32); ((LAS float*)wmask)[96 + gi * 64 + lane] = sqrtf(ss) * 8.0f;
                *(LAS s16x8*)(qlds + ((gi * 2 + 0) * 64 + lane) * 16) = qa; *(LAS s16x8*)(qlds + ((gi * 2 + 1) * 64 + lane) * 16) = qb; }
            LDS_WAIT();
        }
#pragma unroll
        for (int gi = 0; gi < 4; ++gi) { L[gi] = (f32x4){0.f, 0.f, 0.f, 0.f};
#pragma unroll
            for (int dg = 0; dg < 4; ++dg) O[gi][dg] = (f32x4){0.f, 0.f, 0.f, 0.f}; }
        s16x8 Qf[4][2];
#pragma unroll
        for (int gi = 0; gi < 4; ++gi) { Qf[gi][0] = *(const LAS s16x8*)(qlds + ((gi * 2 + 0) * 64 + lane) * 16); Qf[gi][1] = *(const LAS s16x8*)(qlds + ((gi * 2 + 1) * 64 + lane) * 16); }
        const LAS float* mrefl = (const LAS float*)wmask + 96 + lane;
        bool bigref; { float mx = 0.f;
#pragma unroll
            for (int gi = 0; gi < 4; ++gi) mx = fmaxf(mx, mrefl[64 * gi] * gk);
            bigref = __builtin_amdgcn_readfirstlane(__float_as_int(wave_max(mx))) > __float_as_int(64.0f); }
        const int nlast = 2 * tb + 1, nfirst = PASS == 0 ? 0 : (2 * tb - 8 > 0 ? 2 * tb - 8 : 0);
        const int drow = 8 * wave + (lane >> 3); const unsigned dsrc = (unsigned)(drow * 128 + (((lane & 7) ^ ((drow >> 1) & 7)) * 16));
        const unsigned fsw0 = (unsigned)((((0 + fq) ^ ((fr >> 1) & 7)) * 16)), fsw1 = (unsigned)((((4 + fq) ^ ((fr >> 1) & 7)) * 16));
#define AT_DMA_BLOCK(nn, sl) do { const size_t bo_ = (size_t)(nn) * 2 * 4096 * 2 + dsrc; \
            __builtin_amdgcn_global_load_lds((const unsigned*)(kimg + bo_), (LAS unsigned*)(lds + (sl) * AT_SLOT + wave * 1024), 16, 0, 0); \
            __builtin_amdgcn_global_load_lds((const unsigned*)(vimg + bo_), (LAS unsigned*)(lds + (sl) * AT_SLOT + AT_VOFF + wave * 1024), 16, 0, 0); } while (0)
        const int nblk = nlast - nfirst + 1, nint = (nblk + 1) >> 1;
        AT_DMA_BLOCK(nfirst, 0); if (nblk > 1) AT_DMA_BLOCK(nfirst + 1, 1);
        asm volatile("s_waitcnt vmcnt(0) lgkmcnt(0)\n\ts_barrier" ::: "memory");
        unsigned gwc[4] = {0u, 0u, 0u, 0u}, twc[4] = {0u, 0u, 0u, 0u}; int wcur = -1;
        auto do_block = [&](const int n, const LAS unsigned char* kb, auto bigc) __attribute__((always_inline)) {
            constexpr bool BIG = decltype(bigc)::v;
            const LAS unsigned char* vb = kb + AT_VOFF;
            if (PASS == 0 && (n >> 5) != wcur) { wcur = n >> 5;
#pragma unroll
                for (int gi = 0; gi < 4; ++gi) { gwc[gi] = (unsigned)__builtin_amdgcn_readfirstlane((int)wmask[64 + gi * 4 + wcur]); twc[gi] = wmask[(4 * gi + tok_i) * 4 + wcur]; } }
            int actm = 0;
#pragma unroll
            for (int gi = 0; gi < 4; ++gi) { int av;
                if (PASS == 0) { av = (int)((gwc[gi] >> (n & 31)) & 1u); }
                else { const int tlo = 128 * tb + 16 * wave + 4 * gi; const int b_lo = tlo - 511 > 0 ? (tlo - 511) >> 6 : 0, b_hi = (tlo + 3) >> 6; av = (n >= b_lo && n <= b_hi) ? 1 : 0; }
                actm |= av << gi; }
            actm = __builtin_amdgcn_readfirstlane(actm);
            if (actm != 0) {
#pragma unroll
                for (int kc = 0; kc < 2; ++kc) {
                    s16x8 Kf[2][2], Vf[4];
#pragma unroll
                    for (int x = 0; x < 2; ++x)
#pragma unroll
                        for (int k = 0; k < 2; ++k) Kf[x][k] = *(const LAS s16x8*)(kb + (16 * (2 * kc + x) + fr) * 128 + (k ? fsw1 : fsw0));
#pragma unroll
                    for (int dg = 0; dg < 4; ++dg) Vf[dg] = *(const LAS s16x8*)(vb + (16 * dg + fr) * 128 + (kc ? fsw1 : fsw0));
#pragma unroll
                    for (int gi = 0; gi < 4; ++gi) if ((actm >> gi) & 1) {
                        const int tl = 16 * wave + 4 * gi + tok_i, t = 128 * tb + tl, rel = t - 64 * n;
                        const int tlo = 128 * tb + 16 * wave + 4 * gi;
                        const bool edge = (64 * n + 63 > tlo) || (PASS == 1 && 64 * n < tlo + 3 - 511);
                        const s16x8 qf0 = Qf[gi][0], qf1 = Qf[gi][1];
                        f32x4 S[2];
                        if (PASS == 0 || BIG) {
                            const bool tsel = PASS == 0 ? ((twc[gi] >> (n & 31)) & 1u) != 0u : true;
                            float nm = 0.f; if (BIG) nm = -mrefl[64 * gi] * gk;
                            nm = tsel ? nm : -1e30f;
                            const f32x4 c0 = {nm, nm, nm, nm};
#pragma unroll
                            for (int x = 0; x < 2; ++x) S[x] = mfma16(Kf[x][0], qf0, c0);
                        } else {
#pragma unroll
                            for (int x = 0; x < 2; ++x) S[x] = mfma16(Kf[x][0], qf0, (f32x4){0.f, 0.f, 0.f, 0.f});
                        }
#pragma unroll
                        for (int x = 0; x < 2; ++x) S[x] = mfma16(Kf[x][1], qf1, S[x]);
                        if (edge) {
#pragma unroll
                            for (int x = 0; x < 2; ++x)
#pragma unroll
                                for (int i = 0; i < 4; ++i) { const int j = 16 * (2 * kc + x) + 4 * fq + i; const bool ok = j <= rel && (PASS == 0 || j > rel - 512);
                                    S[x][i] = ok ? __builtin_amdgcn_exp2f(S[x][i]) : 0.f; }
                        } else {
#pragma unroll
                            for (int x = 0; x < 2; ++x)
#pragma unroll
                                for (int i = 0; i < 4; ++i) S[x][i] = __builtin_amdgcn_exp2f(S[x][i]);
                        }
                        v4u pk; pk.x = cvtpk(S[0][0], S[0][1]); pk.y = cvtpk(S[0][2], S[0][3]); pk.z = cvtpk(S[1][0], S[1][1]); pk.w = cvtpk(S[1][2], S[1][3]);
                        const s16x8 pb = __builtin_bit_cast(s16x8, pk);
#pragma unroll
                        for (int dg = 0; dg < 4; ++dg) O[gi][dg] = mfma16(Vf[dg], pb, O[gi][dg]);
                        L[gi] = mfma16(ones, pb, L[gi]);
                    }
                }
            }
        };
        auto run = [&](auto bigc) __attribute__((always_inline)) {
#pragma nounroll
            for (int iv = 0; iv < nint; ++iv) {
                const int n0 = nfirst + 2 * iv, sp = (iv & 1) * 2;
                if (n0 + 2 <= nlast) AT_DMA_BLOCK(n0 + 2, 2 - sp);
                if (n0 + 3 <= nlast) AT_DMA_BLOCK(n0 + 3, 3 - sp);
                do_block(n0, lds + sp * AT_SLOT, bigc);
                if (n0 + 1 <= nlast) do_block(n0 + 1, lds + (sp + 1) * AT_SLOT, bigc);
                asm volatile("s_waitcnt vmcnt(0) lgkmcnt(0)\n\ts_barrier" ::: "memory");
            } };
        if (bigref) run(BoolC<true>{}); else run(BoolC<false>{});
#pragma unroll
        for (int gi = 0; gi < 4; ++gi) { const int row = r0 + 16 * wave + 4 * gi + tok_i;
            const float l = L[gi][0];
            const float sc = BG[(size_t)row * 24 + hq * 3 + 1 + PASS] / fmaxf(l, 1e-30f);
            float* oc = OC + (size_t)row * 512 + hq * 64 + 4 * fq;
#pragma unroll
            for (int dg = 0; dg < 4; ++dg) { const f32x4 v = *(const f32x4*)(oc + 16 * dg) + O[gi][dg] * sc;
                if (PASS == 0) *(f32x4*)(oc + 16 * dg) = v;
                else { v2u w; w.x = cvtpk(v[0], v[1]); w.y = cvtpk(v[2], v[3]); *(v2u*)((bf16*)(ws + WS_O) + (size_t)row * 512 + hq * 64 + 16 * dg + 4 * fq) = w; } } }
        }
}
__device__ __forceinline__ void attn_unit(const Args& a, LAS unsigned char* lds, int b, int kvh, int tb, int wave, int lane, int tid) {
    unsigned char* ws = a.ws; asm volatile("" : "+s"(ws)); asm volatile("" : "+v"(lane)); asm volatile("" : "+v"(tid));
    const int fr = lane & 15, fq = lane >> 4, tok_i = fr >> 2, g = fr & 3;
    const int r0 = b * 8192 + 128 * tb;
    const bf16* QP = (const bf16*)(ws + WS_QP); const bf16* QR = (const bf16*)(ws + WS_QR);
    const float* BG = (const float*)(ws + WS_BG); float* OC = (float*)(ws + WS_OC);
    LAS unsigned* wmask = (LAS unsigned*)(lds + AT_MASK + wave * 1536);
    const int hq = kvh * 4 + g;
    { const char* kcb = (const char*)((const bf16*)(ws + WS_KCB) + (size_t)(b * 2 + kvh) * 128 * 64); const char* vct = (const char*)((const bf16*)(ws + WS_VCT) + (size_t)(b * 2 + kvh) * 64 * 128);
      for (int c = tid; c < 1024; c += 512) { const v4u v = *(const v4u*)(kcb + c * 16); *(LAS v4u*)(lds + (c >> 3) * 144 + (c & 7) * 16) = v; }
      for (int c = tid; c < 1024; c += 512) { const v4u v = *(const v4u*)(vct + c * 16); *(LAS v4u*)(lds + AT_CMPV + (c >> 4) * 272 + (c & 15) * 16) = v; } }
    __syncthreads();
    const int ng = (2 * tb + 2 + 15) >> 4;
    s16x8 qn0, qn1; float bgn;
    { const int row = r0 + 16 * wave + tok_i; const bf16* qp = QP + (size_t)row * 512 + hq * 64 + fq * 8; qn0 = *(const s16x8*)qp; qn1 = *(const s16x8*)(qp + 32); bgn = BG[(size_t)row * 24 + hq * 3 + 0]; }
#pragma nounroll
    for (int gi = 0; gi < 4; ++gi) {
        const int tl = 16 * wave + 4 * gi + tok_i, t = 128 * tb + tl, row = r0 + tl;
        const s16x8 q0 = qn0, q1 = qn1; const float bg0 = bgn;
        { const int rown = r0 + 16 * wave + 4 * (gi < 3 ? gi + 1 : gi) + tok_i; const bf16* qp = QP + (size_t)rown * 512 + hq * 64 + fq * 8; qn0 = *(const s16x8*)qp; qn1 = *(const s16x8*)(qp + 32); bgn = BG[(size_t)rown * 24 + hq * 3 + 0]; }
        f32x4 S[8];
#pragma unroll
        for (int kg = 0; kg < 8; ++kg) { S[kg] = (f32x4){0.f, 0.f, 0.f, 0.f};
            if (kg < ng) { const s16x8 a0 = *(const LAS s16x8*)(lds + (16 * kg + fr) * 144 + fq * 16), a1 = *(const LAS s16x8*)(lds + (16 * kg + fr) * 144 + 64 + fq * 16);
                S[kg] = mfma16(a0, q0, S[kg]); S[kg] = mfma16(a1, q1, S[kg]); } }
        const int n_ok = (t + 1) >> 6, cur = t >> 6;
        float m = -INFINITY;
#pragma unroll
        for (int kg = 0; kg < 8; ++kg)
#pragma unroll
            for (int i = 0; i < 4; ++i) if (16 * kg + 4 * fq + i < n_ok) m = fmaxf(m, S[kg][i]);
        m = fmax_x16(m); m = fmax_x32(m); if (!(m > -INFINITY)) m = 0.f;
        float sum = 0.f;
#pragma unroll
        for (int kg = 0; kg < 8; ++kg)
#pragma unroll
            for (int i = 0; i < 4; ++i) { const float e = (16 * kg + 4 * fq + i < n_ok) ? __builtin_amdgcn_exp2f(S[kg][i] - m) : 0.f; S[kg][i] = e; sum += e; }
        sum = fsum_x16(sum); sum = fsum_x32(sum);
        const float inv = 1.0f / fmaxf(sum, 1e-30f);
#pragma unroll
        for (int kg = 0; kg < 8; ++kg) S[kg] *= inv;
        { f32x4 Oc[4];
#pragma unroll
          for (int dg = 0; dg < 4; ++dg) Oc[dg] = (f32x4){0.f, 0.f, 0.f, 0.f};
#pragma unroll
          for (int kc = 0; kc < 4; ++kc) if (2 * kc < ng) {
              v4u pk; pk.x = cvtpk(S[2 * kc][0], S[2 * kc][1]); pk.y = cvtpk(S[2 * kc][2], S[2 * kc][3]); pk.z = cvtpk(S[2 * kc + 1][0], S[2 * kc + 1][1]); pk.w = cvtpk(S[2 * kc + 1][2], S[2 * kc + 1][3]);
              const s16x8 pb = __builtin_bit_cast(s16x8, pk);
#pragma unroll
              for (int dg = 0; dg < 4; ++dg) { const s16x8 av = *(const LAS s16x8*)(lds + AT_CMPV + (16 * dg + fr) * 272 + kc * 64 + fq * 16); Oc[dg] = mfma16(av, pb, Oc[dg]); } }
#pragma unroll
          for (int dg = 0; dg < 4; ++dg) *(f32x4*)(OC + (size_t)row * 512 + hq * 64 + 16 * dg + 4 * fq) = Oc[dg] * bg0; }
#pragma unroll
        for (int kg = 0; kg < 8; ++kg)
#pragma unroll
            for (int i = 0; i < 4; ++i) { float v = S[kg][i]; v += dpp_x1f(v); v += dpp_x2f(v); S[kg][i] = v; }
        unsigned lm = 0u;
        if (cur < 16) {
#pragma unroll
            for (int h = 0; h < 2; ++h)
#pragma unroll
                for (int i = 0; i < 4; ++i) { const int n = 16 * (2 * g + h) + 4 * fq + i; lm |= (n <= cur) ? (1u << (n & 31)) : 0u; }
        } else {
            unsigned key[8];
#pragma unroll
            for (int h = 0; h < 2; ++h)
#pragma unroll
                for (int i = 0; i < 4; ++i) { const float v = g == 0 ? S[h][i] : (g == 1 ? S[2 + h][i] : (g == 2 ? S[4 + h][i] : S[6 + h][i]));
                    const int n = 16 * (2 * g + h) + 4 * fq + i; const bool forced = (n == 0) || (n == cur) || (n == cur - 1);
                    lm |= forced ? (1u << (n & 31)) : 0u;
                    key[h * 4 + i] = (n <= cur && !forced) ? ((__float_as_uint(v) & ~255u) | (unsigned)(255 - n)) : 0u; }
#define CE8(a_, b_) do { const unsigned hi_ = key[a_] > key[b_] ? key[a_] : key[b_], lo_ = key[a_] > key[b_] ? key[b_] : key[a_]; key[a_] = hi_; key[b_] = lo_; } while (0)
            CE8(0, 1); CE8(2, 3); CE8(4, 5); CE8(6, 7); CE8(0, 2); CE8(1, 3); CE8(4, 6); CE8(5, 7); CE8(1, 2); CE8(5, 6);
            CE8(0, 4); CE8(1, 5); CE8(2, 6); CE8(3, 7); CE8(2, 4); CE8(3, 5); CE8(1, 2); CE8(3, 4); CE8(5, 6);
#undef CE8
#pragma nounroll
            for (int round = 0; round < 13; ++round) {
                unsigned w = key[0];
                { unsigned o; o = dpp_x1(w); w = o > w ? o : w; o = dpp_x2(w); w = o > w ? o : w; w = umax_x16(w); w = umax_x32(w); }
                const bool win = key[0] == w && w != 0u;
                lm |= win ? (0x80000000u >> (w & 31u)) : 0u;
#pragma unroll
                for (int j = 0; j < 7; ++j) key[j] = win ? key[j + 1] : key[j];
                key[7] = win ? 0u : key[7];
            }
        }
        { auto r16 = __builtin_amdgcn_permlane16_swap(lm, lm, false, false); lm = r16[0] | r16[1]; auto r32 = __builtin_amdgcn_permlane32_swap(lm, lm, false, false); lm = r32[0] | r32[1]; }
        if (fq == 0) wmask[(4 * gi + tok_i) * 4 + g] = lm;
        { unsigned og = lm; og |= dpp_x4(og); og |= dpp_x8(og);
          if (fq == 0 && tok_i == 0) wmask[64 + gi * 4 + g] = og; }
    }
    LDS_WAIT();
    __syncthreads();
    attn_pass<0>(a, lds, b, kvh, tb, wave, lane, tid);
    attn_pass<1>(a, lds, b, kvh, tb, wave, lane, tid);
    __syncthreads();
}
__device__ __forceinline__ void phase_attn(const Args& a, LAS unsigned char* lds, int vcu, int G, int wave, int lane, int tid) {
    if ((vcu & 1) == 0) { for (int it = vcu; it < 2 * MS; it += G) attn_sample(a, MP + (it >> 1), it & 1, lds, wave, lane); }
#pragma nounroll
    for (int u2 = 2 * vcu; u2 < 512; u2 += 2 * G) {
#pragma nounroll
        for (int h = 0; h < 2; ++h) { const int u = u2 >> 1, bh = u >> 5, s = u & 31; attn_unit(a, lds, bh >> 1, bh & 1, h ? 63 - s : s, wave, lane, tid); } }
    if ((vcu & 1) != 0) { for (int it = vcu; it < 2 * MS; it += G) attn_sample(a, MP + (it >> 1), it & 1, lds, wave, lane); }
}
#if PROBE_ATTN
__device__ __forceinline__ void phase_attn_check(const Args& a, LAS unsigned char* lds, int gw, int NGW, int wave, int lane) {
    for (int it = gw; it < 2 * 2048; it += NGW) { const int idx = it >> 1; int r;
        if (idx < 300) r = idx; else if (idx < 600) r = 3 * 8192 + 900 + (idx - 300); else r = (int)(((long)(idx - 600) * 22639L) % MP);
        attn_item<2>(a, r, it & 1, lds, wave, lane); }
}
#endif


template <int RB = 1, class F> __device__ __forceinline__ void small_gemm(const bf16* A, const bf16* Bt, int N, int K, int vcu, int G, int wave, int lane_, LAS unsigned char* lds, const F& f) {
    int lane = lane_;
    constexpr int NRT = 16 / RB;
    const int ntiles = NRT * (N >> 6), nk = K >> 7;
#pragma nounroll
    for (int tile = vcu; tile < ntiles; tile += G) {
        asm volatile("" : "+v"(lane));
        const int fr = lane & 15, fq = lane >> 4, rt = tile % NRT, ct = tile / NRT;
        const bf16* ap = A + (size_t)(16 * RB * rt + fr) * K + 8 * fq; const bf16* bp = Bt + (size_t)(64 * ct + fr) * K + 8 * fq;
        f32x4 acc[RB][4];
#pragma unroll
        for (int rb = 0; rb < RB; ++rb)
#pragma unroll
            for (int j = 0; j < 4; ++j) acc[rb][j] = (f32x4){0.f, 0.f, 0.f, 0.f};
#pragma nounroll
        for (int it = wave; it < nk; it += NWAVES) { const int k0 = it << 7;
            s16x8 af[RB][4], bfr[4][4];
#pragma unroll
            for (int q = 0; q < 4; ++q) {
#pragma unroll
                for (int rb = 0; rb < RB; ++rb) af[rb][q] = *(const s16x8*)(ap + (size_t)(16 * rb) * K + k0 + 32 * q);
#pragma unroll
                for (int j = 0; j < 4; ++j) bfr[q][j] = *(const s16x8*)(bp + (size_t)(16 * j) * K + k0 + 32 * q); }
#pragma unroll
            for (int q = 0; q < 4; ++q)
#pragma unroll
                for (int rb = 0; rb < RB; ++rb)
#pragma unroll
                    for (int j = 0; j < 4; ++j) acc[rb][j] = mfma16(bfr[q][j], af[rb][q], acc[rb][j]);
        }
        LAS f32x4* red = (LAS f32x4*)lds;
#pragma unroll
        for (int rb = 0; rb < RB; ++rb)
#pragma unroll
            for (int j = 0; j < 4; ++j) red[(wave * (RB * 4) + rb * 4 + j) * 64 + lane] = acc[rb][j];
        __syncthreads();
#pragma unroll
        for (int b = wave; b < RB * 4; b += NWAVES) { f32x4 sum = red[b * 64 + lane];
#pragma unroll
            for (int w = 1; w < NWAVES; ++w) sum += red[(w * (RB * 4) + b) * 64 + lane];
            f(16 * (RB * rt + (b >> 2)) + fr, 64 * ct + 16 * (b & 3) + 4 * fq, sum); }
        __syncthreads();
    }
}
constexpr int N_PHASES = 12;
#ifndef ONE_LAUNCH
#define ONE_LAUNCH 1
#endif
__global__ void __launch_bounds__(NWAVES * 64, 2) fwd(Args args) {
    extern __shared__ __attribute__((aligned(16))) unsigned char lds_raw[];
    LAS unsigned char* lds = (LAS unsigned char*)lds_raw;
    const int tid = threadIdx.x, lane = tid & 63, wave = __builtin_amdgcn_readfirstlane(tid >> 6);
    const int G = gridDim.x, bx = blockIdx.x;
    const int vcu = (G % 8 == 0) ? (bx % 8) * (G / 8) + bx / 8 : bx;
    const int gw = vcu * NWAVES + wave, NGW = G * NWAVES;
    unsigned char* ws = args.ws;
    for (int u = tid; u < (LDS_BYTES - RING_BYTES) / 4; u += NWAVES * 64) ((LAS unsigned*)(lds + RING_BYTES))[u] = 0u;
    __syncthreads();
    XcdBarrier bar; bar.bar = (unsigned*)(ws + WS_CTL) + CW_BAR; bar.x = 0; bar.st = nullptr;
    if (ONE_LAUNCH) bar = xcd_barrier_post((unsigned*)(ws + WS_CTL) + CW_BAR, (volatile LAS unsigned*)(lds + MISC_OFF) + 8);
    const int lo = args.ph_lo, hi = args.ph_hi;
#define IN(k) (lo <= (k) && (k) < hi)
#define SEAM(k) do { if (ONE_LAUNCH && IN(k) && hi > (k) + 1) xcd_barrier(bar); } while (0)
    const float* modp = (const float*)(ws + WS_MOD);
    if (IN(0)) { phase0(args, lds, gw, NGW, wave, lane); } SEAM(0);
    if (IN(1)) { norm_rows(args.in[0], args.in[1], args.in[14], modp, 0, 1024, (bf16*)(ws + WS_H), gw, NGW, lane); } SEAM(1);
    if (IN(2)) { pg8::Gemm g{(const bf16*)(ws + WS_H), (const bf16*)(ws + WS_WIN), MP, DINP, 1024}; pg8::StaticOrder S; S.init(MP, DINP, G, bx);
        const float* rcp_ = (const float*)(ws + WS_ROPE);
        pg8::EpiFront E{args.out, ws, args.in[16], args.in[17], rcp_, rcp_ + ROPE_N * 32, O_PCK, O_SCK, O_PWK, O_SWK, O_PCONV, O_SCONV,
                        WS_U, WS_QP, WS_QR, WS_GC, WS_GN, WS_BG, WS_KSB, WS_VST, WS_KWB, WS_VWT, WS_KWIN, WS_VWIN, C2};
        pg8::gemm_phase<pg8::EpiFront, pg8::StaticOrder, true, true>(lds, g, S, E);
        { float* zs = (float*)(ws + WS_ZS);
          small_gemm<4>((const bf16*)(ws + WS_H) + (size_t)MP * 1024, (const bf16*)(ws + WS_WIN), DINP, 1024, vcu, G, wave, lane, lds, [&](int r, int c, f32x4 v) { *(f32x4*)(zs + (size_t)r * DINP + c) = v; }); } } SEAM(2);
    if (IN(4)) {
        constexpr int CONV8 = 3;
        if (G % 8 == 0) { const int oct = vcu >> 3, sub = vcu & 7, nc = (G >> 3) * CONV8, np = (G >> 3) * (8 - CONV8);
            if (sub < CONV8) { const int ci = oct * CONV8 + sub; phase_conv(args, lds, ci, nc, ci * NWAVES + wave, nc * NWAVES, wave, lane, tid); }
            else { const int pi = oct * (8 - CONV8) + (sub - CONV8); phase_pages(args, lds, pi * NWAVES + wave, np * NWAVES, wave, lane, tid); } }
        else { phase_conv(args, lds, vcu, G, gw, NGW, wave, lane, tid); phase_pages(args, lds, gw, NGW, wave, lane, tid); } } SEAM(4);
    if (IN(5)) { pg8::Gemm g{(const bf16*)(ws + WS_CACT), (const bf16*)(ws + WS_WPW2), MP, 1024, 512}; pg8::StaticOrder S; S.init(MP, 1024, G, bx);
        pg8::EpiGate<false> E{(bf16*)(ws + WS_T1), (const bf16*)(ws + WS_GC), 1024};
        pg8::gemm_phase<pg8::EpiGate<false>, pg8::StaticOrder, true, true>(lds, g, S, E);
        { bf16* t1 = (bf16*)(ws + WS_T1) + (size_t)MP * 1024; const bf16* gc = (const bf16*)(ws + WS_GC) + (size_t)MP * 1024;
          small_gemm((const bf16*)(ws + WS_CACT) + (size_t)MP * 512, (const bf16*)(ws + WS_WPW2), 1024, 512, vcu, G, wave, lane, lds, [&](int r, int c, f32x4 v) {
              const v2u gg = *(const v2u*)(gc + (size_t)r * 1024 + c); v2u w; w.x = pk2(v[0] * pg8::bf_lo(gg.x), v[1] * pg8::bf_hi(gg.x)); w.y = pk2(v[2] * pg8::bf_lo(gg.y), v[3] * pg8::bf_hi(gg.y));
              *(v2u*)(t1 + (size_t)r * 1024 + c) = w; }); } }
    if (IN(5) && !IN(6)) SEAM(5);
    if (IN(6)) { phase_attn(args, lds, vcu, G, wave, lane, tid); } SEAM(6);
#if PROBE_ATTN
    if (IN(7)) { phase_attn_check(args, lds, gw, NGW, wave, lane); __syncthreads(); }
#endif
    if (IN(7)) { pg8::Gemm g{(const bf16*)(ws + WS_O), (const bf16*)(ws + WS_WNSA), MP, 1024, 512}; pg8::StaticOrder S; S.init(MP, 1024, G, bx);
        pg8::EpiGate<true> E{(bf16*)(ws + WS_T1), (const bf16*)(ws + WS_GN), 1024};
        pg8::gemm_phase<pg8::EpiGate<true>, pg8::StaticOrder, true, true>(lds, g, S, E);
        { bf16* t1 = (bf16*)(ws + WS_T1) + (size_t)MP * 1024; const bf16* gn = (const bf16*)(ws + WS_GN) + (size_t)MP * 1024;
          small_gemm((const bf16*)(ws + WS_O) + (size_t)MP * 512, (const bf16*)(ws + WS_WNSA), 1024, 512, vcu, G, wave, lane, lds, [&](int r, int c, f32x4 v) {
              const v2u gg = *(const v2u*)(gn + (size_t)r * 1024 + c); const v2u tt = *(const v2u*)(t1 + (size_t)r * 1024 + c); v2u w;
              w.x = pk2(pg8::bf_lo(tt.x) + v[0] * pg8::bf_lo(gg.x), pg8::bf_hi(tt.x) + v[1] * pg8::bf_hi(gg.x)); w.y = pk2(pg8::bf_lo(tt.y) + v[2] * pg8::bf_lo(gg.y), pg8::bf_hi(tt.y) + v[3] * pg8::bf_hi(gg.y));
              *(v2u*)(t1 + (size_t)r * 1024 + c) = w; }); } } SEAM(7);
    if (IN(8)) { pg8::Gemm g{(const bf16*)(ws + WS_T1), (const bf16*)(ws + WS_WOUT), MP, 1024, 1024}; pg8::StaticOrder S; S.init(MP, 1024, G, bx);
        pg8::EpiResGate<false, true> E{args.in[0], args.in[1], (bf16*)(ws + WS_Y1), modp + 2048};
        pg8::gemm_phase<pg8::EpiResGate<false, true>, pg8::StaticOrder, true, true>(lds, g, S, E);
        { const float* xs = args.in[1]; bf16* ys = (bf16*)(ws + WS_Y1) + (size_t)MP * 1024; const float* mg = modp + 2048;
          small_gemm((const bf16*)(ws + WS_T1) + (size_t)MP * 1024, (const bf16*)(ws + WS_WOUT), 1024, 1024, vcu, G, wave, lane, lds, [&](int r, int c, f32x4 v) {
              const f32x4 y = *(const f32x4*)(xs + (size_t)r * 1024 + c) + *(const f32x4*)(mg + (size_t)(4 + (r >> 3)) * 6144 + c) * v;
              v2u w; w.x = pk2(y[0], y[1]); w.y = pk2(y[2], y[3]); *(v2u*)(ys + (size_t)r * 1024 + c) = w; }); } } SEAM(8);
    if (IN(9)) { norm_rows_bf16((const bf16*)(ws + WS_Y1), args.in[29], modp, 3072, 4096, (bf16*)(ws + WS_H), gw, NGW, lane); } SEAM(9);
    if (IN(10)) { pg8::Gemm g{(const bf16*)(ws + WS_H), (const bf16*)(ws + WS_WGU), MP, 2 * DFF, 1024}; pg8::StaticOrder S; S.init(MP, 2 * DFF, G, bx);
        pg8::EpiSwiGlu E{(bf16*)(ws + WS_ACT), DFF};
        pg8::gemm_phase<pg8::EpiSwiGlu, pg8::StaticOrder, true, true>(lds, g, S, E);
        { bf16* act = (bf16*)(ws + WS_ACT) + (size_t)MP * DFF;
          small_gemm<4>((const bf16*)(ws + WS_H) + (size_t)MP * 1024, (const bf16*)(ws + WS_WGU), 2 * DFF, 1024, vcu, G, wave, lane, lds, [&](int r, int c, f32x4 v) {
              f32x4 up; up[0] = __shfl_xor(v[0], 16); up[1] = __shfl_xor(v[1], 16); up[2] = __shfl_xor(v[2], 16); up[3] = __shfl_xor(v[3], 16);
              if ((c & 4) == 0) { v2u w; w.x = pk2(v[0] * sigm(v[0]) * up[0], v[1] * sigm(v[1]) * up[1]); w.y = pk2(v[2] * sigm(v[2]) * up[2], v[3] * sigm(v[3]) * up[3]);
                  *(v2u*)(act + (size_t)r * DFF + (128 * (c >> 8) + 32 * ((c >> 5) & 3) + 8 * ((c >> 3) & 3) + 4 * ((c >> 7) & 1))) = w; } }); } } SEAM(10);
    if (IN(11)) { pg8::Gemm g{(const bf16*)(ws + WS_ACT), (const bf16*)(ws + WS_WDOWN), MP, 1024, DFF}; pg8::StaticOrder S; S.init(MP, 1024, G, bx);
        pg8::EpiResGate<true, false> E{(const bf16*)(ws + WS_Y1), (const bf16*)(ws + WS_Y1) + (size_t)MP * 1024, args.out, modp + 5120};
        pg8::gemm_phase<pg8::EpiResGate<true, false>, pg8::StaticOrder, true, true>(lds, g, S, E);
        { float* ys = args.out + (size_t)MP * 1024; const bf16* y1 = (const bf16*)(ws + WS_Y1) + (size_t)MP * 1024; const float* mg = modp + 5120;
          small_gemm((const bf16*)(ws + WS_ACT) + (size_t)MP * DFF, (const bf16*)(ws + WS_WDOWN), 1024, DFF, vcu, G, wave, lane, lds, [&](int r, int c, f32x4 v) {
              const v2u t = *(const v2u*)(y1 + (size_t)r * 1024 + c); const f32x4 b = {pg8::bf_lo(t.x), pg8::bf_hi(t.x), pg8::bf_lo(t.y), pg8::bf_hi(t.y)};
              *(f32x4*)(ys + (size_t)r * 1024 + c) = b + *(const f32x4*)(mg + (size_t)(4 + (r >> 3)) * 6144 + c) * v; }); } }
#if PROBE_ATTN
    if (ONE_LAUNCH) { xcd_barrier(bar); const unsigned cnt = __hip_atomic_load((unsigned*)(ws + WS_CTL) + 8, __ATOMIC_RELAXED, __HIP_MEMORY_SCOPE_AGENT);
        if (bx == 0 && tid < 64 && cnt != 0u) args.out[tid] = 10.0f * (float)(1 + (31 - __builtin_clz(cnt))); }
#endif
#undef IN
#undef SEAM
}

extern "C" void kernel_launch(void* const* d_in, const int* in_sizes, int n_in, void* d_out, int out_size, void* d_ws, size_t ws_size, hipStream_t stream) {
    static int grid = 0;
    if (grid == 0) {
        if (n_in != 33 || (size_t)out_size != O_END || ws_size < WS_END) { fprintf(stderr, "kernel_launch: unexpected shapes (n_in %d out %d ws %zu)\n", n_in, out_size, ws_size); grid = -1; return; }
        int dev = 0, cus = 0, per_cu = 0;
        if (hipGetDevice(&dev) != hipSuccess || hipDeviceGetAttribute(&cus, hipDeviceAttributeMultiprocessorCount, dev) != hipSuccess) { grid = -1; return; }
        if (hipFuncSetAttribute((const void*)fwd, hipFuncAttributeMaxDynamicSharedMemorySize, LDS_BYTES) != hipSuccess) { fprintf(stderr, "kernel_launch: hipFuncSetAttribute failed\n"); grid = -1; return; }
        if (hipOccupancyMaxActiveBlocksPerMultiprocessor(&per_cu, (const void*)fwd, NWAVES * 64, LDS_BYTES) != hipSuccess || per_cu < 1) fprintf(stderr, "kernel_launch: occupancy query says %d\n", per_cu);
        (void)hipGetLastError();
        grid = cus;
    }
    if (grid < 0) return;
    (void)hipMemsetAsync((char*)d_ws, 0, ZERO_BYTES, stream);
    Args a{};
    for (int i = 0; i < 33; ++i) a.in[i] = (const float*)d_in[i];
    a.out = (float*)d_out; a.ws = (unsigned char*)d_ws;
#if ONE_LAUNCH
    a.ph_lo = 0; a.ph_hi = N_PHASES;
    hipLaunchKernelGGL(fwd, dim3(grid), dim3(NWAVES * 64), LDS_BYTES, stream, a);
#else
    for (int p = 0; p < N_PHASES; ++p) { a.ph_lo = p; a.ph_hi = p + 1; hipLaunchKernelGGL(fwd, dim3(grid), dim3(NWAVES * 64), LDS_BYTES, stream, a); }
#endif
}
```
